# Optimizing an MI355X kernel written in HIP

```python
import math
import jax, jax.numpy as jnp
from jax import lax
import numpy as np

D_MODEL = 1024
BATCH = 32
SEQ = 256
DEPTH = 2
DEC_BATCH = 2
DEC_SEQ = 2048
PAST_LEN = 512

GRID_W = 64
N_AB_LAYERS = (DEPTH + 1) // 2
N_CD_LAYERS = DEPTH // 2
HEAD_DIM = 64
N_HEADS = (D_MODEL // 2) // HEAD_DIM
N_KV_HEADS = N_HEADS // 4
ROPE_PAIRS = HEAD_DIM // 4
ROPE_THETA = 10000.0
Q_BLOCK = 128
SSM_WIDTH = D_MODEL // 2
SSM_GROUP_CH = 16
SSM_GROUPS = SSM_WIDTH // SSM_GROUP_CH
SSM_STATE = 64
GMLP_WIDTH = D_MODEL // 2
GMLP_GROUPS = 8
GMLP_GROUP_CH = GMLP_WIDTH // GMLP_GROUPS
CHUNK = 128
FNET_WIDTH = D_MODEL // 2
FNET_GROUPS = 4
FNET_GROUP_CH = FNET_WIDTH // FNET_GROUPS
RMS_EPS = 1e-6
ATTN_Q = N_HEADS * HEAD_DIM
ATTN_KV = N_KV_HEADS * HEAD_DIM
AB_SECTIONS = (ATTN_Q, ATTN_KV, ATTN_KV, ATTN_Q, SSM_WIDTH, SSM_WIDTH)
CD_SECTIONS = (GMLP_WIDTH, GMLP_WIDTH, GMLP_WIDTH, FNET_WIDTH, FNET_WIDTH)
AB_IN = sum(AB_SECTIONS)
CD_IN = sum(CD_SECTIONS)
AB_MIX = ATTN_Q + SSM_WIDTH
CD_MIX = GMLP_WIDTH + FNET_WIDTH

kernel_name = "hybrid_prefix_diffusion_step"

f32 = jnp.float32


def split_sections(x, sizes):
    bounds = np.cumsum(sizes)[:-1]
    return jnp.split(x, [int(b) for b in bounds], axis=-1)


def rmsnorm(x, g):
    xf = x.astype(f32)
    y = xf * lax.rsqrt(jnp.mean(xf * xf, axis=-1, keepdims=True) + RMS_EPS)
    return (y * g.astype(f32)).astype(x.dtype)


def ada_modulation(cond, w, b, dtype):
    m = jax.nn.silu(cond.astype(f32)) @ w.astype(f32) + b.astype(f32)
    shift, scale, gate = jnp.split(m.astype(dtype), 3, axis=-1)
    return shift[:, None, :], scale[:, None, :], gate[:, None, :]


def axial_rope_tables(L):
    rows = L // GRID_W
    row = jnp.broadcast_to(jnp.arange(rows, dtype=f32)[:, None], (rows, GRID_W)).reshape(-1)
    col = jnp.broadcast_to(jnp.arange(GRID_W, dtype=f32)[None, :], (rows, GRID_W)).reshape(-1)
    inv = ROPE_THETA ** (-jnp.arange(ROPE_PAIRS, dtype=f32) / ROPE_PAIRS)
    ang = jnp.stack([row[:, None] * inv, col[:, None] * inv], axis=1)
    return jnp.cos(ang), jnp.sin(ang)


def apply_axial_rope(x, cos, sin):
    B, L, H, Dh = x.shape
    xf = x.astype(f32).reshape(B, L, H, 2, 2, ROPE_PAIRS)
    x1, x2 = xf[..., 0, :], xf[..., 1, :]
    cs, sn = cos[None, :, None], sin[None, :, None]
    out = jnp.stack([x1 * cs - x2 * sn, x1 * sn + x2 * cs], axis=-2)
    return out.reshape(B, L, H, Dh).astype(x.dtype)


def block_attention(q, k, v):
    B, Lq, H, Dh = q.shape
    KV = k.shape[2]
    G = H // KV
    nb = Lq // Q_BLOCK
    qb = q.reshape(B, nb, Q_BLOCK, KV, G, Dh).transpose(1, 0, 2, 3, 4, 5)
    scale = HEAD_DIM ** -0.5

    def one_block(qblk):
        s = jnp.einsum('bqkgd,bskd->bkgqs', qblk, k, preferred_element_type=f32) * scale
        p = jax.nn.softmax(s, axis=-1)
        return jnp.einsum('bkgqs,bskd->bqkgd', p.astype(v.dtype), v)

    o = lax.map(one_block, qb)
    return o.transpose(1, 0, 2, 3, 4, 5).reshape(B, Lq, H * Dh)


def _ssm_combine(e1, e2):
    a1, b1 = e1
    a2, b2 = e2
    return a1 * a2, a2 * b1 + b2


def s5_mixer(u, lam_re, lam_im, log_dt, b_re, b_im, c_re, c_im, d_skip, glu_w, glu_b, h0):
    Bsz, L, _ = u.shape
    uf = u.astype(f32)
    ug = uf.reshape(Bsz, L, SSM_GROUPS, SSM_GROUP_CH).astype(jnp.complex64)
    y = uf * d_skip.astype(f32)
    finals = []
    for di in range(2):
        reverse = di == 1
        lam = lax.complex(lam_re[di].astype(f32), lam_im[di].astype(f32))
        dt = jnp.exp(log_dt[di].astype(f32))[:, None]
        lam_bar = jnp.exp(lam * dt)
        b_bar = ((lam_bar - 1.0) / lam)[..., None] * lax.complex(b_re[di].astype(f32), b_im[di].astype(f32))
        bu = jnp.einsum('blgh,gph->blgp', ug, b_bar)
        if h0 is not None:
            edge = L - 1 if reverse else 0
            bu = bu.at[:, edge].add(lam_bar * h0[:, di])
        a = jnp.broadcast_to(lam_bar, (1, L) + lam_bar.shape)
        _, hs = lax.associative_scan(_ssm_combine, (a, bu), reverse=reverse, axis=1)
        finals.append(hs[:, 0] if reverse else hs[:, L - 1])
        cm = lax.complex(c_re[di].astype(f32), c_im[di].astype(f32))
        y = y + jnp.einsum('blgp,ghp->blgh', hs, cm).real.reshape(Bsz, L, SSM_WIDTH)
    y = jax.nn.gelu(y)
    y = y * jax.nn.sigmoid(y @ glu_w.astype(f32) + glu_b.astype(f32))
    return y.astype(u.dtype), jnp.stack(finals, axis=1)


def ab_mixer(h, w_in, q_gain, k_gain, lam_re, lam_im, log_dt, b_re, b_im, c_re, c_im,
             d_skip, glu_w, glu_b, w_out, ctx):
    Bsz, L, _ = h.shape
    q, k, v, g_a, u, g_b = split_sections(h @ w_in, AB_SECTIONS)
    q = rmsnorm(q.reshape(Bsz, L, N_HEADS, HEAD_DIM), q_gain)
    k = rmsnorm(k.reshape(Bsz, L, N_KV_HEADS, HEAD_DIM), k_gain)
    v = v.reshape(Bsz, L, N_KV_HEADS, HEAD_DIM)
    if ctx is None:
        attn = block_attention(q, k, v)
        h0 = None
    else:
        ctx_k, ctx_v, h0 = ctx
        cos, sin = axial_rope_tables(L)
        k_all = jnp.concatenate([ctx_k.astype(k.dtype), apply_axial_rope(k, cos, sin)], axis=1)
        v_all = jnp.concatenate([ctx_v.astype(v.dtype), v], axis=1)
        attn = block_attention(apply_axial_rope(q, cos, sin), k_all, v_all)
    ssm_out, h_final = s5_mixer(u, lam_re, lam_im, log_dt, b_re, b_im, c_re, c_im,
                                d_skip, glu_w, glu_b, h0)
    mixed = jnp.concatenate([attn * jax.nn.silu(g_a), ssm_out * jax.nn.silu(g_b)], axis=-1)
    state = jnp.stack([h_final.real, h_final.imag], axis=2)
    return mixed @ w_out, k, v, state


def cd_mixer(h, w_in, v_gain, w_s, b_s, fnet_w, w_out):
    Bsz, L, _ = h.shape
    cu, cv, g_c, dz, g_d = split_sections(h @ w_in, CD_SECTIONS)
    cu = jax.nn.gelu(cu)
    cv = rmsnorm(jax.nn.gelu(cv), v_gain)
    cvb = cv.reshape(Bsz, L // CHUNK, CHUNK, GMLP_GROUPS, GMLP_GROUP_CH)
    sp = jnp.einsum('hts,bnshc->bnthc', w_s, cvb) + b_s.T[None, None, :, :, None]
    out_c = cu * sp.reshape(Bsz, L, GMLP_WIDTH) * jax.nn.silu(g_c)
    z = dz.astype(f32).reshape(Bsz, L, FNET_GROUPS, FNET_GROUP_CH)
    fz = jnp.fft.fft2(z, axes=(1, 3), norm='ortho').real.reshape(Bsz, L, FNET_WIDTH)
    out_d = (fz.astype(h.dtype) @ fnet_w) * jax.nn.silu(g_d)
    return jnp.concatenate([out_c, out_d], axis=-1) @ w_out


def setup_inputs(seed: int = 0) -> dict:
    key = jax.random.key(seed)
    ks = iter(jax.random.split(key, 48))

    def nrm(shape, scale):
        return jax.random.normal(next(ks), shape, f32) * scale

    n_idx = jnp.arange(SSM_STATE, dtype=f32)
    return {
        'x_prompt': nrm((BATCH, SEQ, D_MODEL), 1.0),
        'x_sample': nrm((DEC_BATCH, DEC_SEQ, D_MODEL), 1.0),
        'cache_k': nrm((DEC_BATCH, N_AB_LAYERS, PAST_LEN, N_KV_HEADS, HEAD_DIM), 1.0),
        'cache_v': nrm((DEC_BATCH, N_AB_LAYERS, PAST_LEN, N_KV_HEADS, HEAD_DIM), 1.0),
        'state_ssm': nrm((DEC_BATCH, N_AB_LAYERS, 2, 2, SSM_GROUPS, SSM_STATE), 0.3),
        'c': nrm((DEC_BATCH, D_MODEL), 1.0),
        'c_ctx': nrm((D_MODEL,), 1.0),
        'ada_w': nrm((DEPTH, D_MODEL, 3 * D_MODEL), 0.5 * D_MODEL ** -0.5),
        'ada_b': nrm((DEPTH, 3 * D_MODEL), 0.02),
        'norm_pre': 1.0 + nrm((DEPTH, D_MODEL), 0.05),
        'norm_post': 1.0 + nrm((DEPTH, D_MODEL), 0.05),
        'ab_w_in': nrm((N_AB_LAYERS, D_MODEL, AB_IN), D_MODEL ** -0.5),
        'ab_q_norm': 1.0 + nrm((N_AB_LAYERS, HEAD_DIM), 0.05),
        'ab_k_norm': 1.0 + nrm((N_AB_LAYERS, HEAD_DIM), 0.05),
        'ssm_lambda_re': -0.5 + nrm((N_AB_LAYERS, 2, SSM_GROUPS, SSM_STATE), 0.01),
        'ssm_lambda_im': jnp.pi * n_idx + nrm((N_AB_LAYERS, 2, SSM_GROUPS, SSM_STATE), 0.01),
        'ssm_log_dt': jax.random.uniform(next(ks), (N_AB_LAYERS, 2, SSM_GROUPS), f32,
                                         math.log(1e-3), math.log(1e-1)),
        'ssm_b_re': nrm((N_AB_LAYERS, 2, SSM_GROUPS, SSM_STATE, SSM_GROUP_CH), (2 * SSM_GROUP_CH) ** -0.5),
        'ssm_b_im': nrm((N_AB_LAYERS, 2, SSM_GROUPS, SSM_STATE, SSM_GROUP_CH), (2 * SSM_GROUP_CH) ** -0.5),
        'ssm_c_re': nrm((N_AB_LAYERS, 2, SSM_GROUPS, SSM_GROUP_CH, SSM_STATE), SSM_STATE ** -0.5),
        'ssm_c_im': nrm((N_AB_LAYERS, 2, SSM_GROUPS, SSM_GROUP_CH, SSM_STATE), SSM_STATE ** -0.5),
        'ssm_d': nrm((N_AB_LAYERS, SSM_WIDTH), 1.0),
        'ssm_glu_w': nrm((N_AB_LAYERS, SSM_WIDTH, SSM_WIDTH), SSM_WIDTH ** -0.5),
        'ssm_glu_b': nrm((N_AB_LAYERS, SSM_WIDTH), 0.02),
        'ab_w_out': nrm((N_AB_LAYERS, AB_MIX, D_MODEL), AB_MIX ** -0.5),
        'cd_w_in': nrm((N_CD_LAYERS, D_MODEL, CD_IN), D_MODEL ** -0.5),
        'gmlp_v_norm': 1.0 + nrm((N_CD_LAYERS, GMLP_WIDTH), 0.05),
        'gmlp_w_s': nrm((N_CD_LAYERS, GMLP_GROUPS, CHUNK, CHUNK), CHUNK ** -0.5),
        'gmlp_b_s': 1.0 + nrm((N_CD_LAYERS, GMLP_GROUPS, CHUNK), 0.1),
        'fnet_w': nrm((N_CD_LAYERS, FNET_WIDTH, FNET_WIDTH), FNET_WIDTH ** -0.5),
        'cd_w_out': nrm((N_CD_LAYERS, CD_MIX, D_MODEL), CD_MIX ** -0.5),
    }


def reference(x_prompt, x_sample, cache_k, cache_v, state_ssm, c, c_ctx, ada_w, ada_b, norm_pre,
              norm_post, ab_w_in, ab_q_norm, ab_k_norm, ssm_lambda_re, ssm_lambda_im, ssm_log_dt,
              ssm_b_re, ssm_b_im, ssm_c_re, ssm_c_im, ssm_d, ssm_glu_w, ssm_glu_b, ab_w_out,
              cd_w_in, gmlp_v_norm, gmlp_w_s, gmlp_b_s, fnet_w, cd_w_out):

    def trunk(x, cond, ctx):
        ks, vs, ss = [], [], []
        for l in range(DEPTH):
            i = l // 2
            shift, scale, gate = ada_modulation(cond, ada_w[l], ada_b[l], x.dtype)
            hn = rmsnorm(x, norm_pre[l]) * (1 + scale) + shift
            if l % 2 == 0:
                if ctx is None:
                    layer_ctx = None
                else:
                    st = ctx[2][:, i]
                    h0 = lax.complex(st[:, :, 0].astype(f32), st[:, :, 1].astype(f32))
                    layer_ctx = (ctx[0][:, i], ctx[1][:, i], h0)
                o, k_l, v_l, s_l = ab_mixer(hn, ab_w_in[i], ab_q_norm[i], ab_k_norm[i],
                                            ssm_lambda_re[i], ssm_lambda_im[i], ssm_log_dt[i],
                                            ssm_b_re[i], ssm_b_im[i], ssm_c_re[i], ssm_c_im[i],
                                            ssm_d[i], ssm_glu_w[i], ssm_glu_b[i], ab_w_out[i], layer_ctx)
                ks.append(k_l)
                vs.append(v_l)
                ss.append(s_l)
            else:
                o = cd_mixer(hn, cd_w_in[i], gmlp_v_norm[i], gmlp_w_s[i], gmlp_b_s[i],
                             fnet_w[i], cd_w_out[i])
            x = x + gate * rmsnorm(o, norm_post[l])
        return x, ks, vs, ss

    y_prompt, ks, vs, ss = trunk(x_prompt, c_ctx[None, :], None)
    new_cache_k = jnp.stack(ks, axis=1)
    new_cache_v = jnp.stack(vs, axis=1)
    new_state_ssm = jnp.stack(ss, axis=1)
    y_sample, _, _, _ = trunk(x_sample, c, (cache_k, cache_v, state_ssm))
    return (y_prompt, y_sample, new_cache_k, new_cache_v, new_state_ssm)
```

```cpp
#include <hip/hip_runtime.h>
#include <hip/hip_cooperative_groups.h>
#include <cstdio>
#include <cstdint>
namespace cg = cooperative_groups;

#define DI __device__ __forceinline__
typedef unsigned short bfr;
using bf16x8 = __attribute__((ext_vector_type(8))) short;
using s16x4  = __attribute__((ext_vector_type(4))) short;
using f32x16 = __attribute__((ext_vector_type(16))) float;
using f32x4  = __attribute__((ext_vector_type(4))) float;

#define MFMA32(a, b, c) __builtin_amdgcn_mfma_f32_32x32x16_bf16((a), (b), (c), 0, 0, 0)
#define MFMA16(a, b, c) __builtin_amdgcn_mfma_f32_16x16x32_bf16((a), (b), (c), 0, 0, 0)

constexpr int NTOK = 12288, NCTX = 8192;
constexpr float EPS = 1e-6f;

constexpr size_t OFF_MOD   = 0;
constexpr size_t OFF_ROWSS = OFF_MOD + 73728;
constexpr size_t OFF_ROPE  = OFF_ROWSS + 49152;
constexpr size_t OFF_LAMB  = OFF_ROPE + 8192;
constexpr size_t OFF_LAMP  = OFF_LAMB + 32768;
constexpr size_t OFF_BB    = OFF_LAMP + 32768;
constexpr size_t OFF_CMB   = OFF_BB + 524288;
constexpr size_t OFF_E     = OFF_CMB + 262144;
constexpr size_t OFF_WIN0  = OFF_E + 1572864;
constexpr size_t OFF_GLU   = OFF_WIN0 + 4718592;
constexpr size_t OFF_WOUT0 = OFF_GLU + 524288;
constexpr size_t OFF_WIN1  = OFF_WOUT0 + 2097152;
constexpr size_t OFF_FNET  = OFF_WIN1 + 6291456;
constexpr size_t OFF_WOUT1 = OFF_FNET + 524288;
constexpr size_t OFF_ACTX  = OFF_WOUT1 + 2097152;
constexpr size_t OFF_ALAT  = OFF_ACTX + 262144;
constexpr size_t OFF_X1    = OFF_ALAT + 16777216;
constexpr size_t OFF_HN    = OFF_X1 + 50331648;
constexpr size_t OFF_MIX   = OFF_HN + 25165824;
constexpr size_t OFF_O     = OFF_MIX + 25165824;
constexpr size_t OFF_U     = OFF_O;
constexpr size_t OFF_R     = OFF_O + 25165824;
constexpr size_t OFF_QB = OFF_R;
constexpr size_t OFF_KC = OFF_QB + 12582912;
constexpr size_t OFF_KL = OFF_KC + 2097152;
constexpr size_t OFF_VC = OFF_KL + 1310720;
constexpr size_t OFF_VL = OFF_VC + 2097152;
constexpr size_t OFF_GA = OFF_VL + 1310720;
constexpr size_t OFF_GB = OFF_GA + 12582912;
constexpr size_t OFF_YF = OFF_GB + 12582912;
constexpr size_t OFF_YB = OFF_YF + 12582912;
constexpr size_t OFF_YG = OFF_YB + 12582912;
constexpr size_t END_L0 = OFF_YG + 12582912;
constexpr size_t OFF_CUG = OFF_R;
constexpr size_t OFF_GCS = OFF_CUG + 12582912;
constexpr size_t OFF_GDS = OFF_GCS + 12582912;
constexpr size_t OFF_CVT = OFF_GDS + 12582912;
constexpr size_t OFF_FZ  = OFF_CVT + 12582912;
constexpr size_t OFF_ZTC = OFF_FZ + 12582912;
constexpr size_t OFF_ZTL = OFF_ZTC + 16777216;
constexpr size_t END_L1 = OFF_ZTL + 8388608;
constexpr size_t WS_NEED = (END_L0 > END_L1 ? END_L0 : END_L1);
static_assert(WS_NEED <= (size_t)256 * 1024 * 1024, "workspace too large");

constexpr size_t OUT_Y = 0, OUT_K = 12582912, OUT_V = 13631488, OUT_S = 14680064;

struct Params {
  const float* in[31];
  float* out;
  unsigned char* ws;
  int ph_lo, ph_hi;
};

DI unsigned short f2bf(float x) { unsigned u = __float_as_uint(x); u += 0x7fffu + ((u >> 16) & 1u); return (unsigned short)(u >> 16); }
DI float bf2f(unsigned short b) { return __uint_as_float(((unsigned)b) << 16); }
DI unsigned pk2(float lo, float hi) { return (unsigned)f2bf(lo) | ((unsigned)f2bf(hi) << 16); }
DI float wave_sum(float v) {
#pragma unroll
  for (int o = 1; o < 64; o <<= 1) v += __shfl_xor(v, o);
  return v;
}
DI float half_sum32(float v) {
#pragma unroll
  for (int o = 1; o < 32; o <<= 1) v += __shfl_xor(v, o);
  return v;
}
DI float silu_f(float x) { return x / (1.f + __expf(-x)); }
DI float sigmoid_f(float x) { return 1.f / (1.f + __expf(-x)); }
DI float gelu_f(float x) { float z = 0.7978845608028654f * (x + 0.044715f * x * x * x); return x / (1.f + __expf(-2.f * z)); }
DI int crow(int i, int h) { return (i & 3) + 8 * (i >> 2) + 4 * h; }
DI const float* xrow(const Params& p, int T) { return T < NCTX ? p.in[0] + (size_t)T * 1024 : p.in[1] + (size_t)(T - NCTX) * 1024; }
DI int cond_of(int T) { return T < NCTX ? 0 : 1 + ((T - NCTX) >> 11); }

template <int BN, class AL, class BL, class EP>
DI void gemm_tile(int nk, AL al, BL bl, EP ep, unsigned char* smem) {
  constexpr int NI = BN / 64;
  constexpr int NB = BN / 32;
  unsigned short* As = (unsigned short*)smem;
  unsigned short* Bs = As + 128 * 72;
  const int tid = threadIdx.x, lane = tid & 63, wave = tid >> 6, l32 = lane & 31, h = lane >> 5;
  const int wm = wave >> 1, wn = wave & 1;
  f32x16 acc[2][NI];
#pragma unroll
  for (int mi = 0; mi < 2; ++mi)
#pragma unroll
    for (int ni = 0; ni < NI; ++ni)
#pragma unroll
      for (int i = 0; i < 16; ++i) acc[mi][ni][i] = 0.f;
  uint4 ra[4], rb[NB];
#pragma unroll
  for (int i = 0; i < 4; ++i) { const int id = tid + 256 * i; ra[i] = al(id >> 3, (id & 7) * 8); }
#pragma unroll
  for (int i = 0; i < NB; ++i) { const int id = tid + 256 * i; rb[i] = bl(id >> 3, (id & 7) * 8); }
  for (int kt = 0; kt < nk; ++kt) {
    __syncthreads();
#pragma unroll
    for (int i = 0; i < 4; ++i) { const int id = tid + 256 * i; *(uint4*)(As + (id >> 3) * 72 + (id & 7) * 8) = ra[i]; }
#pragma unroll
    for (int i = 0; i < NB; ++i) { const int id = tid + 256 * i; *(uint4*)(Bs + (id >> 3) * 72 + (id & 7) * 8) = rb[i]; }
    __syncthreads();
    if (kt + 1 < nk) {
      const int kb = (kt + 1) * 64;
#pragma unroll
      for (int i = 0; i < 4; ++i) { const int id = tid + 256 * i; ra[i] = al(id >> 3, kb + (id & 7) * 8); }
#pragma unroll
      for (int i = 0; i < NB; ++i) { const int id = tid + 256 * i; rb[i] = bl(id >> 3, kb + (id & 7) * 8); }
    }
#pragma unroll
    for (int ks = 0; ks < 4; ++ks) {
      bf16x8 a[2], b[NI];
#pragma unroll
      for (int mi = 0; mi < 2; ++mi) a[mi] = *(const bf16x8*)(As + (wm * 64 + mi * 32 + l32) * 72 + ks * 16 + h * 8);
#pragma unroll
      for (int ni = 0; ni < NI; ++ni) b[ni] = *(const bf16x8*)(Bs + (wn * (BN / 2) + ni * 32 + l32) * 72 + ks * 16 + h * 8);
#pragma unroll
      for (int mi = 0; mi < 2; ++mi)
#pragma unroll
        for (int ni = 0; ni < NI; ++ni) acc[mi][ni] = MFMA32(a[mi], b[ni], acc[mi][ni]);
    }
  }
  ep(acc);
}

struct LdBf {
  const bfr* base; size_t ld;
  DI uint4 operator()(int r, int k) const { return *(const uint4*)(base + (size_t)r * ld + k); }
};

DI void transpose_tile(const float* W, int ldw, int kbase, int nbase, bfr* WT, int ldt, int trow, float* sm) {
  const int tid = threadIdx.x;
#pragma unroll
  for (int i = 0; i < 4; ++i) {
    const int r = (tid >> 4) + 16 * i, c = (tid & 15) * 4;
    const float4 v = *(const float4*)(W + (size_t)(kbase + r) * ldw + nbase + c);
    sm[r * 65 + c] = v.x; sm[r * 65 + c + 1] = v.y; sm[r * 65 + c + 2] = v.z; sm[r * 65 + c + 3] = v.w;
  }
  __syncthreads();
  const int n = tid >> 2, kc = (tid & 3) * 16;
  unsigned o[8];
#pragma unroll
  for (int j = 0; j < 8; ++j) o[j] = pk2(sm[(kc + 2 * j) * 65 + n], sm[(kc + 2 * j + 1) * 65 + n]);
  uint4* dst = (uint4*)(WT + (size_t)(trow + n) * ldt + kbase + kc);
  dst[0] = make_uint4(o[0], o[1], o[2], o[3]);
  dst[1] = make_uint4(o[4], o[5], o[6], o[7]);
}

DI void phase0(const Params& p, unsigned char* smem) {
  const int tid = threadIdx.x;
  float* smf = (float*)smem;
  unsigned char* ws = p.ws;
  constexpr int N_ADA = 192;
  constexpr int N_T0 = 16 * 36, N_TG = 64, N_TO0 = 256, N_T1A = 16 * 24, N_T1B = 16 * 8, N_TF = 64, N_TO1 = 256;
  constexpr int N_FOLD = 128, N_ALAT = 2048, N_ACTX = 256, N_CACHE = 64, N_SSM = 64, N_ZERO = 48, N_ROPE = 4;
  constexpr int B_T0 = N_ADA, B_TG = B_T0 + N_T0, B_TO0 = B_TG + N_TG, B_T1A = B_TO0 + N_TO0, B_T1B = B_T1A + N_T1A,
                B_TF = B_T1B + N_T1B, B_TO1 = B_TF + N_TF, B_FOLD = B_TO1 + N_TO1, B_ALAT = B_FOLD + N_FOLD,
                B_ACTX = B_ALAT + N_ALAT, B_CACHE = B_ACTX + N_ACTX, B_SSM = B_CACHE + N_CACHE, B_ZERO = B_SSM + N_SSM,
                B_ROPE = B_ZERO + N_ZERO, N_ALL = B_ROPE + N_ROPE;
  for (int it = blockIdx.x; it < N_ALL; it += gridDim.x) {
    __syncthreads();
    if (it < B_T0) {
      const int l = it / 96, cgp = it % 96;
      float* sc = smf;
      float* red = smf + 3072;
      for (int e = tid; e < 3072; e += 256) {
        const int ci = e >> 10, k = e & 1023;
        const float cv = ci == 0 ? p.in[6][k] : p.in[5][(ci - 1) * 1024 + k];
        sc[e] = silu_f(cv);
      }
      __syncthreads();
      const int col = tid & 31, kq = tid >> 5, n = cgp * 32 + col;
      const float* w = p.in[7] + (size_t)l * 1024 * 3072 + n;
      float a0 = 0.f, a1 = 0.f, a2 = 0.f;
#pragma unroll 8
      for (int k = kq; k < 1024; k += 8) {
        const float wv = w[(size_t)k * 3072];
        a0 += sc[k] * wv; a1 += sc[1024 + k] * wv; a2 += sc[2048 + k] * wv;
      }
      red[(kq * 32 + col) * 3 + 0] = a0; red[(kq * 32 + col) * 3 + 1] = a1; red[(kq * 32 + col) * 3 + 2] = a2;
      __syncthreads();
      if (tid < 96) {
        const int c2 = tid & 31, ci = tid >> 5;
        float s = 0.f;
#pragma unroll
        for (int q = 0; q < 8; ++q) s += red[(q * 32 + c2) * 3 + ci];
        const int n2 = cgp * 32 + c2;
        ((float*)(ws + OFF_MOD))[(l * 3 + ci) * 3072 + n2] = s + p.in[8][l * 3072 + n2];
      }
    } else if (it < B_FOLD) {
      const float* W; int ldw, nbase_off = 0, trow_off = 0, ntn, ldt; bfr* WT; int r;
      if (it < B_TG)        { r = it - B_T0;  W = p.in[11]; ldw = 2304; ntn = 36; WT = (bfr*)(ws + OFF_WIN0); ldt = 1024; }
      else if (it < B_TO0)  { r = it - B_TG;  W = p.in[22]; ldw = 512;  ntn = 8;  WT = (bfr*)(ws + OFF_GLU); ldt = 512; }
      else if (it < B_T1A)  { r = it - B_TO0; W = p.in[24]; ldw = 1024; ntn = 16; WT = (bfr*)(ws + OFF_WOUT0); ldt = 1024; }
      else if (it < B_T1B)  { r = it - B_T1A; W = p.in[25]; ldw = 2560; ntn = 24; WT = (bfr*)(ws + OFF_WIN1); ldt = 1024; }
      else if (it < B_TF)   { r = it - B_T1B; W = p.in[25]; ldw = 2560; ntn = 8;  WT = (bfr*)(ws + OFF_WIN1); ldt = 1024; nbase_off = 2048; trow_off = 2560; }
      else if (it < B_TO1)  { r = it - B_TF;  W = p.in[29]; ldw = 512;  ntn = 8;  WT = (bfr*)(ws + OFF_FNET); ldt = 512; }
      else                  { r = it - B_TO1; W = p.in[30]; ldw = 1024; ntn = 16; WT = (bfr*)(ws + OFF_WOUT1); ldt = 1024; }
      const int kb = r / ntn, nb = r % ntn;
      transpose_tile(W, ldw, kb * 64, nbase_off + nb * 64, WT, ldt, trow_off + nb * 64, smf);
    } else if (it < B_ALAT) {
      const int r = it - B_FOLD, cs = r & 1, kb = (r >> 1) & 15, g = r >> 5;
      float* tile = smf;
      float* tw = smf + 128 * 68;
      const float* W = p.in[25];
      {
        const int c4 = (tid & 31) * 4, kr = tid >> 5;
#pragma unroll
        for (int i = 0; i < 8; ++i) {
          const int k = kr + 8 * i;
          const float4 v = *(const float4*)(W + (size_t)(kb * 64 + k) * 2560 + 1536 + g * 128 + c4);
          tile[(c4 + 0) * 68 + k] = v.x; tile[(c4 + 1) * 68 + k] = v.y; tile[(c4 + 2) * 68 + k] = v.z; tile[(c4 + 3) * 68 + k] = v.w;
        }
        if (tid < 128) {
          const float a = 2.f * (float)tid / 128.f;
          tw[tid] = (cs == 0 ? cospif(a) : sinpif(a)) * 0.08838834764831845f;
        }
      }
      __syncthreads();
      const int j = tid & 127, kg = tid >> 7;
      float acc[32];
#pragma unroll
      for (int i = 0; i < 32; ++i) acc[i] = 0.f;
      for (int c = 0; c < 128; ++c) {
        const float t = tw[(j * c) & 127];
        const float4* tp = (const float4*)(tile + c * 68 + kg * 32);
#pragma unroll
        for (int q = 0; q < 8; ++q) {
          const float4 v = tp[q];
          acc[4 * q + 0] += v.x * t; acc[4 * q + 1] += v.y * t; acc[4 * q + 2] += v.z * t; acc[4 * q + 3] += v.w * t;
        }
      }
      uint4* dst = (uint4*)((bfr*)(ws + OFF_WIN1) + (size_t)(1536 + cs * 512 + g * 128 + j) * 1024 + kb * 64 + kg * 32);
#pragma unroll
      for (int q = 0; q < 4; ++q)
        dst[q] = make_uint4(pk2(acc[8 * q], acc[8 * q + 1]), pk2(acc[8 * q + 2], acc[8 * q + 3]), pk2(acc[8 * q + 4], acc[8 * q + 5]), pk2(acc[8 * q + 6], acc[8 * q + 7]));
    } else if (it < B_ACTX) {
      const int t = it - B_ALAT;
      bfr* dst = (bfr*)(ws + OFF_ALAT) + (size_t)t * 4096;
      const float nrm = 0.02209708691207961f;
#pragma unroll
      for (int half = 0; half < 2; ++half) {
        const int k0 = half * 2048 + tid * 8;
        unsigned o[4];
#pragma unroll
        for (int j = 0; j < 4; ++j) {
          float v[2];
#pragma unroll
          for (int e = 0; e < 2; ++e) {
            const int k = k0 + 2 * j + e;
            const int m = (t * (k & 2047)) & 2047;
            const float a = (float)m * (2.f / 2048.f);
            v[e] = (k < 2048 ? cospif(a) : -sinpif(a)) * nrm;
          }
          o[j] = pk2(v[0], v[1]);
        }
        *(uint4*)(dst + k0) = make_uint4(o[0], o[1], o[2], o[3]);
      }
    } else if (it < B_CACHE) {
      const int t = it - B_ACTX;
      bfr* dst = (bfr*)(ws + OFF_ACTX) + (size_t)t * 512;
      const float nrm = 0.0625f;
      float v[2];
#pragma unroll
      for (int e = 0; e < 2; ++e) {
        const int k = tid * 2 + e;
        const int m = (t * (k & 255)) & 255;
        const float a = (float)m * (2.f / 256.f);
        v[e] = (k < 256 ? cospif(a) : -sinpif(a)) * nrm;
      }
      *(unsigned*)(dst + tid * 2) = pk2(v[0], v[1]);
    } else if (it < B_SSM) {
      const int r = it - B_CACHE;
#pragma unroll
      for (int i = 0; i < 8; ++i) {
        const int e = r * 2048 + tid + 256 * i;
        const int d = e & 63, kvh = (e >> 6) & 1, key = (e >> 7) & 511, b = e >> 16;
        ((bfr*)(ws + OFF_KL))[((size_t)(b * 2 + kvh) * 2560 + key) * 64 + d] = f2bf(p.in[2][e]);
        ((bfr*)(ws + OFF_VL))[((size_t)(b * 2 + kvh) * 64 + d) * 2560 + key] = f2bf(p.in[3][e]);
      }
    } else if (it < B_ZERO) {
      const int dg = it - B_SSM;
      const int pp = tid & 63, part = tid >> 6;
      const double lr = (double)p.in[14][dg * 64 + pp], li = (double)p.in[15][dg * 64 + pp];
      const double dt = (double)__expf(p.in[16][dg]) ;
      const float dtf = expf(p.in[16][dg]);
      const double dtd = (double)dtf;
      (void)dt;
      const double PI = 3.14159265358979323846;
      double ap = li * dtd / PI;
      double ar = ap - 2.0 * rint(ap * 0.5);
      const float er = expf((float)(lr * dtd));
      const double lbr = (double)er * (double)cospif((float)ar), lbi = (double)er * (double)sinpif((float)ar);
      double ap2 = ap * 256.0;
      double ar2 = ap2 - 2.0 * rint(ap2 * 0.5);
      const float er2 = expf((float)(lr * dtd * 256.0));
      if (part == 0) {
        ((float2*)(ws + OFF_LAMB))[dg * 64 + pp] = make_float2((float)lbr, (float)lbi);
        ((float2*)(ws + OFF_LAMP))[dg * 64 + pp] = make_float2(er2 * cospif((float)ar2), er2 * sinpif((float)ar2));
      }
      const double den = lr * lr + li * li;
      const double fr = ((lbr - 1.0) * lr + lbi * li) / den, fi = (lbi * lr - (lbr - 1.0) * li) / den;
      float* bb = (float*)(ws + OFF_BB) + (size_t)(dg * 64 + pp) * 32;
#pragma unroll
      for (int q = 0; q < 4; ++q) {
        const int c = part * 4 + q;
        const double br = (double)p.in[17][(size_t)(dg * 64 + pp) * 16 + c], bi = (double)p.in[18][(size_t)(dg * 64 + pp) * 16 + c];
        bb[c] = (float)(fr * br - fi * bi);
        bb[16 + c] = (float)(fr * bi + fi * br);
      }
      bfr* cm = (bfr*)(ws + OFF_CMB) + (size_t)dg * 2048;
#pragma unroll
      for (int q = 0; q < 8; ++q) {
        const int e = tid * 8 + q, c = e >> 7, k = e & 127;
        const float v = k < 64 ? p.in[19][(size_t)(dg * 16 + c) * 64 + k] : -p.in[20][(size_t)(dg * 16 + c) * 64 + (k - 64)];
        cm[e] = f2bf(v);
      }
    } else if (it < B_ROPE) {
      const int r = it - B_ZERO;
      ((float*)(ws + OFF_ROWSS))[r * 256 + tid] = 0.f;
    } else {
      const int e = (it - B_ROPE) * 256 + tid;
      const int n = e >> 4, pr = e & 15;
      const double q4[4] = {1.0, 0.5623413251903491, 0.31622776601683794, 0.1778279410038923};
      double inv = q4[0];
      if ((pr & 3) == 1) inv = q4[1]; else if ((pr & 3) == 2) inv = q4[2]; else if ((pr & 3) == 3) inv = q4[3];
      const int dec = pr >> 2;
      if (dec == 1) inv *= 0.1; else if (dec == 2) inv *= 0.01; else if (dec == 3) inv *= 0.001;
      const double ap = (double)n * inv / 3.14159265358979323846;
      const double ar = ap - 2.0 * rint(ap * 0.5);
      ((float2*)(ws + OFF_ROPE))[e] = make_float2(cospif((float)ar), sinpif((float)ar));
    }
  }
}

template <int MODE>
DI void phase_rows(const Params& p) {
  unsigned char* ws = p.ws;
  const int lane = threadIdx.x & 63, wave = threadIdx.x >> 6;
  const float* mod = (const float*)(ws + OFF_MOD);
  for (int it = blockIdx.x; it < NTOK / 4; it += gridDim.x) {
    const int T = it * 4 + wave;
    const int ci = cond_of(T);
    float4 xv[4];
    if (MODE == 2) {
      const float4* xr = (const float4*)((const float*)(ws + OFF_X1) + (size_t)T * 1024) + lane;
#pragma unroll
      for (int j = 0; j < 4; ++j) xv[j] = xr[64 * j];
    } else {
      const float4* xr = (const float4*)xrow(p, T) + lane;
#pragma unroll
      for (int j = 0; j < 4; ++j) xv[j] = xr[64 * j];
    }
    if (MODE >= 1) {
      const int l = MODE - 1;
      const bfr* orow = (const bfr*)(ws + OFF_O) + (size_t)T * 1024;
      float4 ov[4]; float ss = 0.f;
#pragma unroll
      for (int j = 0; j < 4; ++j) {
        const uint2 raw = *(const uint2*)(orow + lane * 4 + 256 * j);
        ov[j].x = bf2f(raw.x & 0xffff); ov[j].y = bf2f(raw.x >> 16); ov[j].z = bf2f(raw.y & 0xffff); ov[j].w = bf2f(raw.y >> 16);
        ss += ov[j].x * ov[j].x + ov[j].y * ov[j].y + ov[j].z * ov[j].z + ov[j].w * ov[j].w;
      }
      const float rinv = rsqrtf(wave_sum(ss) * (1.f / 1024.f) + EPS);
      const float* gate = mod + (l * 3 + ci) * 3072 + 2048;
      const float* gp = p.in[10] + l * 1024;
#pragma unroll
      for (int j = 0; j < 4; ++j) {
        const int k = lane * 4 + 256 * j;
        const float4 g4 = *(const float4*)(gate + k), n4 = *(const float4*)(gp + k);
        xv[j].x += g4.x * (ov[j].x * rinv * n4.x); xv[j].y += g4.y * (ov[j].y * rinv * n4.y);
        xv[j].z += g4.z * (ov[j].z * rinv * n4.z); xv[j].w += g4.w * (ov[j].w * rinv * n4.w);
      }
      if (MODE == 2) {
        float4* yr = (float4*)(p.out + OUT_Y + (size_t)T * 1024) + lane;
#pragma unroll
        for (int j = 0; j < 4; ++j) yr[64 * j] = xv[j];
      } else {
        float4* x1r = (float4*)((float*)(ws + OFF_X1) + (size_t)T * 1024) + lane;
#pragma unroll
        for (int j = 0; j < 4; ++j) x1r[64 * j] = xv[j];
      }
    }
    if (MODE <= 1) {
      const int l = MODE;
      float ss = 0.f;
#pragma unroll
      for (int j = 0; j < 4; ++j) ss += xv[j].x * xv[j].x + xv[j].y * xv[j].y + xv[j].z * xv[j].z + xv[j].w * xv[j].w;
      const float rinv = rsqrtf(wave_sum(ss) * (1.f / 1024.f) + EPS);
      const float* shift = mod + (l * 3 + ci) * 3072;
      const float* scale = shift + 1024;
      const float* gp = p.in[9] + l * 1024;
      bfr* hr = (bfr*)(ws + OFF_HN) + (size_t)T * 1024;
#pragma unroll
      for (int j = 0; j < 4; ++j) {
        const int k = lane * 4 + 256 * j;
        const float4 s4 = *(const float4*)(shift + k), c4 = *(const float4*)(scale + k), n4 = *(const float4*)(gp + k);
        const float a = xv[j].x * rinv * n4.x * (1.f + c4.x) + s4.x;
        const float b = xv[j].y * rinv * n4.y * (1.f + c4.y) + s4.y;
        const float c = xv[j].z * rinv * n4.z * (1.f + c4.z) + s4.z;
        const float d = xv[j].w * rinv * n4.w * (1.f + c4.w) + s4.w;
        *(uint2*)(hr + k) = make_uint2(pk2(a, b), pk2(c, d));
      }
    }
  }
}

DI void phase_win0(const Params& p, unsigned char* smem) {
  unsigned char* ws = p.ws;
  const int lane = threadIdx.x & 63, wave = threadIdx.x >> 6, l32 = lane & 31, h = lane >> 5, wm = wave >> 1, wn = wave & 1;
  const bfr* A = (const bfr*)(ws + OFF_HN);
  const bfr* Bt = (const bfr*)(ws + OFF_WIN0);
  for (int it = blockIdx.x; it < 96 * 18; it += gridDim.x) {
    const int tm = it / 18, tn = it % 18;
    const int m0 = tm * 128, n0 = tn * 128;
    LdBf al{A + (size_t)m0 * 1024, 1024}, bl{Bt + (size_t)n0 * 1024, 1024};
    auto ep = [&](f32x16 (&acc)[2][2]) {
      const int colbase = n0 + wn * 64, rbase = m0 + wm * 64;
      const bool lat = m0 >= NCTX;
      if (colbase < 640) {
        const bool isq = colbase < 512;
        const float* gain = isq ? p.in[12] : p.in[13];
        const float g0 = gain[l32], g1 = gain[32 + l32];
        const int hd = isq ? (colbase >> 6) : ((colbase - 512) >> 6);
        const float2* rope = (const float2*)(ws + OFF_ROPE);
        const float sgn = (l32 & 16) ? 1.f : -1.f;
#pragma unroll
        for (int mi = 0; mi < 2; ++mi)
#pragma unroll
          for (int i = 0; i < 16; ++i) {
            float v0 = acc[mi][0][i], v1 = acc[mi][1][i];
            const float ss = half_sum32(v0 * v0 + v1 * v1);
            const float rinv = rsqrtf(ss * (1.f / 64.f) + EPS);
            v0 *= rinv * g0; v1 *= rinv * g1;
            const int r = rbase + mi * 32 + crow(i, h);
            if (!lat && !isq) {
              p.out[OUT_K + (size_t)r * 128 + hd * 64 + l32] = v0;
              p.out[OUT_K + (size_t)r * 128 + hd * 64 + 32 + l32] = v1;
            }
            if (lat) {
              const int pos = (r - NCTX) & 2047, prow = pos >> 6, pcol = pos & 63;
              const float2 c0 = rope[prow * 16 + (l32 & 15)], c1 = rope[pcol * 16 + (l32 & 15)];
              const float q0 = __shfl_xor(v0, 16), q1 = __shfl_xor(v1, 16);
              v0 = v0 * c0.x + sgn * q0 * c0.y;
              v1 = v1 * c1.x + sgn * q1 * c1.y;
            }
            if (isq) {
              bfr* q = (bfr*)(ws + OFF_QB) + (size_t)r * 512 + hd * 64;
              q[l32] = f2bf(v0 * 0.125f); q[32 + l32] = f2bf(v1 * 0.125f);
            } else if (!lat) {
              const int b = r >> 8, l = r & 255;
              bfr* k = (bfr*)(ws + OFF_KC) + ((size_t)(b * 2 + hd) * 256 + l) * 64;
              k[l32] = f2bf(v0); k[32 + l32] = f2bf(v1);
            } else {
              const int b = (r - NCTX) >> 11, l = (r - NCTX) & 2047;
              bfr* k = (bfr*)(ws + OFF_KL) + ((size_t)(b * 2 + hd) * 2560 + 512 + l) * 64;
              k[l32] = f2bf(v0); k[32 + l32] = f2bf(v1);
            }
          }
      } else if (colbase < 768) {
        const int hd = (colbase - 640) >> 6;
#pragma unroll
        for (int mi = 0; mi < 2; ++mi)
#pragma unroll
          for (int ni = 0; ni < 2; ++ni) {
            const int d = ni * 32 + l32;
#pragma unroll
            for (int i4 = 0; i4 < 4; ++i4) {
              const int r0 = rbase + mi * 32 + 8 * i4 + 4 * h;
              const float a = acc[mi][ni][4 * i4], b2 = acc[mi][ni][4 * i4 + 1], c = acc[mi][ni][4 * i4 + 2], e = acc[mi][ni][4 * i4 + 3];
              const uint2 pk = make_uint2(pk2(a, b2), pk2(c, e));
              if (!lat) {
                p.out[OUT_V + (size_t)(r0 + 0) * 128 + hd * 64 + d] = a;
                p.out[OUT_V + (size_t)(r0 + 1) * 128 + hd * 64 + d] = b2;
                p.out[OUT_V + (size_t)(r0 + 2) * 128 + hd * 64 + d] = c;
                p.out[OUT_V + (size_t)(r0 + 3) * 128 + hd * 64 + d] = e;
                const int b = r0 >> 8, l = r0 & 255;
                *(uint2*)((bfr*)(ws + OFF_VC) + ((size_t)(b * 2 + hd) * 64 + d) * 256 + l) = pk;
              } else {
                const int b = (r0 - NCTX) >> 11, l = (r0 - NCTX) & 2047;
                *(uint2*)((bfr*)(ws + OFF_VL) + ((size_t)(b * 2 + hd) * 64 + d) * 2560 + 512 + l) = pk;
              }
            }
          }
      } else {
        const int sec = colbase < 1280 ? 0 : (colbase < 1792 ? 1 : 2);
        const int cb = colbase - (sec == 0 ? 768 : (sec == 1 ? 1280 : 1792));
#pragma unroll
        for (int mi = 0; mi < 2; ++mi)
#pragma unroll
          for (int ni = 0; ni < 2; ++ni)
#pragma unroll
            for (int i = 0; i < 16; ++i) {
              const int r = rbase + mi * 32 + crow(i, h);
              const int c = cb + ni * 32 + l32;
              const float v = acc[mi][ni][i];
              if (sec == 0) ((bfr*)(ws + OFF_GA))[(size_t)r * 512 + c] = f2bf(silu_f(v));
              else if (sec == 1) ((float*)(ws + OFF_U))[(size_t)r * 512 + c] = v;
              else ((bfr*)(ws + OFF_GB))[(size_t)r * 512 + c] = f2bf(silu_f(v));
            }
      }
    };
    gemm_tile<128>(16, al, bl, ep, smem);
  }
}

DI void attn_item(const Params& p, unsigned char* smem, int it) {
  unsigned char* ws = p.ws;
  const int tid = threadIdx.x, lane = tid & 63, wave = tid >> 6, l32 = lane & 31, h = lane >> 5;
  int T0, nkeys, ldv; const bfr *Kp, *Vp; int kvh;
  if (it < 256) {
    const int b = it >> 7, qt = it & 63; kvh = (it >> 6) & 1;
    T0 = NCTX + b * 2048 + qt * 32; nkeys = 2560; ldv = 2560;
    Kp = (const bfr*)(ws + OFF_KL) + (size_t)(b * 2 + kvh) * 2560 * 64;
    Vp = (const bfr*)(ws + OFF_VL) + (size_t)(b * 2 + kvh) * 64 * 2560;
  } else {
    const int i2 = it - 256; const int b = i2 >> 4, qt = i2 & 7; kvh = (i2 >> 3) & 1;
    T0 = b * 256 + qt * 32; nkeys = 256; ldv = 256;
    Kp = (const bfr*)(ws + OFF_KC) + (size_t)(b * 2 + kvh) * 256 * 64;
    Vp = (const bfr*)(ws + OFF_VC) + (size_t)(b * 2 + kvh) * 64 * 256;
  }
  const int head = kvh * 4 + wave;
  unsigned short* Ks = (unsigned short*)smem;
  unsigned short* Vs = Ks + 64 * 72;
  bf16x8 qf[4];
  {
    const bfr* q = (const bfr*)(ws + OFF_QB) + (size_t)(T0 + l32) * 512 + head * 64 + 8 * h;
#pragma unroll
    for (int ks = 0; ks < 4; ++ks) qf[ks] = *(const bf16x8*)(q + 16 * ks);
  }
  float m = -1e30f, lsum = 0.f;
  f32x16 O[2];
#pragma unroll
  for (int i = 0; i < 16; ++i) { O[0][i] = 0.f; O[1][i] = 0.f; }
  for (int k0 = 0; k0 < nkeys; k0 += 64) {
    __syncthreads();
#pragma unroll
    for (int i = 0; i < 2; ++i) {
      const int id = tid + 256 * i, rr = id >> 3, cc = (id & 7) * 8;
      *(uint4*)(Ks + rr * 72 + cc) = *(const uint4*)(Kp + (size_t)(k0 + rr) * 64 + cc);
      *(uint4*)(Vs + rr * 72 + cc) = *(const uint4*)(Vp + (size_t)rr * ldv + k0 + cc);
    }
    __syncthreads();
    f32x16 st[2];
#pragma unroll
    for (int kt = 0; kt < 2; ++kt) {
#pragma unroll
      for (int i = 0; i < 16; ++i) st[kt][i] = 0.f;
#pragma unroll
      for (int ks = 0; ks < 4; ++ks) {
        const bf16x8 a = *(const bf16x8*)(Ks + (32 * kt + l32) * 72 + 16 * ks + 8 * h);
        st[kt] = MFMA32(a, qf[ks], st[kt]);
      }
    }
    float mx = st[0][0];
#pragma unroll
    for (int i = 0; i < 16; ++i) { mx = fmaxf(mx, st[0][i]); mx = fmaxf(mx, st[1][i]); }
    mx = fmaxf(mx, __shfl_xor(mx, 32));
    const float mn = fmaxf(m, mx);
    const float alpha = __expf(m - mn);
    m = mn;
    float ps = 0.f;
#pragma unroll
    for (int kt = 0; kt < 2; ++kt)
#pragma unroll
      for (int i = 0; i < 16; ++i) { const float e = __expf(st[kt][i] - mn); st[kt][i] = e; ps += e; }
    lsum = lsum * alpha + ps;
#pragma unroll
    for (int i = 0; i < 16; ++i) { O[0][i] *= alpha; O[1][i] *= alpha; }
#pragma unroll
    for (int kt = 0; kt < 2; ++kt)
#pragma unroll
      for (int s = 0; s < 2; ++s) {
        bf16x8 pf;
#pragma unroll
        for (int j = 0; j < 8; ++j) pf[j] = (short)f2bf(st[kt][8 * s + j]);
#pragma unroll
        for (int dt = 0; dt < 2; ++dt) {
          const unsigned short* vr = Vs + (32 * dt + l32) * 72 + 32 * kt + 16 * s + 4 * h;
          const s16x4 lo = *(const s16x4*)vr, hi = *(const s16x4*)(vr + 8);
          const bf16x8 va = __builtin_shufflevector(lo, hi, 0, 1, 2, 3, 4, 5, 6, 7);
          O[dt] = MFMA32(va, pf, O[dt]);
        }
      }
  }
  const float ltot = lsum + __shfl_xor(lsum, 32);
  const float inv = 1.f / ltot;
  const int T = T0 + l32;
#pragma unroll
  for (int dt = 0; dt < 2; ++dt)
#pragma unroll
    for (int i4 = 0; i4 < 4; ++i4) {
      const int d = 32 * dt + 8 * i4 + 4 * h;
      const uint2 g = *(const uint2*)((const bfr*)(ws + OFF_GA) + (size_t)T * 512 + head * 64 + d);
      const float a = O[dt][4 * i4] * inv * bf2f(g.x & 0xffff), b = O[dt][4 * i4 + 1] * inv * bf2f(g.x >> 16);
      const float c = O[dt][4 * i4 + 2] * inv * bf2f(g.y & 0xffff), e = O[dt][4 * i4 + 3] * inv * bf2f(g.y >> 16);
      *(uint2*)((bfr*)(ws + OFF_MIX) + (size_t)T * 1024 + head * 64 + d) = make_uint2(pk2(a, b), pk2(c, e));
    }
}

DI int seg_T0(int seg) { return seg < 32 ? seg * 256 : NCTX + ((seg - 32) >> 3) * 2048 + ((seg - 32) & 7) * 256; }

DI void s5_item(const Params& p, unsigned char* smem, int it) {
  unsigned char* ws = p.ws;
  const int tid = threadIdx.x, lane = tid & 63, wave = tid >> 6;
  const int di = it & 1, g = (it >> 1) & 31, seg = it >> 6;
  const int T0 = seg_T0(seg);
  const int dg = di * 32 + g;
  float* Us = (float*)smem;
  float* BU = Us + 512;
  float bre[16], bim[16];
  {
    const float4* bb = (const float4*)((const float*)(ws + OFF_BB) + (size_t)(dg * 64 + lane) * 32);
#pragma unroll
    for (int q = 0; q < 4; ++q) { const float4 v = bb[q]; bre[4 * q] = v.x; bre[4 * q + 1] = v.y; bre[4 * q + 2] = v.z; bre[4 * q + 3] = v.w; }
#pragma unroll
    for (int q = 0; q < 4; ++q) { const float4 v = bb[4 + q]; bim[4 * q] = v.x; bim[4 * q + 1] = v.y; bim[4 * q + 2] = v.z; bim[4 * q + 3] = v.w; }
  }
  const float2 lam = ((const float2*)(ws + OFF_LAMB))[dg * 64 + lane];
  bf16x8 cmf[4];
  {
    const bfr* cm = (const bfr*)(ws + OFF_CMB) + (size_t)dg * 2048 + (lane & 15) * 128 + 8 * (lane >> 4);
#pragma unroll
    for (int ks = 0; ks < 4; ++ks) cmf[ks] = *(const bf16x8*)(cm + 32 * ks);
  }
  float hr = 0.f, hi = 0.f;
  bfr* yout = (bfr*)(ws + (di == 0 ? OFF_YF : OFF_YB));
  for (int c = 0; c < 8; ++c) {
    __syncthreads();
    if (tid < 128) {
      const int sl = tid >> 2, q = tid & 3;
      const int sg = 32 * c + sl;
      const int T = di == 0 ? T0 + sg : T0 + 255 - sg;
      *(float4*)(Us + sl * 16 + q * 4) = *(const float4*)((const float*)(ws + OFF_U) + (size_t)T * 512 + g * 16 + q * 4);
    }
    __syncthreads();
#pragma unroll
    for (int s8 = 0; s8 < 8; ++s8) {
      const int sl = wave * 8 + s8;
      const float4* up = (const float4*)(Us + sl * 16);
      float ar = 0.f, ai = 0.f;
#pragma unroll
      for (int q = 0; q < 4; ++q) {
        const float4 u = up[q];
        ar += bre[4 * q] * u.x + bre[4 * q + 1] * u.y + bre[4 * q + 2] * u.z + bre[4 * q + 3] * u.w;
        ai += bim[4 * q] * u.x + bim[4 * q + 1] * u.y + bim[4 * q + 2] * u.z + bim[4 * q + 3] * u.w;
      }
      BU[sl * 132 + lane] = ar; BU[sl * 132 + 64 + lane] = ai;
    }
    __syncthreads();
    if (wave == 0) {
#pragma unroll 8
      for (int sl = 0; sl < 32; ++sl) {
        const float br = BU[sl * 132 + lane], bi = BU[sl * 132 + 64 + lane];
        const float nr = lam.x * hr - lam.y * hi + br;
        const float ni = lam.x * hi + lam.y * hr + bi;
        hr = nr; hi = ni;
        BU[sl * 132 + lane] = hr; BU[sl * 132 + 64 + lane] = hi;
      }
    }
    __syncthreads();
    if (wave < 2) {
      f32x4 acc = {0.f, 0.f, 0.f, 0.f};
      const float* hrow = BU + (16 * wave + (lane & 15)) * 132 + 8 * (lane >> 4);
#pragma unroll
      for (int ks = 0; ks < 4; ++ks) {
        const float4 v0 = *(const float4*)(hrow + 32 * ks), v1 = *(const float4*)(hrow + 32 * ks + 4);
        bf16x8 a;
        a[0] = (short)f2bf(v0.x); a[1] = (short)f2bf(v0.y); a[2] = (short)f2bf(v0.z); a[3] = (short)f2bf(v0.w);
        a[4] = (short)f2bf(v1.x); a[5] = (short)f2bf(v1.y); a[6] = (short)f2bf(v1.z); a[7] = (short)f2bf(v1.w);
        acc = MFMA16(a, cmf[ks], acc);
      }
#pragma unroll
      for (int i = 0; i < 4; ++i) {
        const int sg = 32 * c + 16 * wave + 4 * (lane >> 4) + i;
        const int T = di == 0 ? T0 + sg : T0 + 255 - sg;
        yout[(size_t)T * 512 + g * 16 + (lane & 15)] = f2bf(acc[i]);
      }
    }
  }
  if (wave == 0) {
    ((float2*)(ws + OFF_E))[((size_t)(seg * 2 + di) * 32 + g) * 64 + lane] = make_float2(hr, hi);
    if (seg < 32) {
      float* so = p.out + OUT_S + (size_t)((seg * 2 + di) * 2) * 2048 + g * 64 + lane;
      so[0] = hr; so[2048] = hi;
    }
  }
}

DI void phase_mix0(const Params& p, unsigned char* smem) {
  constexpr int N_ATT = 768, N_S5 = 3072;
  for (int it = blockIdx.x; it < N_ATT + N_S5; it += gridDim.x) {
    __syncthreads();
    if (it < 256) attn_item(p, smem, it);
    else if (it < 256 + N_S5) s5_item(p, smem, it - 256);
    else attn_item(p, smem, it - N_S5);
  }
}

DI void phase_s5fix(const Params& p, unsigned char* smem) {
  unsigned char* ws = p.ws;
  const int tid = threadIdx.x, lane = tid & 63, wave = tid >> 6;
  float* HC = (float*)smem;
  float* ycorr = HC + 32 * 132;
  for (int it = blockIdx.x; it < 48 * 32; it += gridDim.x) {
    const int g = it & 31, seg = it >> 5;
    const int T0 = seg_T0(seg);
    __syncthreads();
    for (int e = tid; e < 4096; e += 256) ycorr[e] = 0.f;
    __syncthreads();
    if (seg >= 32) {
      const int b = (seg - 32) >> 3, j = (seg - 32) & 7;
      for (int di = 0; di < 2; ++di) {
        const int dg = di * 32 + g;
        float hr = 0.f, hi = 0.f, cr = 0.f, cim = 0.f;
        float2 lam = make_float2(0.f, 0.f);
        if (wave == 0) {
          lam = ((const float2*)(ws + OFF_LAMB))[dg * 64 + lane];
          const float2 lp = ((const float2*)(ws + OFF_LAMP))[dg * 64 + lane];
          const float* st = p.in[4] + (size_t)((b * 2 + di) * 2) * 2048 + g * 64 + lane;
          hr = st[0]; hi = st[2048];
          const int nprev = di == 0 ? j : 7 - j;
          for (int q = 0; q < nprev; ++q) {
            const int jj = di == 0 ? q : 7 - q;
            const float2 e = ((const float2*)(ws + OFF_E))[((size_t)((32 + b * 8 + jj) * 2 + di) * 32 + g) * 64 + lane];
            const float nr = lp.x * hr - lp.y * hi + e.x, ni = lp.x * hi + lp.y * hr + e.y;
            hr = nr; hi = ni;
          }
          cr = lam.x; cim = lam.y;
        }
        bf16x8 cmf[4];
        {
          const bfr* cm = (const bfr*)(ws + OFF_CMB) + (size_t)dg * 2048 + (lane & 15) * 128 + 8 * (lane >> 4);
#pragma unroll
          for (int ks = 0; ks < 4; ++ks) cmf[ks] = *(const bf16x8*)(cm + 32 * ks);
        }
        for (int c = 0; c < 8; ++c) {
          __syncthreads();
          if (wave == 0) {
#pragma unroll 8
            for (int sl = 0; sl < 32; ++sl) {
              HC[sl * 132 + lane] = cr * hr - cim * hi;
              HC[sl * 132 + 64 + lane] = cr * hi + cim * hr;
              const float nr = cr * lam.x - cim * lam.y, ni = cr * lam.y + cim * lam.x;
              cr = nr; cim = ni;
            }
          }
          __syncthreads();
          if (wave < 2) {
            f32x4 acc = {0.f, 0.f, 0.f, 0.f};
            const float* hrow = HC + (16 * wave + (lane & 15)) * 132 + 8 * (lane >> 4);
#pragma unroll
            for (int ks = 0; ks < 4; ++ks) {
              const float4 v0 = *(const float4*)(hrow + 32 * ks), v1 = *(const float4*)(hrow + 32 * ks + 4);
              bf16x8 a;
              a[0] = (short)f2bf(v0.x); a[1] = (short)f2bf(v0.y); a[2] = (short)f2bf(v0.z); a[3] = (short)f2bf(v0.w);
              a[4] = (short)f2bf(v1.x); a[5] = (short)f2bf(v1.y); a[6] = (short)f2bf(v1.z); a[7] = (short)f2bf(v1.w);
              acc = MFMA16(a, cmf[ks], acc);
            }
#pragma unroll
            for (int i = 0; i < 4; ++i) {
              const int sg = 32 * c + 16 * wave + 4 * (lane >> 4) + i;
              const int tl = di == 0 ? sg : 255 - sg;
              atomicAdd(&ycorr[tl * 16 + (lane & 15)], acc[i]);
            }
          }
        }
      }
      __syncthreads();
    }
    {
      const int T = T0 + tid;
      const float* up = (const float*)(ws + OFF_U) + (size_t)T * 512 + g * 16;
      const bfr* yf = (const bfr*)(ws + OFF_YF) + (size_t)T * 512 + g * 16;
      const bfr* yb = (const bfr*)(ws + OFF_YB) + (size_t)T * 512 + g * 16;
      const float* dsk = p.in[21] + g * 16;
      unsigned o[8];
#pragma unroll
      for (int q = 0; q < 2; ++q) {
        const uint4 f = *(const uint4*)(yf + 8 * q), bk = *(const uint4*)(yb + 8 * q);
        const float4 u0 = *(const float4*)(up + 8 * q), u1 = *(const float4*)(up + 8 * q + 4);
        const float4 d0 = *(const float4*)(dsk + 8 * q), d1 = *(const float4*)(dsk + 8 * q + 4);
        const float* yc = ycorr + tid * 16 + 8 * q;
        const float uu[8] = {u0.x, u0.y, u0.z, u0.w, u1.x, u1.y, u1.z, u1.w};
        const float dd[8] = {d0.x, d0.y, d0.z, d0.w, d1.x, d1.y, d1.z, d1.w};
        const unsigned ff[4] = {f.x, f.y, f.z, f.w}, bb[4] = {bk.x, bk.y, bk.z, bk.w};
        float y[8];
#pragma unroll
        for (int e = 0; e < 8; ++e) {
          const float a = (e & 1) ? bf2f(ff[e >> 1] >> 16) : bf2f(ff[e >> 1] & 0xffff);
          const float c2 = (e & 1) ? bf2f(bb[e >> 1] >> 16) : bf2f(bb[e >> 1] & 0xffff);
          y[e] = gelu_f(uu[e] * dd[e] + a + c2 + yc[e]);
        }
#pragma unroll
        for (int e = 0; e < 4; ++e) o[4 * q + e] = pk2(y[2 * e], y[2 * e + 1]);
      }
      uint4* dst = (uint4*)((bfr*)(ws + OFF_YG) + (size_t)T * 512 + g * 16);
      dst[0] = make_uint4(o[0], o[1], o[2], o[3]);
      dst[1] = make_uint4(o[4], o[5], o[6], o[7]);
    }
  }
}

template <int MODE>
DI void phase_tokgemm(const Params& p, unsigned char* smem, int layer) {
  unsigned char* ws = p.ws;
  const int lane = threadIdx.x & 63, wave = threadIdx.x >> 6, l32 = lane & 31, h = lane >> 5, wm = wave >> 1, wn = wave & 1;
  constexpr int K = MODE == 1 ? 1024 : 512, N = MODE == 1 ? 1024 : 512;
  const bfr* A = (const bfr*)(ws + (MODE == 0 ? OFF_YG : (MODE == 1 ? OFF_MIX : OFF_FZ)));
  const bfr* Bt = (const bfr*)(ws + (MODE == 0 ? OFF_GLU : (MODE == 1 ? (layer == 0 ? OFF_WOUT0 : OFF_WOUT1) : OFF_FNET)));
  constexpr int TN = N / 128;
  for (int it = blockIdx.x; it < 96 * TN; it += gridDim.x) {
    const int tm = it / TN, tn = it % TN, m0 = tm * 128, n0 = tn * 128;
    LdBf al{A + (size_t)m0 * K, (size_t)K}, bl{Bt + (size_t)n0 * K, (size_t)K};
    auto ep = [&](f32x16 (&acc)[2][2]) {
#pragma unroll
      for (int mi = 0; mi < 2; ++mi)
#pragma unroll
        for (int ni = 0; ni < 2; ++ni)
#pragma unroll
          for (int i = 0; i < 16; ++i) {
            const int r = m0 + wm * 64 + mi * 32 + crow(i, h);
            const int n = n0 + wn * 64 + ni * 32 + l32;
            const float v = acc[mi][ni][i];
            if (MODE == 0) {
              const float y = bf2f(((const bfr*)(ws + OFF_YG))[(size_t)r * 512 + n]);
              const float gbv = bf2f(((const bfr*)(ws + OFF_GB))[(size_t)r * 512 + n]);
              ((bfr*)(ws + OFF_MIX))[(size_t)r * 1024 + 512 + n] = f2bf(y * sigmoid_f(v + p.in[23][n]) * gbv);
            } else if (MODE == 1) {
              ((bfr*)(ws + OFF_O))[(size_t)r * 1024 + n] = f2bf(v);
            } else {
              const float gd = bf2f(((const bfr*)(ws + OFF_GDS))[(size_t)r * 512 + n]);
              ((bfr*)(ws + OFF_MIX))[(size_t)r * 1024 + 512 + n] = f2bf(v * gd);
            }
          }
    };
    gemm_tile<128>(K / 64, al, bl, ep, smem);
  }
}

DI void phase_win1(const Params& p, unsigned char* smem) {
  unsigned char* ws = p.ws;
  const int lane = threadIdx.x & 63, wave = threadIdx.x >> 6, l32 = lane & 31, h = lane >> 5, wm = wave >> 1, wn = wave & 1;
  const bfr* A = (const bfr*)(ws + OFF_HN);
  const bfr* Bt = (const bfr*)(ws + OFF_WIN1);
  for (int it = blockIdx.x; it < 96 * 24; it += gridDim.x) {
    const int tm = it / 24, tn = it % 24, m0 = tm * 128, n0 = tn * 128;
    LdBf al{A + (size_t)m0 * 1024, 1024}, bl{Bt + (size_t)n0 * 1024, 1024};
    auto ep = [&](f32x16 (&acc)[2][2]) {
      const int colbase = n0 + wn * 64, rbase = m0 + wm * 64;
      const int sec = colbase >> 9;
      const int cb = colbase & 511;
      const bool lat = m0 >= NCTX;
      if (sec == 0 || sec == 2 || sec == 5) {
        bfr* dst = (bfr*)(ws + (sec == 0 ? OFF_CUG : (sec == 2 ? OFF_GCS : OFF_GDS)));
#pragma unroll
        for (int mi = 0; mi < 2; ++mi)
#pragma unroll
          for (int ni = 0; ni < 2; ++ni)
#pragma unroll
            for (int i = 0; i < 16; ++i) {
              const int r = rbase + mi * 32 + crow(i, h);
              const float v = acc[mi][ni][i];
              dst[(size_t)r * 512 + cb + ni * 32 + l32] = f2bf(sec == 0 ? gelu_f(v) : silu_f(v));
            }
      } else if (sec == 1) {
        float* rowss = (float*)(ws + OFF_ROWSS);
#pragma unroll
        for (int mi = 0; mi < 2; ++mi) {
#pragma unroll
          for (int i = 0; i < 16; ++i) {
            const float g0 = gelu_f(acc[mi][0][i]), g1 = gelu_f(acc[mi][1][i]);
            acc[mi][0][i] = g0; acc[mi][1][i] = g1;
            const float ss = half_sum32(g0 * g0 + g1 * g1);
            if (l32 == 0) atomicAdd(rowss + rbase + mi * 32 + crow(i, h), ss);
          }
#pragma unroll
          for (int ni = 0; ni < 2; ++ni)
#pragma unroll
            for (int i4 = 0; i4 < 4; ++i4) {
              const int r0 = rbase + mi * 32 + 8 * i4 + 4 * h;
              const int n = cb + ni * 32 + l32;
              *(uint2*)((bfr*)(ws + OFF_CVT) + (size_t)n * NTOK + r0) =
                  make_uint2(pk2(acc[mi][ni][4 * i4], acc[mi][ni][4 * i4 + 1]), pk2(acc[mi][ni][4 * i4 + 2], acc[mi][ni][4 * i4 + 3]));
            }
        }
      } else {
        const int isz = sec - 3;
#pragma unroll
        for (int mi = 0; mi < 2; ++mi)
#pragma unroll
          for (int ni = 0; ni < 2; ++ni)
#pragma unroll
            for (int i4 = 0; i4 < 4; ++i4) {
              const int r0 = rbase + mi * 32 + 8 * i4 + 4 * h;
              const int n = cb + ni * 32 + l32;
              const uint2 pk = make_uint2(pk2(acc[mi][ni][4 * i4], acc[mi][ni][4 * i4 + 1]), pk2(acc[mi][ni][4 * i4 + 2], acc[mi][ni][4 * i4 + 3]));
              if (!lat) {
                const int b = r0 >> 8, s = r0 & 255;
                *(uint2*)((bfr*)(ws + OFF_ZTC) + ((size_t)(b * 512 + n)) * 512 + isz * 256 + s) = pk;
              } else {
                const int b = (r0 - NCTX) >> 11, s = (r0 - NCTX) & 2047;
                *(uint2*)((bfr*)(ws + OFF_ZTL) + ((size_t)(b * 512 + n)) * 4096 + isz * 2048 + s) = pk;
              }
            }
      }
    };
    gemm_tile<128>(16, al, bl, ep, smem);
  }
}

struct LdWs {
  const float* w; const float* rowss;
  DI uint4 operator()(int r, int k) const {
    const float4 a = *(const float4*)(w + r * 128 + k), b = *(const float4*)(w + r * 128 + k + 4);
    const float4 s0 = *(const float4*)(rowss + k), s1 = *(const float4*)(rowss + k + 4);
    const float r0 = rsqrtf(s0.x * (1.f / 512.f) + EPS), r1 = rsqrtf(s0.y * (1.f / 512.f) + EPS), r2 = rsqrtf(s0.z * (1.f / 512.f) + EPS), r3 = rsqrtf(s0.w * (1.f / 512.f) + EPS);
    const float r4 = rsqrtf(s1.x * (1.f / 512.f) + EPS), r5 = rsqrtf(s1.y * (1.f / 512.f) + EPS), r6 = rsqrtf(s1.z * (1.f / 512.f) + EPS), r7 = rsqrtf(s1.w * (1.f / 512.f) + EPS);
    return make_uint4(pk2(a.x * r0, a.y * r1), pk2(a.z * r2, a.w * r3), pk2(b.x * r4, b.y * r5), pk2(b.z * r6, b.w * r7));
  }
};

DI void phase_mix1(const Params& p, unsigned char* smem) {
  unsigned char* ws = p.ws;
  const int lane = threadIdx.x & 63, wave = threadIdx.x >> 6, l32 = lane & 31, h = lane >> 5, wm = wave >> 1, wn = wave & 1;
  constexpr int N_FL = 128, N_FC = 256, N_G = 768;
  for (int it = blockIdx.x; it < N_FL + N_FC + N_G; it += gridDim.x) {
    if (it < N_FL + N_FC) {
      const bfr *A, *Bt; int K, Tbase, tm, tn;
      if (it < N_FL) {
        const int b = it >> 6; tm = (it >> 2) & 15; tn = it & 3; K = 4096;
        A = (const bfr*)(ws + OFF_ALAT); Bt = (const bfr*)(ws + OFF_ZTL) + (size_t)b * 512 * 4096; Tbase = NCTX + b * 2048;
      } else {
        const int i2 = it - N_FL; const int b = i2 >> 3; tm = (i2 >> 2) & 1; tn = i2 & 3; K = 512;
        A = (const bfr*)(ws + OFF_ACTX); Bt = (const bfr*)(ws + OFF_ZTC) + (size_t)b * 512 * 512; Tbase = b * 256;
      }
      LdBf al{A + (size_t)tm * 128 * K, (size_t)K}, bl{Bt + (size_t)tn * 128 * K, (size_t)K};
      auto ep = [&](f32x16 (&acc)[2][2]) {
#pragma unroll
        for (int mi = 0; mi < 2; ++mi)
#pragma unroll
          for (int ni = 0; ni < 2; ++ni)
#pragma unroll
            for (int i = 0; i < 16; ++i) {
              const int T = Tbase + tm * 128 + wm * 64 + mi * 32 + crow(i, h);
              const int n = tn * 128 + wn * 64 + ni * 32 + l32;
              ((bfr*)(ws + OFF_FZ))[(size_t)T * 512 + n] = f2bf(acc[mi][ni][i]);
            }
      };
      gemm_tile<128>(K / 64, al, bl, ep, smem);
    } else {
      const int i2 = it - N_FL - N_FC; const int hg = i2 & 7, chunk = i2 >> 3;
      LdWs al{p.in[27] + (size_t)hg * 128 * 128, (const float*)(ws + OFF_ROWSS) + chunk * 128};
      LdBf bl{(const bfr*)(ws + OFF_CVT) + (size_t)(hg * 64) * NTOK + chunk * 128, (size_t)NTOK};
      auto ep = [&](f32x16 (&acc)[2][1]) {
        const int c = hg * 64 + wn * 32 + l32;
        const float vg = p.in[26][c];
#pragma unroll
        for (int mi = 0; mi < 2; ++mi)
#pragma unroll
          for (int i = 0; i < 16; ++i) {
            const int t = wm * 64 + mi * 32 + crow(i, h);
            const int T = chunk * 128 + t;
            const float sp = acc[mi][0][i] * vg + p.in[28][hg * 128 + t];
            const float cu = bf2f(((const bfr*)(ws + OFF_CUG))[(size_t)T * 512 + c]);
            const float gc = bf2f(((const bfr*)(ws + OFF_GCS))[(size_t)T * 512 + c]);
            ((bfr*)(ws + OFF_MIX))[(size_t)T * 1024 + c] = f2bf(cu * sp * gc);
          }
      };
      gemm_tile<64>(2, al, bl, ep, smem);
    }
  }
}

constexpr int NPHASE = 13;
template <int PH>
DI void run_phase(const Params& p, unsigned char* smem) {
  if constexpr (PH == 0) phase0(p, smem);
  else if constexpr (PH == 1) phase_rows<0>(p);
  else if constexpr (PH == 2) phase_win0(p, smem);
  else if constexpr (PH == 3) phase_mix0(p, smem);
  else if constexpr (PH == 4) phase_s5fix(p, smem);
  else if constexpr (PH == 5) phase_tokgemm<0>(p, smem, 0);
  else if constexpr (PH == 6) phase_tokgemm<1>(p, smem, 0);
  else if constexpr (PH == 7) phase_rows<1>(p);
  else if constexpr (PH == 8) phase_win1(p, smem);
  else if constexpr (PH == 9) phase_mix1(p, smem);
  else if constexpr (PH == 10) phase_tokgemm<2>(p, smem, 1);
  else if constexpr (PH == 11) phase_tokgemm<1>(p, smem, 1);
  else if constexpr (PH == 12) phase_rows<2>(p);
}
template <int LO, int HI>
DI void run_range(const Params& p, unsigned char* smem) {
  if constexpr (LO < HI) {
    run_phase<LO>(p, smem);
    if constexpr (LO + 1 < HI) { cg::this_grid().sync(); run_range<LO + 1, HI>(p, smem); }
  }
}
template <int LO, int HI>
__global__ void __launch_bounds__(256, 2) mega(Params p) {
  __shared__ __attribute__((aligned(16))) unsigned char smem[36864];
  run_range<LO, HI>(p, smem);
}

#ifndef ONE_LAUNCH
#define ONE_LAUNCH 1
#endif
#if !ONE_LAUNCH
template <int PH>
static void launch_phases(Params& p, int grid, hipStream_t stream) {
  if constexpr (PH < NPHASE) {
    hipLaunchKernelGGL((mega<PH, PH + 1>), dim3(grid), dim3(256), 0, stream, p);
    launch_phases<PH + 1>(p, grid, stream);
  }
}
#endif

#ifndef ONE_LAUNCH
#define ONE_LAUNCH 1
#endif

extern "C" void kernel_launch(void* const* d_in, const int* in_sizes, int n_in, void* d_out, int out_size, void* d_ws, size_t ws_size, hipStream_t stream) {
  static int grid_blocks = 0;
  if (!grid_blocks) {
    int dev = 0, cus = 0, per_cu = 0;
    (void)hipGetDevice(&dev);
    (void)hipDeviceGetAttribute(&cus, hipDeviceAttributeMultiprocessorCount, dev);
    (void)hipOccupancyMaxActiveBlocksPerMultiprocessor(&per_cu, mega<0, NPHASE>, 256, 0);
    if (per_cu > 2) per_cu = 2;
    if (per_cu < 1) per_cu = 1;
    grid_blocks = cus * per_cu;
    if (n_in != 31 || ws_size < WS_NEED) fprintf(stderr, "kernel_launch: unexpected n_in %d or ws_size %zu (need %zu)\n", n_in, ws_size, (size_t)WS_NEED);
  }
  Params p{};
  for (int i = 0; i < 31; ++i) p.in[i] = (const float*)d_in[i];
  p.out = (float*)d_out; p.ws = (unsigned char*)d_ws;
#if ONE_LAUNCH
  p.ph_lo = 0; p.ph_hi = NPHASE;
  void* args[] = {&p};
  hipError_t e = hipLaunchCooperativeKernel((void*)mega<0, NPHASE>, dim3(grid_blocks), dim3(256), args, 0, stream);
  if (e != hipSuccess) fprintf(stderr, "cooperative launch failed: %s (grid %d)\n", hipGetErrorString(e), grid_blocks);
#else
  launch_phases<0>(p, grid_blocks, stream);
#endif
}
```

```cpp
#include <hip/hip_runtime.h>
#include <hip/hip_cooperative_groups.h>
#include <cstdio>
#include <cstdint>
namespace cg = cooperative_groups;

#define DI __device__ __forceinline__
typedef unsigned short bfr;
using bf16x8 = __attribute__((ext_vector_type(8))) short;
using s16x4  = __attribute__((ext_vector_type(4))) short;
using f32x16 = __attribute__((ext_vector_type(16))) float;
using f32x4  = __attribute__((ext_vector_type(4))) float;

#define MFMA32(a, b, c) __builtin_amdgcn_mfma_f32_32x32x16_bf16((a), (b), (c), 0, 0, 0)
#define MFMA16(a, b, c) __builtin_amdgcn_mfma_f32_16x16x32_bf16((a), (b), (c), 0, 0, 0)

constexpr int NTOK = 12288, NCTX = 8192;
constexpr float EPS = 1e-6f;

constexpr size_t OFF_MOD   = 0;
constexpr size_t OFF_ROWSS = OFF_MOD + 73728;
constexpr size_t OFF_ROPE  = OFF_ROWSS + 49152;
constexpr size_t OFF_LAMB  = OFF_ROPE + 8192;
constexpr size_t OFF_LAMP  = OFF_LAMB + 32768;
constexpr size_t OFF_BB    = OFF_LAMP + 32768;
constexpr size_t OFF_CMB   = OFF_BB + 524288;
constexpr size_t OFF_E     = OFF_CMB + 262144;
constexpr size_t OFF_WIN0  = OFF_E + 1572864;
constexpr size_t OFF_GLU   = OFF_WIN0 + 4718592;
constexpr size_t OFF_WOUT0 = OFF_GLU + 524288;
constexpr size_t OFF_WIN1  = OFF_WOUT0 + 2097152;
constexpr size_t OFF_FNET  = OFF_WIN1 + 6291456;
constexpr size_t OFF_WOUT1 = OFF_FNET + 524288;
constexpr size_t OFF_ACTX  = OFF_WOUT1 + 2097152;
constexpr size_t OFF_ALAT  = OFF_ACTX + 262144;
constexpr size_t OFF_X1    = OFF_ALAT + 16777216;
constexpr size_t OFF_HN    = OFF_X1 + 50331648;
constexpr size_t OFF_MIX   = OFF_HN + 25165824;
constexpr size_t OFF_O     = OFF_MIX + 25165824;
constexpr size_t OFF_U     = OFF_O;
constexpr size_t OFF_R     = OFF_O + 25165824;
constexpr size_t OFF_QB = OFF_R;
constexpr size_t OFF_KC = OFF_QB + 12582912;
constexpr size_t OFF_KL = OFF_KC + 2097152;
constexpr size_t OFF_VC = OFF_KL + 1310720;
constexpr size_t OFF_VL = OFF_VC + 2097152;
constexpr size_t OFF_GA = OFF_VL + 1310720;
constexpr size_t OFF_GB = OFF_GA + 12582912;
constexpr size_t OFF_YF = OFF_GB + 12582912;
constexpr size_t OFF_YB = OFF_YF + 12582912;
constexpr size_t OFF_YG = OFF_YB + 12582912;
constexpr size_t END_L0 = OFF_YG + 12582912;
constexpr size_t OFF_CUG = OFF_R;
constexpr size_t OFF_GCS = OFF_CUG + 12582912;
constexpr size_t OFF_GDS = OFF_GCS + 12582912;
constexpr size_t OFF_CVT = OFF_GDS + 12582912;
constexpr size_t OFF_FZ  = OFF_CVT + 12582912;
constexpr size_t OFF_ZTC = OFF_FZ + 12582912;
constexpr size_t OFF_ZTL = OFF_ZTC + 16777216;
constexpr size_t END_L1 = OFF_ZTL + 8388608;
constexpr size_t WS_NEED = (END_L0 > END_L1 ? END_L0 : END_L1);
constexpr size_t OFF_BAR = WS_NEED;
constexpr size_t WS_TOTAL = OFF_BAR + 16384;
static_assert(WS_TOTAL <= (size_t)256 * 1024 * 1024, "workspace too large");

constexpr size_t OUT_Y = 0, OUT_K = 12582912, OUT_V = 13631488, OUT_S = 14680064;

struct Params {
  const float* in[31];
  float* out;
  unsigned char* ws;
  int ph_lo, ph_hi;
};

DI unsigned short f2bf(float x) { unsigned u = __float_as_uint(x); u += 0x7fffu + ((u >> 16) & 1u); return (unsigned short)(u >> 16); }
DI float bf2f(unsigned short b) { return __uint_as_float(((unsigned)b) << 16); }
DI unsigned pk2(float lo, float hi) { return (unsigned)f2bf(lo) | ((unsigned)f2bf(hi) << 16); }
DI float wave_sum(float v) {
#pragma unroll
  for (int o = 1; o < 64; o <<= 1) v += __shfl_xor(v, o);
  return v;
}
DI float half_sum32(float v) {
#pragma unroll
  for (int o = 1; o < 32; o <<= 1) v += __shfl_xor(v, o);
  return v;
}
DI float silu_f(float x) { return x / (1.f + __expf(-x)); }
DI float sigmoid_f(float x) { return 1.f / (1.f + __expf(-x)); }
DI float gelu_f(float x) { float z = 0.7978845608028654f * (x + 0.044715f * x * x * x); return x / (1.f + __expf(-2.f * z)); }
DI int crow(int i, int h) { return (i & 3) + 8 * (i >> 2) + 4 * h; }
DI const float* xrow(const Params& p, int T) { return T < NCTX ? p.in[0] + (size_t)T * 1024 : p.in[1] + (size_t)(T - NCTX) * 1024; }
DI int cond_of(int T) { return T < NCTX ? 0 : 1 + ((T - NCTX) >> 11); }

template <int BN, class AL, class BL, class EP>
DI void gemm_tile(int nk, AL al, BL bl, EP ep, unsigned char* smem) {
  constexpr int NI = BN / 64;
  constexpr int NB = BN / 32;
  unsigned short* As = (unsigned short*)smem;
  unsigned short* Bs = As + 128 * 72;
  const int tid = threadIdx.x, lane = tid & 63, wave = tid >> 6, l32 = lane & 31, h = lane >> 5;
  const int wm = wave >> 1, wn = wave & 1;
  f32x16 acc[2][NI];
#pragma unroll
  for (int mi = 0; mi < 2; ++mi)
#pragma unroll
    for (int ni = 0; ni < NI; ++ni)
#pragma unroll
      for (int i = 0; i < 16; ++i) acc[mi][ni][i] = 0.f;
  uint4 ra[4], rb[NB];
#pragma unroll
  for (int i = 0; i < 4; ++i) { const int id = tid + 256 * i; ra[i] = al(id >> 3, (id & 7) * 8); }
#pragma unroll
  for (int i = 0; i < NB; ++i) { const int id = tid + 256 * i; rb[i] = bl(id >> 3, (id & 7) * 8); }
  for (int kt = 0; kt < nk; ++kt) {
    __syncthreads();
#pragma unroll
    for (int i = 0; i < 4; ++i) { const int id = tid + 256 * i; *(uint4*)(As + (id >> 3) * 72 + (id & 7) * 8) = ra[i]; }
#pragma unroll
    for (int i = 0; i < NB; ++i) { const int id = tid + 256 * i; *(uint4*)(Bs + (id >> 3) * 72 + (id & 7) * 8) = rb[i]; }
    __syncthreads();
    if (kt + 1 < nk) {
      const int kb = (kt + 1) * 64;
#pragma unroll
      for (int i = 0; i < 4; ++i) { const int id = tid + 256 * i; ra[i] = al(id >> 3, kb + (id & 7) * 8); }
#pragma unroll
      for (int i = 0; i < NB; ++i) { const int id = tid + 256 * i; rb[i] = bl(id >> 3, kb + (id & 7) * 8); }
    }
#pragma unroll
    for (int ks = 0; ks < 4; ++ks) {
      bf16x8 a[2], b[NI];
#pragma unroll
      for (int mi = 0; mi < 2; ++mi) a[mi] = *(const bf16x8*)(As + (wm * 64 + mi * 32 + l32) * 72 + ks * 16 + h * 8);
#pragma unroll
      for (int ni = 0; ni < NI; ++ni) b[ni] = *(const bf16x8*)(Bs + (wn * (BN / 2) + ni * 32 + l32) * 72 + ks * 16 + h * 8);
#pragma unroll
      for (int mi = 0; mi < 2; ++mi)
#pragma unroll
        for (int ni = 0; ni < NI; ++ni) acc[mi][ni] = MFMA32(a[mi], b[ni], acc[mi][ni]);
    }
  }
  ep(acc);
}

struct LdBf {
  const bfr* base; size_t ld;
  DI uint4 operator()(int r, int k) const { return *(const uint4*)(base + (size_t)r * ld + k); }
};

#define XB_TMO      128
#define XB_XCNT(j)  (256  + 64 * (j))
#define XB_XSUB(j)  (1280 + 64 * (j))
#define XB_XGEN(j)  (2304 + 64 * (j))
#define XB_TOP      3328
#define XB_TOPGEN   3392
#define XCD_BAR_WORDS 3456
#define XB_SPIN_CAP (1u << 20)
#define LAS __attribute__((address_space(3)))
DI unsigned xb_ld(unsigned* p)              { return __hip_atomic_load(p, __ATOMIC_RELAXED, __HIP_MEMORY_SCOPE_AGENT); }
DI unsigned xb_add(unsigned* p, unsigned v) { return __hip_atomic_fetch_add(p, v, __ATOMIC_RELAXED, __HIP_MEMORY_SCOPE_AGENT); }
DI unsigned xb_xcc_id() { return (unsigned)__builtin_amdgcn_s_getreg((3 << 11) | 20) & 0xFu; }
#define XB_SPIN(cond, bar) do { unsigned _sp = 0; while (cond) { __builtin_amdgcn_s_sleep(1); \
    if ((++_sp & 255u) == 0u) { if (xb_ld(&(bar)[XB_TMO])) break; if (_sp > XB_SPIN_CAP) { atomicAdd(&(bar)[XB_TMO], 1u); break; } } } } while (0)
struct XcdBarrier { unsigned* bar; unsigned x; volatile LAS unsigned* st; };
DI XcdBarrier xcd_barrier_post(unsigned* bar, volatile LAS unsigned* st) {
  XcdBarrier b; b.bar = bar; b.x = xb_xcc_id(); b.st = st;
  if (threadIdx.x == 0) (void)xb_add(&bar[XB_XCNT(b.x)], 1u);
  return b;
}
DI void xcd_barrier_complete(unsigned* bar, unsigned x, unsigned& nloc, unsigned& nx) {
  const unsigned G = gridDim.x * gridDim.y * gridDim.z;
  unsigned sum, cnt, mine, sp = 0u;
  for (;;) {
    sum = 0u; cnt = 0u; mine = 0u;
#pragma unroll
    for (unsigned j = 0; j < 16; ++j) { const unsigned c = xb_ld(&bar[XB_XCNT(j)]); sum += c; cnt += (c > 0u) ? 1u : 0u; mine = (j == x) ? c : mine; }
    if (sum == G) break;
    __builtin_amdgcn_s_sleep(1);
    if ((++sp & 255u) == 0u) { if (xb_ld(&bar[XB_TMO])) break; if (sp > XB_SPIN_CAP) { atomicAdd(&bar[XB_TMO], 1u); break; } }
  }
  nloc = mine > 0u ? mine : 1u; nx = cnt > 0u ? cnt : 1u;
}
DI void xcd_barrier(const XcdBarrier& b) {
  asm volatile("s_waitcnt vmcnt(0)" ::: "memory");
  __syncthreads();
  if (threadIdx.x == 0) {
    unsigned* bar = b.bar;
    __builtin_amdgcn_s_waitcnt(0);
    unsigned nloc = b.st[0], nx = b.st[1];
    if (nloc == 0u) { xcd_barrier_complete(bar, b.x, nloc, nx); b.st[0] = nloc; b.st[1] = nx; }
    const unsigned old = xb_add(&bar[XB_XSUB(b.x)], 1u);
    const unsigned gen = old / nloc;
    if (old + 1u == (gen + 1u) * nloc) {
      __builtin_amdgcn_fence(__ATOMIC_RELEASE, "agent");
      asm volatile("s_waitcnt vmcnt(0)" ::: "memory");
      const unsigned og = xb_add(&bar[XB_TOP], 1u);
      const unsigned tg = og / nx;
      if (og + 1u == (tg + 1u) * nx) xb_add(&bar[XB_TOPGEN], 1u);
      else XB_SPIN(xb_ld(&bar[XB_TOPGEN]) == tg, bar);
      __builtin_amdgcn_fence(__ATOMIC_ACQUIRE, "agent");
      xb_add(&bar[XB_XGEN(b.x)], 1u);
      asm volatile("s_waitcnt vmcnt(0)" ::: "memory");
    } else {
      XB_SPIN(xb_ld(&bar[XB_XGEN(b.x)]) == gen, bar);
      __builtin_amdgcn_fence(__ATOMIC_ACQUIRE, "agent");
      asm volatile("s_waitcnt vmcnt(0)" ::: "memory");
    }
  }
  __syncthreads();
}

DI void transpose_tile(const float* W, int ldw, int kbase, int nbase, bfr* WT, int ldt, int trow, float* sm) {
  const int tid = threadIdx.x;
#pragma unroll
  for (int i = 0; i < 4; ++i) {
    const int r = (tid >> 4) + 16 * i, c = (tid & 15) * 4;
    const float4 v = *(const float4*)(W + (size_t)(kbase + r) * ldw + nbase + c);
    sm[r * 65 + c] = v.x; sm[r * 65 + c + 1] = v.y; sm[r * 65 + c + 2] = v.z; sm[r * 65 + c + 3] = v.w;
  }
  __syncthreads();
  const int n = tid >> 2, kc = (tid & 3) * 16;
  unsigned o[8];
#pragma unroll
  for (int j = 0; j < 8; ++j) o[j] = pk2(sm[(kc + 2 * j) * 65 + n], sm[(kc + 2 * j + 1) * 65 + n]);
  uint4* dst = (uint4*)(WT + (size_t)(trow + n) * ldt + kbase + kc);
  dst[0] = make_uint4(o[0], o[1], o[2], o[3]);
  dst[1] = make_uint4(o[4], o[5], o[6], o[7]);
}

DI void phase0(const Params& p, unsigned char* smem) {
  const int tid = threadIdx.x;
  float* smf = (float*)smem;
  unsigned char* ws = p.ws;
  constexpr int N_ADA = 192;
  constexpr int N_T0 = 16 * 36, N_TG = 64, N_TO0 = 256, N_T1A = 16 * 24, N_T1B = 16 * 8, N_TF = 64, N_TO1 = 256;
  constexpr int N_FOLD = 128, N_ALAT = 2048, N_ACTX = 256, N_CACHE = 64, N_SSM = 64, N_ZERO = 48, N_ROPE = 4;
  constexpr int B_T0 = N_ADA, B_TG = B_T0 + N_T0, B_TO0 = B_TG + N_TG, B_T1A = B_TO0 + N_TO0, B_T1B = B_T1A + N_T1A,
                B_TF = B_T1B + N_T1B, B_TO1 = B_TF + N_TF, B_FOLD = B_TO1 + N_TO1, B_ALAT = B_FOLD + N_FOLD,
                B_ACTX = B_ALAT + N_ALAT, B_CACHE = B_ACTX + N_ACTX, B_SSM = B_CACHE + N_CACHE, B_ZERO = B_SSM + N_SSM,
                B_ROPE = B_ZERO + N_ZERO, N_ALL = B_ROPE + N_ROPE;
  for (int it = blockIdx.x; it < N_ALL; it += gridDim.x) {
    __syncthreads();
    if (it < B_T0) {
      const int l = it / 96, cgp = it % 96;
      float* sc = smf;
      float* red = smf + 3072;
      for (int e = tid; e < 3072; e += 256) {
        const int ci = e >> 10, k = e & 1023;
        const float cv = ci == 0 ? p.in[6][k] : p.in[5][(ci - 1) * 1024 + k];
        sc[e] = silu_f(cv);
      }
      __syncthreads();
      const int col = tid & 31, kq = tid >> 5, n = cgp * 32 + col;
      const float* w = p.in[7] + (size_t)l * 1024 * 3072 + n;
      float a0 = 0.f, a1 = 0.f, a2 = 0.f;
#pragma unroll 8
      for (int k = kq; k < 1024; k += 8) {
        const float wv = w[(size_t)k * 3072];
        a0 += sc[k] * wv; a1 += sc[1024 + k] * wv; a2 += sc[2048 + k] * wv;
      }
      red[(kq * 32 + col) * 3 + 0] = a0; red[(kq * 32 + col) * 3 + 1] = a1; red[(kq * 32 + col) * 3 + 2] = a2;
      __syncthreads();
      if (tid < 96) {
        const int c2 = tid & 31, ci = tid >> 5;
        float s = 0.f;
#pragma unroll
        for (int q = 0; q < 8; ++q) s += red[(q * 32 + c2) * 3 + ci];
        const int n2 = cgp * 32 + c2;
        ((float*)(ws + OFF_MOD))[(l * 3 + ci) * 3072 + n2] = s + p.in[8][l * 3072 + n2];
      }
    } else if (it < B_FOLD) {
      const float* W; int ldw, nbase_off = 0, trow_off = 0, ntn, ldt; bfr* WT; int r;
      if (it < B_TG)        { r = it - B_T0;  W = p.in[11]; ldw = 2304; ntn = 36; WT = (bfr*)(ws + OFF_WIN0); ldt = 1024; }
      else if (it < B_TO0)  { r = it - B_TG;  W = p.in[22]; ldw = 512;  ntn = 8;  WT = (bfr*)(ws + OFF_GLU); ldt = 512; }
      else if (it < B_T1A)  { r = it - B_TO0; W = p.in[24]; ldw = 1024; ntn = 16; WT = (bfr*)(ws + OFF_WOUT0); ldt = 1024; }
      else if (it < B_T1B)  { r = it - B_T1A; W = p.in[25]; ldw = 2560; ntn = 24; WT = (bfr*)(ws + OFF_WIN1); ldt = 1024; }
      else if (it < B_TF)   { r = it - B_T1B; W = p.in[25]; ldw = 2560; ntn = 8;  WT = (bfr*)(ws + OFF_WIN1); ldt = 1024; nbase_off = 2048; trow_off = 2560; }
      else if (it < B_TO1)  { r = it - B_TF;  W = p.in[29]; ldw = 512;  ntn = 8;  WT = (bfr*)(ws + OFF_FNET); ldt = 512; }
      else                  { r = it - B_TO1; W = p.in[30]; ldw = 1024; ntn = 16; WT = (bfr*)(ws + OFF_WOUT1); ldt = 1024; }
      const int kb = r / ntn, nb = r % ntn;
      transpose_tile(W, ldw, kb * 64, nbase_off + nb * 64, WT, ldt, trow_off + nb * 64, smf);
    } else if (it < B_ALAT) {
      const int r = it - B_FOLD, cs = r & 1, kb = (r >> 1) & 15, g = r >> 5;
      float* tile = smf;
      float* tw = smf + 128 * 68;
      const float* W = p.in[25];
      {
        const int c4 = (tid & 31) * 4, kr = tid >> 5;
#pragma unroll
        for (int i = 0; i < 8; ++i) {
          const int k = kr + 8 * i;
          const float4 v = *(const float4*)(W + (size_t)(kb * 64 + k) * 2560 + 1536 + g * 128 + c4);
          tile[(c4 + 0) * 68 + k] = v.x; tile[(c4 + 1) * 68 + k] = v.y; tile[(c4 + 2) * 68 + k] = v.z; tile[(c4 + 3) * 68 + k] = v.w;
        }
        if (tid < 128) {
          const float a = 2.f * (float)tid / 128.f;
          tw[tid] = (cs == 0 ? cospif(a) : sinpif(a)) * 0.08838834764831845f;
        }
      }
      __syncthreads();
      const int j = tid & 127, kg = tid >> 7;
      float acc[32];
#pragma unroll
      for (int i = 0; i < 32; ++i) acc[i] = 0.f;
      for (int c = 0; c < 128; ++c) {
        const float t = tw[(j * c) & 127];
        const float4* tp = (const float4*)(tile + c * 68 + kg * 32);
#pragma unroll
        for (int q = 0; q < 8; ++q) {
          const float4 v = tp[q];
          acc[4 * q + 0] += v.x * t; acc[4 * q + 1] += v.y * t; acc[4 * q + 2] += v.z * t; acc[4 * q + 3] += v.w * t;
        }
      }
      uint4* dst = (uint4*)((bfr*)(ws + OFF_WIN1) + (size_t)(1536 + cs * 512 + g * 128 + j) * 1024 + kb * 64 + kg * 32);
#pragma unroll
      for (int q = 0; q < 4; ++q)
        dst[q] = make_uint4(pk2(acc[8 * q], acc[8 * q + 1]), pk2(acc[8 * q + 2], acc[8 * q + 3]), pk2(acc[8 * q + 4], acc[8 * q + 5]), pk2(acc[8 * q + 6], acc[8 * q + 7]));
    } else if (it < B_ACTX) {
      const int t = it - B_ALAT;
      bfr* dst = (bfr*)(ws + OFF_ALAT) + (size_t)t * 4096;
      const float nrm = 0.02209708691207961f;
#pragma unroll
      for (int half = 0; half < 2; ++half) {
        const int k0 = half * 2048 + tid * 8;
        unsigned o[4];
#pragma unroll
        for (int j = 0; j < 4; ++j) {
          float v[2];
#pragma unroll
          for (int e = 0; e < 2; ++e) {
            const int k = k0 + 2 * j + e;
            const int m = (t * (k & 2047)) & 2047;
            const float a = (float)m * (2.f / 2048.f);
            v[e] = (k < 2048 ? cospif(a) : -sinpif(a)) * nrm;
          }
          o[j] = pk2(v[0], v[1]);
        }
        *(uint4*)(dst + k0) = make_uint4(o[0], o[1], o[2], o[3]);
      }
    } else if (it < B_CACHE) {
      const int t = it - B_ACTX;
      bfr* dst = (bfr*)(ws + OFF_ACTX) + (size_t)t * 512;
      const float nrm = 0.0625f;
      float v[2];
#pragma unroll
      for (int e = 0; e < 2; ++e) {
        const int k = tid * 2 + e;
        const int m = (t * (k & 255)) & 255;
        const float a = (float)m * (2.f / 256.f);
        v[e] = (k < 256 ? cospif(a) : -sinpif(a)) * nrm;
      }
      *(unsigned*)(dst + tid * 2) = pk2(v[0], v[1]);
    } else if (it < B_SSM) {
      const int r = it - B_CACHE;
#pragma unroll
      for (int i = 0; i < 8; ++i) {
        const int e = r * 2048 + tid + 256 * i;
        const int d = e & 63, kvh = (e >> 6) & 1, key = (e >> 7) & 511, b = e >> 16;
        ((bfr*)(ws + OFF_KL))[((size_t)(b * 2 + kvh) * 2560 + key) * 64 + d] = f2bf(p.in[2][e]);
        ((bfr*)(ws + OFF_VL))[((size_t)(b * 2 + kvh) * 64 + d) * 2560 + key] = f2bf(p.in[3][e]);
      }
    } else if (it < B_ZERO) {
      const int dg = it - B_SSM;
      const int pp = tid & 63, part = tid >> 6;
      const double lr = (double)p.in[14][dg * 64 + pp], li = (double)p.in[15][dg * 64 + pp];
      const double dt = (double)__expf(p.in[16][dg]) ;
      const float dtf = expf(p.in[16][dg]);
      const double dtd = (double)dtf;
      (void)dt;
      const double PI = 3.14159265358979323846;
      double ap = li * dtd / PI;
      double ar = ap - 2.0 * rint(ap * 0.5);
      const float er = expf((float)(lr * dtd));
      const double lbr = (double)er * (double)cospif((float)ar), lbi = (double)er * (double)sinpif((float)ar);
      double ap2 = ap * 256.0;
      double ar2 = ap2 - 2.0 * rint(ap2 * 0.5);
      const float er2 = expf((float)(lr * dtd * 256.0));
      if (part == 0) {
        ((float2*)(ws + OFF_LAMB))[dg * 64 + pp] = make_float2((float)lbr, (float)lbi);
        ((float2*)(ws + OFF_LAMP))[dg * 64 + pp] = make_float2(er2 * cospif((float)ar2), er2 * sinpif((float)ar2));
      }
      const double den = lr * lr + li * li;
      const double fr = ((lbr - 1.0) * lr + lbi * li) / den, fi = (lbi * lr - (lbr - 1.0) * li) / den;
      float* bb = (float*)(ws + OFF_BB) + (size_t)(dg * 64 + pp) * 32;
#pragma unroll
      for (int q = 0; q < 4; ++q) {
        const int c = part * 4 + q;
        const double br = (double)p.in[17][(size_t)(dg * 64 + pp) * 16 + c], bi = (double)p.in[18][(size_t)(dg * 64 + pp) * 16 + c];
        bb[c] = (float)(fr * br - fi * bi);
        bb[16 + c] = (float)(fr * bi + fi * br);
      }
      bfr* cm = (bfr*)(ws + OFF_CMB) + (size_t)dg * 2048;
#pragma unroll
      for (int q = 0; q < 8; ++q) {
        const int e = tid * 8 + q, c = e >> 7, k = e & 127;
        const float v = k < 64 ? p.in[19][(size_t)(dg * 16 + c) * 64 + k] : -p.in[20][(size_t)(dg * 16 + c) * 64 + (k - 64)];
        cm[e] = f2bf(v);
      }
    } else if (it < B_ROPE) {
      const int r = it - B_ZERO;
      ((float*)(ws + OFF_ROWSS))[r * 256 + tid] = 0.f;
    } else {
      const int e = (it - B_ROPE) * 256 + tid;
      const int n = e >> 4, pr = e & 15;
      const double q4[4] = {1.0, 0.5623413251903491, 0.31622776601683794, 0.1778279410038923};
      double inv = q4[0];
      if ((pr & 3) == 1) inv = q4[1]; else if ((pr & 3) == 2) inv = q4[2]; else if ((pr & 3) == 3) inv = q4[3];
      const int dec = pr >> 2;
      if (dec == 1) inv *= 0.1; else if (dec == 2) inv *= 0.01; else if (dec == 3) inv *= 0.001;
      const double ap = (double)n * inv / 3.14159265358979323846;
      const double ar = ap - 2.0 * rint(ap * 0.5);
      ((float2*)(ws + OFF_ROPE))[e] = make_float2(cospif((float)ar), sinpif((float)ar));
    }
  }
}

template <int MODE>
DI void phase_rows(const Params& p) {
  unsigned char* ws = p.ws;
  const int lane = threadIdx.x & 63, wave = threadIdx.x >> 6;
  const float* mod = (const float*)(ws + OFF_MOD);
  for (int it = blockIdx.x; it < NTOK / 4; it += gridDim.x) {
    const int T = it * 4 + wave;
    const int ci = cond_of(T);
    float4 xv[4];
    if (MODE == 2) {
      const float4* xr = (const float4*)((const float*)(ws + OFF_X1) + (size_t)T * 1024) + lane;
#pragma unroll
      for (int j = 0; j < 4; ++j) xv[j] = xr[64 * j];
    } else {
      const float4* xr = (const float4*)xrow(p, T) + lane;
#pragma unroll
      for (int j = 0; j < 4; ++j) xv[j] = xr[64 * j];
    }
    if (MODE >= 1) {
      const int l = MODE - 1;
      const bfr* orow = (const bfr*)(ws + OFF_O) + (size_t)T * 1024;
      float4 ov[4]; float ss = 0.f;
#pragma unroll
      for (int j = 0; j < 4; ++j) {
        const uint2 raw = *(const uint2*)(orow + lane * 4 + 256 * j);
        ov[j].x = bf2f(raw.x & 0xffff); ov[j].y = bf2f(raw.x >> 16); ov[j].z = bf2f(raw.y & 0xffff); ov[j].w = bf2f(raw.y >> 16);
        ss += ov[j].x * ov[j].x + ov[j].y * ov[j].y + ov[j].z * ov[j].z + ov[j].w * ov[j].w;
      }
      const float rinv = rsqrtf(wave_sum(ss) * (1.f / 1024.f) + EPS);
      const float* gate = mod + (l * 3 + ci) * 3072 + 2048;
      const float* gp = p.in[10] + l * 1024;
#pragma unroll
      for (int j = 0; j < 4; ++j) {
        const int k = lane * 4 + 256 * j;
        const float4 g4 = *(const float4*)(gate + k), n4 = *(const float4*)(gp + k);
        xv[j].x += g4.x * (ov[j].x * rinv * n4.x); xv[j].y += g4.y * (ov[j].y * rinv * n4.y);
        xv[j].z += g4.z * (ov[j].z * rinv * n4.z); xv[j].w += g4.w * (ov[j].w * rinv * n4.w);
      }
      if (MODE == 2) {
        float4* yr = (float4*)(p.out + OUT_Y + (size_t)T * 1024) + lane;
#pragma unroll
        for (int j = 0; j < 4; ++j) yr[64 * j] = xv[j];
      } else {
        float4* x1r = (float4*)((float*)(ws + OFF_X1) + (size_t)T * 1024) + lane;
#pragma unroll
        for (int j = 0; j < 4; ++j) x1r[64 * j] = xv[j];
      }
    }
    if (MODE <= 1) {
      const int l = MODE;
      float ss = 0.f;
#pragma unroll
      for (int j = 0; j < 4; ++j) ss += xv[j].x * xv[j].x + xv[j].y * xv[j].y + xv[j].z * xv[j].z + xv[j].w * xv[j].w;
      const float rinv = rsqrtf(wave_sum(ss) * (1.f / 1024.f) + EPS);
      const float* shift = mod + (l * 3 + ci) * 3072;
      const float* scale = shift + 1024;
      const float* gp = p.in[9] + l * 1024;
      bfr* hr = (bfr*)(ws + OFF_HN) + (size_t)T * 1024;
#pragma unroll
      for (int j = 0; j < 4; ++j) {
        const int k = lane * 4 + 256 * j;
        const float4 s4 = *(const float4*)(shift + k), c4 = *(const float4*)(scale + k), n4 = *(const float4*)(gp + k);
        const float a = xv[j].x * rinv * n4.x * (1.f + c4.x) + s4.x;
        const float b = xv[j].y * rinv * n4.y * (1.f + c4.y) + s4.y;
        const float c = xv[j].z * rinv * n4.z * (1.f + c4.z) + s4.z;
        const float d = xv[j].w * rinv * n4.w * (1.f + c4.w) + s4.w;
        *(uint2*)(hr + k) = make_uint2(pk2(a, b), pk2(c, d));
      }
    }
  }
}

DI void phase_win0(const Params& p, unsigned char* smem) {
  unsigned char* ws = p.ws;
  const int lane = threadIdx.x & 63, wave = threadIdx.x >> 6, l32 = lane & 31, h = lane >> 5, wm = wave >> 1, wn = wave & 1;
  const bfr* A = (const bfr*)(ws + OFF_HN);
  const bfr* Bt = (const bfr*)(ws + OFF_WIN0);
  for (int it = blockIdx.x; it < 96 * 18; it += gridDim.x) {
    const int tm = it / 18, tn = it % 18;
    const int m0 = tm * 128, n0 = tn * 128;
    LdBf al{A + (size_t)m0 * 1024, 1024}, bl{Bt + (size_t)n0 * 1024, 1024};
    auto ep = [&](f32x16 (&acc)[2][2]) {
      const int colbase = n0 + wn * 64, rbase = m0 + wm * 64;
      const bool lat = m0 >= NCTX;
      if (colbase < 640) {
        const bool isq = colbase < 512;
        const float* gain = isq ? p.in[12] : p.in[13];
        const float g0 = gain[l32], g1 = gain[32 + l32];
        const int hd = isq ? (colbase >> 6) : ((colbase - 512) >> 6);
        const float2* rope = (const float2*)(ws + OFF_ROPE);
        const float sgn = (l32 & 16) ? 1.f : -1.f;
#pragma unroll
        for (int mi = 0; mi < 2; ++mi)
#pragma unroll
          for (int i = 0; i < 16; ++i) {
            float v0 = acc[mi][0][i], v1 = acc[mi][1][i];
            const float ss = half_sum32(v0 * v0 + v1 * v1);
            const float rinv = rsqrtf(ss * (1.f / 64.f) + EPS);
            v0 *= rinv * g0; v1 *= rinv * g1;
            const int r = rbase + mi * 32 + crow(i, h);
            if (!lat && !isq) {
              p.out[OUT_K + (size_t)r * 128 + hd * 64 + l32] = v0;
              p.out[OUT_K + (size_t)r * 128 + hd * 64 + 32 + l32] = v1;
            }
            if (lat) {
              const int pos = (r - NCTX) & 2047, prow = pos >> 6, pcol = pos & 63;
              const float2 c0 = rope[prow * 16 + (l32 & 15)], c1 = rope[pcol * 16 + (l32 & 15)];
              const float q0 = __shfl_xor(v0, 16), q1 = __shfl_xor(v1, 16);
              v0 = v0 * c0.x + sgn * q0 * c0.y;
              v1 = v1 * c1.x + sgn * q1 * c1.y;
            }
            if (isq) {
              bfr* q = (bfr*)(ws + OFF_QB) + (size_t)r * 512 + hd * 64;
              q[l32] = f2bf(v0 * 0.125f); q[32 + l32] = f2bf(v1 * 0.125f);
            } else if (!lat) {
              const int b = r >> 8, l = r & 255;
              bfr* k = (bfr*)(ws + OFF_KC) + ((size_t)(b * 2 + hd) * 256 + l) * 64;
              k[l32] = f2bf(v0); k[32 + l32] = f2bf(v1);
            } else {
              const int b = (r - NCTX) >> 11, l = (r - NCTX) & 2047;
              bfr* k = (bfr*)(ws + OFF_KL) + ((size_t)(b * 2 + hd) * 2560 + 512 + l) * 64;
              k[l32] = f2bf(v0); k[32 + l32] = f2bf(v1);
            }
          }
      } else if (colbase < 768) {
        const int hd = (colbase - 640) >> 6;
#pragma unroll
        for (int mi = 0; mi < 2; ++mi)
#pragma unroll
          for (int ni = 0; ni < 2; ++ni) {
            const int d = ni * 32 + l32;
#pragma unroll
            for (int i4 = 0; i4 < 4; ++i4) {
              const int r0 = rbase + mi * 32 + 8 * i4 + 4 * h;
              const float a = acc[mi][ni][4 * i4], b2 = acc[mi][ni][4 * i4 + 1], c = acc[mi][ni][4 * i4 + 2], e = acc[mi][ni][4 * i4 + 3];
              const uint2 pk = make_uint2(pk2(a, b2), pk2(c, e));
              if (!lat) {
                p.out[OUT_V + (size_t)(r0 + 0) * 128 + hd * 64 + d] = a;
                p.out[OUT_V + (size_t)(r0 + 1) * 128 + hd * 64 + d] = b2;
                p.out[OUT_V + (size_t)(r0 + 2) * 128 + hd * 64 + d] = c;
                p.out[OUT_V + (size_t)(r0 + 3) * 128 + hd * 64 + d] = e;
                const int b = r0 >> 8, l = r0 & 255;
                *(uint2*)((bfr*)(ws + OFF_VC) + ((size_t)(b * 2 + hd) * 64 + d) * 256 + l) = pk;
              } else {
                const int b = (r0 - NCTX) >> 11, l = (r0 - NCTX) & 2047;
                *(uint2*)((bfr*)(ws + OFF_VL) + ((size_t)(b * 2 + hd) * 64 + d) * 2560 + 512 + l) = pk;
              }
            }
          }
      } else {
        const int sec = colbase < 1280 ? 0 : (colbase < 1792 ? 1 : 2);
        const int cb = colbase - (sec == 0 ? 768 : (sec == 1 ? 1280 : 1792));
#pragma unroll
        for (int mi = 0; mi < 2; ++mi)
#pragma unroll
          for (int ni = 0; ni < 2; ++ni)
#pragma unroll
            for (int i = 0; i < 16; ++i) {
              const int r = rbase + mi * 32 + crow(i, h);
              const int c = cb + ni * 32 + l32;
              const float v = acc[mi][ni][i];
              if (sec == 0) ((bfr*)(ws + OFF_GA))[(size_t)r * 512 + c] = f2bf(silu_f(v));
              else if (sec == 1) ((float*)(ws + OFF_U))[(size_t)r * 512 + c] = v;
              else ((bfr*)(ws + OFF_GB))[(size_t)r * 512 + c] = f2bf(silu_f(v));
            }
      }
    };
    gemm_tile<128>(16, al, bl, ep, smem);
  }
}

DI void attn_item(const Params& p, unsigned char* smem, int it) {
  unsigned char* ws = p.ws;
  const int tid = threadIdx.x, lane = tid & 63, wave = tid >> 6, l32 = lane & 31, h = lane >> 5;
  int T0, nkeys, ldv; const bfr *Kp, *Vp; int kvh;
  if (it < 256) {
    const int b = it >> 7, qt = it & 63; kvh = (it >> 6) & 1;
    T0 = NCTX + b * 2048 + qt * 32; nkeys = 2560; ldv = 2560;
    Kp = (const bfr*)(ws + OFF_KL) + (size_t)(b * 2 + kvh) * 2560 * 64;
    Vp = (const bfr*)(ws + OFF_VL) + (size_t)(b * 2 + kvh) * 64 * 2560;
  } else {
    const int i2 = it - 256; const int b = i2 >> 4, qt = i2 & 7; kvh = (i2 >> 3) & 1;
    T0 = b * 256 + qt * 32; nkeys = 256; ldv = 256;
    Kp = (const bfr*)(ws + OFF_KC) + (size_t)(b * 2 + kvh) * 256 * 64;
    Vp = (const bfr*)(ws + OFF_VC) + (size_t)(b * 2 + kvh) * 64 * 256;
  }
  const int head = kvh * 4 + wave;
  unsigned short* Ks = (unsigned short*)smem;
  unsigned short* Vs = Ks + 64 * 72;
  bf16x8 qf[4];
  {
    const bfr* q = (const bfr*)(ws + OFF_QB) + (size_t)(T0 + l32) * 512 + head * 64 + 8 * h;
#pragma unroll
    for (int ks = 0; ks < 4; ++ks) qf[ks] = *(const bf16x8*)(q + 16 * ks);
  }
  float m = -1e30f, lsum = 0.f;
  f32x16 O[2];
#pragma unroll
  for (int i = 0; i < 16; ++i) { O[0][i] = 0.f; O[1][i] = 0.f; }
  for (int k0 = 0; k0 < nkeys; k0 += 64) {
    __syncthreads();
#pragma unroll
    for (int i = 0; i < 2; ++i) {
      const int id = tid + 256 * i, rr = id >> 3, cc = (id & 7) * 8;
      *(uint4*)(Ks + rr * 72 + cc) = *(const uint4*)(Kp + (size_t)(k0 + rr) * 64 + cc);
      *(uint4*)(Vs + rr * 72 + cc) = *(const uint4*)(Vp + (size_t)rr * ldv + k0 + cc);
    }
    __syncthreads();
    f32x16 st[2];
#pragma unroll
    for (int kt = 0; kt < 2; ++kt) {
#pragma unroll
      for (int i = 0; i < 16; ++i) st[kt][i] = 0.f;
#pragma unroll
      for (int ks = 0; ks < 4; ++ks) {
        const bf16x8 a = *(const bf16x8*)(Ks + (32 * kt + l32) * 72 + 16 * ks + 8 * h);
        st[kt] = MFMA32(a, qf[ks], st[kt]);
      }
    }
    float mx = st[0][0];
#pragma unroll
    for (int i = 0; i < 16; ++i) { mx = fmaxf(mx, st[0][i]); mx = fmaxf(mx, st[1][i]); }
    mx = fmaxf(mx, __shfl_xor(mx, 32));
    const float mn = fmaxf(m, mx);
    const float alpha = __expf(m - mn);
    m = mn;
    float ps = 0.f;
#pragma unroll
    for (int kt = 0; kt < 2; ++kt)
#pragma unroll
      for (int i = 0; i < 16; ++i) { const float e = __expf(st[kt][i] - mn); st[kt][i] = e; ps += e; }
    lsum = lsum * alpha + ps;
#pragma unroll
    for (int i = 0; i < 16; ++i) { O[0][i] *= alpha; O[1][i] *= alpha; }
#pragma unroll
    for (int kt = 0; kt < 2; ++kt)
#pragma unroll
      for (int s = 0; s < 2; ++s) {
        bf16x8 pf;
#pragma unroll
        for (int j = 0; j < 8; ++j) pf[j] = (short)f2bf(st[kt][8 * s + j]);
#pragma unroll
        for (int dt = 0; dt < 2; ++dt) {
          const unsigned short* vr = Vs + (32 * dt + l32) * 72 + 32 * kt + 16 * s + 4 * h;
          const s16x4 lo = *(const s16x4*)vr, hi = *(const s16x4*)(vr + 8);
          const bf16x8 va = __builtin_shufflevector(lo, hi, 0, 1, 2, 3, 4, 5, 6, 7);
          O[dt] = MFMA32(va, pf, O[dt]);
        }
      }
  }
  const float ltot = lsum + __shfl_xor(lsum, 32);
  const float inv = 1.f / ltot;
  const int T = T0 + l32;
#pragma unroll
  for (int dt = 0; dt < 2; ++dt)
#pragma unroll
    for (int i4 = 0; i4 < 4; ++i4) {
      const int d = 32 * dt + 8 * i4 + 4 * h;
      const uint2 g = *(const uint2*)((const bfr*)(ws + OFF_GA) + (size_t)T * 512 + head * 64 + d);
      const float a = O[dt][4 * i4] * inv * bf2f(g.x & 0xffff), b = O[dt][4 * i4 + 1] * inv * bf2f(g.x >> 16);
      const float c = O[dt][4 * i4 + 2] * inv * bf2f(g.y & 0xffff), e = O[dt][4 * i4 + 3] * inv * bf2f(g.y >> 16);
      *(uint2*)((bfr*)(ws + OFF_MIX) + (size_t)T * 1024 + head * 64 + d) = make_uint2(pk2(a, b), pk2(c, e));
    }
}

DI int seg_T0(int seg) { return seg < 32 ? seg * 256 : NCTX + ((seg - 32) >> 3) * 2048 + ((seg - 32) & 7) * 256; }

DI void s5_item(const Params& p, unsigned char* smem, int it) {
  unsigned char* ws = p.ws;
  const int tid = threadIdx.x, lane = tid & 63, wave = tid >> 6;
  const int di = it & 1, g = (it >> 1) & 31, seg = it >> 6;
  const int T0 = seg_T0(seg);
  const int dg = di * 32 + g;
  float* Us = (float*)smem;
  float* BU = Us + 512;
  float bre[16], bim[16];
  {
    const float4* bb = (const float4*)((const float*)(ws + OFF_BB) + (size_t)(dg * 64 + lane) * 32);
#pragma unroll
    for (int q = 0; q < 4; ++q) { const float4 v = bb[q]; bre[4 * q] = v.x; bre[4 * q + 1] = v.y; bre[4 * q + 2] = v.z; bre[4 * q + 3] = v.w; }
#pragma unroll
    for (int q = 0; q < 4; ++q) { const float4 v = bb[4 + q]; bim[4 * q] = v.x; bim[4 * q + 1] = v.y; bim[4 * q + 2] = v.z; bim[4 * q + 3] = v.w; }
  }
  const float2 lam = ((const float2*)(ws + OFF_LAMB))[dg * 64 + lane];
  bf16x8 cmf[4];
  {
    const bfr* cm = (const bfr*)(ws + OFF_CMB) + (size_t)dg * 2048 + (lane & 15) * 128 + 8 * (lane >> 4);
#pragma unroll
    for (int ks = 0; ks < 4; ++ks) cmf[ks] = *(const bf16x8*)(cm + 32 * ks);
  }
  float hr = 0.f, hi = 0.f;
  bfr* yout = (bfr*)(ws + (di == 0 ? OFF_YF : OFF_YB));
  for (int c = 0; c < 8; ++c) {
    __syncthreads();
    if (tid < 128) {
      const int sl = tid >> 2, q = tid & 3;
      const int sg = 32 * c + sl;
      const int T = di == 0 ? T0 + sg : T0 + 255 - sg;
      *(float4*)(Us + sl * 16 + q * 4) = *(const float4*)((const float*)(ws + OFF_U) + (size_t)T * 512 + g * 16 + q * 4);
    }
    __syncthreads();
#pragma unroll
    for (int s8 = 0; s8 < 8; ++s8) {
      const int sl = wave * 8 + s8;
      const float4* up = (const float4*)(Us + sl * 16);
      float ar = 0.f, ai = 0.f;
#pragma unroll
      for (int q = 0; q < 4; ++q) {
        const float4 u = up[q];
        ar += bre[4 * q] * u.x + bre[4 * q + 1] * u.y + bre[4 * q + 2] * u.z + bre[4 * q + 3] * u.w;
        ai += bim[4 * q] * u.x + bim[4 * q + 1] * u.y + bim[4 * q + 2] * u.z + bim[4 * q + 3] * u.w;
      }
      BU[sl * 132 + lane] = ar; BU[sl * 132 + 64 + lane] = ai;
    }
    __syncthreads();
    if (wave == 0) {
#pragma unroll 8
      for (int sl = 0; sl < 32; ++sl) {
        const float br = BU[sl * 132 + lane], bi = BU[sl * 132 + 64 + lane];
        const float nr = lam.x * hr - lam.y * hi + br;
        const float ni = lam.x * hi + lam.y * hr + bi;
        hr = nr; hi = ni;
        BU[sl * 132 + lane] = hr; BU[sl * 132 + 64 + lane] = hi;
      }
    }
    __syncthreads();
    if (wave < 2) {
      f32x4 acc = {0.f, 0.f, 0.f, 0.f};
      const float* hrow = BU + (16 * wave + (lane & 15)) * 132 + 8 * (lane >> 4);
#pragma unroll
      for (int ks = 0; ks < 4; ++ks) {
        const float4 v0 = *(const float4*)(hrow + 32 * ks), v1 = *(const float4*)(hrow + 32 * ks + 4);
        bf16x8 a;
        a[0] = (short)f2bf(v0.x); a[1] = (short)f2bf(v0.y); a[2] = (short)f2bf(v0.z); a[3] = (short)f2bf(v0.w);
        a[4] = (short)f2bf(v1.x); a[5] = (short)f2bf(v1.y); a[6] = (short)f2bf(v1.z); a[7] = (short)f2bf(v1.w);
        acc = MFMA16(a, cmf[ks], acc);
      }
#pragma unroll
      for (int i = 0; i < 4; ++i) {
        const int sg = 32 * c + 16 * wave + 4 * (lane >> 4) + i;
        const int T = di == 0 ? T0 + sg : T0 + 255 - sg;
        yout[(size_t)T * 512 + g * 16 + (lane & 15)] = f2bf(acc[i]);
      }
    }
  }
  if (wave == 0) {
    ((float2*)(ws + OFF_E))[((size_t)(seg * 2 + di) * 32 + g) * 64 + lane] = make_float2(hr, hi);
    if (seg < 32) {
      float* so = p.out + OUT_S + (size_t)((seg * 2 + di) * 2) * 2048 + g * 64 + lane;
      so[0] = hr; so[2048] = hi;
    }
  }
}

DI void phase_mix0(const Params& p, unsigned char* smem) {
  constexpr int N_ATT = 768, N_S5 = 3072;
  for (int it = blockIdx.x; it < N_ATT + N_S5; it += gridDim.x) {
    __syncthreads();
    if (it < 256) attn_item(p, smem, it);
    else if (it < 256 + N_S5) s5_item(p, smem, it - 256);
    else attn_item(p, smem, it - N_S5);
  }
}

DI void phase_s5fix(const Params& p, unsigned char* smem) {
  unsigned char* ws = p.ws;
  const int tid = threadIdx.x, lane = tid & 63, wave = tid >> 6;
  float* HC = (float*)smem;
  float* ycorr = HC + 32 * 132;
  for (int it = blockIdx.x; it < 48 * 32; it += gridDim.x) {
    const int g = it & 31, seg = it >> 5;
    const int T0 = seg_T0(seg);
    __syncthreads();
    for (int e = tid; e < 4096; e += 256) ycorr[e] = 0.f;
    __syncthreads();
    if (seg >= 32) {
      const int b = (seg - 32) >> 3, j = (seg - 32) & 7;
      for (int di = 0; di < 2; ++di) {
        const int dg = di * 32 + g;
        float hr = 0.f, hi = 0.f, cr = 0.f, cim = 0.f;
        float2 lam = make_float2(0.f, 0.f);
        if (wave == 0) {
          lam = ((const float2*)(ws + OFF_LAMB))[dg * 64 + lane];
          const float2 lp = ((const float2*)(ws + OFF_LAMP))[dg * 64 + lane];
          const float* st = p.in[4] + (size_t)((b * 2 + di) * 2) * 2048 + g * 64 + lane;
          hr = st[0]; hi = st[2048];
          const int nprev = di == 0 ? j : 7 - j;
          for (int q = 0; q < nprev; ++q) {
            const int jj = di == 0 ? q : 7 - q;
            const float2 e = ((const float2*)(ws + OFF_E))[((size_t)((32 + b * 8 + jj) * 2 + di) * 32 + g) * 64 + lane];
            const float nr = lp.x * hr - lp.y * hi + e.x, ni = lp.x * hi + lp.y * hr + e.y;
            hr = nr; hi = ni;
          }
          cr = lam.x; cim = lam.y;
        }
        bf16x8 cmf[4];
        {
          const bfr* cm = (const bfr*)(ws + OFF_CMB) + (size_t)dg * 2048 + (lane & 15) * 128 + 8 * (lane >> 4);
#pragma unroll
          for (int ks = 0; ks < 4; ++ks) cmf[ks] = *(const bf16x8*)(cm + 32 * ks);
        }
        for (int c = 0; c < 8; ++c) {
          __syncthreads();
          if (wave == 0) {
#pragma unroll 8
            for (int sl = 0; sl < 32; ++sl) {
              HC[sl * 132 + lane] = cr * hr - cim * hi;
              HC[sl * 132 + 64 + lane] = cr * hi + cim * hr;
              const float nr = cr * lam.x - cim * lam.y, ni = cr * lam.y + cim * lam.x;
              cr = nr; cim = ni;
            }
          }
          __syncthreads();
          if (wave < 2) {
            f32x4 acc = {0.f, 0.f, 0.f, 0.f};
            const float* hrow = HC + (16 * wave + (lane & 15)) * 132 + 8 * (lane >> 4);
#pragma unroll
            for (int ks = 0; ks < 4; ++ks) {
              const float4 v0 = *(const float4*)(hrow + 32 * ks), v1 = *(const float4*)(hrow + 32 * ks + 4);
              bf16x8 a;
              a[0] = (short)f2bf(v0.x); a[1] = (short)f2bf(v0.y); a[2] = (short)f2bf(v0.z); a[3] = (short)f2bf(v0.w);
              a[4] = (short)f2bf(v1.x); a[5] = (short)f2bf(v1.y); a[6] = (short)f2bf(v1.z); a[7] = (short)f2bf(v1.w);
              acc = MFMA16(a, cmf[ks], acc);
            }
#pragma unroll
            for (int i = 0; i < 4; ++i) {
              const int sg = 32 * c + 16 * wave + 4 * (lane >> 4) + i;
              const int tl = di == 0 ? sg : 255 - sg;
              atomicAdd(&ycorr[tl * 16 + (lane & 15)], acc[i]);
            }
          }
        }
      }
      __syncthreads();
    }
    {
      const int T = T0 + tid;
      const float* up = (const float*)(ws + OFF_U) + (size_t)T * 512 + g * 16;
      const bfr* yf = (const bfr*)(ws + OFF_YF) + (size_t)T * 512 + g * 16;
      const bfr* yb = (const bfr*)(ws + OFF_YB) + (size_t)T * 512 + g * 16;
      const float* dsk = p.in[21] + g * 16;
      unsigned o[8];
#pragma unroll
      for (int q = 0; q < 2; ++q) {
        const uint4 f = *(const uint4*)(yf + 8 * q), bk = *(const uint4*)(yb + 8 * q);
        const float4 u0 = *(const float4*)(up + 8 * q), u1 = *(const float4*)(up + 8 * q + 4);
        const float4 d0 = *(const float4*)(dsk + 8 * q), d1 = *(const float4*)(dsk + 8 * q + 4);
        const float* yc = ycorr + tid * 16 + 8 * q;
        const float uu[8] = {u0.x, u0.y, u0.z, u0.w, u1.x, u1.y, u1.z, u1.w};
        const float dd[8] = {d0.x, d0.y, d0.z, d0.w, d1.x, d1.y, d1.z, d1.w};
        const unsigned ff[4] = {f.x, f.y, f.z, f.w}, bb[4] = {bk.x, bk.y, bk.z, bk.w};
        float y[8];
#pragma unroll
        for (int e = 0; e < 8; ++e) {
          const float a = (e & 1) ? bf2f(ff[e >> 1] >> 16) : bf2f(ff[e >> 1] & 0xffff);
          const float c2 = (e & 1) ? bf2f(bb[e >> 1] >> 16) : bf2f(bb[e >> 1] & 0xffff);
          y[e] = gelu_f(uu[e] * dd[e] + a + c2 + yc[e]);
        }
#pragma unroll
        for (int e = 0; e < 4; ++e) o[4 * q + e] = pk2(y[2 * e], y[2 * e + 1]);
      }
      uint4* dst = (uint4*)((bfr*)(ws + OFF_YG) + (size_t)T * 512 + g * 16);
      dst[0] = make_uint4(o[0], o[1], o[2], o[3]);
      dst[1] = make_uint4(o[4], o[5], o[6], o[7]);
    }
  }
}

template <int MODE>
DI void phase_tokgemm(const Params& p, unsigned char* smem, int layer) {
  unsigned char* ws = p.ws;
  const int lane = threadIdx.x & 63, wave = threadIdx.x >> 6, l32 = lane & 31, h = lane >> 5, wm = wave >> 1, wn = wave & 1;
  constexpr int K = MODE == 1 ? 1024 : 512, N = MODE == 1 ? 1024 : 512;
  const bfr* A = (const bfr*)(ws + (MODE == 0 ? OFF_YG : (MODE == 1 ? OFF_MIX : OFF_FZ)));
  const bfr* Bt = (const bfr*)(ws + (MODE == 0 ? OFF_GLU : (MODE == 1 ? (layer == 0 ? OFF_WOUT0 : OFF_WOUT1) : OFF_FNET)));
  constexpr int TN = N / 128;
  for (int it = blockIdx.x; it < 96 * TN; it += gridDim.x) {
    const int tm = it / TN, tn = it % TN, m0 = tm * 128, n0 = tn * 128;
    LdBf al{A + (size_t)m0 * K, (size_t)K}, bl{Bt + (size_t)n0 * K, (size_t)K};
    auto ep = [&](f32x16 (&acc)[2][2]) {
#pragma unroll
      for (int mi = 0; mi < 2; ++mi)
#pragma unroll
        for (int ni = 0; ni < 2; ++ni)
#pragma unroll
          for (int i = 0; i < 16; ++i) {
            const int r = m0 + wm * 64 + mi * 32 + crow(i, h);
            const int n = n0 + wn * 64 + ni * 32 + l32;
            const float v = acc[mi][ni][i];
            if (MODE == 0) {
              const float y = bf2f(((const bfr*)(ws + OFF_YG))[(size_t)r * 512 + n]);
              const float gbv = bf2f(((const bfr*)(ws + OFF_GB))[(size_t)r * 512 + n]);
              ((bfr*)(ws + OFF_MIX))[(size_t)r * 1024 + 512 + n] = f2bf(y * sigmoid_f(v + p.in[23][n]) * gbv);
            } else if (MODE == 1) {
              ((bfr*)(ws + OFF_O))[(size_t)r * 1024 + n] = f2bf(v);
            } else {
              const float gd = bf2f(((const bfr*)(ws + OFF_GDS))[(size_t)r * 512 + n]);
              ((bfr*)(ws + OFF_MIX))[(size_t)r * 1024 + 512 + n] = f2bf(v * gd);
            }
          }
    };
    gemm_tile<128>(K / 64, al, bl, ep, smem);
  }
}

DI void phase_win1(const Params& p, unsigned char* smem) {
  unsigned char* ws = p.ws;
  const int lane = threadIdx.x & 63, wave = threadIdx.x >> 6, l32 = lane & 31, h = lane >> 5, wm = wave >> 1, wn = wave & 1;
  const bfr* A = (const bfr*)(ws + OFF_HN);
  const bfr* Bt = (const bfr*)(ws + OFF_WIN1);
  for (int it = blockIdx.x; it < 96 * 24; it += gridDim.x) {
    const int tm = it / 24, tn = it % 24, m0 = tm * 128, n0 = tn * 128;
    LdBf al{A + (size_t)m0 * 1024, 1024}, bl{Bt + (size_t)n0 * 1024, 1024};
    auto ep = [&](f32x16 (&acc)[2][2]) {
      const int colbase = n0 + wn * 64, rbase = m0 + wm * 64;
      const int sec = colbase >> 9;
      const int cb = colbase & 511;
      const bool lat = m0 >= NCTX;
      if (sec == 0 || sec == 2 || sec == 5) {
        bfr* dst = (bfr*)(ws + (sec == 0 ? OFF_CUG : (sec == 2 ? OFF_GCS : OFF_GDS)));
#pragma unroll
        for (int mi = 0; mi < 2; ++mi)
#pragma unroll
          for (int ni = 0; ni < 2; ++ni)
#pragma unroll
            for (int i = 0; i < 16; ++i) {
              const int r = rbase + mi * 32 + crow(i, h);
              const float v = acc[mi][ni][i];
              dst[(size_t)r * 512 + cb + ni * 32 + l32] = f2bf(sec == 0 ? gelu_f(v) : silu_f(v));
            }
      } else if (sec == 1) {
        float* rowss = (float*)(ws + OFF_ROWSS);
#pragma unroll
        for (int mi = 0; mi < 2; ++mi) {
#pragma unroll
          for (int i = 0; i < 16; ++i) {
            const float g0 = gelu_f(acc[mi][0][i]), g1 = gelu_f(acc[mi][1][i]);
            acc[mi][0][i] = g0; acc[mi][1][i] = g1;
            const float ss = half_sum32(g0 * g0 + g1 * g1);
            if (l32 == 0) atomicAdd(rowss + rbase + mi * 32 + crow(i, h), ss);
          }
#pragma unroll
          for (int ni = 0; ni < 2; ++ni)
#pragma unroll
            for (int i4 = 0; i4 < 4; ++i4) {
              const int r0 = rbase + mi * 32 + 8 * i4 + 4 * h;
              const int n = cb + ni * 32 + l32;
              *(uint2*)((bfr*)(ws + OFF_CVT) + (size_t)n * NTOK + r0) =
                  make_uint2(pk2(acc[mi][ni][4 * i4], acc[mi][ni][4 * i4 + 1]), pk2(acc[mi][ni][4 * i4 + 2], acc[mi][ni][4 * i4 + 3]));
            }
        }
      } else {
        const int isz = sec - 3;
#pragma unroll
        for (int mi = 0; mi < 2; ++mi)
#pragma unroll
          for (int ni = 0; ni < 2; ++ni)
#pragma unroll
            for (int i4 = 0; i4 < 4; ++i4) {
              const int r0 = rbase + mi * 32 + 8 * i4 + 4 * h;
              const int n = cb + ni * 32 + l32;
              const uint2 pk = make_uint2(pk2(acc[mi][ni][4 * i4], acc[mi][ni][4 * i4 + 1]), pk2(acc[mi][ni][4 * i4 + 2], acc[mi][ni][4 * i4 + 3]));
              if (!lat) {
                const int b = r0 >> 8, s = r0 & 255;
                *(uint2*)((bfr*)(ws + OFF_ZTC) + ((size_t)(b * 512 + n)) * 512 + isz * 256 + s) = pk;
              } else {
                const int b = (r0 - NCTX) >> 11, s = (r0 - NCTX) & 2047;
                *(uint2*)((bfr*)(ws + OFF_ZTL) + ((size_t)(b * 512 + n)) * 4096 + isz * 2048 + s) = pk;
              }
            }
      }
    };
    gemm_tile<128>(16, al, bl, ep, smem);
  }
}

struct LdWs {
  const float* w; const float* rowss;
  DI uint4 operator()(int r, int k) const {
    const float4 a = *(const float4*)(w + r * 128 + k), b = *(const float4*)(w + r * 128 + k + 4);
    const float4 s0 = *(const float4*)(rowss + k), s1 = *(const float4*)(rowss + k + 4);
    const float r0 = rsqrtf(s0.x * (1.f / 512.f) + EPS), r1 = rsqrtf(s0.y * (1.f / 512.f) + EPS), r2 = rsqrtf(s0.z * (1.f / 512.f) + EPS), r3 = rsqrtf(s0.w * (1.f / 512.f) + EPS);
    const float r4 = rsqrtf(s1.x * (1.f / 512.f) + EPS), r5 = rsqrtf(s1.y * (1.f / 512.f) + EPS), r6 = rsqrtf(s1.z * (1.f / 512.f) + EPS), r7 = rsqrtf(s1.w * (1.f / 512.f) + EPS);
    return make_uint4(pk2(a.x * r0, a.y * r1), pk2(a.z * r2, a.w * r3), pk2(b.x * r4, b.y * r5), pk2(b.z * r6, b.w * r7));
  }
};

DI void phase_mix1(const Params& p, unsigned char* smem) {
  unsigned char* ws = p.ws;
  const int lane = threadIdx.x & 63, wave = threadIdx.x >> 6, l32 = lane & 31, h = lane >> 5, wm = wave >> 1, wn = wave & 1;
  constexpr int N_FL = 128, N_FC = 256, N_G = 768;
  for (int it = blockIdx.x; it < N_FL + N_FC + N_G; it += gridDim.x) {
    if (it < N_FL + N_FC) {
      const bfr *A, *Bt; int K, Tbase, tm, tn;
      if (it < N_FL) {
        const int b = it >> 6; tm = (it >> 2) & 15; tn = it & 3; K = 4096;
        A = (const bfr*)(ws + OFF_ALAT); Bt = (const bfr*)(ws + OFF_ZTL) + (size_t)b * 512 * 4096; Tbase = NCTX + b * 2048;
      } else {
        const int i2 = it - N_FL; const int b = i2 >> 3; tm = (i2 >> 2) & 1; tn = i2 & 3; K = 512;
        A = (const bfr*)(ws + OFF_ACTX); Bt = (const bfr*)(ws + OFF_ZTC) + (size_t)b * 512 * 512; Tbase = b * 256;
      }
      LdBf al{A + (size_t)tm * 128 * K, (size_t)K}, bl{Bt + (size_t)tn * 128 * K, (size_t)K};
      auto ep = [&](f32x16 (&acc)[2][2]) {
#pragma unroll
        for (int mi = 0; mi < 2; ++mi)
#pragma unroll
          for (int ni = 0; ni < 2; ++ni)
#pragma unroll
            for (int i = 0; i < 16; ++i) {
              const int T = Tbase + tm * 128 + wm * 64 + mi * 32 + crow(i, h);
              const int n = tn * 128 + wn * 64 + ni * 32 + l32;
              ((bfr*)(ws + OFF_FZ))[(size_t)T * 512 + n] = f2bf(acc[mi][ni][i]);
            }
      };
      gemm_tile<128>(K / 64, al, bl, ep, smem);
    } else {
      const int i2 = it - N_FL - N_FC; const int hg = i2 & 7, chunk = i2 >> 3;
      LdWs al{p.in[27] + (size_t)hg * 128 * 128, (const float*)(ws + OFF_ROWSS) + chunk * 128};
      LdBf bl{(const bfr*)(ws + OFF_CVT) + (size_t)(hg * 64) * NTOK + chunk * 128, (size_t)NTOK};
      auto ep = [&](f32x16 (&acc)[2][1]) {
        const int c = hg * 64 + wn * 32 + l32;
        const float vg = p.in[26][c];
#pragma unroll
        for (int mi = 0; mi < 2; ++mi)
#pragma unroll
          for (int i = 0; i < 16; ++i) {
            const int t = wm * 64 + mi * 32 + crow(i, h);
            const int T = chunk * 128 + t;
            const float sp = acc[mi][0][i] * vg + p.in[28][hg * 128 + t];
            const float cu = bf2f(((const bfr*)(ws + OFF_CUG))[(size_t)T * 512 + c]);
            const float gc = bf2f(((const bfr*)(ws + OFF_GCS))[(size_t)T * 512 + c]);
            ((bfr*)(ws + OFF_MIX))[(size_t)T * 1024 + c] = f2bf(cu * sp * gc);
          }
      };
      gemm_tile<64>(2, al, bl, ep, smem);
    }
  }
}

constexpr int NPHASE = 13;
template <int PH>
DI void run_phase(const Params& p, unsigned char* smem) {
  if constexpr (PH == 0) phase0(p, smem);
  else if constexpr (PH == 1) phase_rows<0>(p);
  else if constexpr (PH == 2) phase_win0(p, smem);
  else if constexpr (PH == 3) phase_mix0(p, smem);
  else if constexpr (PH == 4) phase_s5fix(p, smem);
  else if constexpr (PH == 5) phase_tokgemm<0>(p, smem, 0);
  else if constexpr (PH == 6) phase_tokgemm<1>(p, smem, 0);
  else if constexpr (PH == 7) phase_rows<1>(p);
  else if constexpr (PH == 8) phase_win1(p, smem);
  else if constexpr (PH == 9) phase_mix1(p, smem);
  else if constexpr (PH == 10) phase_tokgemm<2>(p, smem, 1);
  else if constexpr (PH == 11) phase_tokgemm<1>(p, smem, 1);
  else if constexpr (PH == 12) phase_rows<2>(p);
}
template <int LO, int HI>
DI void run_range(const Params& p, unsigned char* smem, const XcdBarrier& xb) {
  if constexpr (LO < HI) {
    run_phase<LO>(p, smem);
    if constexpr (LO + 1 < HI) { xcd_barrier(xb); run_range<LO + 1, HI>(p, smem, xb); }
  }
}
template <int LO, int HI>
__global__ void __launch_bounds__(256, 2) mega(Params p) {
  __shared__ __attribute__((aligned(16))) unsigned char smem[36864];
  __shared__ uint4 xb_words;
  if (threadIdx.x == 0) xb_words = make_uint4(0u, 0u, 0u, 0u);
  __syncthreads();
  XcdBarrier xb = xcd_barrier_post((unsigned*)(p.ws + OFF_BAR), (volatile LAS unsigned*)&xb_words);
  run_range<LO, HI>(p, smem, xb);
  if (p.ph_lo != 0) cg::this_grid().sync();
}

#ifndef ONE_LAUNCH
#define ONE_LAUNCH 1
#endif
#if !ONE_LAUNCH
template <int PH>
static void launch_phases(Params& p, int grid, hipStream_t stream) {
  if constexpr (PH < NPHASE) {
    hipLaunchKernelGGL((mega<PH, PH + 1>), dim3(grid), dim3(256), 0, stream, p);
    launch_phases<PH + 1>(p, grid, stream);
  }
}
#endif

#ifndef ONE_LAUNCH
#define ONE_LAUNCH 1
#endif

extern "C" void kernel_launch(void* const* d_in, const int* in_sizes, int n_in, void* d_out, int out_size, void* d_ws, size_t ws_size, hipStream_t stream) {
  static int grid_blocks = 0;
  if (!grid_blocks) {
    int dev = 0, cus = 0, per_cu = 0;
    (void)hipGetDevice(&dev);
    (void)hipDeviceGetAttribute(&cus, hipDeviceAttributeMultiprocessorCount, dev);
    (void)hipOccupancyMaxActiveBlocksPerMultiprocessor(&per_cu, mega<0, NPHASE>, 256, 0);
    if (per_cu > 2) per_cu = 2;
    if (per_cu < 1) per_cu = 1;
    grid_blocks = cus * per_cu;
    if (n_in != 31 || ws_size < WS_TOTAL) fprintf(stderr, "kernel_launch: unexpected n_in %d or ws_size %zu (need %zu)\n", n_in, ws_size, (size_t)WS_TOTAL);
  }
  Params p{};
  for (int i = 0; i < 31; ++i) p.in[i] = (const float*)d_in[i];
  p.out = (float*)d_out; p.ws = (unsigned char*)d_ws;
  (void)hipMemsetAsync((unsigned char*)d_ws + OFF_BAR, 0, 16384, stream);
#if ONE_LAUNCH
  p.ph_lo = 0; p.ph_hi = NPHASE;
  void* args[] = {&p};
  hipError_t e = hipLaunchCooperativeKernel((void*)mega<0, NPHASE>, dim3(grid_blocks), dim3(256), args, 0, stream);
  if (e != hipSuccess) fprintf(stderr, "cooperative launch failed: %s (grid %d)\n", hipGetErrorString(e), grid_blocks);
#else
  launch_phases<0>(p, grid_blocks, stream);
#endif
}
```

```cpp
#include <hip/hip_runtime.h>
#include <hip/hip_cooperative_groups.h>
#include <cstdio>
#include <cstdint>
namespace cg = cooperative_groups;

#define DI __device__ __forceinline__
typedef unsigned short bfr;
using bf16x8 = __attribute__((ext_vector_type(8))) short;
using s16x4  = __attribute__((ext_vector_type(4))) short;
using f32x16 = __attribute__((ext_vector_type(16))) float;
using f32x4  = __attribute__((ext_vector_type(4))) float;

#define MFMA32(a, b, c) __builtin_amdgcn_mfma_f32_32x32x16_bf16((a), (b), (c), 0, 0, 0)
#define MFMA16(a, b, c) __builtin_amdgcn_mfma_f32_16x16x32_bf16((a), (b), (c), 0, 0, 0)

constexpr int NTOK = 12288, NCTX = 8192;
constexpr float EPS = 1e-6f;

constexpr size_t OFF_MOD   = 0;
constexpr size_t OFF_ROWSS = OFF_MOD + 73728;
constexpr size_t OFF_ROPE  = OFF_ROWSS + 49152;
constexpr size_t OFF_LAMB  = OFF_ROPE + 8192;
constexpr size_t OFF_LAMP  = OFF_LAMB + 32768;
constexpr size_t OFF_BB    = OFF_LAMP + 32768;
constexpr size_t OFF_CMB   = OFF_BB + 524288;
constexpr size_t OFF_E     = OFF_CMB + 262144;
constexpr size_t OFF_WIN0  = OFF_E + 1572864;
constexpr size_t OFF_GLU   = OFF_WIN0 + 4718592;
constexpr size_t OFF_WOUT0 = OFF_GLU + 524288;
constexpr size_t OFF_WIN1  = OFF_WOUT0 + 2097152;
constexpr size_t OFF_FNET  = OFF_WIN1 + 6291456;
constexpr size_t OFF_WOUT1 = OFF_FNET + 524288;
constexpr size_t OFF_ACTX  = OFF_WOUT1 + 2097152;
constexpr size_t OFF_ALAT  = OFF_ACTX + 262144;
constexpr size_t OFF_X1    = OFF_ALAT + 16777216;
constexpr size_t OFF_HN    = OFF_X1 + 50331648;
constexpr size_t OFF_MIX   = OFF_HN + 25165824;
constexpr size_t OFF_O     = OFF_MIX + 25165824;
constexpr size_t OFF_U     = OFF_O;
constexpr size_t OFF_R     = OFF_O + 25165824;
constexpr size_t OFF_QB = OFF_R;
constexpr size_t OFF_KC = OFF_QB + 12582912;
constexpr size_t OFF_KL = OFF_KC + 2097152;
constexpr size_t OFF_VC = OFF_KL + 1310720;
constexpr size_t OFF_VL = OFF_VC + 2097152;
constexpr size_t OFF_GA = OFF_VL + 1310720;
constexpr size_t OFF_GB = OFF_GA + 12582912;
constexpr size_t OFF_YF = OFF_GB + 12582912;
constexpr size_t OFF_YB = OFF_YF + 12582912;
constexpr size_t OFF_YG = OFF_YB + 12582912;
constexpr size_t END_L0 = OFF_YG + 12582912;
constexpr size_t OFF_CUG = OFF_R;
constexpr size_t OFF_GCS = OFF_CUG + 12582912;
constexpr size_t OFF_GDS = OFF_GCS + 12582912;
constexpr size_t OFF_CVT = OFF_GDS + 12582912;
constexpr size_t OFF_FZ  = OFF_CVT + 12582912;
constexpr size_t OFF_ZTC = OFF_FZ + 12582912;
constexpr size_t OFF_ZTL = OFF_ZTC + 16777216;
constexpr size_t END_L1 = OFF_ZTL + 8388608;
constexpr size_t WS_NEED = (END_L0 > END_L1 ? END_L0 : END_L1);
constexpr size_t OFF_BAR = WS_NEED;
constexpr size_t WS_TOTAL = OFF_BAR + 16384;
static_assert(WS_TOTAL <= (size_t)256 * 1024 * 1024, "workspace too large");

constexpr size_t OUT_Y = 0, OUT_K = 12582912, OUT_V = 13631488, OUT_S = 14680064;

struct Params {
  const float* in[31];
  float* out;
  unsigned char* ws;
  int ph_lo, ph_hi;
};

typedef __bf16 hbf2 __attribute__((ext_vector_type(2)));
typedef float hfl2 __attribute__((ext_vector_type(2)));
DI unsigned pk2(float lo, float hi) { hfl2 v = {lo, hi}; hbf2 r = __builtin_convertvector(v, hbf2); return __builtin_bit_cast(unsigned, r); }
DI unsigned short f2bf(float x) { return (unsigned short)(pk2(x, 0.f) & 0xffffu); }
DI float bf2f(unsigned short b) { return __uint_as_float(((unsigned)b) << 16); }
DI float wave_sum(float v) {
#pragma unroll
  for (int o = 1; o < 64; o <<= 1) v += __shfl_xor(v, o);
  return v;
}
DI float half_sum32(float v) {
#pragma unroll
  for (int o = 1; o < 32; o <<= 1) v += __shfl_xor(v, o);
  return v;
}
DI float silu_f(float x) { return x / (1.f + __expf(-x)); }
DI float sigmoid_f(float x) { return 1.f / (1.f + __expf(-x)); }
DI float gelu_f(float x) { float z = 0.7978845608028654f * (x + 0.044715f * x * x * x); return x / (1.f + __expf(-2.f * z)); }
DI int crow(int i, int h) { return (i & 3) + 8 * (i >> 2) + 4 * h; }
DI const float* xrow(const Params& p, int T) { return T < NCTX ? p.in[0] + (size_t)T * 1024 : p.in[1] + (size_t)(T - NCTX) * 1024; }
DI int cond_of(int T) { return T < NCTX ? 0 : 1 + ((T - NCTX) >> 11); }

template <int BN, bool D2 = true, class AL, class BL, class EP>
DI void gemm_tile(int nk, bool swp, AL al, BL bl, EP ep, unsigned char* smem) {
  constexpr int NI = BN / 64;
  constexpr int NB = BN / 32;
  constexpr int STG = (128 + BN) * 72;
  unsigned short* S0 = (unsigned short*)smem;
  const int tid = threadIdx.x, lane = tid & 63, wave = tid >> 6, l32 = lane & 31, h = lane >> 5;
  const int wm = wave >> 1, wn = wave & 1;
  const int xoff = (swp ? 128 * 72 + (wn * 64 + l32) * 72 : (wm * 64 + l32) * 72) + h * 8;
  const int yoff = (swp ? (wm * 64 + l32) * 72 : 128 * 72 + (wn * (BN / 2) + l32) * 72) + h * 8;
  f32x16 acc[2][NI];
#pragma unroll
  for (int mi = 0; mi < 2; ++mi)
#pragma unroll
    for (int ni = 0; ni < NI; ++ni)
#pragma unroll
      for (int i = 0; i < 16; ++i) acc[mi][ni][i] = 0.f;
  uint4 ra[2][4], rb[2][NB];
  const int lrow = tid >> 3, lcol = (tid & 7) * 8;
  al.init(lrow, lcol); bl.init(lrow, lcol);
  int nxt = 0;
  auto gload = [&](uint4 (&a4)[4], uint4 (&b4)[NB]) {
#pragma unroll
    for (int i = 0; i < 4; ++i) a4[i] = al.load(i);
#pragma unroll
    for (int i = 0; i < NB; ++i) b4[i] = bl.load(i);
    const int adv = (nxt + 1 < nk) ? 1 : 0;
    al.advance(adv); bl.advance(adv); nxt += adv;
  };
  auto lstore = [&](const uint4 (&a4)[4], const uint4 (&b4)[NB], unsigned short* st) {
#pragma unroll
    for (int i = 0; i < 4; ++i) *(uint4*)(st + (lrow + 32 * i) * 72 + lcol) = a4[i];
#pragma unroll
    for (int i = 0; i < NB; ++i) *(uint4*)(st + 128 * 72 + (lrow + 32 * i) * 72 + lcol) = b4[i];
  };
  auto compute = [&](const unsigned short* st) {
#pragma unroll
    for (int ks = 0; ks < 4; ++ks) {
      bf16x8 x[2], y[NI];
#pragma unroll
      for (int mi = 0; mi < 2; ++mi) x[mi] = *(const bf16x8*)(st + xoff + mi * 32 * 72 + ks * 16);
#pragma unroll
      for (int ni = 0; ni < NI; ++ni) y[ni] = *(const bf16x8*)(st + yoff + ni * 32 * 72 + ks * 16);
#pragma unroll
      for (int mi = 0; mi < 2; ++mi)
#pragma unroll
        for (int ni = 0; ni < NI; ++ni) acc[mi][ni] = MFMA32(x[mi], y[ni], acc[mi][ni]);
    }
  };
  if constexpr (D2) {
    gload(ra[0], rb[0]);
    gload(ra[1], rb[1]);
    __syncthreads();
    lstore(ra[0], rb[0], S0);
    gload(ra[0], rb[0]);
    __syncthreads();
    for (int kt = 0; kt < nk; kt += 2) {
      compute(S0);
      lstore(ra[1], rb[1], S0 + STG);
      gload(ra[1], rb[1]);
      __syncthreads();
      compute(S0 + STG);
      if (kt + 2 < nk) lstore(ra[0], rb[0], S0);
      gload(ra[0], rb[0]);
      __syncthreads();
    }
  } else {
    gload(ra[0], rb[0]);
    __syncthreads();
    lstore(ra[0], rb[0], S0);
    gload(ra[0], rb[0]);
    __syncthreads();
    for (int kt = 0; kt < nk; kt += 2) {
      compute(S0);
      lstore(ra[0], rb[0], S0 + STG);
      gload(ra[0], rb[0]);
      __syncthreads();
      compute(S0 + STG);
      if (kt + 2 < nk) lstore(ra[0], rb[0], S0);
      gload(ra[0], rb[0]);
      __syncthreads();
    }
  }
  ep(acc);
}

DI bool xcd_tile(int step, int ntn, int& tm, int& tn) {
  const int G = gridDim.x;
  if ((G & 7) == 0) {
    const int x = blockIdx.x & 7, loc = blockIdx.x >> 3, per = G >> 3;
    const int j = loc + step * per;
    if (j >= 12 * ntn) return false;
    tn = j / 12; tm = 12 * x + j % 12;
    return true;
  }
  const int it = blockIdx.x + step * G;
  if (it >= 96 * ntn) return false;
  tm = it / ntn; tn = it % ntn;
  return true;
}

#define GAS __attribute__((address_space(1)))
typedef unsigned u32x4 __attribute__((ext_vector_type(4)));
DI uint4 gld16(const GAS char* q) { const u32x4 v = *(const GAS u32x4*)q; return make_uint4(v.x, v.y, v.z, v.w); }
struct LdBf {
  const bfr* base; size_t ld;
  const GAS char* p[4];
  DI void init(int lrow, int lcol) {
#pragma unroll
    for (int i = 0; i < 4; ++i) { p[i] = (const GAS char*)(base + (size_t)(lrow + 32 * i) * ld + lcol); asm volatile("" : "+v"(p[i])); }
  }
  DI uint4 load(int i) const { return gld16(p[i]); }
  DI void advance(int adv) {
#pragma unroll
    for (int i = 0; i < 4; ++i) p[i] += 128 * adv;
  }
};
#define XB_TMO      128
#define XB_XCNT(j)  (256  + 64 * (j))
#define XB_XSUB(j)  (1280 + 64 * (j))
#define XB_XGEN(j)  (2304 + 64 * (j))
#define XB_TOP      3328
#define XB_TOPGEN   3392
#define XCD_BAR_WORDS 3456
#define XB_SPIN_CAP (1u << 20)
#define LAS __attribute__((address_space(3)))
DI unsigned xb_ld(unsigned* p)              { return __hip_atomic_load(p, __ATOMIC_RELAXED, __HIP_MEMORY_SCOPE_AGENT); }
DI unsigned xb_add(unsigned* p, unsigned v) { return __hip_atomic_fetch_add(p, v, __ATOMIC_RELAXED, __HIP_MEMORY_SCOPE_AGENT); }
DI unsigned xb_xcc_id() { return (unsigned)__builtin_amdgcn_s_getreg((3 << 11) | 20) & 0xFu; }
#define XB_SPIN(cond, bar) do { unsigned _sp = 0; while (cond) { __builtin_amdgcn_s_sleep(1); \
    if ((++_sp & 255u) == 0u) { if (xb_ld(&(bar)[XB_TMO])) break; if (_sp > XB_SPIN_CAP) { atomicAdd(&(bar)[XB_TMO], 1u); break; } } } } while (0)
struct XcdBarrier { unsigned* bar; unsigned x; volatile LAS unsigned* st; };
DI XcdBarrier xcd_barrier_post(unsigned* bar, volatile LAS unsigned* st) {
  XcdBarrier b; b.bar = bar; b.x = xb_xcc_id(); b.st = st;
  if (threadIdx.x == 0) (void)xb_add(&bar[XB_XCNT(b.x)], 1u);
  return b;
}
DI void xcd_barrier_complete(unsigned* bar, unsigned x, unsigned& nloc, unsigned& nx) {
  const unsigned G = gridDim.x * gridDim.y * gridDim.z;
  unsigned sum, cnt, mine, sp = 0u;
  for (;;) {
    sum = 0u; cnt = 0u; mine = 0u;
#pragma unroll
    for (unsigned j = 0; j < 16; ++j) { const unsigned c = xb_ld(&bar[XB_XCNT(j)]); sum += c; cnt += (c > 0u) ? 1u : 0u; mine = (j == x) ? c : mine; }
    if (sum == G) break;
    __builtin_amdgcn_s_sleep(1);
    if ((++sp & 255u) == 0u) { if (xb_ld(&bar[XB_TMO])) break; if (sp > XB_SPIN_CAP) { atomicAdd(&bar[XB_TMO], 1u); break; } }
  }
  nloc = mine > 0u ? mine : 1u; nx = cnt > 0u ? cnt : 1u;
}
DI void xcd_barrier(const XcdBarrier& b) {
  asm volatile("s_waitcnt vmcnt(0)" ::: "memory");
  __syncthreads();
  if (threadIdx.x == 0) {
    unsigned* bar = b.bar;
    __builtin_amdgcn_s_waitcnt(0);
    unsigned nloc = b.st[0], nx = b.st[1];
    if (nloc == 0u) { xcd_barrier_complete(bar, b.x, nloc, nx); b.st[0] = nloc; b.st[1] = nx; }
    const unsigned old = xb_add(&bar[XB_XSUB(b.x)], 1u);
    const unsigned gen = old / nloc;
    if (old + 1u == (gen + 1u) * nloc) {
      __builtin_amdgcn_fence(__ATOMIC_RELEASE, "agent");
      asm volatile("s_waitcnt vmcnt(0)" ::: "memory");
      const unsigned og = xb_add(&bar[XB_TOP], 1u);
      const unsigned tg = og / nx;
      if (og + 1u == (tg + 1u) * nx) xb_add(&bar[XB_TOPGEN], 1u);
      else XB_SPIN(xb_ld(&bar[XB_TOPGEN]) == tg, bar);
      __builtin_amdgcn_fence(__ATOMIC_ACQUIRE, "agent");
      xb_add(&bar[XB_XGEN(b.x)], 1u);
      asm volatile("s_waitcnt vmcnt(0)" ::: "memory");
    } else {
      XB_SPIN(xb_ld(&bar[XB_XGEN(b.x)]) == gen, bar);
      __builtin_amdgcn_fence(__ATOMIC_ACQUIRE, "agent");
      asm volatile("s_waitcnt vmcnt(0)" ::: "memory");
    }
  }
  __syncthreads();
}

struct LdFz {
  const bfr* pz;
  const GAS char* p[4];
  DI void init(int lrow, int lcol) {
#pragma unroll
    for (int i = 0; i < 4; ++i) { p[i] = (const GAS char*)(pz + (size_t)(lrow + 32 * i) * 512 + lcol); asm volatile("" : "+v"(p[i])); }
  }
  DI void advance(int adv) {
#pragma unroll
    for (int i = 0; i < 4; ++i) p[i] += 128 * adv;
  }
  DI uint4 load(int i) const {
    const GAS char* q = p[i];
    const uint4 a = gld16(q), b = gld16(q + (size_t)4096 * 512 * 2), c = gld16(q + (size_t)2 * 4096 * 512 * 2), d = gld16(q + (size_t)3 * 4096 * 512 * 2);
#define SUM4(f) pk2(bf2f(a.f & 0xffff) + bf2f(b.f & 0xffff) + bf2f(c.f & 0xffff) + bf2f(d.f & 0xffff), bf2f(a.f >> 16) + bf2f(b.f >> 16) + bf2f(c.f >> 16) + bf2f(d.f >> 16))
    return make_uint4(SUM4(x), SUM4(y), SUM4(z), SUM4(w));
#undef SUM4
  }
};

DI void transpose_tile(const float* W, int ldw, int kbase, int nbase, bfr* WT, int ldt, int trow, float* sm) {
  const int tid = threadIdx.x;
#pragma unroll
  for (int i = 0; i < 4; ++i) {
    const int r = (tid >> 4) + 16 * i, c = (tid & 15) * 4;
    const float4 v = *(const float4*)(W + (size_t)(kbase + r) * ldw + nbase + c);
    sm[r * 65 + c] = v.x; sm[r * 65 + c + 1] = v.y; sm[r * 65 + c + 2] = v.z; sm[r * 65 + c + 3] = v.w;
  }
  __syncthreads();
  const int n = tid >> 2, kc = (tid & 3) * 16;
  unsigned o[8];
#pragma unroll
  for (int j = 0; j < 8; ++j) o[j] = pk2(sm[(kc + 2 * j) * 65 + n], sm[(kc + 2 * j + 1) * 65 + n]);
  uint4* dst = (uint4*)(WT + (size_t)(trow + n) * ldt + kbase + kc);
  dst[0] = make_uint4(o[0], o[1], o[2], o[3]);
  dst[1] = make_uint4(o[4], o[5], o[6], o[7]);
}

DI void phase0(const Params& p, unsigned char* smem) {
  const int tid = threadIdx.x;
  float* smf = (float*)smem;
  unsigned char* ws = p.ws;
  constexpr int N_ADA = 192;
  constexpr int N_T0 = 16 * 36, N_TG = 64, N_TO0 = 256, N_T1A = 16 * 24, N_T1B = 16 * 8, N_TF = 64, N_TO1 = 256;
  constexpr int N_FOLD = 128, N_ALAT = 2048, N_ACTX = 256, N_CACHE = 64, N_SSM = 64, N_ZERO = 48, N_ROPE = 4;
  constexpr int B_T0 = N_ADA, B_TG = B_T0 + N_T0, B_TO0 = B_TG + N_TG, B_T1A = B_TO0 + N_TO0, B_T1B = B_T1A + N_T1A,
                B_TF = B_T1B + N_T1B, B_TO1 = B_TF + N_TF, B_FOLD = B_TO1 + N_TO1, B_ALAT = B_FOLD + N_FOLD,
                B_ACTX = B_ALAT + N_ALAT, B_CACHE = B_ACTX + N_ACTX, B_SSM = B_CACHE + N_CACHE, B_ZERO = B_SSM + N_SSM,
                B_ROPE = B_ZERO + N_ZERO, N_ALL = B_ROPE + N_ROPE;
  for (int it = blockIdx.x; it < N_ALL; it += gridDim.x) {
    __syncthreads();
    if (it < B_T0) {
      const int l = it / 96, cgp = it % 96;
      float* sc = smf;
      float* red = smf + 3072;
      for (int e = tid; e < 3072; e += 256) {
        const int ci = e >> 10, k = e & 1023;
        const float cv = ci == 0 ? p.in[6][k] : p.in[5][(ci - 1) * 1024 + k];
        sc[e] = silu_f(cv);
      }
      __syncthreads();
      const int col = tid & 31, kq = tid >> 5, n = cgp * 32 + col;
      const float* w = p.in[7] + (size_t)l * 1024 * 3072 + n;
      float a0 = 0.f, a1 = 0.f, a2 = 0.f;
#pragma unroll 8
      for (int k = kq; k < 1024; k += 8) {
        const float wv = w[(size_t)k * 3072];
        a0 += sc[k] * wv; a1 += sc[1024 + k] * wv; a2 += sc[2048 + k] * wv;
      }
      red[(kq * 32 + col) * 3 + 0] = a0; red[(kq * 32 + col) * 3 + 1] = a1; red[(kq * 32 + col) * 3 + 2] = a2;
      __syncthreads();
      if (tid < 96) {
        const int c2 = tid & 31, ci = tid >> 5;
        float s = 0.f;
#pragma unroll
        for (int q = 0; q < 8; ++q) s += red[(q * 32 + c2) * 3 + ci];
        const int n2 = cgp * 32 + c2;
        ((float*)(ws + OFF_MOD))[(l * 3 + ci) * 3072 + n2] = s + p.in[8][l * 3072 + n2];
      }
    } else if (it < B_FOLD) {
      const float* W; int ldw, nbase_off = 0, trow_off = 0, ntn, ldt; bfr* WT; int r;
      if (it < B_TG)        { r = it - B_T0;  W = p.in[11]; ldw = 2304; ntn = 36; WT = (bfr*)(ws + OFF_WIN0); ldt = 1024; }
      else if (it < B_TO0)  { r = it - B_TG;  W = p.in[22]; ldw = 512;  ntn = 8;  WT = (bfr*)(ws + OFF_GLU); ldt = 512; }
      else if (it < B_T1A)  { r = it - B_TO0; W = p.in[24]; ldw = 1024; ntn = 16; WT = (bfr*)(ws + OFF_WOUT0); ldt = 1024; }
      else if (it < B_T1B)  { r = it - B_T1A; W = p.in[25]; ldw = 2560; ntn = 24; WT = (bfr*)(ws + OFF_WIN1); ldt = 1024; }
      else if (it < B_TF)   { r = it - B_T1B; W = p.in[25]; ldw = 2560; ntn = 8;  WT = (bfr*)(ws + OFF_WIN1); ldt = 1024; nbase_off = 2048; trow_off = 2560; }
      else if (it < B_TO1)  { r = it - B_TF;  W = p.in[29]; ldw = 512;  ntn = 8;  WT = (bfr*)(ws + OFF_FNET); ldt = 512; }
      else                  { r = it - B_TO1; W = p.in[30]; ldw = 1024; ntn = 16; WT = (bfr*)(ws + OFF_WOUT1); ldt = 1024; }
      const int kb = r / ntn, nb = r % ntn;
      transpose_tile(W, ldw, kb * 64, nbase_off + nb * 64, WT, ldt, trow_off + nb * 64, smf);
    } else if (it < B_ALAT) {
      const int r = it - B_FOLD, cs = r & 1, kb = (r >> 1) & 15, g = r >> 5;
      float* tile = smf;
      float* tw = smf + 128 * 68;
      const float* W = p.in[25];
      {
        const int c4 = (tid & 31) * 4, kr = tid >> 5;
#pragma unroll
        for (int i = 0; i < 8; ++i) {
          const int k = kr + 8 * i;
          const float4 v = *(const float4*)(W + (size_t)(kb * 64 + k) * 2560 + 1536 + g * 128 + c4);
          tile[(c4 + 0) * 68 + k] = v.x; tile[(c4 + 1) * 68 + k] = v.y; tile[(c4 + 2) * 68 + k] = v.z; tile[(c4 + 3) * 68 + k] = v.w;
        }
        if (tid < 128) {
          const float a = 2.f * (float)tid / 128.f;
          tw[tid] = (cs == 0 ? cospif(a) : sinpif(a)) * 0.08838834764831845f;
        }
      }
      __syncthreads();
      const int j = tid & 127, kg = tid >> 7;
      float acc[32];
#pragma unroll
      for (int i = 0; i < 32; ++i) acc[i] = 0.f;
      for (int c = 0; c < 128; ++c) {
        const float t = tw[(j * c) & 127];
        const float4* tp = (const float4*)(tile + c * 68 + kg * 32);
#pragma unroll
        for (int q = 0; q < 8; ++q) {
          const float4 v = tp[q];
          acc[4 * q + 0] += v.x * t; acc[4 * q + 1] += v.y * t; acc[4 * q + 2] += v.z * t; acc[4 * q + 3] += v.w * t;
        }
      }
      uint4* dst = (uint4*)((bfr*)(ws + OFF_WIN1) + (size_t)(1536 + cs * 512 + g * 128 + j) * 1024 + kb * 64 + kg * 32);
#pragma unroll
      for (int q = 0; q < 4; ++q)
        dst[q] = make_uint4(pk2(acc[8 * q], acc[8 * q + 1]), pk2(acc[8 * q + 2], acc[8 * q + 3]), pk2(acc[8 * q + 4], acc[8 * q + 5]), pk2(acc[8 * q + 6], acc[8 * q + 7]));
    } else if (it < B_ACTX) {
      const int t = it - B_ALAT;
      bfr* dst = (bfr*)(ws + OFF_ALAT) + (size_t)t * 4096;
      const float nrm = 0.02209708691207961f;
#pragma unroll
      for (int half = 0; half < 2; ++half) {
        const int k0 = half * 2048 + tid * 8;
        unsigned o[4];
#pragma unroll
        for (int j = 0; j < 4; ++j) {
          float v[2];
#pragma unroll
          for (int e = 0; e < 2; ++e) {
            const int k = k0 + 2 * j + e;
            const int m = (t * (k & 2047)) & 2047;
            const float a = (float)m * (2.f / 2048.f);
            v[e] = (k < 2048 ? cospif(a) : -sinpif(a)) * nrm;
          }
          o[j] = pk2(v[0], v[1]);
        }
        *(uint4*)(dst + k0) = make_uint4(o[0], o[1], o[2], o[3]);
      }
    } else if (it < B_CACHE) {
      const int t = it - B_ACTX;
      bfr* dst = (bfr*)(ws + OFF_ACTX) + (size_t)t * 512;
      const float nrm = 0.0625f;
      float v[2];
#pragma unroll
      for (int e = 0; e < 2; ++e) {
        const int k = tid * 2 + e;
        const int m = (t * (k & 255)) & 255;
        const float a = (float)m * (2.f / 256.f);
        v[e] = (k < 256 ? cospif(a) : -sinpif(a)) * nrm;
      }
      *(unsigned*)(dst + tid * 2) = pk2(v[0], v[1]);
    } else if (it < B_SSM) {
      const int r = it - B_CACHE;
#pragma unroll
      for (int i = 0; i < 8; ++i) {
        const int e = r * 2048 + tid + 256 * i;
        const int d = e & 63, kvh = (e >> 6) & 1, key = (e >> 7) & 511, b = e >> 16;
        ((bfr*)(ws + OFF_KL))[((size_t)(b * 2 + kvh) * 2560 + key) * 64 + d] = f2bf(p.in[2][e]);
        ((bfr*)(ws + OFF_VL))[((size_t)(b * 2 + kvh) * 64 + d) * 2560 + key] = f2bf(p.in[3][e]);
      }
    } else if (it < B_ZERO) {
      const int dg = it - B_SSM;
      const int pp = tid & 63, part = tid >> 6;
      const double lr = (double)p.in[14][dg * 64 + pp], li = (double)p.in[15][dg * 64 + pp];
      const double dt = (double)__expf(p.in[16][dg]) ;
      const float dtf = expf(p.in[16][dg]);
      const double dtd = (double)dtf;
      (void)dt;
      const double PI = 3.14159265358979323846;
      double ap = li * dtd / PI;
      double ar = ap - 2.0 * rint(ap * 0.5);
      const float er = expf((float)(lr * dtd));
      const double lbr = (double)er * (double)cospif((float)ar), lbi = (double)er * (double)sinpif((float)ar);
      double ap2 = ap * 256.0;
      double ar2 = ap2 - 2.0 * rint(ap2 * 0.5);
      const float er2 = expf((float)(lr * dtd * 256.0));
      if (part == 0) {
        ((float2*)(ws + OFF_LAMB))[dg * 64 + pp] = make_float2((float)lbr, (float)lbi);
        ((float2*)(ws + OFF_LAMP))[dg * 64 + pp] = make_float2(er2 * cospif((float)ar2), er2 * sinpif((float)ar2));
      }
      const double den = lr * lr + li * li;
      const double fr = ((lbr - 1.0) * lr + lbi * li) / den, fi = (lbi * lr - (lbr - 1.0) * li) / den;
      float* bb = (float*)(ws + OFF_BB) + (size_t)(dg * 64 + pp) * 32;
#pragma unroll
      for (int q = 0; q < 4; ++q) {
        const int c = part * 4 + q;
        const double br = (double)p.in[17][(size_t)(dg * 64 + pp) * 16 + c], bi = (double)p.in[18][(size_t)(dg * 64 + pp) * 16 + c];
        bb[c] = (float)(fr * br - fi * bi);
        bb[16 + c] = (float)(fr * bi + fi * br);
      }
      bfr* cm = (bfr*)(ws + OFF_CMB) + (size_t)dg * 2048;
#pragma unroll
      for (int q = 0; q < 8; ++q) {
        const int e = tid * 8 + q, c = e >> 7, k = e & 127;
        const float v = k < 64 ? p.in[19][(size_t)(dg * 16 + c) * 64 + k] : -p.in[20][(size_t)(dg * 16 + c) * 64 + (k - 64)];
        cm[e] = f2bf(v);
      }
    } else if (it < B_ROPE) {
      const int r = it - B_ZERO;
      ((float*)(ws + OFF_ROWSS))[r * 256 + tid] = 0.f;
    } else {
      const int e = (it - B_ROPE) * 256 + tid;
      const int n = e >> 4, pr = e & 15;
      const double q4[4] = {1.0, 0.5623413251903491, 0.31622776601683794, 0.1778279410038923};
      double inv = q4[0];
      if ((pr & 3) == 1) inv = q4[1]; else if ((pr & 3) == 2) inv = q4[2]; else if ((pr & 3) == 3) inv = q4[3];
      const int dec = pr >> 2;
      if (dec == 1) inv *= 0.1; else if (dec == 2) inv *= 0.01; else if (dec == 3) inv *= 0.001;
      const double ap = (double)n * inv / 3.14159265358979323846;
      const double ar = ap - 2.0 * rint(ap * 0.5);
      ((float2*)(ws + OFF_ROPE))[e] = make_float2(cospif((float)ar), sinpif((float)ar));
    }
  }
}

template <int MODE>
DI void phase_rows(const Params& p) {
  unsigned char* ws = p.ws;
  const int lane = threadIdx.x & 63, wave = threadIdx.x >> 6;
  const float* mod = (const float*)(ws + OFF_MOD);
  for (int it = blockIdx.x; it < NTOK / 4; it += gridDim.x) {
    const int T = it * 4 + wave;
    const int ci = cond_of(T);
    float4 xv[4];
    if (MODE == 2) {
      const float4* xr = (const float4*)((const float*)(ws + OFF_X1) + (size_t)T * 1024) + lane;
#pragma unroll
      for (int j = 0; j < 4; ++j) xv[j] = xr[64 * j];
    } else {
      const float4* xr = (const float4*)xrow(p, T) + lane;
#pragma unroll
      for (int j = 0; j < 4; ++j) xv[j] = xr[64 * j];
    }
    if (MODE >= 1) {
      const int l = MODE - 1;
      const bfr* orow = (const bfr*)(ws + OFF_O) + (size_t)T * 1024;
      float4 ov[4]; float ss = 0.f;
#pragma unroll
      for (int j = 0; j < 4; ++j) {
        const uint2 raw = *(const uint2*)(orow + lane * 4 + 256 * j);
        ov[j].x = bf2f(raw.x & 0xffff); ov[j].y = bf2f(raw.x >> 16); ov[j].z = bf2f(raw.y & 0xffff); ov[j].w = bf2f(raw.y >> 16);
        ss += ov[j].x * ov[j].x + ov[j].y * ov[j].y + ov[j].z * ov[j].z + ov[j].w * ov[j].w;
      }
      const float rinv = rsqrtf(wave_sum(ss) * (1.f / 1024.f) + EPS);
      const float* gate = mod + (l * 3 + ci) * 3072 + 2048;
      const float* gp = p.in[10] + l * 1024;
#pragma unroll
      for (int j = 0; j < 4; ++j) {
        const int k = lane * 4 + 256 * j;
        const float4 g4 = *(const float4*)(gate + k), n4 = *(const float4*)(gp + k);
        xv[j].x += g4.x * (ov[j].x * rinv * n4.x); xv[j].y += g4.y * (ov[j].y * rinv * n4.y);
        xv[j].z += g4.z * (ov[j].z * rinv * n4.z); xv[j].w += g4.w * (ov[j].w * rinv * n4.w);
      }
      if (MODE == 2) {
        float4* yr = (float4*)(p.out + OUT_Y + (size_t)T * 1024) + lane;
#pragma unroll
        for (int j = 0; j < 4; ++j) yr[64 * j] = xv[j];
      } else {
        float4* x1r = (float4*)((float*)(ws + OFF_X1) + (size_t)T * 1024) + lane;
#pragma unroll
        for (int j = 0; j < 4; ++j) x1r[64 * j] = xv[j];
      }
    }
    if (MODE <= 1) {
      const int l = MODE;
      float ss = 0.f;
#pragma unroll
      for (int j = 0; j < 4; ++j) ss += xv[j].x * xv[j].x + xv[j].y * xv[j].y + xv[j].z * xv[j].z + xv[j].w * xv[j].w;
      const float rinv = rsqrtf(wave_sum(ss) * (1.f / 1024.f) + EPS);
      const float* shift = mod + (l * 3 + ci) * 3072;
      const float* scale = shift + 1024;
      const float* gp = p.in[9] + l * 1024;
      bfr* hr = (bfr*)(ws + OFF_HN) + (size_t)T * 1024;
#pragma unroll
      for (int j = 0; j < 4; ++j) {
        const int k = lane * 4 + 256 * j;
        const float4 s4 = *(const float4*)(shift + k), c4 = *(const float4*)(scale + k), n4 = *(const float4*)(gp + k);
        const float a = xv[j].x * rinv * n4.x * (1.f + c4.x) + s4.x;
        const float b = xv[j].y * rinv * n4.y * (1.f + c4.y) + s4.y;
        const float c = xv[j].z * rinv * n4.z * (1.f + c4.z) + s4.z;
        const float d = xv[j].w * rinv * n4.w * (1.f + c4.w) + s4.w;
        *(uint2*)(hr + k) = make_uint2(pk2(a, b), pk2(c, d));
      }
    }
  }
}

DI void phase_win0(const Params& p, unsigned char* smem) {
  unsigned char* ws = p.ws;
  const int lane = threadIdx.x & 63, wave = threadIdx.x >> 6, l32 = lane & 31, h = lane >> 5, wm = wave >> 1, wn = wave & 1;
  const bfr* A = (const bfr*)(ws + OFF_HN);
  const bfr* Bt = (const bfr*)(ws + OFF_WIN0);
  for (int step = 0;; ++step) {
    int tm, tn;
    if (!xcd_tile(step, 18, tm, tn)) break;
    const int m0 = tm * 128, n0 = tn * 128;
    LdBf al{A + (size_t)m0 * 1024, 1024}, bl{Bt + (size_t)n0 * 1024, 1024};
    auto ep = [&](f32x16 (&acc)[2][2]) {
      const int colbase = n0 + wn * 64, rbase = m0 + wm * 64;
      const bool lat = m0 >= NCTX;
      if (colbase < 640) {
        const bool isq = colbase < 512;
        const float* gain = isq ? p.in[12] : p.in[13];
        const float g0 = gain[l32], g1 = gain[32 + l32];
        const int hd = isq ? (colbase >> 6) : ((colbase - 512) >> 6);
        const float2* rope = (const float2*)(ws + OFF_ROPE);
        const float sgn = (l32 & 16) ? 1.f : -1.f;
#pragma unroll
        for (int mi = 0; mi < 2; ++mi)
#pragma unroll
          for (int i = 0; i < 16; ++i) {
            float v0 = acc[mi][0][i], v1 = acc[mi][1][i];
            const float ss = half_sum32(v0 * v0 + v1 * v1);
            const float rinv = rsqrtf(ss * (1.f / 64.f) + EPS);
            v0 *= rinv * g0; v1 *= rinv * g1;
            const int r = rbase + mi * 32 + crow(i, h);
            if (!lat && !isq) {
              p.out[OUT_K + (size_t)r * 128 + hd * 64 + l32] = v0;
              p.out[OUT_K + (size_t)r * 128 + hd * 64 + 32 + l32] = v1;
            }
            if (lat) {
              const int pos = (r - NCTX) & 2047, prow = pos >> 6, pcol = pos & 63;
              const float2 c0 = rope[prow * 16 + (l32 & 15)], c1 = rope[pcol * 16 + (l32 & 15)];
              const float q0 = __shfl_xor(v0, 16), q1 = __shfl_xor(v1, 16);
              v0 = v0 * c0.x + sgn * q0 * c0.y;
              v1 = v1 * c1.x + sgn * q1 * c1.y;
            }
            if (isq) {
              bfr* q = (bfr*)(ws + OFF_QB) + (size_t)r * 512 + hd * 64;
              q[l32] = f2bf(v0 * 0.125f); q[32 + l32] = f2bf(v1 * 0.125f);
            } else if (!lat) {
              const int b = r >> 8, l = r & 255;
              bfr* k = (bfr*)(ws + OFF_KC) + ((size_t)(b * 2 + hd) * 256 + l) * 64;
              k[l32] = f2bf(v0); k[32 + l32] = f2bf(v1);
            } else {
              const int b = (r - NCTX) >> 11, l = (r - NCTX) & 2047;
              bfr* k = (bfr*)(ws + OFF_KL) + ((size_t)(b * 2 + hd) * 2560 + 512 + l) * 64;
              k[l32] = f2bf(v0); k[32 + l32] = f2bf(v1);
            }
          }
      } else if (colbase < 768) {
        const int hd = (colbase - 640) >> 6;
#pragma unroll
        for (int mi = 0; mi < 2; ++mi)
#pragma unroll
          for (int ni = 0; ni < 2; ++ni) {
            const int d = ni * 32 + l32;
#pragma unroll
            for (int i4 = 0; i4 < 4; ++i4) {
              const int r0 = rbase + mi * 32 + 8 * i4 + 4 * h;
              const float a = acc[mi][ni][4 * i4], b2 = acc[mi][ni][4 * i4 + 1], c = acc[mi][ni][4 * i4 + 2], e = acc[mi][ni][4 * i4 + 3];
              const uint2 pk = make_uint2(pk2(a, b2), pk2(c, e));
              if (!lat) {
                p.out[OUT_V + (size_t)(r0 + 0) * 128 + hd * 64 + d] = a;
                p.out[OUT_V + (size_t)(r0 + 1) * 128 + hd * 64 + d] = b2;
                p.out[OUT_V + (size_t)(r0 + 2) * 128 + hd * 64 + d] = c;
                p.out[OUT_V + (size_t)(r0 + 3) * 128 + hd * 64 + d] = e;
                const int b = r0 >> 8, l = r0 & 255;
                *(uint2*)((bfr*)(ws + OFF_VC) + ((size_t)(b * 2 + hd) * 64 + d) * 256 + l) = pk;
              } else {
                const int b = (r0 - NCTX) >> 11, l = (r0 - NCTX) & 2047;
                *(uint2*)((bfr*)(ws + OFF_VL) + ((size_t)(b * 2 + hd) * 64 + d) * 2560 + 512 + l) = pk;
              }
            }
          }
      } else {
        const int sec = colbase < 1280 ? 0 : (colbase < 1792 ? 1 : 2);
        const int cb = colbase - (sec == 0 ? 768 : (sec == 1 ? 1280 : 1792));
#pragma unroll
        for (int mi = 0; mi < 2; ++mi)
#pragma unroll
          for (int ni = 0; ni < 2; ++ni)
#pragma unroll
            for (int i = 0; i < 16; ++i) {
              const int r = rbase + mi * 32 + crow(i, h);
              const int c = cb + ni * 32 + l32;
              const float v = acc[mi][ni][i];
              if (sec == 0) ((bfr*)(ws + OFF_GA))[(size_t)r * 512 + c] = f2bf(silu_f(v));
              else if (sec == 1) ((float*)(ws + OFF_U))[(size_t)r * 512 + c] = v;
              else ((bfr*)(ws + OFF_GB))[(size_t)r * 512 + c] = f2bf(silu_f(v));
            }
      }
    };
    gemm_tile<128>(16, false, al, bl, ep, smem);
  }
}

DI void attn_item(const Params& p, unsigned char* smem, int it) {
  unsigned char* ws = p.ws;
  const int tid = threadIdx.x, lane = tid & 63, wave = tid >> 6, l32 = lane & 31, h = lane >> 5;
  int T0, nkeys, ldv; const bfr *Kp, *Vp; int kvh;
  if (it < 256) {
    const int b = it >> 7, qt = it & 63; kvh = (it >> 6) & 1;
    T0 = NCTX + b * 2048 + qt * 32; nkeys = 2560; ldv = 2560;
    Kp = (const bfr*)(ws + OFF_KL) + (size_t)(b * 2 + kvh) * 2560 * 64;
    Vp = (const bfr*)(ws + OFF_VL) + (size_t)(b * 2 + kvh) * 64 * 2560;
  } else {
    const int i2 = it - 256; const int b = i2 >> 4, qt = i2 & 7; kvh = (i2 >> 3) & 1;
    T0 = b * 256 + qt * 32; nkeys = 256; ldv = 256;
    Kp = (const bfr*)(ws + OFF_KC) + (size_t)(b * 2 + kvh) * 256 * 64;
    Vp = (const bfr*)(ws + OFF_VC) + (size_t)(b * 2 + kvh) * 64 * 256;
  }
  const int head = kvh * 4 + wave;
  unsigned short* Ks = (unsigned short*)smem;
  unsigned short* Vs = Ks + 64 * 72;
  bf16x8 qf[4];
  {
    const bfr* q = (const bfr*)(ws + OFF_QB) + (size_t)(T0 + l32) * 512 + head * 64 + 8 * h;
#pragma unroll
    for (int ks = 0; ks < 4; ++ks) qf[ks] = *(const bf16x8*)(q + 16 * ks);
  }
  float m = -1e30f, lsum = 0.f;
  f32x16 O[2];
#pragma unroll
  for (int i = 0; i < 16; ++i) { O[0][i] = 0.f; O[1][i] = 0.f; }
  const int rr0 = tid >> 3, cc0 = (tid & 7) * 8;
  const bfr* kp0 = Kp + (size_t)rr0 * 64 + cc0;
  const bfr* vp0 = Vp + (size_t)rr0 * ldv + cc0;
  uint4 kreg0 = *(const uint4*)kp0, kreg1 = *(const uint4*)(kp0 + 32 * 64);
  uint4 vreg0 = *(const uint4*)vp0, vreg1 = *(const uint4*)(vp0 + (size_t)32 * ldv);
  for (int k0 = 0; k0 < nkeys; k0 += 64) {
    __syncthreads();
    *(uint4*)(Ks + rr0 * 72 + cc0) = kreg0; *(uint4*)(Ks + (rr0 + 32) * 72 + cc0) = kreg1;
    *(uint4*)(Vs + rr0 * 72 + cc0) = vreg0; *(uint4*)(Vs + (rr0 + 32) * 72 + cc0) = vreg1;
    __syncthreads();
    if (k0 + 64 < nkeys) {
      kreg0 = *(const uint4*)(kp0 + (size_t)(k0 + 64) * 64); kreg1 = *(const uint4*)(kp0 + (size_t)(k0 + 96) * 64);
      vreg0 = *(const uint4*)(vp0 + k0 + 64); vreg1 = *(const uint4*)(vp0 + (size_t)32 * ldv + k0 + 64);
    }
    f32x16 st[2];
#pragma unroll
    for (int kt = 0; kt < 2; ++kt) {
#pragma unroll
      for (int i = 0; i < 16; ++i) st[kt][i] = 0.f;
#pragma unroll
      for (int ks = 0; ks < 4; ++ks) {
        const bf16x8 a = *(const bf16x8*)(Ks + (32 * kt + l32) * 72 + 16 * ks + 8 * h);
        st[kt] = MFMA32(a, qf[ks], st[kt]);
      }
    }
    float mx = st[0][0];
#pragma unroll
    for (int i = 0; i < 16; ++i) { mx = fmaxf(mx, st[0][i]); mx = fmaxf(mx, st[1][i]); }
    mx = fmaxf(mx, __shfl_xor(mx, 32));
    const float mn = fmaxf(m, mx);
    const float alpha = __expf(m - mn);
    m = mn;
    float ps = 0.f;
#pragma unroll
    for (int kt = 0; kt < 2; ++kt)
#pragma unroll
      for (int i = 0; i < 16; ++i) { const float e = __expf(st[kt][i] - mn); st[kt][i] = e; ps += e; }
    lsum = lsum * alpha + ps;
#pragma unroll
    for (int i = 0; i < 16; ++i) { O[0][i] *= alpha; O[1][i] *= alpha; }
#pragma unroll
    for (int kt = 0; kt < 2; ++kt)
#pragma unroll
      for (int s = 0; s < 2; ++s) {
        const uint4 pu = make_uint4(pk2(st[kt][8 * s], st[kt][8 * s + 1]), pk2(st[kt][8 * s + 2], st[kt][8 * s + 3]),
                                    pk2(st[kt][8 * s + 4], st[kt][8 * s + 5]), pk2(st[kt][8 * s + 6], st[kt][8 * s + 7]));
        const bf16x8 pf = __builtin_bit_cast(bf16x8, pu);
#pragma unroll
        for (int dt = 0; dt < 2; ++dt) {
          const unsigned short* vr = Vs + (32 * dt + l32) * 72 + 32 * kt + 16 * s + 4 * h;
          const s16x4 lo = *(const s16x4*)vr, hi = *(const s16x4*)(vr + 8);
          const bf16x8 va = __builtin_shufflevector(lo, hi, 0, 1, 2, 3, 4, 5, 6, 7);
          O[dt] = MFMA32(va, pf, O[dt]);
        }
      }
  }
  const float ltot = lsum + __shfl_xor(lsum, 32);
  const float inv = 1.f / ltot;
  const int T = T0 + l32;
#pragma unroll
  for (int dt = 0; dt < 2; ++dt)
#pragma unroll
    for (int i4 = 0; i4 < 4; ++i4) {
      const int d = 32 * dt + 8 * i4 + 4 * h;
      const uint2 g = *(const uint2*)((const bfr*)(ws + OFF_GA) + (size_t)T * 512 + head * 64 + d);
      const float a = O[dt][4 * i4] * inv * bf2f(g.x & 0xffff), b = O[dt][4 * i4 + 1] * inv * bf2f(g.x >> 16);
      const float c = O[dt][4 * i4 + 2] * inv * bf2f(g.y & 0xffff), e = O[dt][4 * i4 + 3] * inv * bf2f(g.y >> 16);
      *(uint2*)((bfr*)(ws + OFF_MIX) + (size_t)T * 1024 + head * 64 + d) = make_uint2(pk2(a, b), pk2(c, e));
    }
}

DI int seg_T0(int seg) { return seg < 32 ? seg * 256 : NCTX + ((seg - 32) >> 3) * 2048 + ((seg - 32) & 7) * 256; }

DI void split_bf16(const float4& v0, const float4& v1, bf16x8& hi, bf16x8& lo) {
  const unsigned h0 = pk2(v0.x, v0.y), h1 = pk2(v0.z, v0.w), h2 = pk2(v1.x, v1.y), h3 = pk2(v1.z, v1.w);
  hi = __builtin_bit_cast(bf16x8, make_uint4(h0, h1, h2, h3));
  const unsigned l0 = pk2(v0.x - bf2f(h0 & 0xffff), v0.y - bf2f(h0 >> 16)), l1 = pk2(v0.z - bf2f(h1 & 0xffff), v0.w - bf2f(h1 >> 16));
  const unsigned l2 = pk2(v1.x - bf2f(h2 & 0xffff), v1.y - bf2f(h2 >> 16)), l3 = pk2(v1.z - bf2f(h3 & 0xffff), v1.w - bf2f(h3 >> 16));
  lo = __builtin_bit_cast(bf16x8, make_uint4(l0, l1, l2, l3));
}

DI void s5_wave(const Params& p, float* BU  , int it) {
  unsigned char* ws = p.ws;
  const int lane = threadIdx.x & 63, l32 = lane & 31, h = lane >> 5;
  const int di = it & 1, g = (it >> 1) & 31, seg = it >> 6;
  const int T0 = seg_T0(seg);
  const int dg = di * 32 + g;
  bf16x8 bhi[4], blo[4];
#pragma unroll
  for (int nt = 0; nt < 4; ++nt) {
    const float* bb = (const float*)(ws + OFF_BB) + (size_t)(dg * 64 + (nt & 1) * 32 + l32) * 32 + (nt >> 1) * 16 + 8 * h;
    split_bf16(*(const float4*)bb, *(const float4*)(bb + 4), bhi[nt], blo[nt]);
  }
  const float2 lam = ((const float2*)(ws + OFF_LAMB))[dg * 64 + lane];
  bf16x8 cmf[4];
  {
    const bfr* cm = (const bfr*)(ws + OFF_CMB) + (size_t)dg * 2048 + (lane & 15) * 128 + 8 * (lane >> 4);
#pragma unroll
    for (int ks = 0; ks < 4; ++ks) cmf[ks] = *(const bf16x8*)(cm + 32 * ks);
  }
  float hr = 0.f, hi = 0.f;
  bfr* yout = (bfr*)(ws + (di == 0 ? OFF_YF : OFF_YB));
  const float* ubase = (const float*)(ws + OFF_U) + g * 16 + 8 * h;
  float4 u0, u1;
  { const int T = di == 0 ? T0 + l32 : T0 + 255 - l32; const float* up = ubase + (size_t)T * 512; u0 = *(const float4*)up; u1 = *(const float4*)(up + 4); }
  for (int c = 0; c < 8; ++c) {
    bf16x8 ahi, alo;
    split_bf16(u0, u1, ahi, alo);
    if (c < 7) { const int sg = 32 * (c + 1) + l32; const int T = di == 0 ? T0 + sg : T0 + 255 - sg; const float* up = ubase + (size_t)T * 512; u0 = *(const float4*)up; u1 = *(const float4*)(up + 4); }
#pragma unroll
    for (int nt = 0; nt < 4; ++nt) {
      f32x16 acc;
#pragma unroll
      for (int i = 0; i < 16; ++i) acc[i] = 0.f;
      acc = MFMA32(ahi, bhi[nt], acc);
      acc = MFMA32(alo, bhi[nt], acc);
      acc = MFMA32(ahi, blo[nt], acc);
#pragma unroll
      for (int i = 0; i < 16; ++i) BU[crow(i, h) * 132 + 32 * nt + l32] = acc[i];
    }
    __builtin_amdgcn_wave_barrier();
#pragma unroll 8
    for (int sl = 0; sl < 32; ++sl) {
      const float br = BU[sl * 132 + lane], bi = BU[sl * 132 + 64 + lane];
      const float nr = lam.x * hr - lam.y * hi + br;
      const float ni = lam.x * hi + lam.y * hr + bi;
      hr = nr; hi = ni;
      BU[sl * 132 + lane] = hr; BU[sl * 132 + 64 + lane] = hi;
    }
    __builtin_amdgcn_wave_barrier();
#pragma unroll
    for (int tt = 0; tt < 2; ++tt) {
      f32x4 acc = {0.f, 0.f, 0.f, 0.f};
      const float* hrow = BU + (16 * tt + (lane & 15)) * 132 + 8 * (lane >> 4);
#pragma unroll
      for (int ks = 0; ks < 4; ++ks) {
        const float4 v0 = *(const float4*)(hrow + 32 * ks), v1 = *(const float4*)(hrow + 32 * ks + 4);
        const bf16x8 a = __builtin_bit_cast(bf16x8, make_uint4(pk2(v0.x, v0.y), pk2(v0.z, v0.w), pk2(v1.x, v1.y), pk2(v1.z, v1.w)));
        acc = MFMA16(a, cmf[ks], acc);
      }
#pragma unroll
      for (int i = 0; i < 4; ++i) {
        const int sg = 32 * c + 16 * tt + 4 * (lane >> 4) + i;
        const int T = di == 0 ? T0 + sg : T0 + 255 - sg;
        yout[(size_t)T * 512 + g * 16 + (lane & 15)] = f2bf(acc[i]);
      }
    }
    __builtin_amdgcn_wave_barrier();
  }
  ((float2*)(ws + OFF_E))[((size_t)(seg * 2 + di) * 32 + g) * 64 + lane] = make_float2(hr, hi);
  if (seg < 32) {
    float* so = p.out + OUT_S + (size_t)((seg * 2 + di) * 2) * 2048 + g * 64 + lane;
    so[0] = hr; so[2048] = hi;
  }
}

DI void phase_mix0(const Params& p, unsigned char* smem) {
  constexpr int N_S5 = 3072;
  const int b = blockIdx.x, G = gridDim.x, wave = threadIdx.x >> 6;
  float* BUw = (float*)smem + wave * (32 * 132);
  if (G == 512) {
    if (b < 256) {
      attn_item(p, smem, b);
    } else {
      const int bb = b - 256;
      for (int r = 0; r < 3; ++r) s5_wave(p, BUw, bb * 12 + r * 4 + wave);
      for (int r = 0; r < 2; ++r) { __syncthreads(); attn_item(p, smem, 256 + bb * 2 + r); }
    }
  } else {
    for (int it = b * 4 + wave; it < N_S5; it += G * 4) s5_wave(p, BUw, it);
    for (int it = b; it < 768; it += G) { __syncthreads(); attn_item(p, smem, it); }
  }
}

DI void phase_s5fix(const Params& p, unsigned char* smem) {
  unsigned char* ws = p.ws;
  const int tid = threadIdx.x, lane = tid & 63, wave = tid >> 6;
  float* HC = (float*)smem;
  float* ycorr = HC + 32 * 132;
  for (int it = blockIdx.x; it < 48 * 32; it += gridDim.x) {
    const int g = it & 31, seg = it >> 5;
    const int T0 = seg_T0(seg);
    __syncthreads();
    for (int e = tid; e < 4096; e += 256) ycorr[e] = 0.f;
    __syncthreads();
    if (seg >= 32) {
      const int b = (seg - 32) >> 3, j = (seg - 32) & 7;
      for (int di = 0; di < 2; ++di) {
        const int dg = di * 32 + g;
        float hr = 0.f, hi = 0.f, cr = 0.f, cim = 0.f;
        float2 lam = make_float2(0.f, 0.f);
        if (wave == 0) {
          lam = ((const float2*)(ws + OFF_LAMB))[dg * 64 + lane];
          const float2 lp = ((const float2*)(ws + OFF_LAMP))[dg * 64 + lane];
          const float* st = p.in[4] + (size_t)((b * 2 + di) * 2) * 2048 + g * 64 + lane;
          hr = st[0]; hi = st[2048];
          const int nprev = di == 0 ? j : 7 - j;
          for (int q = 0; q < nprev; ++q) {
            const int jj = di == 0 ? q : 7 - q;
            const float2 e = ((const float2*)(ws + OFF_E))[((size_t)((32 + b * 8 + jj) * 2 + di) * 32 + g) * 64 + lane];
            const float nr = lp.x * hr - lp.y * hi + e.x, ni = lp.x * hi + lp.y * hr + e.y;
            hr = nr; hi = ni;
          }
          cr = lam.x; cim = lam.y;
        }
        bf16x8 cmf[4];
        {
          const bfr* cm = (const bfr*)(ws + OFF_CMB) + (size_t)dg * 2048 + (lane & 15) * 128 + 8 * (lane >> 4);
#pragma unroll
          for (int ks = 0; ks < 4; ++ks) cmf[ks] = *(const bf16x8*)(cm + 32 * ks);
        }
        for (int c = 0; c < 8; ++c) {
          __syncthreads();
          if (wave == 0) {
#pragma unroll 8
            for (int sl = 0; sl < 32; ++sl) {
              HC[sl * 132 + lane] = cr * hr - cim * hi;
              HC[sl * 132 + 64 + lane] = cr * hi + cim * hr;
              const float nr = cr * lam.x - cim * lam.y, ni = cr * lam.y + cim * lam.x;
              cr = nr; cim = ni;
            }
          }
          __syncthreads();
          if (wave < 2) {
            f32x4 acc = {0.f, 0.f, 0.f, 0.f};
            const float* hrow = HC + (16 * wave + (lane & 15)) * 132 + 8 * (lane >> 4);
#pragma unroll
            for (int ks = 0; ks < 4; ++ks) {
              const float4 v0 = *(const float4*)(hrow + 32 * ks), v1 = *(const float4*)(hrow + 32 * ks + 4);
              const bf16x8 a = __builtin_bit_cast(bf16x8, make_uint4(pk2(v0.x, v0.y), pk2(v0.z, v0.w), pk2(v1.x, v1.y), pk2(v1.z, v1.w)));
              acc = MFMA16(a, cmf[ks], acc);
            }
#pragma unroll
            for (int i = 0; i < 4; ++i) {
              const int sg = 32 * c + 16 * wave + 4 * (lane >> 4) + i;
              const int tl = di == 0 ? sg : 255 - sg;
              atomicAdd(&ycorr[tl * 16 + (lane & 15)], acc[i]);
            }
          }
        }
      }
      __syncthreads();
    }
    {
      const int T = T0 + tid;
      const float* up = (const float*)(ws + OFF_U) + (size_t)T * 512 + g * 16;
      const bfr* yf = (const bfr*)(ws + OFF_YF) + (size_t)T * 512 + g * 16;
      const bfr* yb = (const bfr*)(ws + OFF_YB) + (size_t)T * 512 + g * 16;
      const float* dsk = p.in[21] + g * 16;
      unsigned o[8];
#pragma unroll
      for (int q = 0; q < 2; ++q) {
        const uint4 f = *(const uint4*)(yf + 8 * q), bk = *(const uint4*)(yb + 8 * q);
        const float4 u0 = *(const float4*)(up + 8 * q), u1 = *(const float4*)(up + 8 * q + 4);
        const float4 d0 = *(const float4*)(dsk + 8 * q), d1 = *(const float4*)(dsk + 8 * q + 4);
        const float* yc = ycorr + tid * 16 + 8 * q;
        const float uu[8] = {u0.x, u0.y, u0.z, u0.w, u1.x, u1.y, u1.z, u1.w};
        const float dd[8] = {d0.x, d0.y, d0.z, d0.w, d1.x, d1.y, d1.z, d1.w};
        const unsigned ff[4] = {f.x, f.y, f.z, f.w}, bb[4] = {bk.x, bk.y, bk.z, bk.w};
        float y[8];
#pragma unroll
        for (int e = 0; e < 8; ++e) {
          const float a = (e & 1) ? bf2f(ff[e >> 1] >> 16) : bf2f(ff[e >> 1] & 0xffff);
          const float c2 = (e & 1) ? bf2f(bb[e >> 1] >> 16) : bf2f(bb[e >> 1] & 0xffff);
          y[e] = gelu_f(uu[e] * dd[e] + a + c2 + yc[e]);
        }
#pragma unroll
        for (int e = 0; e < 4; ++e) o[4 * q + e] = pk2(y[2 * e], y[2 * e + 1]);
      }
      uint4* dst = (uint4*)((bfr*)(ws + OFF_YG) + (size_t)T * 512 + g * 16);
      dst[0] = make_uint4(o[0], o[1], o[2], o[3]);
      dst[1] = make_uint4(o[4], o[5], o[6], o[7]);
    }
  }
}

template <int MODE>
DI void phase_tokgemm(const Params& p, unsigned char* smem, int layer) {
  unsigned char* ws = p.ws;
  const int lane = threadIdx.x & 63, wave = threadIdx.x >> 6, l32 = lane & 31, h = lane >> 5, wm = wave >> 1, wn = wave & 1;
  constexpr int K = MODE == 1 ? 1024 : 512, N = MODE == 1 ? 1024 : 512;
  const bfr* A = (const bfr*)(ws + (MODE == 0 ? OFF_YG : (MODE == 1 ? OFF_MIX : OFF_FZ)));
  const bfr* Bt = (const bfr*)(ws + (MODE == 0 ? OFF_GLU : (MODE == 1 ? (layer == 0 ? OFF_WOUT0 : OFF_WOUT1) : OFF_FNET)));
  constexpr int TN = N / 128;
  for (int step = 0;; ++step) {
    int tm, tn;
    if (!xcd_tile(step, TN, tm, tn)) break;
    const int m0 = tm * 128, n0 = tn * 128;
    LdBf bl{Bt + (size_t)n0 * K, (size_t)K};
    auto ep = [&](f32x16 (&acc)[2][2]) {
#pragma unroll
      for (int mi = 0; mi < 2; ++mi)
#pragma unroll
        for (int ni = 0; ni < 2; ++ni)
#pragma unroll
          for (int i = 0; i < 16; ++i) {
            const int r = m0 + wm * 64 + mi * 32 + crow(i, h);
            const int n = n0 + wn * 64 + ni * 32 + l32;
            const float v = acc[mi][ni][i];
            if (MODE == 0) {
              const float y = bf2f(((const bfr*)(ws + OFF_YG))[(size_t)r * 512 + n]);
              const float gbv = bf2f(((const bfr*)(ws + OFF_GB))[(size_t)r * 512 + n]);
              ((bfr*)(ws + OFF_MIX))[(size_t)r * 1024 + 512 + n] = f2bf(y * sigmoid_f(v + p.in[23][n]) * gbv);
            } else if (MODE == 1) {
              ((bfr*)(ws + OFF_O))[(size_t)r * 1024 + n] = f2bf(v);
            } else {
              const float gd = bf2f(((const bfr*)(ws + OFF_GDS))[(size_t)r * 512 + n]);
              ((bfr*)(ws + OFF_MIX))[(size_t)r * 1024 + 512 + n] = f2bf(v * gd);
            }
          }
    };
    if constexpr (MODE == 2) {
      if (m0 < NCTX) {
        LdBf al{A + (size_t)m0 * K, (size_t)K};
        gemm_tile<128>(K / 64, false, al, bl, ep, smem);
      } else {
        LdFz al{(const bfr*)(ws + OFF_HN) + (size_t)(m0 - NCTX) * 512};
        gemm_tile<128, false>(K / 64, false, al, bl, ep, smem);
      }
    } else {
      LdBf al{A + (size_t)m0 * K, (size_t)K};
      gemm_tile<128>(K / 64, false, al, bl, ep, smem);
    }
  }
}

DI void phase_win1(const Params& p, unsigned char* smem) {
  unsigned char* ws = p.ws;
  const int lane = threadIdx.x & 63, wave = threadIdx.x >> 6, l32 = lane & 31, h = lane >> 5, wm = wave >> 1, wn = wave & 1;
  const bfr* A = (const bfr*)(ws + OFF_HN);
  const bfr* Bt = (const bfr*)(ws + OFF_WIN1);
  for (int step = 0;; ++step) {
    int tm, tn;
    if (!xcd_tile(step, 24, tm, tn)) break;
    const int m0 = tm * 128, n0 = tn * 128;
    LdBf al{A + (size_t)m0 * 1024, 1024}, bl{Bt + (size_t)n0 * 1024, 1024};
    auto ep = [&](f32x16 (&acc)[2][2]) {
      const int colbase = n0 + wn * 64, rbase = m0 + wm * 64;
      const int sec = colbase >> 9;
      const int cb = colbase & 511;
      const bool lat = m0 >= NCTX;
      if (sec == 0 || sec == 2 || sec == 5) {
        bfr* dst = (bfr*)(ws + (sec == 0 ? OFF_CUG : (sec == 2 ? OFF_GCS : OFF_GDS)));
#pragma unroll
        for (int mi = 0; mi < 2; ++mi)
#pragma unroll
          for (int ni = 0; ni < 2; ++ni)
#pragma unroll
            for (int i = 0; i < 16; ++i) {
              const int r = rbase + mi * 32 + crow(i, h);
              const float v = acc[mi][ni][i];
              dst[(size_t)r * 512 + cb + ni * 32 + l32] = f2bf(sec == 0 ? gelu_f(v) : silu_f(v));
            }
      } else if (sec == 1) {
        float* rowss = (float*)(ws + OFF_ROWSS);
#pragma unroll
        for (int mi = 0; mi < 2; ++mi) {
#pragma unroll
          for (int i = 0; i < 16; ++i) {
            const float g0 = gelu_f(acc[mi][0][i]), g1 = gelu_f(acc[mi][1][i]);
            acc[mi][0][i] = g0; acc[mi][1][i] = g1;
            const float ss = half_sum32(g0 * g0 + g1 * g1);
            if (l32 == 0) atomicAdd(rowss + rbase + mi * 32 + crow(i, h), ss);
          }
#pragma unroll
          for (int ni = 0; ni < 2; ++ni)
#pragma unroll
            for (int i4 = 0; i4 < 4; ++i4) {
              const int r0 = rbase + mi * 32 + 8 * i4 + 4 * h;
              const int n = cb + ni * 32 + l32;
              *(uint2*)((bfr*)(ws + OFF_CVT) + (size_t)n * NTOK + r0) =
                  make_uint2(pk2(acc[mi][ni][4 * i4], acc[mi][ni][4 * i4 + 1]), pk2(acc[mi][ni][4 * i4 + 2], acc[mi][ni][4 * i4 + 3]));
            }
        }
      } else {
        const int isz = sec - 3;
#pragma unroll
        for (int mi = 0; mi < 2; ++mi)
#pragma unroll
          for (int ni = 0; ni < 2; ++ni)
#pragma unroll
            for (int i4 = 0; i4 < 4; ++i4) {
              const int r0 = rbase + mi * 32 + 8 * i4 + 4 * h;
              const int n = cb + ni * 32 + l32;
              const uint2 pk = make_uint2(pk2(acc[mi][ni][4 * i4], acc[mi][ni][4 * i4 + 1]), pk2(acc[mi][ni][4 * i4 + 2], acc[mi][ni][4 * i4 + 3]));
              if (!lat) {
                const int b = r0 >> 8, s = r0 & 255;
                *(uint2*)((bfr*)(ws + OFF_ZTC) + ((size_t)(b * 512 + n)) * 512 + isz * 256 + s) = pk;
              } else {
                const int b = (r0 - NCTX) >> 11, s = (r0 - NCTX) & 2047;
                *(uint2*)((bfr*)(ws + OFF_ZTL) + ((size_t)(b * 512 + n)) * 4096 + isz * 2048 + s) = pk;
              }
            }
      }
    };
    gemm_tile<128>(16, false, al, bl, ep, smem);
  }
}

struct LdWs {
  const float* w; const float* rowss;
  const float* p[4]; const float* rp;
  DI void init(int lrow, int lcol) {
#pragma unroll
    for (int i = 0; i < 4; ++i) p[i] = w + (lrow + 32 * i) * 128 + lcol;
    rp = rowss + lcol;
  }
  DI void advance(int adv) {
#pragma unroll
    for (int i = 0; i < 4; ++i) p[i] += 64 * adv;
    rp += 64 * adv;
  }
  DI uint4 load(int i) const {
    const float* wp = p[i];
    const float4 a = *(const float4*)wp, b = *(const float4*)(wp + 4);
    const float4 s0 = *(const float4*)rp, s1 = *(const float4*)(rp + 4);
    const float r0 = rsqrtf(s0.x * (1.f / 512.f) + EPS), r1 = rsqrtf(s0.y * (1.f / 512.f) + EPS), r2 = rsqrtf(s0.z * (1.f / 512.f) + EPS), r3 = rsqrtf(s0.w * (1.f / 512.f) + EPS);
    const float r4 = rsqrtf(s1.x * (1.f / 512.f) + EPS), r5 = rsqrtf(s1.y * (1.f / 512.f) + EPS), r6 = rsqrtf(s1.z * (1.f / 512.f) + EPS), r7 = rsqrtf(s1.w * (1.f / 512.f) + EPS);
    return make_uint4(pk2(a.x * r0, a.y * r1), pk2(a.z * r2, a.w * r3), pk2(b.x * r4, b.y * r5), pk2(b.z * r6, b.w * r7));
  }
};

DI void phase_mix1(const Params& p, unsigned char* smem) {
  unsigned char* ws = p.ws;
  const int lane = threadIdx.x & 63, wave = threadIdx.x >> 6, l32 = lane & 31, h = lane >> 5, wm = wave >> 1, wn = wave & 1;
  constexpr int N_FL = 512, N_FC = 256, N_G = 768;
  for (int it = blockIdx.x; it < N_FL + N_FC + N_G; it += gridDim.x) {
    if (it < N_FL + N_FC) {
      const bfr *A, *Bt; int K, Tbase, tm, tn;
      int kq = 0; bool isl = it < N_FL;
      if (isl) {
        const int b = it >> 8; kq = it & 3; tn = (it >> 2) & 3; tm = (it >> 4) & 15; K = 4096;
        A = (const bfr*)(ws + OFF_ALAT) + kq * 1024; Bt = (const bfr*)(ws + OFF_ZTL) + (size_t)b * 512 * 4096 + kq * 1024; Tbase = NCTX + b * 2048;
      } else {
        const int i2 = it - N_FL; const int b = i2 >> 3; tm = (i2 >> 2) & 1; tn = i2 & 3; K = 512;
        A = (const bfr*)(ws + OFF_ACTX); Bt = (const bfr*)(ws + OFF_ZTC) + (size_t)b * 512 * 512; Tbase = b * 256;
      }
      LdBf al{A + (size_t)tm * 128 * K, (size_t)K}, bl{Bt + (size_t)tn * 128 * K, (size_t)K};
      auto ep = [&](f32x16 (&acc)[2][2]) {
#pragma unroll
        for (int mi = 0; mi < 2; ++mi)
#pragma unroll
          for (int ni = 0; ni < 2; ++ni)
#pragma unroll
            for (int i = 0; i < 16; ++i) {
              const int T = Tbase + tm * 128 + wm * 64 + mi * 32 + crow(i, h);
              const int n = tn * 128 + wn * 64 + ni * 32 + l32;
              if (!isl) ((bfr*)(ws + OFF_FZ))[(size_t)T * 512 + n] = f2bf(acc[mi][ni][i]);
              else ((bfr*)(ws + OFF_HN))[((size_t)kq * 4096 + (T - NCTX)) * 512 + n] = f2bf(acc[mi][ni][i]);
            }
      };
      gemm_tile<128>(isl ? 16 : K / 64, false, al, bl, ep, smem);
    } else {
      const int i2 = it - N_FL - N_FC; const int hg = i2 & 7, chunk = i2 >> 3;
      LdWs al{p.in[27] + (size_t)hg * 128 * 128, (const float*)(ws + OFF_ROWSS) + chunk * 128};
      LdBf bl{(const bfr*)(ws + OFF_CVT) + (size_t)(hg * 64) * NTOK + chunk * 128, (size_t)NTOK};
      auto ep = [&](f32x16 (&acc)[2][1]) {
        const int c = hg * 64 + wn * 32 + l32;
        const float vg = p.in[26][c];
#pragma unroll
        for (int mi = 0; mi < 2; ++mi)
#pragma unroll
          for (int i = 0; i < 16; ++i) {
            const int t = wm * 64 + mi * 32 + crow(i, h);
            const int T = chunk * 128 + t;
            const float sp = acc[mi][0][i] * vg + p.in[28][hg * 128 + t];
            const float cu = bf2f(((const bfr*)(ws + OFF_CUG))[(size_t)T * 512 + c]);
            const float gc = bf2f(((const bfr*)(ws + OFF_GCS))[(size_t)T * 512 + c]);
            ((bfr*)(ws + OFF_MIX))[(size_t)T * 1024 + c] = f2bf(cu * sp * gc);
          }
      };
      gemm_tile<64>(2, false, al, bl, ep, smem);
    }
  }
}

constexpr int NPHASE = 13;
#ifndef DOUBLE_MASK
#define DOUBLE_MASK 0
#endif
template <int PH>
DI void run_phase(const Params& p, unsigned char* smem) {
  if constexpr (PH == 0) phase0(p, smem);
  else if constexpr (PH == 1) phase_rows<0>(p);
  else if constexpr (PH == 2) phase_win0(p, smem);
  else if constexpr (PH == 3) phase_mix0(p, smem);
  else if constexpr (PH == 4) phase_s5fix(p, smem);
  else if constexpr (PH == 5) phase_tokgemm<0>(p, smem, 0);
  else if constexpr (PH == 6) phase_tokgemm<1>(p, smem, 0);
  else if constexpr (PH == 7) phase_rows<1>(p);
  else if constexpr (PH == 8) phase_win1(p, smem);
  else if constexpr (PH == 9) phase_mix1(p, smem);
  else if constexpr (PH == 10) phase_tokgemm<2>(p, smem, 1);
  else if constexpr (PH == 11) phase_tokgemm<1>(p, smem, 1);
  else if constexpr (PH == 12) phase_rows<2>(p);
}
template <int LO, int HI>
DI void run_range(const Params& p, unsigned char* smem, const XcdBarrier& xb) {
  if constexpr (LO < HI) {
    run_phase<LO>(p, smem);
    if constexpr (((DOUBLE_MASK) >> LO) & 1) { xcd_barrier(xb); run_phase<LO>(p, smem); }
    if constexpr (LO + 1 < HI) { xcd_barrier(xb); run_range<LO + 1, HI>(p, smem, xb); }
  }
}
template <int LO, int HI>
__global__ void __launch_bounds__(256, 2) mega(Params p) {
  __shared__ __attribute__((aligned(16))) unsigned char smem[73728];
  __shared__ uint4 xb_words;
  if (threadIdx.x == 0) xb_words = make_uint4(0u, 0u, 0u, 0u);
  __syncthreads();
  XcdBarrier xb = xcd_barrier_post((unsigned*)(p.ws + OFF_BAR), (volatile LAS unsigned*)&xb_words);
  run_range<LO, HI>(p, smem, xb);
  if (p.ph_lo != 0) cg::this_grid().sync();
}

#ifndef ONE_LAUNCH
#define ONE_LAUNCH 1
#endif
#if !ONE_LAUNCH
template <int PH>
static void launch_phases(Params& p, int grid, hipStream_t stream) {
  if constexpr (PH < NPHASE) {
    hipLaunchKernelGGL((mega<PH, PH + 1>), dim3(grid), dim3(256), 0, stream, p);
    launch_phases<PH + 1>(p, grid, stream);
  }
}
#endif

#ifndef ONE_LAUNCH
#define ONE_LAUNCH 1
#endif

extern "C" void kernel_launch(void* const* d_in, const int* in_sizes, int n_in, void* d_out, int out_size, void* d_ws, size_t ws_size, hipStream_t stream) {
  static int grid_blocks = 0;
  if (!grid_blocks) {
    int dev = 0, cus = 0, per_cu = 0;
    (void)hipGetDevice(&dev);
    (void)hipDeviceGetAttribute(&cus, hipDeviceAttributeMultiprocessorCount, dev);
    (void)hipOccupancyMaxActiveBlocksPerMultiprocessor(&per_cu, mega<0, NPHASE>, 256, 0);
    if (per_cu > 2) per_cu = 2;
    if (per_cu < 1) per_cu = 1;
    grid_blocks = cus * per_cu;
    if (n_in != 31 || ws_size < WS_TOTAL) fprintf(stderr, "kernel_launch: unexpected n_in %d or ws_size %zu (need %zu)\n", n_in, ws_size, (size_t)WS_TOTAL);
  }
  Params p{};
  for (int i = 0; i < 31; ++i) p.in[i] = (const float*)d_in[i];
  p.out = (float*)d_out; p.ws = (unsigned char*)d_ws;
  (void)hipMemsetAsync((unsigned char*)d_ws + OFF_BAR, 0, 16384, stream);
#if ONE_LAUNCH
  p.ph_lo = 0; p.ph_hi = NPHASE;
  void* args[] = {&p};
  hipError_t e = hipLaunchCooperativeKernel((void*)mega<0, NPHASE>, dim3(grid_blocks), dim3(256), args, 0, stream);
  if (e != hipSuccess) fprintf(stderr, "cooperative launch failed: %s (grid %d)\n", hipGetErrorString(e), grid_blocks);
#else
  launch_phases<0>(p, grid_blocks, stream);
#endif
}
```

```cpp
#include <hip/hip_runtime.h>
#include <hip/hip_cooperative_groups.h>
#include <cstdio>
#include <cstdint>
namespace cg = cooperative_groups;

#define DI __device__ __forceinline__
typedef unsigned short bfr;
using bf16x8 = __attribute__((ext_vector_type(8))) short;
using s16x4  = __attribute__((ext_vector_type(4))) short;
using f32x16 = __attribute__((ext_vector_type(16))) float;
using f32x4  = __attribute__((ext_vector_type(4))) float;

#define MFMA32(a, b, c) __builtin_amdgcn_mfma_f32_32x32x16_bf16((a), (b), (c), 0, 0, 0)
#define MFMA16(a, b, c) __builtin_amdgcn_mfma_f32_16x16x32_bf16((a), (b), (c), 0, 0, 0)

constexpr int NTOK = 12288, NCTX = 8192;
constexpr float EPS = 1e-6f;

constexpr size_t OFF_MOD   = 0;
constexpr size_t OFF_ROWSS = OFF_MOD + 73728;
constexpr size_t OFF_ROPE  = OFF_ROWSS + 49152;
constexpr size_t OFF_LAMB  = OFF_ROPE + 8192;
constexpr size_t OFF_LAMP  = OFF_LAMB + 32768;
constexpr size_t OFF_BB    = OFF_LAMP + 32768;
constexpr size_t OFF_CMB   = OFF_BB + 524288;
constexpr size_t OFF_E     = OFF_CMB + 262144;
constexpr size_t OFF_WIN0  = OFF_E + 1572864;
constexpr size_t OFF_GLU   = OFF_WIN0 + 4718592;
constexpr size_t OFF_WOUT0 = OFF_GLU + 524288;
constexpr size_t OFF_WIN1  = OFF_WOUT0 + 2097152;
constexpr size_t OFF_FNET  = OFF_WIN1 + 6291456;
constexpr size_t OFF_WOUT1 = OFF_FNET + 524288;
constexpr size_t OFF_ACTX  = OFF_WOUT1 + 2097152;
constexpr size_t OFF_ALAT  = OFF_ACTX + 262144;
constexpr size_t OFF_X1    = OFF_ALAT + 16777216;
constexpr size_t OFF_HN    = OFF_X1 + 50331648;
constexpr size_t OFF_MIX   = OFF_HN + 25165824;
constexpr size_t OFF_O     = OFF_MIX + 25165824;
constexpr size_t OFF_U     = OFF_O;
constexpr size_t OFF_R     = OFF_O + 25165824;
constexpr size_t OFF_QB = OFF_R;
constexpr size_t OFF_KC = OFF_QB + 12582912;
constexpr size_t OFF_KL = OFF_KC + 2097152;
constexpr size_t OFF_VC = OFF_KL + 1310720;
constexpr size_t OFF_VL = OFF_VC + 2097152;
constexpr size_t OFF_GA = OFF_VL + 1310720;
constexpr size_t OFF_GB = OFF_GA + 12582912;
constexpr size_t OFF_YF = OFF_GB + 12582912;
constexpr size_t OFF_YB = OFF_YF + 12582912;
constexpr size_t OFF_YG = OFF_YB + 12582912;
constexpr size_t END_L0 = OFF_YG + 12582912;
constexpr size_t OFF_CUG = OFF_R;
constexpr size_t OFF_GCS = OFF_CUG + 12582912;
constexpr size_t OFF_GDS = OFF_GCS + 12582912;
constexpr size_t OFF_CVT = OFF_GDS + 12582912;
constexpr size_t OFF_FZ  = OFF_CVT + 12582912;
constexpr size_t OFF_ZTC = OFF_FZ + 12582912;
constexpr size_t OFF_ZTL = OFF_ZTC + 16777216;
constexpr size_t END_L1 = OFF_ZTL + 8388608;
constexpr size_t WS_NEED = (END_L0 > END_L1 ? END_L0 : END_L1);
constexpr size_t OFF_BAR = WS_NEED;
constexpr size_t WS_TOTAL = OFF_BAR + 16384;
static_assert(WS_TOTAL <= (size_t)256 * 1024 * 1024, "workspace too large");

constexpr size_t OUT_Y = 0, OUT_K = 12582912, OUT_V = 13631488, OUT_S = 14680064;

struct Params {
  const float* in[31];
  float* out;
  unsigned char* ws;
  int ph_lo, ph_hi;
};

typedef __bf16 hbf2 __attribute__((ext_vector_type(2)));
typedef float hfl2 __attribute__((ext_vector_type(2)));
DI unsigned pk2(float lo, float hi) { hfl2 v = {lo, hi}; hbf2 r = __builtin_convertvector(v, hbf2); return __builtin_bit_cast(unsigned, r); }
DI unsigned short f2bf(float x) { return (unsigned short)(pk2(x, 0.f) & 0xffffu); }
DI float bf2f(unsigned short b) { return __uint_as_float(((unsigned)b) << 16); }
DI float wave_sum(float v) {
#pragma unroll
  for (int o = 1; o < 64; o <<= 1) v += __shfl_xor(v, o);
  return v;
}
DI float half_sum32(float v) {
#pragma unroll
  for (int o = 1; o < 32; o <<= 1) v += __shfl_xor(v, o);
  return v;
}
DI float silu_f(float x) { return x / (1.f + __expf(-x)); }
DI float sigmoid_f(float x) { return 1.f / (1.f + __expf(-x)); }
DI float gelu_f(float x) { float z = 0.7978845608028654f * (x + 0.044715f * x * x * x); return x / (1.f + __expf(-2.f * z)); }
DI int crow(int i, int h) { return (i & 3) + 8 * (i >> 2) + 4 * h; }
DI const float* xrow(const Params& p, int T) { return T < NCTX ? p.in[0] + (size_t)T * 1024 : p.in[1] + (size_t)(T - NCTX) * 1024; }
DI int cond_of(int T) { return T < NCTX ? 0 : 1 + ((T - NCTX) >> 11); }

template <int BN, bool D2 = true, class AL, class BL, class EP>
DI void gemm_tile(int nk, bool swp, AL al, BL bl, EP ep, unsigned char* smem) {
  constexpr int NI = BN / 64;
  constexpr int NB = BN / 32;
  constexpr int STG = (128 + BN) * 72;
  unsigned short* S0 = (unsigned short*)smem;
  const int tid = threadIdx.x, lane = tid & 63, wave = tid >> 6, l32 = lane & 31, h = lane >> 5;
  const int wm = wave >> 1, wn = wave & 1;
  const int xoff = (swp ? 128 * 72 + (wn * 64 + l32) * 72 : (wm * 64 + l32) * 72) + h * 8;
  const int yoff = (swp ? (wm * 64 + l32) * 72 : 128 * 72 + (wn * (BN / 2) + l32) * 72) + h * 8;
  f32x16 acc[2][NI];
#pragma unroll
  for (int mi = 0; mi < 2; ++mi)
#pragma unroll
    for (int ni = 0; ni < NI; ++ni)
#pragma unroll
      for (int i = 0; i < 16; ++i) acc[mi][ni][i] = 0.f;
  uint4 ra[2][4], rb[2][NB];
  const int lrow = tid >> 3, lcol = (tid & 7) * 8;
  al.init(lrow, lcol); bl.init(lrow, lcol);
  int nxt = 0;
  auto gload = [&](uint4 (&a4)[4], uint4 (&b4)[NB]) {
#pragma unroll
    for (int i = 0; i < 4; ++i) a4[i] = al.load(i);
#pragma unroll
    for (int i = 0; i < NB; ++i) b4[i] = bl.load(i);
    const int adv = (nxt + 1 < nk) ? 1 : 0;
    al.advance(adv); bl.advance(adv); nxt += adv;
  };
  auto lstore = [&](const uint4 (&a4)[4], const uint4 (&b4)[NB], unsigned short* st) {
#pragma unroll
    for (int i = 0; i < 4; ++i) *(uint4*)(st + (lrow + 32 * i) * 72 + lcol) = a4[i];
#pragma unroll
    for (int i = 0; i < NB; ++i) *(uint4*)(st + 128 * 72 + (lrow + 32 * i) * 72 + lcol) = b4[i];
  };
  auto compute = [&](const unsigned short* st) {
#pragma unroll
    for (int ks = 0; ks < 4; ++ks) {
      bf16x8 x[2], y[NI];
#pragma unroll
      for (int mi = 0; mi < 2; ++mi) x[mi] = *(const bf16x8*)(st + xoff + mi * 32 * 72 + ks * 16);
#pragma unroll
      for (int ni = 0; ni < NI; ++ni) y[ni] = *(const bf16x8*)(st + yoff + ni * 32 * 72 + ks * 16);
#pragma unroll
      for (int mi = 0; mi < 2; ++mi)
#pragma unroll
        for (int ni = 0; ni < NI; ++ni) acc[mi][ni] = MFMA32(x[mi], y[ni], acc[mi][ni]);
    }
  };
  if constexpr (D2) {
    gload(ra[0], rb[0]);
    gload(ra[1], rb[1]);
    __syncthreads();
    lstore(ra[0], rb[0], S0);
    gload(ra[0], rb[0]);
    __syncthreads();
    for (int kt = 0; kt < nk; kt += 2) {
      compute(S0);
      lstore(ra[1], rb[1], S0 + STG);
      gload(ra[1], rb[1]);
      __syncthreads();
      compute(S0 + STG);
      if (kt + 2 < nk) lstore(ra[0], rb[0], S0);
      gload(ra[0], rb[0]);
      __syncthreads();
    }
  } else {
    gload(ra[0], rb[0]);
    __syncthreads();
    lstore(ra[0], rb[0], S0);
    gload(ra[0], rb[0]);
    __syncthreads();
    for (int kt = 0; kt < nk; kt += 2) {
      compute(S0);
      lstore(ra[0], rb[0], S0 + STG);
      gload(ra[0], rb[0]);
      __syncthreads();
      compute(S0 + STG);
      if (kt + 2 < nk) lstore(ra[0], rb[0], S0);
      gload(ra[0], rb[0]);
      __syncthreads();
    }
  }
  ep(acc);
}

template <int BN> struct GStage { uint4 ra[2][4]; uint4 rb[2][BN / 32]; int nxt; };
template <int BN, class AL, class BL, class EP, class NX>
DI bool gemm_tile_pf(int nk, bool swp, bool first, AL& al, BL& bl, GStage<BN>& st, EP ep, NX next_tile, unsigned char* smem) {
  constexpr int NI = BN / 64;
  constexpr int NB = BN / 32;
  constexpr int STG = (128 + BN) * 72;
  unsigned short* S0 = (unsigned short*)smem;
  const int tid = threadIdx.x, lane = tid & 63, wave = tid >> 6, l32 = lane & 31, h = lane >> 5;
  const int wm = wave >> 1, wn = wave & 1;
  const int xoff = (swp ? 128 * 72 + (wn * 64 + l32) * 72 : (wm * 64 + l32) * 72) + h * 8;
  const int yoff = (swp ? (wm * 64 + l32) * 72 : 128 * 72 + (wn * (BN / 2) + l32) * 72) + h * 8;
  f32x16 acc[2][NI];
#pragma unroll
  for (int mi = 0; mi < 2; ++mi)
#pragma unroll
    for (int ni = 0; ni < NI; ++ni)
#pragma unroll
      for (int i = 0; i < 16; ++i) acc[mi][ni][i] = 0.f;
  const int lrow = tid >> 3, lcol = (tid & 7) * 8;
  auto gload = [&](uint4 (&a4)[4], uint4 (&b4)[NB]) {
#pragma unroll
    for (int i = 0; i < 4; ++i) a4[i] = al.load(i);
#pragma unroll
    for (int i = 0; i < NB; ++i) b4[i] = bl.load(i);
    const int adv = (st.nxt + 1 < nk) ? 1 : 0;
    al.advance(adv); bl.advance(adv); st.nxt += adv;
  };
  auto lstore = [&](const uint4 (&a4)[4], const uint4 (&b4)[NB], unsigned short* sp) {
#pragma unroll
    for (int i = 0; i < 4; ++i) *(uint4*)(sp + (lrow + 32 * i) * 72 + lcol) = a4[i];
#pragma unroll
    for (int i = 0; i < NB; ++i) *(uint4*)(sp + 128 * 72 + (lrow + 32 * i) * 72 + lcol) = b4[i];
  };
  auto compute = [&](const unsigned short* sp) {
#pragma unroll
    for (int ks = 0; ks < 4; ++ks) {
      bf16x8 x[2], y[NI];
#pragma unroll
      for (int mi = 0; mi < 2; ++mi) x[mi] = *(const bf16x8*)(sp + xoff + mi * 32 * 72 + ks * 16);
#pragma unroll
      for (int ni = 0; ni < NI; ++ni) y[ni] = *(const bf16x8*)(sp + yoff + ni * 32 * 72 + ks * 16);
#pragma unroll
      for (int mi = 0; mi < 2; ++mi)
#pragma unroll
        for (int ni = 0; ni < NI; ++ni) acc[mi][ni] = MFMA32(x[mi], y[ni], acc[mi][ni]);
    }
  };
  if (first) {
    al.init(lrow, lcol); bl.init(lrow, lcol); st.nxt = 0;
    gload(st.ra[0], st.rb[0]);
    gload(st.ra[1], st.rb[1]);
  }
  __syncthreads();
  lstore(st.ra[0], st.rb[0], S0);
  gload(st.ra[0], st.rb[0]);
  __syncthreads();
  for (int kt = 0; kt < nk; kt += 2) {
    compute(S0);
    lstore(st.ra[1], st.rb[1], S0 + STG);
    gload(st.ra[1], st.rb[1]);
    __syncthreads();
    compute(S0 + STG);
    if (kt + 2 < nk) lstore(st.ra[0], st.rb[0], S0);
    gload(st.ra[0], st.rb[0]);
    __syncthreads();
  }
  const bool more = next_tile();
  if (more) {
    al.init(lrow, lcol); bl.init(lrow, lcol); st.nxt = 0;
    gload(st.ra[0], st.rb[0]);
    gload(st.ra[1], st.rb[1]);
  }
  ep(acc);
  return more;
}

DI bool xcd_tile(int step, int ntn, int& tm, int& tn) {
  const int G = gridDim.x;
  if ((G & 7) == 0) {
    const int x = blockIdx.x & 7, loc = blockIdx.x >> 3, per = G >> 3;
    const int j = loc + step * per;
    if (j >= 12 * ntn) return false;
    tn = j / 12; tm = 12 * x + j % 12;
    return true;
  }
  const int it = blockIdx.x + step * G;
  if (it >= 96 * ntn) return false;
  tm = it / ntn; tn = it % ntn;
  return true;
}

#define GAS __attribute__((address_space(1)))
typedef unsigned u32x4 __attribute__((ext_vector_type(4)));
DI uint4 gld16(const GAS char* q) { const u32x4 v = *(const GAS u32x4*)q; return make_uint4(v.x, v.y, v.z, v.w); }
struct LdBf {
  const bfr* base; size_t ld;
  const GAS char* p[4];
  DI void init(int lrow, int lcol) {
#pragma unroll
    for (int i = 0; i < 4; ++i) { p[i] = (const GAS char*)(base + (size_t)(lrow + 32 * i) * ld + lcol); asm volatile("" : "+v"(p[i])); }
  }
  DI uint4 load(int i) const { return gld16(p[i]); }
  DI void advance(int adv) {
#pragma unroll
    for (int i = 0; i < 4; ++i) p[i] += 128 * adv;
  }
};
#define XB_TMO      128
#define XB_XCNT(j)  (256  + 64 * (j))
#define XB_XSUB(j)  (1280 + 64 * (j))
#define XB_XGEN(j)  (2304 + 64 * (j))
#define XB_TOP      3328
#define XB_TOPGEN   3392
#define XCD_BAR_WORDS 3456
#define XB_SPIN_CAP (1u << 20)
#define LAS __attribute__((address_space(3)))
DI unsigned xb_ld(unsigned* p)              { return __hip_atomic_load(p, __ATOMIC_RELAXED, __HIP_MEMORY_SCOPE_AGENT); }
DI unsigned xb_add(unsigned* p, unsigned v) { return __hip_atomic_fetch_add(p, v, __ATOMIC_RELAXED, __HIP_MEMORY_SCOPE_AGENT); }
DI unsigned xb_xcc_id() { return (unsigned)__builtin_amdgcn_s_getreg((3 << 11) | 20) & 0xFu; }
#define XB_SPIN(cond, bar) do { unsigned _sp = 0; while (cond) { __builtin_amdgcn_s_sleep(1); \
    if ((++_sp & 255u) == 0u) { if (xb_ld(&(bar)[XB_TMO])) break; if (_sp > XB_SPIN_CAP) { atomicAdd(&(bar)[XB_TMO], 1u); break; } } } } while (0)
struct XcdBarrier { unsigned* bar; unsigned x; volatile LAS unsigned* st; };
DI XcdBarrier xcd_barrier_post(unsigned* bar, volatile LAS unsigned* st) {
  XcdBarrier b; b.bar = bar; b.x = xb_xcc_id(); b.st = st;
  if (threadIdx.x == 0) (void)xb_add(&bar[XB_XCNT(b.x)], 1u);
  return b;
}
DI void xcd_barrier_complete(unsigned* bar, unsigned x, unsigned& nloc, unsigned& nx) {
  const unsigned G = gridDim.x * gridDim.y * gridDim.z;
  unsigned sum, cnt, mine, sp = 0u;
  for (;;) {
    sum = 0u; cnt = 0u; mine = 0u;
#pragma unroll
    for (unsigned j = 0; j < 16; ++j) { const unsigned c = xb_ld(&bar[XB_XCNT(j)]); sum += c; cnt += (c > 0u) ? 1u : 0u; mine = (j == x) ? c : mine; }
    if (sum == G) break;
    __builtin_amdgcn_s_sleep(1);
    if ((++sp & 255u) == 0u) { if (xb_ld(&bar[XB_TMO])) break; if (sp > XB_SPIN_CAP) { atomicAdd(&bar[XB_TMO], 1u); break; } }
  }
  nloc = mine > 0u ? mine : 1u; nx = cnt > 0u ? cnt : 1u;
}
DI void xcd_barrier(const XcdBarrier& b) {
  asm volatile("s_waitcnt vmcnt(0)" ::: "memory");
  __syncthreads();
  if (threadIdx.x == 0) {
    unsigned* bar = b.bar;
    __builtin_amdgcn_s_waitcnt(0);
    unsigned nloc = b.st[0], nx = b.st[1];
    if (nloc == 0u) { xcd_barrier_complete(bar, b.x, nloc, nx); b.st[0] = nloc; b.st[1] = nx; }
    const unsigned old = xb_add(&bar[XB_XSUB(b.x)], 1u);
    const unsigned gen = old / nloc;
    if (old + 1u == (gen + 1u) * nloc) {
      __builtin_amdgcn_fence(__ATOMIC_RELEASE, "agent");
      asm volatile("s_waitcnt vmcnt(0)" ::: "memory");
      const unsigned og = xb_add(&bar[XB_TOP], 1u);
      const unsigned tg = og / nx;
      if (og + 1u == (tg + 1u) * nx) xb_add(&bar[XB_TOPGEN], 1u);
      else XB_SPIN(xb_ld(&bar[XB_TOPGEN]) == tg, bar);
      __builtin_amdgcn_fence(__ATOMIC_ACQUIRE, "agent");
      xb_add(&bar[XB_XGEN(b.x)], 1u);
      asm volatile("s_waitcnt vmcnt(0)" ::: "memory");
    } else {
      XB_SPIN(xb_ld(&bar[XB_XGEN(b.x)]) == gen, bar);
      __builtin_amdgcn_fence(__ATOMIC_ACQUIRE, "agent");
      asm volatile("s_waitcnt vmcnt(0)" ::: "memory");
    }
  }
  __syncthreads();
}

struct LdFz {
  const bfr* pz;
  const GAS char* p[4];
  DI void init(int lrow, int lcol) {
#pragma unroll
    for (int i = 0; i < 4; ++i) { p[i] = (const GAS char*)(pz + (size_t)(lrow + 32 * i) * 512 + lcol); asm volatile("" : "+v"(p[i])); }
  }
  DI void advance(int adv) {
#pragma unroll
    for (int i = 0; i < 4; ++i) p[i] += 128 * adv;
  }
  DI uint4 load(int i) const {
    const GAS char* q = p[i];
    const uint4 a = gld16(q), b = gld16(q + (size_t)4096 * 512 * 2), c = gld16(q + (size_t)2 * 4096 * 512 * 2), d = gld16(q + (size_t)3 * 4096 * 512 * 2);
#define SUM4(f) pk2(bf2f(a.f & 0xffff) + bf2f(b.f & 0xffff) + bf2f(c.f & 0xffff) + bf2f(d.f & 0xffff), bf2f(a.f >> 16) + bf2f(b.f >> 16) + bf2f(c.f >> 16) + bf2f(d.f >> 16))
    return make_uint4(SUM4(x), SUM4(y), SUM4(z), SUM4(w));
#undef SUM4
  }
};

DI void transpose_tile(const float* W, int ldw, int kbase, int nbase, bfr* WT, int ldt, int trow, float* sm) {
  const int tid = threadIdx.x;
#pragma unroll
  for (int i = 0; i < 4; ++i) {
    const int r = (tid >> 4) + 16 * i, c = (tid & 15) * 4;
    const float4 v = *(const float4*)(W + (size_t)(kbase + r) * ldw + nbase + c);
    sm[r * 65 + c] = v.x; sm[r * 65 + c + 1] = v.y; sm[r * 65 + c + 2] = v.z; sm[r * 65 + c + 3] = v.w;
  }
  __syncthreads();
  const int n = tid >> 2, kc = (tid & 3) * 16;
  unsigned o[8];
#pragma unroll
  for (int j = 0; j < 8; ++j) o[j] = pk2(sm[(kc + 2 * j) * 65 + n], sm[(kc + 2 * j + 1) * 65 + n]);
  uint4* dst = (uint4*)(WT + (size_t)(trow + n) * ldt + kbase + kc);
  dst[0] = make_uint4(o[0], o[1], o[2], o[3]);
  dst[1] = make_uint4(o[4], o[5], o[6], o[7]);
}

DI void phase0(const Params& p, unsigned char* smem) {
  const int tid = threadIdx.x;
  float* smf = (float*)smem;
  unsigned char* ws = p.ws;
  constexpr int N_ADA = 192;
  constexpr int N_T0 = 16 * 36, N_TG = 64, N_TO0 = 256, N_T1A = 16 * 24, N_T1B = 16 * 8, N_TF = 64, N_TO1 = 256;
  constexpr int N_FOLD = 128, N_ALAT = 2048, N_ACTX = 256, N_CACHE = 64, N_SSM = 64, N_ZERO = 48, N_ROPE = 4;
  constexpr int B_T0 = N_ADA, B_TG = B_T0 + N_T0, B_TO0 = B_TG + N_TG, B_T1A = B_TO0 + N_TO0, B_T1B = B_T1A + N_T1A,
                B_TF = B_T1B + N_T1B, B_TO1 = B_TF + N_TF, B_FOLD = B_TO1 + N_TO1, B_ALAT = B_FOLD + N_FOLD,
                B_ACTX = B_ALAT + N_ALAT, B_CACHE = B_ACTX + N_ACTX, B_SSM = B_CACHE + N_CACHE, B_ZERO = B_SSM + N_SSM,
                B_ROPE = B_ZERO + N_ZERO, N_ALL = B_ROPE + N_ROPE;
  for (int it = blockIdx.x; it < N_ALL; it += gridDim.x) {
    __syncthreads();
    if (it < B_T0) {
      const int l = it / 96, cgp = it % 96;
      float* sc = smf;
      float* red = smf + 3072;
      for (int e = tid; e < 3072; e += 256) {
        const int ci = e >> 10, k = e & 1023;
        const float cv = ci == 0 ? p.in[6][k] : p.in[5][(ci - 1) * 1024 + k];
        sc[e] = silu_f(cv);
      }
      __syncthreads();
      const int cq = tid & 7, rg = tid >> 3;
      const float* w = p.in[7] + (size_t)l * 1024 * 3072 + cgp * 32 + cq * 4;
      float4 a0 = make_float4(0.f, 0.f, 0.f, 0.f), a1 = a0, a2 = a0;
#pragma unroll 16
      for (int k = rg; k < 1024; k += 32) {
        const float4 wv = *(const float4*)(w + (size_t)k * 3072);
        const float s0 = sc[k], s1 = sc[1024 + k], s2 = sc[2048 + k];
        a0.x += s0 * wv.x; a0.y += s0 * wv.y; a0.z += s0 * wv.z; a0.w += s0 * wv.w;
        a1.x += s1 * wv.x; a1.y += s1 * wv.y; a1.z += s1 * wv.z; a1.w += s1 * wv.w;
        a2.x += s2 * wv.x; a2.y += s2 * wv.y; a2.z += s2 * wv.z; a2.w += s2 * wv.w;
      }
      *(float4*)(red + (0 * 32 + rg) * 32 + cq * 4) = a0;
      *(float4*)(red + (1 * 32 + rg) * 32 + cq * 4) = a1;
      *(float4*)(red + (2 * 32 + rg) * 32 + cq * 4) = a2;
      __syncthreads();
      if (tid < 96) {
        const int c2 = tid & 31, ci = tid >> 5;
        float s = 0.f;
#pragma unroll
        for (int q = 0; q < 32; ++q) s += red[(ci * 32 + q) * 32 + c2];
        const int n2 = cgp * 32 + c2;
        ((float*)(ws + OFF_MOD))[(l * 3 + ci) * 3072 + n2] = s + p.in[8][l * 3072 + n2];
      }
    } else if (it < B_FOLD) {
      const float* W; int ldw, nbase_off = 0, trow_off = 0, ntn, ldt; bfr* WT; int r;
      if (it < B_TG)        { r = it - B_T0;  W = p.in[11]; ldw = 2304; ntn = 36; WT = (bfr*)(ws + OFF_WIN0); ldt = 1024; }
      else if (it < B_TO0)  { r = it - B_TG;  W = p.in[22]; ldw = 512;  ntn = 8;  WT = (bfr*)(ws + OFF_GLU); ldt = 512; }
      else if (it < B_T1A)  { r = it - B_TO0; W = p.in[24]; ldw = 1024; ntn = 16; WT = (bfr*)(ws + OFF_WOUT0); ldt = 1024; }
      else if (it < B_T1B)  { r = it - B_T1A; W = p.in[25]; ldw = 2560; ntn = 24; WT = (bfr*)(ws + OFF_WIN1); ldt = 1024; }
      else if (it < B_TF)   { r = it - B_T1B; W = p.in[25]; ldw = 2560; ntn = 8;  WT = (bfr*)(ws + OFF_WIN1); ldt = 1024; nbase_off = 2048; trow_off = 2560; }
      else if (it < B_TO1)  { r = it - B_TF;  W = p.in[29]; ldw = 512;  ntn = 8;  WT = (bfr*)(ws + OFF_FNET); ldt = 512; }
      else                  { r = it - B_TO1; W = p.in[30]; ldw = 1024; ntn = 16; WT = (bfr*)(ws + OFF_WOUT1); ldt = 1024; }
      const int kb = r / ntn, nb = r % ntn;
      transpose_tile(W, ldw, kb * 64, nbase_off + nb * 64, WT, ldt, trow_off + nb * 64, smf);
    } else if (it < B_ALAT) {
      const int r = it - B_FOLD, cs = r & 1, kb = (r >> 1) & 15, g = r >> 5;
      float* tile = smf;
      float* tw = smf + 128 * 68;
      const float* W = p.in[25];
      {
        const int c4 = (tid & 31) * 4, kr = tid >> 5;
#pragma unroll
        for (int i = 0; i < 8; ++i) {
          const int k = kr + 8 * i;
          const float4 v = *(const float4*)(W + (size_t)(kb * 64 + k) * 2560 + 1536 + g * 128 + c4);
          tile[(c4 + 0) * 68 + k] = v.x; tile[(c4 + 1) * 68 + k] = v.y; tile[(c4 + 2) * 68 + k] = v.z; tile[(c4 + 3) * 68 + k] = v.w;
        }
        if (tid < 128) {
          const float a = 2.f * (float)tid / 128.f;
          tw[tid] = (cs == 0 ? cospif(a) : sinpif(a)) * 0.08838834764831845f;
        }
      }
      __syncthreads();
      const int j = tid & 127, kg = tid >> 7;
      float acc[32];
#pragma unroll
      for (int i = 0; i < 32; ++i) acc[i] = 0.f;
      for (int c = 0; c < 128; ++c) {
        const float t = tw[(j * c) & 127];
        const float4* tp = (const float4*)(tile + c * 68 + kg * 32);
#pragma unroll
        for (int q = 0; q < 8; ++q) {
          const float4 v = tp[q];
          acc[4 * q + 0] += v.x * t; acc[4 * q + 1] += v.y * t; acc[4 * q + 2] += v.z * t; acc[4 * q + 3] += v.w * t;
        }
      }
      uint4* dst = (uint4*)((bfr*)(ws + OFF_WIN1) + (size_t)(1536 + cs * 512 + g * 128 + j) * 1024 + kb * 64 + kg * 32);
#pragma unroll
      for (int q = 0; q < 4; ++q)
        dst[q] = make_uint4(pk2(acc[8 * q], acc[8 * q + 1]), pk2(acc[8 * q + 2], acc[8 * q + 3]), pk2(acc[8 * q + 4], acc[8 * q + 5]), pk2(acc[8 * q + 6], acc[8 * q + 7]));
    } else if (it < B_ACTX) {
      const int t = it - B_ALAT;
      bfr* dst = (bfr*)(ws + OFF_ALAT) + (size_t)t * 4096;
      const float nrm = 0.02209708691207961f;
#pragma unroll
      for (int half = 0; half < 2; ++half) {
        const int k0 = half * 2048 + tid * 8;
        unsigned o[4];
#pragma unroll
        for (int j = 0; j < 4; ++j) {
          float v[2];
#pragma unroll
          for (int e = 0; e < 2; ++e) {
            const int k = k0 + 2 * j + e;
            const int m = (t * (k & 2047)) & 2047;
            const float a = (float)m * (2.f / 2048.f);
            v[e] = (k < 2048 ? cospif(a) : -sinpif(a)) * nrm;
          }
          o[j] = pk2(v[0], v[1]);
        }
        *(uint4*)(dst + k0) = make_uint4(o[0], o[1], o[2], o[3]);
      }
    } else if (it < B_CACHE) {
      const int t = it - B_ACTX;
      bfr* dst = (bfr*)(ws + OFF_ACTX) + (size_t)t * 512;
      const float nrm = 0.0625f;
      float v[2];
#pragma unroll
      for (int e = 0; e < 2; ++e) {
        const int k = tid * 2 + e;
        const int m = (t * (k & 255)) & 255;
        const float a = (float)m * (2.f / 256.f);
        v[e] = (k < 256 ? cospif(a) : -sinpif(a)) * nrm;
      }
      *(unsigned*)(dst + tid * 2) = pk2(v[0], v[1]);
    } else if (it < B_SSM) {
      const int r = it - B_CACHE;
#pragma unroll
      for (int i = 0; i < 8; ++i) {
        const int e = r * 2048 + tid + 256 * i;
        const int d = e & 63, kvh = (e >> 6) & 1, key = (e >> 7) & 511, b = e >> 16;
        ((bfr*)(ws + OFF_KL))[((size_t)(b * 2 + kvh) * 2560 + key) * 64 + d] = f2bf(p.in[2][e]);
        ((bfr*)(ws + OFF_VL))[((size_t)(b * 2 + kvh) * 64 + d) * 2560 + key] = f2bf(p.in[3][e]);
      }
    } else if (it < B_ZERO) {
      const int dg = it - B_SSM;
      const int pp = tid & 63, part = tid >> 6;
      const double lr = (double)p.in[14][dg * 64 + pp], li = (double)p.in[15][dg * 64 + pp];
      const double dt = (double)__expf(p.in[16][dg]) ;
      const float dtf = expf(p.in[16][dg]);
      const double dtd = (double)dtf;
      (void)dt;
      const double PI = 3.14159265358979323846;
      double ap = li * dtd / PI;
      double ar = ap - 2.0 * rint(ap * 0.5);
      const float er = expf((float)(lr * dtd));
      const double lbr = (double)er * (double)cospif((float)ar), lbi = (double)er * (double)sinpif((float)ar);
      double ap2 = ap * 256.0;
      double ar2 = ap2 - 2.0 * rint(ap2 * 0.5);
      const float er2 = expf((float)(lr * dtd * 256.0));
      if (part == 0) {
        ((float2*)(ws + OFF_LAMB))[dg * 64 + pp] = make_float2((float)lbr, (float)lbi);
        ((float2*)(ws + OFF_LAMP))[dg * 64 + pp] = make_float2(er2 * cospif((float)ar2), er2 * sinpif((float)ar2));
      }
      const double den = lr * lr + li * li;
      const double fr = ((lbr - 1.0) * lr + lbi * li) / den, fi = (lbi * lr - (lbr - 1.0) * li) / den;
      float* bb = (float*)(ws + OFF_BB) + (size_t)(dg * 64 + pp) * 32;
#pragma unroll
      for (int q = 0; q < 4; ++q) {
        const int c = part * 4 + q;
        const double br = (double)p.in[17][(size_t)(dg * 64 + pp) * 16 + c], bi = (double)p.in[18][(size_t)(dg * 64 + pp) * 16 + c];
        bb[c] = (float)(fr * br - fi * bi);
        bb[16 + c] = (float)(fr * bi + fi * br);
      }
      bfr* cm = (bfr*)(ws + OFF_CMB) + (size_t)dg * 2048;
#pragma unroll
      for (int q = 0; q < 8; ++q) {
        const int e = tid * 8 + q, c = e >> 7, k = e & 127;
        const float v = k < 64 ? p.in[19][(size_t)(dg * 16 + c) * 64 + k] : -p.in[20][(size_t)(dg * 16 + c) * 64 + (k - 64)];
        cm[e] = f2bf(v);
      }
    } else if (it < B_ROPE) {
      const int r = it - B_ZERO;
      ((float*)(ws + OFF_ROWSS))[r * 256 + tid] = 0.f;
    } else {
      const int e = (it - B_ROPE) * 256 + tid;
      const int n = e >> 4, pr = e & 15;
      const double q4[4] = {1.0, 0.5623413251903491, 0.31622776601683794, 0.1778279410038923};
      double inv = q4[0];
      if ((pr & 3) == 1) inv = q4[1]; else if ((pr & 3) == 2) inv = q4[2]; else if ((pr & 3) == 3) inv = q4[3];
      const int dec = pr >> 2;
      if (dec == 1) inv *= 0.1; else if (dec == 2) inv *= 0.01; else if (dec == 3) inv *= 0.001;
      const double ap = (double)n * inv / 3.14159265358979323846;
      const double ar = ap - 2.0 * rint(ap * 0.5);
      ((float2*)(ws + OFF_ROPE))[e] = make_float2(cospif((float)ar), sinpif((float)ar));
    }
  }
}

template <int MODE>
DI void phase_rows(const Params& p) {
  unsigned char* ws = p.ws;
  const int lane = threadIdx.x & 63, wave = threadIdx.x >> 6;
  const float* mod = (const float*)(ws + OFF_MOD);
  for (int it = blockIdx.x; it < NTOK / 4; it += gridDim.x) {
    const int T = it * 4 + wave;
    const int ci = cond_of(T);
    float4 xv[4];
    if (MODE == 2) {
      const float4* xr = (const float4*)((const float*)(ws + OFF_X1) + (size_t)T * 1024) + lane;
#pragma unroll
      for (int j = 0; j < 4; ++j) xv[j] = xr[64 * j];
    } else {
      const float4* xr = (const float4*)xrow(p, T) + lane;
#pragma unroll
      for (int j = 0; j < 4; ++j) xv[j] = xr[64 * j];
    }
    if (MODE >= 1) {
      const int l = MODE - 1;
      const bfr* orow = (const bfr*)(ws + OFF_O) + (size_t)T * 1024;
      float4 ov[4]; float ss = 0.f;
#pragma unroll
      for (int j = 0; j < 4; ++j) {
        const uint2 raw = *(const uint2*)(orow + lane * 4 + 256 * j);
        ov[j].x = bf2f(raw.x & 0xffff); ov[j].y = bf2f(raw.x >> 16); ov[j].z = bf2f(raw.y & 0xffff); ov[j].w = bf2f(raw.y >> 16);
        ss += ov[j].x * ov[j].x + ov[j].y * ov[j].y + ov[j].z * ov[j].z + ov[j].w * ov[j].w;
      }
      const float rinv = rsqrtf(wave_sum(ss) * (1.f / 1024.f) + EPS);
      const float* gate = mod + (l * 3 + ci) * 3072 + 2048;
      const float* gp = p.in[10] + l * 1024;
#pragma unroll
      for (int j = 0; j < 4; ++j) {
        const int k = lane * 4 + 256 * j;
        const float4 g4 = *(const float4*)(gate + k), n4 = *(const float4*)(gp + k);
        xv[j].x += g4.x * (ov[j].x * rinv * n4.x); xv[j].y += g4.y * (ov[j].y * rinv * n4.y);
        xv[j].z += g4.z * (ov[j].z * rinv * n4.z); xv[j].w += g4.w * (ov[j].w * rinv * n4.w);
      }
      if (MODE == 2) {
        float4* yr = (float4*)(p.out + OUT_Y + (size_t)T * 1024) + lane;
#pragma unroll
        for (int j = 0; j < 4; ++j) yr[64 * j] = xv[j];
      } else {
        float4* x1r = (float4*)((float*)(ws + OFF_X1) + (size_t)T * 1024) + lane;
#pragma unroll
        for (int j = 0; j < 4; ++j) x1r[64 * j] = xv[j];
      }
    }
    if (MODE <= 1) {
      const int l = MODE;
      float ss = 0.f;
#pragma unroll
      for (int j = 0; j < 4; ++j) ss += xv[j].x * xv[j].x + xv[j].y * xv[j].y + xv[j].z * xv[j].z + xv[j].w * xv[j].w;
      const float rinv = rsqrtf(wave_sum(ss) * (1.f / 1024.f) + EPS);
      const float* shift = mod + (l * 3 + ci) * 3072;
      const float* scale = shift + 1024;
      const float* gp = p.in[9] + l * 1024;
      bfr* hr = (bfr*)(ws + OFF_HN) + (size_t)T * 1024;
#pragma unroll
      for (int j = 0; j < 4; ++j) {
        const int k = lane * 4 + 256 * j;
        const float4 s4 = *(const float4*)(shift + k), c4 = *(const float4*)(scale + k), n4 = *(const float4*)(gp + k);
        const float a = xv[j].x * rinv * n4.x * (1.f + c4.x) + s4.x;
        const float b = xv[j].y * rinv * n4.y * (1.f + c4.y) + s4.y;
        const float c = xv[j].z * rinv * n4.z * (1.f + c4.z) + s4.z;
        const float d = xv[j].w * rinv * n4.w * (1.f + c4.w) + s4.w;
        *(uint2*)(hr + k) = make_uint2(pk2(a, b), pk2(c, d));
      }
    }
  }
}

DI void phase_win0(const Params& p, unsigned char* smem) {
  unsigned char* ws = p.ws;
  const int lane = threadIdx.x & 63, wave = threadIdx.x >> 6, l32 = lane & 31, h = lane >> 5, wm = wave >> 1, wn = wave & 1;
  const bfr* A = (const bfr*)(ws + OFF_HN);
  const bfr* Bt = (const bfr*)(ws + OFF_WIN0);
  int tm, tn;
  if (!xcd_tile(0, 18, tm, tn)) return;
  LdBf al{A + (size_t)tm * 128 * 1024, 1024}, bl{Bt + (size_t)tn * 128 * 1024, 1024};
  for (int step = 0;; ++step) {
    const int m0 = tm * 128, n0 = tn * 128;
    int tm2 = 0, tn2 = 0;
    auto next_tile = [&]() {
      if (!xcd_tile(step + 1, 18, tm2, tn2)) return false;
      al.base = A + (size_t)tm2 * 128 * 1024; bl.base = Bt + (size_t)tn2 * 128 * 1024;
      return true;
    };
    auto ep = [&](f32x16 (&acc)[2][2]) {
      const int colbase = n0 + wn * 64, rbase = m0 + wm * 64;
      const bool lat = m0 >= NCTX;
      if (tn == 5) {
        const int hd = (colbase - 640) >> 6;
#pragma unroll
        for (int mi = 0; mi < 2; ++mi)
#pragma unroll
          for (int ni = 0; ni < 2; ++ni) {
            const int d = ni * 32 + l32;
#pragma unroll
            for (int i4 = 0; i4 < 4; ++i4) {
              const int r0 = rbase + mi * 32 + 8 * i4 + 4 * h;
              const float a = acc[mi][ni][4 * i4], b2 = acc[mi][ni][4 * i4 + 1], c = acc[mi][ni][4 * i4 + 2], e = acc[mi][ni][4 * i4 + 3];
              const uint2 pk = make_uint2(pk2(a, b2), pk2(c, e));
              if (!lat) {
                p.out[OUT_V + (size_t)(r0 + 0) * 128 + hd * 64 + d] = a;
                p.out[OUT_V + (size_t)(r0 + 1) * 128 + hd * 64 + d] = b2;
                p.out[OUT_V + (size_t)(r0 + 2) * 128 + hd * 64 + d] = c;
                p.out[OUT_V + (size_t)(r0 + 3) * 128 + hd * 64 + d] = e;
                const int b = r0 >> 8, l = r0 & 255;
                *(uint2*)((bfr*)(ws + OFF_VC) + ((size_t)(b * 2 + hd) * 64 + d) * 256 + l) = pk;
              } else {
                const int b = (r0 - NCTX) >> 11, l = (r0 - NCTX) & 2047;
                *(uint2*)((bfr*)(ws + OFF_VL) + ((size_t)(b * 2 + hd) * 64 + d) * 2560 + 512 + l) = pk;
              }
            }
          }
      } else if (colbase < 640) {
        const bool isq = colbase < 512;
        const float* gain = isq ? p.in[12] : p.in[13];
        const int hd = isq ? (colbase >> 6) : ((colbase - 512) >> 6);
        float4 gv[2][4];
#pragma unroll
        for (int mi = 0; mi < 2; ++mi)
#pragma unroll
          for (int i4 = 0; i4 < 4; ++i4) gv[mi][i4] = *(const float4*)(gain + mi * 32 + 8 * i4 + 4 * h);
#pragma unroll
        for (int ni = 0; ni < 2; ++ni) {
          const int T = rbase + ni * 32 + l32;
          float ss = 0.f;
#pragma unroll
          for (int mi = 0; mi < 2; ++mi)
#pragma unroll
            for (int i = 0; i < 16; ++i) ss += acc[mi][ni][i] * acc[mi][ni][i];
          ss += __shfl_xor(ss, 32);
          const float rinv = rsqrtf(ss * (1.f / 64.f) + EPS);
          float v[2][16];
#pragma unroll
          for (int mi = 0; mi < 2; ++mi)
#pragma unroll
            for (int i4 = 0; i4 < 4; ++i4) {
              v[mi][4 * i4 + 0] = acc[mi][ni][4 * i4 + 0] * rinv * gv[mi][i4].x;
              v[mi][4 * i4 + 1] = acc[mi][ni][4 * i4 + 1] * rinv * gv[mi][i4].y;
              v[mi][4 * i4 + 2] = acc[mi][ni][4 * i4 + 2] * rinv * gv[mi][i4].z;
              v[mi][4 * i4 + 3] = acc[mi][ni][4 * i4 + 3] * rinv * gv[mi][i4].w;
            }
          if (!lat && !isq) {
#pragma unroll
            for (int mi = 0; mi < 2; ++mi)
#pragma unroll
              for (int i4 = 0; i4 < 4; ++i4)
                *(float4*)(p.out + OUT_K + (size_t)T * 128 + hd * 64 + mi * 32 + 8 * i4 + 4 * h) = make_float4(v[mi][4 * i4], v[mi][4 * i4 + 1], v[mi][4 * i4 + 2], v[mi][4 * i4 + 3]);
          }
          if (lat) {
            const int pos = (T - NCTX) & 2047;
            const float* rope = (const float*)(ws + OFF_ROPE);
#pragma unroll
            for (int mi = 0; mi < 2; ++mi) {
              const float* rb = rope + ((mi == 0 ? (pos >> 6) : (pos & 63)) * 16 + 4 * h) * 2;
#pragma unroll
              for (int i4 = 0; i4 < 2; ++i4) {
                const float4 cs0 = *(const float4*)(rb + 16 * i4), cs1 = *(const float4*)(rb + 16 * i4 + 4);
                const float cc[4] = {cs0.x, cs0.z, cs1.x, cs1.z}, sn[4] = {cs0.y, cs0.w, cs1.y, cs1.w};
#pragma unroll
                for (int e = 0; e < 4; ++e) {
                  const float x1 = v[mi][4 * i4 + e], x2 = v[mi][4 * i4 + e + 8];
                  v[mi][4 * i4 + e] = x1 * cc[e] - x2 * sn[e];
                  v[mi][4 * i4 + e + 8] = x1 * sn[e] + x2 * cc[e];
                }
              }
            }
          }
          bfr* dst;
          float sc = 1.f;
          if (isq) { dst = (bfr*)(ws + OFF_QB) + (size_t)T * 512 + hd * 64; sc = 0.125f; }
          else if (!lat) { dst = (bfr*)(ws + OFF_KC) + ((size_t)((T >> 8) * 2 + hd) * 256 + (T & 255)) * 64; }
          else { dst = (bfr*)(ws + OFF_KL) + ((size_t)(((T - NCTX) >> 11) * 2 + hd) * 2560 + 512 + ((T - NCTX) & 2047)) * 64; }
#pragma unroll
          for (int mi = 0; mi < 2; ++mi)
#pragma unroll
            for (int i4 = 0; i4 < 4; ++i4)
              *(uint2*)(dst + mi * 32 + 8 * i4 + 4 * h) = make_uint2(pk2(v[mi][4 * i4] * sc, v[mi][4 * i4 + 1] * sc), pk2(v[mi][4 * i4 + 2] * sc, v[mi][4 * i4 + 3] * sc));
        }
      } else {
        const int sec = colbase < 1280 ? 0 : (colbase < 1792 ? 1 : 2);
        const int cb = colbase - (sec == 0 ? 768 : (sec == 1 ? 1280 : 1792));
#pragma unroll
        for (int ni = 0; ni < 2; ++ni) {
          const int T = rbase + ni * 32 + l32;
#pragma unroll
          for (int mi = 0; mi < 2; ++mi)
#pragma unroll
            for (int i4 = 0; i4 < 4; ++i4) {
              const int c = cb + mi * 32 + 8 * i4 + 4 * h;
              const float a = acc[mi][ni][4 * i4], b2 = acc[mi][ni][4 * i4 + 1], c2 = acc[mi][ni][4 * i4 + 2], e = acc[mi][ni][4 * i4 + 3];
              if (sec == 1) *(float4*)((float*)(ws + OFF_U) + (size_t)T * 512 + c) = make_float4(a, b2, c2, e);
              else *(uint2*)((bfr*)(ws + (sec == 0 ? OFF_GA : OFF_GB)) + (size_t)T * 512 + c) = make_uint2(pk2(silu_f(a), silu_f(b2)), pk2(silu_f(c2), silu_f(e)));
            }
        }
      }
    };
    al.base = A + (size_t)m0 * 1024; bl.base = Bt + (size_t)n0 * 1024;
    gemm_tile<128>(16, tn != 5, al, bl, ep, smem);
    if (!next_tile()) break;
    tm = tm2; tn = tn2;
  }
}

DI void attn_item(const Params& p, unsigned char* smem, int it) {
  unsigned char* ws = p.ws;
  const int tid = threadIdx.x, lane = tid & 63, wave = tid >> 6, l32 = lane & 31, h = lane >> 5;
  int T0, nkeys, ldv; const bfr *Kp, *Vp; int kvh;
  if (it < 256) {
    const int b = it >> 7, qt = it & 63; kvh = (it >> 6) & 1;
    T0 = NCTX + b * 2048 + qt * 32; nkeys = 2560; ldv = 2560;
    Kp = (const bfr*)(ws + OFF_KL) + (size_t)(b * 2 + kvh) * 2560 * 64;
    Vp = (const bfr*)(ws + OFF_VL) + (size_t)(b * 2 + kvh) * 64 * 2560;
  } else {
    const int i2 = it - 256; const int b = i2 >> 4, qt = i2 & 7; kvh = (i2 >> 3) & 1;
    T0 = b * 256 + qt * 32; nkeys = 256; ldv = 256;
    Kp = (const bfr*)(ws + OFF_KC) + (size_t)(b * 2 + kvh) * 256 * 64;
    Vp = (const bfr*)(ws + OFF_VC) + (size_t)(b * 2 + kvh) * 64 * 256;
  }
  const int head = kvh * 4 + wave;
  unsigned short* Ks = (unsigned short*)smem;
  unsigned short* Vs = Ks + 64 * 72;
  bf16x8 qf[4];
  {
    const bfr* q = (const bfr*)(ws + OFF_QB) + (size_t)(T0 + l32) * 512 + head * 64 + 8 * h;
#pragma unroll
    for (int ks = 0; ks < 4; ++ks) qf[ks] = *(const bf16x8*)(q + 16 * ks);
  }
  float m = -1e30f, lsum = 0.f;
  f32x16 O[2];
#pragma unroll
  for (int i = 0; i < 16; ++i) { O[0][i] = 0.f; O[1][i] = 0.f; }
  const int rr0 = tid >> 3, cc0 = (tid & 7) * 8;
  const bfr* kp0 = Kp + (size_t)rr0 * 64 + cc0;
  const bfr* vp0 = Vp + (size_t)rr0 * ldv + cc0;
  uint4 kreg0 = *(const uint4*)kp0, kreg1 = *(const uint4*)(kp0 + 32 * 64);
  uint4 vreg0 = *(const uint4*)vp0, vreg1 = *(const uint4*)(vp0 + (size_t)32 * ldv);
  for (int k0 = 0; k0 < nkeys; k0 += 64) {
    __syncthreads();
    *(uint4*)(Ks + rr0 * 72 + cc0) = kreg0; *(uint4*)(Ks + (rr0 + 32) * 72 + cc0) = kreg1;
    *(uint4*)(Vs + rr0 * 72 + cc0) = vreg0; *(uint4*)(Vs + (rr0 + 32) * 72 + cc0) = vreg1;
    __syncthreads();
    if (k0 + 64 < nkeys) {
      kreg0 = *(const uint4*)(kp0 + (size_t)(k0 + 64) * 64); kreg1 = *(const uint4*)(kp0 + (size_t)(k0 + 96) * 64);
      vreg0 = *(const uint4*)(vp0 + k0 + 64); vreg1 = *(const uint4*)(vp0 + (size_t)32 * ldv + k0 + 64);
    }
    f32x16 st[2];
#pragma unroll
    for (int kt = 0; kt < 2; ++kt) {
#pragma unroll
      for (int i = 0; i < 16; ++i) st[kt][i] = 0.f;
#pragma unroll
      for (int ks = 0; ks < 4; ++ks) {
        const bf16x8 a = *(const bf16x8*)(Ks + (32 * kt + l32) * 72 + 16 * ks + 8 * h);
        st[kt] = MFMA32(a, qf[ks], st[kt]);
      }
    }
    float mx = st[0][0];
#pragma unroll
    for (int i = 0; i < 16; ++i) { mx = fmaxf(mx, st[0][i]); mx = fmaxf(mx, st[1][i]); }
    mx = fmaxf(mx, __shfl_xor(mx, 32));
    const float mn = fmaxf(m, mx);
    const float alpha = __expf(m - mn);
    m = mn;
    float ps = 0.f;
#pragma unroll
    for (int kt = 0; kt < 2; ++kt)
#pragma unroll
      for (int i = 0; i < 16; ++i) { const float e = __expf(st[kt][i] - mn); st[kt][i] = e; ps += e; }
    lsum = lsum * alpha + ps;
#pragma unroll
    for (int i = 0; i < 16; ++i) { O[0][i] *= alpha; O[1][i] *= alpha; }
#pragma unroll
    for (int kt = 0; kt < 2; ++kt)
#pragma unroll
      for (int s = 0; s < 2; ++s) {
        const uint4 pu = make_uint4(pk2(st[kt][8 * s], st[kt][8 * s + 1]), pk2(st[kt][8 * s + 2], st[kt][8 * s + 3]),
                                    pk2(st[kt][8 * s + 4], st[kt][8 * s + 5]), pk2(st[kt][8 * s + 6], st[kt][8 * s + 7]));
        const bf16x8 pf = __builtin_bit_cast(bf16x8, pu);
#pragma unroll
        for (int dt = 0; dt < 2; ++dt) {
          const unsigned short* vr = Vs + (32 * dt + l32) * 72 + 32 * kt + 16 * s + 4 * h;
          const s16x4 lo = *(const s16x4*)vr, hi = *(const s16x4*)(vr + 8);
          const bf16x8 va = __builtin_shufflevector(lo, hi, 0, 1, 2, 3, 4, 5, 6, 7);
          O[dt] = MFMA32(va, pf, O[dt]);
        }
      }
  }
  const float ltot = lsum + __shfl_xor(lsum, 32);
  const float inv = 1.f / ltot;
  const int T = T0 + l32;
#pragma unroll
  for (int dt = 0; dt < 2; ++dt)
#pragma unroll
    for (int i4 = 0; i4 < 4; ++i4) {
      const int d = 32 * dt + 8 * i4 + 4 * h;
      const uint2 g = *(const uint2*)((const bfr*)(ws + OFF_GA) + (size_t)T * 512 + head * 64 + d);
      const float a = O[dt][4 * i4] * inv * bf2f(g.x & 0xffff), b = O[dt][4 * i4 + 1] * inv * bf2f(g.x >> 16);
      const float c = O[dt][4 * i4 + 2] * inv * bf2f(g.y & 0xffff), e = O[dt][4 * i4 + 3] * inv * bf2f(g.y >> 16);
      *(uint2*)((bfr*)(ws + OFF_MIX) + (size_t)T * 1024 + head * 64 + d) = make_uint2(pk2(a, b), pk2(c, e));
    }
}

DI void attn_lat_item(const Params& p, unsigned char* smem, int it) {
  unsigned char* ws = p.ws;
  const int tid = threadIdx.x, lane = tid & 63, wave = tid >> 6, l32 = lane & 31, h = lane >> 5;
  const int b = it >> 8, kvh = (it >> 7) & 1, qt = (it >> 1) & 63, hp = it & 1;
  const int hw = wave & 1, kh = wave >> 1;
  const int T0 = NCTX + b * 2048 + qt * 32;
  const int head = kvh * 4 + hp * 2 + hw;
  const bfr* Kp = (const bfr*)(ws + OFF_KL) + ((size_t)(b * 2 + kvh) * 2560 + kh * 1280) * 64;
  const bfr* Vp = (const bfr*)(ws + OFF_VL) + (size_t)(b * 2 + kvh) * 64 * 2560 + kh * 1280;
  unsigned short* Ks = (unsigned short*)smem + kh * (2 * 64 * 72);
  unsigned short* Vs = Ks + 64 * 72;
  bf16x8 qf[4];
  {
    const bfr* q = (const bfr*)(ws + OFF_QB) + (size_t)(T0 + l32) * 512 + head * 64 + 8 * h;
#pragma unroll
    for (int ks = 0; ks < 4; ++ks) qf[ks] = *(const bf16x8*)(q + 16 * ks);
  }
  float m = -1e30f, lsum = 0.f;
  f32x16 O[2];
#pragma unroll
  for (int i = 0; i < 16; ++i) { O[0][i] = 0.f; O[1][i] = 0.f; }
  const int t2 = tid & 127, rr0 = t2 >> 3, cc0 = (t2 & 7) * 8;
  const bfr* kp0 = Kp + (size_t)rr0 * 64 + cc0;
  const bfr* vp0 = Vp + (size_t)rr0 * 2560 + cc0;
  uint4 kr0 = *(const uint4*)kp0, kr1 = *(const uint4*)(kp0 + 16 * 64), kr2 = *(const uint4*)(kp0 + 32 * 64), kr3 = *(const uint4*)(kp0 + 48 * 64);
  uint4 vr0 = *(const uint4*)vp0, vr1 = *(const uint4*)(vp0 + (size_t)16 * 2560), vr2 = *(const uint4*)(vp0 + (size_t)32 * 2560), vr3 = *(const uint4*)(vp0 + (size_t)48 * 2560);
  for (int k0 = 0; k0 < 1280; k0 += 64) {
    __syncthreads();
    *(uint4*)(Ks + rr0 * 72 + cc0) = kr0; *(uint4*)(Ks + (rr0 + 16) * 72 + cc0) = kr1; *(uint4*)(Ks + (rr0 + 32) * 72 + cc0) = kr2; *(uint4*)(Ks + (rr0 + 48) * 72 + cc0) = kr3;
    *(uint4*)(Vs + rr0 * 72 + cc0) = vr0; *(uint4*)(Vs + (rr0 + 16) * 72 + cc0) = vr1; *(uint4*)(Vs + (rr0 + 32) * 72 + cc0) = vr2; *(uint4*)(Vs + (rr0 + 48) * 72 + cc0) = vr3;
    __syncthreads();
    if (k0 + 64 < 1280) {
      const bfr* kq = kp0 + (size_t)(k0 + 64) * 64; const bfr* vq = vp0 + k0 + 64;
      kr0 = *(const uint4*)kq; kr1 = *(const uint4*)(kq + 16 * 64); kr2 = *(const uint4*)(kq + 32 * 64); kr3 = *(const uint4*)(kq + 48 * 64);
      vr0 = *(const uint4*)vq; vr1 = *(const uint4*)(vq + (size_t)16 * 2560); vr2 = *(const uint4*)(vq + (size_t)32 * 2560); vr3 = *(const uint4*)(vq + (size_t)48 * 2560);
    }
    f32x16 st[2];
#pragma unroll
    for (int kt = 0; kt < 2; ++kt) {
#pragma unroll
      for (int i = 0; i < 16; ++i) st[kt][i] = 0.f;
#pragma unroll
      for (int ks = 0; ks < 4; ++ks) {
        const bf16x8 a = *(const bf16x8*)(Ks + (32 * kt + l32) * 72 + 16 * ks + 8 * h);
        st[kt] = MFMA32(a, qf[ks], st[kt]);
      }
    }
    float mx = st[0][0];
#pragma unroll
    for (int i = 0; i < 16; ++i) { mx = fmaxf(mx, st[0][i]); mx = fmaxf(mx, st[1][i]); }
    mx = fmaxf(mx, __shfl_xor(mx, 32));
    const float mn = fmaxf(m, mx);
    const float alpha = __expf(m - mn);
    m = mn;
    float ps = 0.f;
#pragma unroll
    for (int kt = 0; kt < 2; ++kt)
#pragma unroll
      for (int i = 0; i < 16; ++i) { const float e = __expf(st[kt][i] - mn); st[kt][i] = e; ps += e; }
    lsum = lsum * alpha + ps;
#pragma unroll
    for (int i = 0; i < 16; ++i) { O[0][i] *= alpha; O[1][i] *= alpha; }
#pragma unroll
    for (int kt = 0; kt < 2; ++kt)
#pragma unroll
      for (int s = 0; s < 2; ++s) {
        const uint4 pu = make_uint4(pk2(st[kt][8 * s], st[kt][8 * s + 1]), pk2(st[kt][8 * s + 2], st[kt][8 * s + 3]),
                                    pk2(st[kt][8 * s + 4], st[kt][8 * s + 5]), pk2(st[kt][8 * s + 6], st[kt][8 * s + 7]));
        const bf16x8 pf = __builtin_bit_cast(bf16x8, pu);
#pragma unroll
        for (int dt = 0; dt < 2; ++dt) {
          const unsigned short* vr = Vs + (32 * dt + l32) * 72 + 32 * kt + 16 * s + 4 * h;
          const s16x4 lo = *(const s16x4*)vr, hi = *(const s16x4*)(vr + 8);
          const bf16x8 va = __builtin_shufflevector(lo, hi, 0, 1, 2, 3, 4, 5, 6, 7);
          O[dt] = MFMA32(va, pf, O[dt]);
        }
      }
  }
  float ltot = lsum + __shfl_xor(lsum, 32);
  float* xb = (float*)smem + (hw * 64 + lane) * 36;
  __syncthreads();
  if (kh == 1) {
#pragma unroll
    for (int i = 0; i < 16; ++i) { xb[i] = O[0][i]; xb[16 + i] = O[1][i]; }
    xb[32] = m; xb[33] = ltot;
  }
  __syncthreads();
  if (kh == 0) {
    const float m2 = xb[32], l2 = xb[33];
    const float mm = fmaxf(m, m2), a1 = __expf(m - mm), a2 = __expf(m2 - mm);
    ltot = ltot * a1 + l2 * a2;
    const float inv = 1.f / ltot;
#pragma unroll
    for (int i = 0; i < 16; ++i) { O[0][i] = (O[0][i] * a1 + xb[i] * a2) * inv; O[1][i] = (O[1][i] * a1 + xb[16 + i] * a2) * inv; }
    const int T = T0 + l32;
#pragma unroll
    for (int dt = 0; dt < 2; ++dt)
#pragma unroll
      for (int i4 = 0; i4 < 4; ++i4) {
        const int d = 32 * dt + 8 * i4 + 4 * h;
        const uint2 g = *(const uint2*)((const bfr*)(ws + OFF_GA) + (size_t)T * 512 + head * 64 + d);
        const float a = O[dt][4 * i4] * bf2f(g.x & 0xffff), bq = O[dt][4 * i4 + 1] * bf2f(g.x >> 16);
        const float c = O[dt][4 * i4 + 2] * bf2f(g.y & 0xffff), e = O[dt][4 * i4 + 3] * bf2f(g.y >> 16);
        *(uint2*)((bfr*)(ws + OFF_MIX) + (size_t)T * 1024 + head * 64 + d) = make_uint2(pk2(a, bq), pk2(c, e));
      }
  }
}

DI int seg_T0(int seg) { return seg < 32 ? seg * 256 : NCTX + ((seg - 32) >> 3) * 2048 + ((seg - 32) & 7) * 256; }

DI void split_bf16(const float4& v0, const float4& v1, bf16x8& hi, bf16x8& lo) {
  const unsigned h0 = pk2(v0.x, v0.y), h1 = pk2(v0.z, v0.w), h2 = pk2(v1.x, v1.y), h3 = pk2(v1.z, v1.w);
  hi = __builtin_bit_cast(bf16x8, make_uint4(h0, h1, h2, h3));
  const unsigned l0 = pk2(v0.x - bf2f(h0 & 0xffff), v0.y - bf2f(h0 >> 16)), l1 = pk2(v0.z - bf2f(h1 & 0xffff), v0.w - bf2f(h1 >> 16));
  const unsigned l2 = pk2(v1.x - bf2f(h2 & 0xffff), v1.y - bf2f(h2 >> 16)), l3 = pk2(v1.z - bf2f(h3 & 0xffff), v1.w - bf2f(h3 >> 16));
  lo = __builtin_bit_cast(bf16x8, make_uint4(l0, l1, l2, l3));
}

DI void s5_wave(const Params& p, float* BU  , int it) {
  unsigned char* ws = p.ws;
  const int lane = threadIdx.x & 63, l32 = lane & 31, h = lane >> 5;
  const int di = it & 1, g = (it >> 1) & 31, seg = it >> 6;
  const int T0 = seg_T0(seg);
  const int dg = di * 32 + g;
  bf16x8 bhi[4], blo[4];
#pragma unroll
  for (int nt = 0; nt < 4; ++nt) {
    const float* bb = (const float*)(ws + OFF_BB) + (size_t)(dg * 64 + (nt & 1) * 32 + l32) * 32 + (nt >> 1) * 16 + 8 * h;
    split_bf16(*(const float4*)bb, *(const float4*)(bb + 4), bhi[nt], blo[nt]);
  }
  const float2 lam = ((const float2*)(ws + OFF_LAMB))[dg * 64 + lane];
  bf16x8 cmf[4];
  {
    const bfr* cm = (const bfr*)(ws + OFF_CMB) + (size_t)dg * 2048 + (lane & 15) * 128 + 8 * (lane >> 4);
#pragma unroll
    for (int ks = 0; ks < 4; ++ks) cmf[ks] = *(const bf16x8*)(cm + 32 * ks);
  }
  float hr = 0.f, hi = 0.f;
  bfr* yout = (bfr*)(ws + (di == 0 ? OFF_YF : OFF_YB));
  const float* ubase = (const float*)(ws + OFF_U) + g * 16 + 8 * h;
  float4 u0, u1;
  { const int T = di == 0 ? T0 + l32 : T0 + 255 - l32; const float* up = ubase + (size_t)T * 512; u0 = *(const float4*)up; u1 = *(const float4*)(up + 4); }
  for (int c = 0; c < 8; ++c) {
    bf16x8 ahi, alo;
    split_bf16(u0, u1, ahi, alo);
    if (c < 7) { const int sg = 32 * (c + 1) + l32; const int T = di == 0 ? T0 + sg : T0 + 255 - sg; const float* up = ubase + (size_t)T * 512; u0 = *(const float4*)up; u1 = *(const float4*)(up + 4); }
#pragma unroll
    for (int nt = 0; nt < 4; ++nt) {
      f32x16 acc;
#pragma unroll
      for (int i = 0; i < 16; ++i) acc[i] = 0.f;
      acc = MFMA32(ahi, bhi[nt], acc);
      acc = MFMA32(alo, bhi[nt], acc);
      acc = MFMA32(ahi, blo[nt], acc);
#pragma unroll
      for (int i = 0; i < 16; ++i) BU[crow(i, h) * 132 + 32 * nt + l32] = acc[i];
    }
    __builtin_amdgcn_wave_barrier();
#pragma unroll 8
    for (int sl = 0; sl < 32; ++sl) {
      const float br = BU[sl * 132 + lane], bi = BU[sl * 132 + 64 + lane];
      const float nr = lam.x * hr - lam.y * hi + br;
      const float ni = lam.x * hi + lam.y * hr + bi;
      hr = nr; hi = ni;
      BU[sl * 132 + lane] = hr; BU[sl * 132 + 64 + lane] = hi;
    }
    __builtin_amdgcn_wave_barrier();
#pragma unroll
    for (int tt = 0; tt < 2; ++tt) {
      f32x4 acc = {0.f, 0.f, 0.f, 0.f};
      const float* hrow = BU + (16 * tt + (lane & 15)) * 132 + 8 * (lane >> 4);
#pragma unroll
      for (int ks = 0; ks < 4; ++ks) {
        const float4 v0 = *(const float4*)(hrow + 32 * ks), v1 = *(const float4*)(hrow + 32 * ks + 4);
        const bf16x8 a = __builtin_bit_cast(bf16x8, make_uint4(pk2(v0.x, v0.y), pk2(v0.z, v0.w), pk2(v1.x, v1.y), pk2(v1.z, v1.w)));
        acc = MFMA16(a, cmf[ks], acc);
      }
#pragma unroll
      for (int i = 0; i < 4; ++i) {
        const int sg = 32 * c + 16 * tt + 4 * (lane >> 4) + i;
        const int T = di == 0 ? T0 + sg : T0 + 255 - sg;
        yout[(size_t)T * 512 + g * 16 + (lane & 15)] = f2bf(acc[i]);
      }
    }
    __builtin_amdgcn_wave_barrier();
  }
  ((float2*)(ws + OFF_E))[((size_t)(seg * 2 + di) * 32 + g) * 64 + lane] = make_float2(hr, hi);
  if (seg < 32) {
    float* so = p.out + OUT_S + (size_t)((seg * 2 + di) * 2) * 2048 + g * 64 + lane;
    so[0] = hr; so[2048] = hi;
  }
}

DI void phase_mix0(const Params& p, unsigned char* smem) {
  constexpr int N_S5 = 3072;
  const int b = blockIdx.x, G = gridDim.x, wave = threadIdx.x >> 6;
  float* BUw = (float*)smem + wave * (32 * 132);
  if (G == 512) {
    attn_lat_item(p, smem, b);
    __syncthreads();
    if (b < 256) { for (int r = 0; r < 2; ++r) s5_wave(p, BUw, b * 8 + r * 4 + wave); }
    else s5_wave(p, BUw, 2048 + (b - 256) * 4 + wave);
    __syncthreads();
    attn_item(p, smem, 256 + b);
  } else {
    for (int it = b * 4 + wave; it < N_S5; it += G * 4) s5_wave(p, BUw, it);
    for (int it = b; it < 512; it += G) { __syncthreads(); attn_lat_item(p, smem, it); }
    for (int it = b; it < 512; it += G) { __syncthreads(); attn_item(p, smem, 256 + it); }
  }
}

DI void phase_s5fix(const Params& p, unsigned char* smem) {
  unsigned char* ws = p.ws;
  const int tid = threadIdx.x, lane = tid & 63, wave = tid >> 6;
  float* ycorr = (float*)smem;
  float* HC = (float*)smem + 4096 + wave * (16 * 132);
  for (int it = blockIdx.x; it < 48 * 32; it += gridDim.x) {
    const int g = it & 31, seg = it >> 5;
    const int T0 = seg_T0(seg);
    __syncthreads();
    if (seg >= 32) {
      for (int e = tid; e < 4096; e += 256) ycorr[e] = 0.f;
      __syncthreads();
      const int b = (seg - 32) >> 3, j = (seg - 32) & 7;
      const int di = wave & 1, half = wave >> 1;
      const int dg = di * 32 + g;
      const float2 lam = ((const float2*)(ws + OFF_LAMB))[dg * 64 + lane];
      const float2 lp = ((const float2*)(ws + OFF_LAMP))[dg * 64 + lane];
      const float* st = p.in[4] + (size_t)((b * 2 + di) * 2) * 2048 + g * 64 + lane;
      float hr = st[0], hi = st[2048];
      const int nprev = di == 0 ? j : 7 - j;
      float2 ev[7];
#pragma unroll
      for (int q = 0; q < 7; ++q) {
        const int jj = di == 0 ? q : 7 - q;
        ev[q] = ((const float2*)(ws + OFF_E))[((size_t)((32 + b * 8 + jj) * 2 + di) * 32 + g) * 64 + lane];
      }
#pragma unroll
      for (int q = 0; q < 7; ++q) {
        if (q < nprev) {
          const float nr = lp.x * hr - lp.y * hi + ev[q].x, ni = lp.x * hi + lp.y * hr + ev[q].y;
          hr = nr; hi = ni;
        }
      }
      float cr = lam.x, cim = lam.y;
      if (half) {
        float sr = lam.x, si = lam.y;
#pragma unroll
        for (int q = 0; q < 7; ++q) { const float t = sr * sr - si * si; si = 2.f * sr * si; sr = t; }
        cr = sr * lam.x - si * lam.y; cim = sr * lam.y + si * lam.x;
      }
      bf16x8 cmf[4];
      {
        const bfr* cm = (const bfr*)(ws + OFF_CMB) + (size_t)dg * 2048 + (lane & 15) * 128 + 8 * (lane >> 4);
#pragma unroll
        for (int ks = 0; ks < 4; ++ks) cmf[ks] = *(const bf16x8*)(cm + 32 * ks);
      }
      for (int c = 0; c < 8; ++c) {
#pragma unroll 8
        for (int sl = 0; sl < 16; ++sl) {
          HC[sl * 132 + lane] = cr * hr - cim * hi;
          HC[sl * 132 + 64 + lane] = cr * hi + cim * hr;
          const float nr = cr * lam.x - cim * lam.y, ni = cr * lam.y + cim * lam.x;
          cr = nr; cim = ni;
        }
        __builtin_amdgcn_wave_barrier();
        f32x4 acc = {0.f, 0.f, 0.f, 0.f};
        const float* hrow = HC + (lane & 15) * 132 + 8 * (lane >> 4);
#pragma unroll
        for (int ks = 0; ks < 4; ++ks) {
          const float4 v0 = *(const float4*)(hrow + 32 * ks), v1 = *(const float4*)(hrow + 32 * ks + 4);
          const bf16x8 a = __builtin_bit_cast(bf16x8, make_uint4(pk2(v0.x, v0.y), pk2(v0.z, v0.w), pk2(v1.x, v1.y), pk2(v1.z, v1.w)));
          acc = MFMA16(a, cmf[ks], acc);
        }
#pragma unroll
        for (int i = 0; i < 4; ++i) {
          const int sg = 128 * half + 16 * c + 4 * (lane >> 4) + i;
          const int tl = di == 0 ? sg : 255 - sg;
          atomicAdd(&ycorr[tl * 16 + (lane & 15)], acc[i]);
        }
        __builtin_amdgcn_wave_barrier();
      }
      __syncthreads();
    }
    {
      const int T = T0 + tid;
      const float* up = (const float*)(ws + OFF_U) + (size_t)T * 512 + g * 16;
      const bfr* yf = (const bfr*)(ws + OFF_YF) + (size_t)T * 512 + g * 16;
      const bfr* yb = (const bfr*)(ws + OFF_YB) + (size_t)T * 512 + g * 16;
      const float* dsk = p.in[21] + g * 16;
      unsigned o[8];
#pragma unroll
      for (int q = 0; q < 2; ++q) {
        const uint4 f = *(const uint4*)(yf + 8 * q), bk = *(const uint4*)(yb + 8 * q);
        const float4 u0 = *(const float4*)(up + 8 * q), u1 = *(const float4*)(up + 8 * q + 4);
        const float4 d0 = *(const float4*)(dsk + 8 * q), d1 = *(const float4*)(dsk + 8 * q + 4);
        const float* yc = ycorr + tid * 16 + 8 * q;
        const float uu[8] = {u0.x, u0.y, u0.z, u0.w, u1.x, u1.y, u1.z, u1.w};
        const float dd[8] = {d0.x, d0.y, d0.z, d0.w, d1.x, d1.y, d1.z, d1.w};
        const unsigned ff[4] = {f.x, f.y, f.z, f.w}, bb[4] = {bk.x, bk.y, bk.z, bk.w};
        float y[8];
#pragma unroll
        for (int e = 0; e < 8; ++e) {
          const float a = (e & 1) ? bf2f(ff[e >> 1] >> 16) : bf2f(ff[e >> 1] & 0xffff);
          const float c2 = (e & 1) ? bf2f(bb[e >> 1] >> 16) : bf2f(bb[e >> 1] & 0xffff);
          y[e] = gelu_f(uu[e] * dd[e] + a + c2 + (seg >= 32 ? yc[e] : 0.f));
        }
#pragma unroll
        for (int e = 0; e < 4; ++e) o[4 * q + e] = pk2(y[2 * e], y[2 * e + 1]);
      }
      uint4* dst = (uint4*)((bfr*)(ws + OFF_YG) + (size_t)T * 512 + g * 16);
      dst[0] = make_uint4(o[0], o[1], o[2], o[3]);
      dst[1] = make_uint4(o[4], o[5], o[6], o[7]);
    }
  }
}

template <int MODE>
DI void phase_tokgemm(const Params& p, unsigned char* smem, int layer) {
  unsigned char* ws = p.ws;
  const int lane = threadIdx.x & 63, wave = threadIdx.x >> 6, l32 = lane & 31, h = lane >> 5, wm = wave >> 1, wn = wave & 1;
  constexpr int K = MODE == 1 ? 1024 : 512, N = MODE == 1 ? 1024 : 512;
  const bfr* A = (const bfr*)(ws + (MODE == 0 ? OFF_YG : (MODE == 1 ? OFF_MIX : OFF_FZ)));
  const bfr* Bt = (const bfr*)(ws + (MODE == 0 ? OFF_GLU : (MODE == 1 ? (layer == 0 ? OFF_WOUT0 : OFF_WOUT1) : OFF_FNET)));
  constexpr int TN = N / 128;
  int tm, tn;
  if (!xcd_tile(0, TN, tm, tn)) return;
  LdBf alp{A + (size_t)tm * 128 * K, (size_t)K}, bl{Bt + (size_t)tn * 128 * K, (size_t)K};
  GStage<128> gst;
  bool first = true;
  for (int step = 0;; ++step) {
    const int m0 = tm * 128, n0 = tn * 128;
    int tm2 = 0, tn2 = 0;
    auto next_tile = [&]() {
      if (!xcd_tile(step + 1, TN, tm2, tn2)) return false;
      alp.base = A + (size_t)tm2 * 128 * K; bl.base = Bt + (size_t)tn2 * 128 * K;
      return true;
    };
    auto ep = [&](f32x16 (&acc)[2][2]) {
#pragma unroll
      for (int ni = 0; ni < 2; ++ni) {
        const int T = m0 + wm * 64 + ni * 32 + l32;
#pragma unroll
        for (int mi = 0; mi < 2; ++mi)
#pragma unroll
          for (int i4 = 0; i4 < 4; ++i4) {
            const int n = n0 + wn * 64 + mi * 32 + 8 * i4 + 4 * h;
            float a = acc[mi][ni][4 * i4], b2 = acc[mi][ni][4 * i4 + 1], c2 = acc[mi][ni][4 * i4 + 2], e = acc[mi][ni][4 * i4 + 3];
            if (MODE == 0) {
              const uint2 y = *(const uint2*)((const bfr*)(ws + OFF_YG) + (size_t)T * 512 + n);
              const uint2 gb = *(const uint2*)((const bfr*)(ws + OFF_GB) + (size_t)T * 512 + n);
              const float4 bs = *(const float4*)(p.in[23] + n);
              a = bf2f(y.x & 0xffff) * sigmoid_f(a + bs.x) * bf2f(gb.x & 0xffff);
              b2 = bf2f(y.x >> 16) * sigmoid_f(b2 + bs.y) * bf2f(gb.x >> 16);
              c2 = bf2f(y.y & 0xffff) * sigmoid_f(c2 + bs.z) * bf2f(gb.y & 0xffff);
              e = bf2f(y.y >> 16) * sigmoid_f(e + bs.w) * bf2f(gb.y >> 16);
              *(uint2*)((bfr*)(ws + OFF_MIX) + (size_t)T * 1024 + 512 + n) = make_uint2(pk2(a, b2), pk2(c2, e));
            } else if (MODE == 1) {
              *(uint2*)((bfr*)(ws + OFF_O) + (size_t)T * 1024 + n) = make_uint2(pk2(a, b2), pk2(c2, e));
            } else {
              const uint2 gd = *(const uint2*)((const bfr*)(ws + OFF_GDS) + (size_t)T * 512 + n);
              a *= bf2f(gd.x & 0xffff); b2 *= bf2f(gd.x >> 16); c2 *= bf2f(gd.y & 0xffff); e *= bf2f(gd.y >> 16);
              *(uint2*)((bfr*)(ws + OFF_MIX) + (size_t)T * 1024 + 512 + n) = make_uint2(pk2(a, b2), pk2(c2, e));
            }
          }
      }
    };
    if constexpr (MODE == 2) {
      bl.base = Bt + (size_t)n0 * K;
      if (m0 < NCTX) {
        LdBf al{A + (size_t)m0 * K, (size_t)K};
        gemm_tile<128>(K / 64, true, al, bl, ep, smem);
      } else {
        LdFz al{(const bfr*)(ws + OFF_HN) + (size_t)(m0 - NCTX) * 512};
        gemm_tile<128, false>(K / 64, true, al, bl, ep, smem);
      }
      if (!next_tile()) break;
    } else {
      const bool more = gemm_tile_pf<128>(K / 64, true, first, alp, bl, gst, ep, next_tile, smem);
      first = false;
      if (!more) break;
    }
    tm = tm2; tn = tn2;
  }
}

DI void phase_win1(const Params& p, unsigned char* smem) {
  unsigned char* ws = p.ws;
  const int lane = threadIdx.x & 63, wave = threadIdx.x >> 6, l32 = lane & 31, h = lane >> 5, wm = wave >> 1, wn = wave & 1;
  const bfr* A = (const bfr*)(ws + OFF_HN);
  const bfr* Bt = (const bfr*)(ws + OFF_WIN1);
  int tm, tn;
  if (!xcd_tile(0, 24, tm, tn)) return;
  LdBf al{A + (size_t)tm * 128 * 1024, 1024}, bl{Bt + (size_t)tn * 128 * 1024, 1024};
  GStage<128> gst;
  bool first = true;
  for (int step = 0;; ++step) {
    const int m0 = tm * 128, n0 = tn * 128;
    int tm2 = 0, tn2 = 0;
    auto next_tile = [&]() {
      if (!xcd_tile(step + 1, 24, tm2, tn2)) return false;
      al.base = A + (size_t)tm2 * 128 * 1024; bl.base = Bt + (size_t)tn2 * 128 * 1024;
      return true;
    };
    auto ep = [&](f32x16 (&acc)[2][2]) {
      const int colbase = n0 + wn * 64, rbase = m0 + wm * 64;
      const int sec = colbase >> 9;
      const int cb = colbase & 511;
      const bool lat = m0 >= NCTX;
      if (sec == 0 || sec == 2 || sec == 5) {
        bfr* dst = (bfr*)(ws + (sec == 0 ? OFF_CUG : (sec == 2 ? OFF_GCS : OFF_GDS)));
#pragma unroll
        for (int ni = 0; ni < 2; ++ni) {
          const int T = rbase + ni * 32 + l32;
#pragma unroll
          for (int mi = 0; mi < 2; ++mi)
#pragma unroll
            for (int i4 = 0; i4 < 4; ++i4) {
              const float a = acc[mi][ni][4 * i4], b2 = acc[mi][ni][4 * i4 + 1], c2 = acc[mi][ni][4 * i4 + 2], e = acc[mi][ni][4 * i4 + 3];
              const uint2 o = sec == 0 ? make_uint2(pk2(gelu_f(a), gelu_f(b2)), pk2(gelu_f(c2), gelu_f(e))) : make_uint2(pk2(silu_f(a), silu_f(b2)), pk2(silu_f(c2), silu_f(e)));
              *(uint2*)(dst + (size_t)T * 512 + cb + mi * 32 + 8 * i4 + 4 * h) = o;
            }
        }
      } else if (sec == 1) {
        float* rowss = (float*)(ws + OFF_ROWSS);
#pragma unroll
        for (int mi = 0; mi < 2; ++mi) {
#pragma unroll
          for (int i = 0; i < 16; ++i) {
            const float g0 = gelu_f(acc[mi][0][i]), g1 = gelu_f(acc[mi][1][i]);
            acc[mi][0][i] = g0; acc[mi][1][i] = g1;
            const float ss = half_sum32(g0 * g0 + g1 * g1);
            if (l32 == 0) atomicAdd(rowss + rbase + mi * 32 + crow(i, h), ss);
          }
#pragma unroll
          for (int ni = 0; ni < 2; ++ni)
#pragma unroll
            for (int i4 = 0; i4 < 4; ++i4) {
              const int r0 = rbase + mi * 32 + 8 * i4 + 4 * h;
              const int n = cb + ni * 32 + l32;
              *(uint2*)((bfr*)(ws + OFF_CVT) + (size_t)n * NTOK + r0) =
                  make_uint2(pk2(acc[mi][ni][4 * i4], acc[mi][ni][4 * i4 + 1]), pk2(acc[mi][ni][4 * i4 + 2], acc[mi][ni][4 * i4 + 3]));
            }
        }
      } else {
        const int isz = sec - 3;
#pragma unroll
        for (int mi = 0; mi < 2; ++mi)
#pragma unroll
          for (int ni = 0; ni < 2; ++ni)
#pragma unroll
            for (int i4 = 0; i4 < 4; ++i4) {
              const int r0 = rbase + mi * 32 + 8 * i4 + 4 * h;
              const int n = cb + ni * 32 + l32;
              const uint2 pk = make_uint2(pk2(acc[mi][ni][4 * i4], acc[mi][ni][4 * i4 + 1]), pk2(acc[mi][ni][4 * i4 + 2], acc[mi][ni][4 * i4 + 3]));
              if (!lat) {
                const int b = r0 >> 8, s = r0 & 255;
                *(uint2*)((bfr*)(ws + OFF_ZTC) + ((size_t)(b * 512 + n)) * 512 + isz * 256 + s) = pk;
              } else {
                const int b = (r0 - NCTX) >> 11, s = (r0 - NCTX) & 2047;
                *(uint2*)((bfr*)(ws + OFF_ZTL) + ((size_t)(b * 512 + n)) * 4096 + isz * 2048 + s) = pk;
              }
            }
      }
    };
    const int sec0 = n0 >> 9;
    const bool more = gemm_tile_pf<128>(16, sec0 == 0 || sec0 == 2 || sec0 == 5, first, al, bl, gst, ep, next_tile, smem);
    first = false;
    if (!more) break;
    tm = tm2; tn = tn2;
  }
}

struct LdWs {
  const float* w; const float* rowss;
  const float* p[4]; const float* rp;
  DI void init(int lrow, int lcol) {
#pragma unroll
    for (int i = 0; i < 4; ++i) p[i] = w + (lrow + 32 * i) * 128 + lcol;
    rp = rowss + lcol;
  }
  DI void advance(int adv) {
#pragma unroll
    for (int i = 0; i < 4; ++i) p[i] += 64 * adv;
    rp += 64 * adv;
  }
  DI uint4 load(int i) const {
    const float* wp = p[i];
    const float4 a = *(const float4*)wp, b = *(const float4*)(wp + 4);
    const float4 s0 = *(const float4*)rp, s1 = *(const float4*)(rp + 4);
    const float r0 = rsqrtf(s0.x * (1.f / 512.f) + EPS), r1 = rsqrtf(s0.y * (1.f / 512.f) + EPS), r2 = rsqrtf(s0.z * (1.f / 512.f) + EPS), r3 = rsqrtf(s0.w * (1.f / 512.f) + EPS);
    const float r4 = rsqrtf(s1.x * (1.f / 512.f) + EPS), r5 = rsqrtf(s1.y * (1.f / 512.f) + EPS), r6 = rsqrtf(s1.z * (1.f / 512.f) + EPS), r7 = rsqrtf(s1.w * (1.f / 512.f) + EPS);
    return make_uint4(pk2(a.x * r0, a.y * r1), pk2(a.z * r2, a.w * r3), pk2(b.x * r4, b.y * r5), pk2(b.z * r6, b.w * r7));
  }
};

DI void phase_mix1(const Params& p, unsigned char* smem) {
  unsigned char* ws = p.ws;
  const int lane = threadIdx.x & 63, wave = threadIdx.x >> 6, l32 = lane & 31, h = lane >> 5, wm = wave >> 1, wn = wave & 1;
  constexpr int N_FL = 512, N_FC = 256, N_G = 768;
  for (int it = blockIdx.x; it < N_FL + N_FC + N_G; it += gridDim.x) {
    if (it < N_FL + N_FC) {
      const bfr *A, *Bt; int K, Tbase, tm, tn;
      int kq = 0; bool isl = it < N_FL;
      if (isl) {
        const int b = it >> 8; kq = it & 3; tn = (it >> 2) & 3; tm = (it >> 4) & 15; K = 4096;
        A = (const bfr*)(ws + OFF_ALAT) + kq * 1024; Bt = (const bfr*)(ws + OFF_ZTL) + (size_t)b * 512 * 4096 + kq * 1024; Tbase = NCTX + b * 2048;
      } else {
        const int i2 = it - N_FL; const int b = i2 >> 3; tm = (i2 >> 2) & 1; tn = i2 & 3; K = 512;
        A = (const bfr*)(ws + OFF_ACTX); Bt = (const bfr*)(ws + OFF_ZTC) + (size_t)b * 512 * 512; Tbase = b * 256;
      }
      LdBf al{A + (size_t)tm * 128 * K, (size_t)K}, bl{Bt + (size_t)tn * 128 * K, (size_t)K};
      auto ep = [&](f32x16 (&acc)[2][2]) {
#pragma unroll
        for (int mi = 0; mi < 2; ++mi)
#pragma unroll
          for (int ni = 0; ni < 2; ++ni)
#pragma unroll
            for (int i = 0; i < 16; ++i) {
              const int T = Tbase + tm * 128 + wm * 64 + mi * 32 + crow(i, h);
              const int n = tn * 128 + wn * 64 + ni * 32 + l32;
              if (!isl) ((bfr*)(ws + OFF_FZ))[(size_t)T * 512 + n] = f2bf(acc[mi][ni][i]);
              else ((bfr*)(ws + OFF_HN))[((size_t)kq * 4096 + (T - NCTX)) * 512 + n] = f2bf(acc[mi][ni][i]);
            }
      };
      gemm_tile<128>(isl ? 16 : K / 64, false, al, bl, ep, smem);
    } else {
      const int i2 = it - N_FL - N_FC; const int hg = i2 & 7, chunk = i2 >> 3;
      LdWs al{p.in[27] + (size_t)hg * 128 * 128, (const float*)(ws + OFF_ROWSS) + chunk * 128};
      LdBf bl{(const bfr*)(ws + OFF_CVT) + (size_t)(hg * 64) * NTOK + chunk * 128, (size_t)NTOK};
      auto ep = [&](f32x16 (&acc)[2][1]) {
        const int c = hg * 64 + wn * 32 + l32;
        const float vg = p.in[26][c];
#pragma unroll
        for (int mi = 0; mi < 2; ++mi)
#pragma unroll
          for (int i = 0; i < 16; ++i) {
            const int t = wm * 64 + mi * 32 + crow(i, h);
            const int T = chunk * 128 + t;
            const float sp = acc[mi][0][i] * vg + p.in[28][hg * 128 + t];
            const float cu = bf2f(((const bfr*)(ws + OFF_CUG))[(size_t)T * 512 + c]);
            const float gc = bf2f(((const bfr*)(ws + OFF_GCS))[(size_t)T * 512 + c]);
            ((bfr*)(ws + OFF_MIX))[(size_t)T * 1024 + c] = f2bf(cu * sp * gc);
          }
      };
      gemm_tile<64>(2, false, al, bl, ep, smem);
    }
  }
}

constexpr int NPHASE = 13;
#ifndef DOUBLE_MASK
#define DOUBLE_MASK 0
#endif
template <int PH>
DI void run_phase(const Params& p, unsigned char* smem) {
  if constexpr (PH == 0) phase0(p, smem);
  else if constexpr (PH == 1) phase_rows<0>(p);
  else if constexpr (PH == 2) phase_win0(p, smem);
  else if constexpr (PH == 3) phase_mix0(p, smem);
  else if constexpr (PH == 4) phase_s5fix(p, smem);
  else if constexpr (PH == 5) phase_tokgemm<0>(p, smem, 0);
  else if constexpr (PH == 6) phase_tokgemm<1>(p, smem, 0);
  else if constexpr (PH == 7) phase_rows<1>(p);
  else if constexpr (PH == 8) phase_win1(p, smem);
  else if constexpr (PH == 9) phase_mix1(p, smem);
  else if constexpr (PH == 10) phase_tokgemm<2>(p, smem, 1);
  else if constexpr (PH == 11) phase_tokgemm<1>(p, smem, 1);
  else if constexpr (PH == 12) phase_rows<2>(p);
}
template <int LO, int HI>
DI void run_range(const Params& p, unsigned char* smem, const XcdBarrier& xb) {
  if constexpr (LO < HI) {
    run_phase<LO>(p, smem);
    if constexpr (((DOUBLE_MASK) >> LO) & 1) { xcd_barrier(xb); run_phase<LO>(p, smem); }
    if constexpr (LO + 1 < HI) { xcd_barrier(xb); run_range<LO + 1, HI>(p, smem, xb); }
  }
}
template <int LO, int HI>
__global__ void __launch_bounds__(256, 2) mega(Params p) {
  __shared__ __attribute__((aligned(16))) unsigned char smem[73728];
  __shared__ uint4 xb_words;
  if (threadIdx.x == 0) xb_words = make_uint4(0u, 0u, 0u, 0u);
  __syncthreads();
  XcdBarrier xb = xcd_barrier_post((unsigned*)(p.ws + OFF_BAR), (volatile LAS unsigned*)&xb_words);
  run_range<LO, HI>(p, smem, xb);
  if (p.ph_lo != 0) cg::this_grid().sync();
}

#ifndef ONE_LAUNCH
#define ONE_LAUNCH 1
#endif
#if !ONE_LAUNCH
template <int PH>
static void launch_phases(Params& p, int grid, hipStream_t stream) {
  if constexpr (PH < NPHASE) {
    hipLaunchKernelGGL((mega<PH, PH + 1>), dim3(grid), dim3(256), 0, stream, p);
    launch_phases<PH + 1>(p, grid, stream);
  }
}
#endif

#ifndef ONE_LAUNCH
#define ONE_LAUNCH 1
#endif

extern "C" void kernel_launch(void* const* d_in, const int* in_sizes, int n_in, void* d_out, int out_size, void* d_ws, size_t ws_size, hipStream_t stream) {
  static int grid_blocks = 0;
  if (!grid_blocks) {
    int dev = 0, cus = 0, per_cu = 0;
    (void)hipGetDevice(&dev);
    (void)hipDeviceGetAttribute(&cus, hipDeviceAttributeMultiprocessorCount, dev);
    (void)hipOccupancyMaxActiveBlocksPerMultiprocessor(&per_cu, mega<0, NPHASE>, 256, 0);
    if (per_cu > 2) per_cu = 2;
    if (per_cu < 1) per_cu = 1;
    grid_blocks = cus * per_cu;
    if (n_in != 31 || ws_size < WS_TOTAL) fprintf(stderr, "kernel_launch: unexpected n_in %d or ws_size %zu (need %zu)\n", n_in, ws_size, (size_t)WS_TOTAL);
  }
  Params p{};
  for (int i = 0; i < 31; ++i) p.in[i] = (const float*)d_in[i];
  p.out = (float*)d_out; p.ws = (unsigned char*)d_ws;
  (void)hipMemsetAsync((unsigned char*)d_ws + OFF_BAR, 0, 16384, stream);
#if ONE_LAUNCH
  p.ph_lo = 0; p.ph_hi = NPHASE;
  void* args[] = {&p};
  hipError_t e = hipLaunchCooperativeKernel((void*)mega<0, NPHASE>, dim3(grid_blocks), dim3(256), args, 0, stream);
  if (e != hipSuccess) fprintf(stderr, "cooperative launch failed: %s (grid %d)\n", hipGetErrorString(e), grid_blocks);
#else
  launch_phases<0>(p, grid_blocks, stream);
#endif
}
```

```cpp
#include <hip/hip_runtime.h>
#include <hip/hip_cooperative_groups.h>
#include <cstdio>
#include <cstdint>
namespace cg = cooperative_groups;

#define DI __device__ __forceinline__
typedef unsigned short bfr;
using bf16x8 = __attribute__((ext_vector_type(8))) short;
using s16x4  = __attribute__((ext_vector_type(4))) short;
using f32x16 = __attribute__((ext_vector_type(16))) float;
using f32x4  = __attribute__((ext_vector_type(4))) float;

#define MFMA32(a, b, c) __builtin_amdgcn_mfma_f32_32x32x16_bf16((a), (b), (c), 0, 0, 0)
#define MFMA16(a, b, c) __builtin_amdgcn_mfma_f32_16x16x32_bf16((a), (b), (c), 0, 0, 0)

constexpr int NTOK = 12288, NCTX = 8192;
constexpr float EPS = 1e-6f;

constexpr size_t OFF_MOD   = 0;
constexpr size_t OFF_ROWSS = OFF_MOD + 73728;
constexpr size_t OFF_ROPE  = OFF_ROWSS + 49152;
constexpr size_t OFF_LAMB  = OFF_ROPE + 8192;
constexpr size_t OFF_LAMP  = OFF_LAMB + 32768;
constexpr size_t OFF_BB    = OFF_LAMP + 32768;
constexpr size_t OFF_CMB   = OFF_BB + 524288;
constexpr size_t OFF_E     = OFF_CMB + 262144;
constexpr size_t OFF_WIN0  = OFF_E + 1572864;
constexpr size_t OFF_GLU   = OFF_WIN0 + 4718592;
constexpr size_t OFF_WOUT0 = OFF_GLU + 524288;
constexpr size_t OFF_WIN1  = OFF_WOUT0 + 2097152;
constexpr size_t OFF_FNET  = OFF_WIN1 + 6291456;
constexpr size_t OFF_WOUT1 = OFF_FNET + 524288;
constexpr size_t OFF_ACTX  = OFF_WOUT1 + 2097152;
constexpr size_t OFF_ALAT  = OFF_ACTX + 262144;
constexpr size_t OFF_X1    = OFF_ALAT + 16777216;
constexpr size_t OFF_HN    = OFF_X1 + 50331648;
constexpr size_t OFF_MIX   = OFF_HN + 25165824;
constexpr size_t OFF_O     = OFF_MIX + 25165824;
constexpr size_t OFF_U     = OFF_O;
constexpr size_t OFF_R     = OFF_O + 25165824;
constexpr size_t OFF_QB = OFF_R;
constexpr size_t OFF_KC = OFF_QB + 12582912;
constexpr size_t OFF_KL = OFF_KC + 2097152;
constexpr size_t OFF_VC = OFF_KL + 1310720;
constexpr size_t OFF_VL = OFF_VC + 2097152;
constexpr size_t OFF_GA = OFF_VL + 1310720;
constexpr size_t OFF_GB = OFF_GA + 12582912;
constexpr size_t OFF_YF = OFF_GB + 12582912;
constexpr size_t OFF_YB = OFF_YF + 12582912;
constexpr size_t OFF_YG = OFF_YB + 12582912;
constexpr size_t END_L0 = OFF_YG + 12582912;
constexpr size_t OFF_CUG = OFF_R;
constexpr size_t OFF_GCS = OFF_CUG + 12582912;
constexpr size_t OFF_GDS = OFF_GCS + 12582912;
constexpr size_t OFF_CVT = OFF_GDS + 12582912;
constexpr size_t OFF_FZ  = OFF_CVT + 12582912;
constexpr size_t OFF_ZTC = OFF_FZ + 12582912;
constexpr size_t OFF_ZTL = OFF_ZTC + 16777216;
constexpr size_t END_L1 = OFF_ZTL + 8388608;
constexpr size_t WS_NEED = (END_L0 > END_L1 ? END_L0 : END_L1);
constexpr size_t OFF_BAR = WS_NEED;
constexpr size_t WS_TOTAL = OFF_BAR + 16384;
static_assert(WS_TOTAL <= (size_t)256 * 1024 * 1024, "workspace too large");

constexpr size_t OUT_Y = 0, OUT_K = 12582912, OUT_V = 13631488, OUT_S = 14680064;

struct Params {
  const float* in[31];
  float* out;
  unsigned char* ws;
  int ph_lo, ph_hi;
};

typedef __bf16 hbf2 __attribute__((ext_vector_type(2)));
typedef float hfl2 __attribute__((ext_vector_type(2)));
DI unsigned pk2(float lo, float hi) { hfl2 v = {lo, hi}; hbf2 r = __builtin_convertvector(v, hbf2); return __builtin_bit_cast(unsigned, r); }
DI unsigned short f2bf(float x) { return (unsigned short)(pk2(x, 0.f) & 0xffffu); }
DI float bf2f(unsigned short b) { return __uint_as_float(((unsigned)b) << 16); }
DI float wave_sum(float v) {
#pragma unroll
  for (int o = 1; o < 64; o <<= 1) v += __shfl_xor(v, o);
  return v;
}
DI float half_sum32(float v) {
#pragma unroll
  for (int o = 1; o < 32; o <<= 1) v += __shfl_xor(v, o);
  return v;
}
DI float silu_f(float x) { return x / (1.f + __expf(-x)); }
DI float sigmoid_f(float x) { return 1.f / (1.f + __expf(-x)); }
DI float gelu_f(float x) { float z = 0.7978845608028654f * (x + 0.044715f * x * x * x); return x / (1.f + __expf(-2.f * z)); }
DI int crow(int i, int h) { return (i & 3) + 8 * (i >> 2) + 4 * h; }
DI const float* xrow(const Params& p, int T) { return T < NCTX ? p.in[0] + (size_t)T * 1024 : p.in[1] + (size_t)(T - NCTX) * 1024; }
DI int cond_of(int T) { return T < NCTX ? 0 : 1 + ((T - NCTX) >> 11); }

template <int BN, bool D2 = true, class AL, class BL, class EP>
DI void gemm_tile(int nk, bool swp, AL al, BL bl, EP ep, unsigned char* smem) {
  constexpr int NI = BN / 64;
  constexpr int NB = BN / 32;
  constexpr int STG = (128 + BN) * 72;
  unsigned short* S0 = (unsigned short*)smem;
  const int tid = threadIdx.x, lane = tid & 63, wave = tid >> 6, l32 = lane & 31, h = lane >> 5;
  const int wm = wave >> 1, wn = wave & 1;
  const int xoff = (swp ? 128 * 72 + (wn * 64 + l32) * 72 : (wm * 64 + l32) * 72) + h * 8;
  const int yoff = (swp ? (wm * 64 + l32) * 72 : 128 * 72 + (wn * (BN / 2) + l32) * 72) + h * 8;
  f32x16 acc[2][NI];
#pragma unroll
  for (int mi = 0; mi < 2; ++mi)
#pragma unroll
    for (int ni = 0; ni < NI; ++ni)
#pragma unroll
      for (int i = 0; i < 16; ++i) acc[mi][ni][i] = 0.f;
  uint4 ra[2][4], rb[2][NB];
  const int lrow = tid >> 3, lcol = (tid & 7) * 8;
  al.init(lrow, lcol); bl.init(lrow, lcol);
  int nxt = 0;
  auto gload = [&](uint4 (&a4)[4], uint4 (&b4)[NB]) {
#pragma unroll
    for (int i = 0; i < 4; ++i) a4[i] = al.load(i);
#pragma unroll
    for (int i = 0; i < NB; ++i) b4[i] = bl.load(i);
    const int adv = (nxt + 1 < nk) ? 1 : 0;
    al.advance(adv); bl.advance(adv); nxt += adv;
  };
  auto lstore = [&](const uint4 (&a4)[4], const uint4 (&b4)[NB], unsigned short* st) {
#pragma unroll
    for (int i = 0; i < 4; ++i) *(uint4*)(st + (lrow + 32 * i) * 72 + lcol) = a4[i];
#pragma unroll
    for (int i = 0; i < NB; ++i) *(uint4*)(st + 128 * 72 + (lrow + 32 * i) * 72 + lcol) = b4[i];
  };
  auto compute = [&](const unsigned short* st) {
#pragma unroll
    for (int ks = 0; ks < 4; ++ks) {
      bf16x8 x[2], y[NI];
#pragma unroll
      for (int mi = 0; mi < 2; ++mi) x[mi] = *(const bf16x8*)(st + xoff + mi * 32 * 72 + ks * 16);
#pragma unroll
      for (int ni = 0; ni < NI; ++ni) y[ni] = *(const bf16x8*)(st + yoff + ni * 32 * 72 + ks * 16);
#pragma unroll
      for (int mi = 0; mi < 2; ++mi)
#pragma unroll
        for (int ni = 0; ni < NI; ++ni) acc[mi][ni] = MFMA32(x[mi], y[ni], acc[mi][ni]);
    }
  };
  if constexpr (D2) {
    gload(ra[0], rb[0]);
    gload(ra[1], rb[1]);
    __syncthreads();
    lstore(ra[0], rb[0], S0);
    gload(ra[0], rb[0]);
    __syncthreads();
    for (int kt = 0; kt < nk; kt += 2) {
      compute(S0);
      lstore(ra[1], rb[1], S0 + STG);
      gload(ra[1], rb[1]);
      __syncthreads();
      compute(S0 + STG);
      if (kt + 2 < nk) lstore(ra[0], rb[0], S0);
      gload(ra[0], rb[0]);
      __syncthreads();
    }
  } else {
    gload(ra[0], rb[0]);
    __syncthreads();
    lstore(ra[0], rb[0], S0);
    gload(ra[0], rb[0]);
    __syncthreads();
    for (int kt = 0; kt < nk; kt += 2) {
      compute(S0);
      lstore(ra[0], rb[0], S0 + STG);
      gload(ra[0], rb[0]);
      __syncthreads();
      compute(S0 + STG);
      if (kt + 2 < nk) lstore(ra[0], rb[0], S0);
      gload(ra[0], rb[0]);
      __syncthreads();
    }
  }
  ep(acc);
}

template <int BN> struct GStage { uint4 ra[2][4]; uint4 rb[2][BN / 32]; int nxt; };
template <int BN, class AL, class BL, class EP, class NX>
DI bool gemm_tile_pf(int nk, bool swp, bool first, AL& al, BL& bl, GStage<BN>& st, EP ep, NX next_tile, unsigned char* smem) {
  constexpr int NI = BN / 64;
  constexpr int NB = BN / 32;
  constexpr int STG = (128 + BN) * 72;
  unsigned short* S0 = (unsigned short*)smem;
  const int tid = threadIdx.x, lane = tid & 63, wave = tid >> 6, l32 = lane & 31, h = lane >> 5;
  const int wm = wave >> 1, wn = wave & 1;
  const int xoff = (swp ? 128 * 72 + (wn * 64 + l32) * 72 : (wm * 64 + l32) * 72) + h * 8;
  const int yoff = (swp ? (wm * 64 + l32) * 72 : 128 * 72 + (wn * (BN / 2) + l32) * 72) + h * 8;
  f32x16 acc[2][NI];
#pragma unroll
  for (int mi = 0; mi < 2; ++mi)
#pragma unroll
    for (int ni = 0; ni < NI; ++ni)
#pragma unroll
      for (int i = 0; i < 16; ++i) acc[mi][ni][i] = 0.f;
  const int lrow = tid >> 3, lcol = (tid & 7) * 8;
  auto gload = [&](uint4 (&a4)[4], uint4 (&b4)[NB]) {
#pragma unroll
    for (int i = 0; i < 4; ++i) a4[i] = al.load(i);
#pragma unroll
    for (int i = 0; i < NB; ++i) b4[i] = bl.load(i);
    const int adv = (st.nxt + 1 < nk) ? 1 : 0;
    al.advance(adv); bl.advance(adv); st.nxt += adv;
  };
  auto lstore = [&](const uint4 (&a4)[4], const uint4 (&b4)[NB], unsigned short* sp) {
#pragma unroll
    for (int i = 0; i < 4; ++i) *(uint4*)(sp + (lrow + 32 * i) * 72 + lcol) = a4[i];
#pragma unroll
    for (int i = 0; i < NB; ++i) *(uint4*)(sp + 128 * 72 + (lrow + 32 * i) * 72 + lcol) = b4[i];
  };
  auto compute = [&](const unsigned short* sp) {
#pragma unroll
    for (int ks = 0; ks < 4; ++ks) {
      bf16x8 x[2], y[NI];
#pragma unroll
      for (int mi = 0; mi < 2; ++mi) x[mi] = *(const bf16x8*)(sp + xoff + mi * 32 * 72 + ks * 16);
#pragma unroll
      for (int ni = 0; ni < NI; ++ni) y[ni] = *(const bf16x8*)(sp + yoff + ni * 32 * 72 + ks * 16);
#pragma unroll
      for (int mi = 0; mi < 2; ++mi)
#pragma unroll
        for (int ni = 0; ni < NI; ++ni) acc[mi][ni] = MFMA32(x[mi], y[ni], acc[mi][ni]);
    }
  };
  if (first) {
    al.init(lrow, lcol); bl.init(lrow, lcol); st.nxt = 0;
    gload(st.ra[0], st.rb[0]);
    gload(st.ra[1], st.rb[1]);
  }
  __syncthreads();
  lstore(st.ra[0], st.rb[0], S0);
  gload(st.ra[0], st.rb[0]);
  __syncthreads();
  for (int kt = 0; kt < nk; kt += 2) {
    compute(S0);
    lstore(st.ra[1], st.rb[1], S0 + STG);
    gload(st.ra[1], st.rb[1]);
    __syncthreads();
    compute(S0 + STG);
    if (kt + 2 < nk) lstore(st.ra[0], st.rb[0], S0);
    gload(st.ra[0], st.rb[0]);
    __syncthreads();
  }
  const bool more = next_tile();
  if (more) {
    al.init(lrow, lcol); bl.init(lrow, lcol); st.nxt = 0;
    gload(st.ra[0], st.rb[0]);
    gload(st.ra[1], st.rb[1]);
  }
  ep(acc);
  return more;
}

DI bool xcd_tile(int step, int ntn, int& tm, int& tn) {
  const int G = gridDim.x;
  if ((G & 7) == 0) {
    const int x = blockIdx.x & 7, loc = blockIdx.x >> 3, per = G >> 3;
    const int j = loc + step * per;
    if (j >= 12 * ntn) return false;
    tn = j / 12; tm = 12 * x + j % 12;
    return true;
  }
  const int it = blockIdx.x + step * G;
  if (it >= 96 * ntn) return false;
  tm = it / ntn; tn = it % ntn;
  return true;
}

#define GAS __attribute__((address_space(1)))
typedef unsigned u32x4 __attribute__((ext_vector_type(4)));
DI uint4 gld16(const GAS char* q) { const u32x4 v = *(const GAS u32x4*)q; return make_uint4(v.x, v.y, v.z, v.w); }
struct LdBf {
  const bfr* base; size_t ld;
  const GAS char* p[4];
  DI void init(int lrow, int lcol) {
#pragma unroll
    for (int i = 0; i < 4; ++i) { p[i] = (const GAS char*)(base + (size_t)(lrow + 32 * i) * ld + lcol); asm volatile("" : "+v"(p[i])); }
  }
  DI uint4 load(int i) const { return gld16(p[i]); }
  DI void advance(int adv) {
#pragma unroll
    for (int i = 0; i < 4; ++i) p[i] += 128 * adv;
  }
};
#define XB_TMO      128
#define XB_XCNT(j)  (256  + 64 * (j))
#define XB_XSUB(j)  (1280 + 64 * (j))
#define XB_XGEN(j)  (2304 + 64 * (j))
#define XB_TOP      3328
#define XB_TOPGEN   3392
#define XCD_BAR_WORDS 3456
#define XB_SPIN_CAP (1u << 20)
#define LAS __attribute__((address_space(3)))
DI unsigned xb_ld(unsigned* p)              { return __hip_atomic_load(p, __ATOMIC_RELAXED, __HIP_MEMORY_SCOPE_AGENT); }
DI unsigned xb_add(unsigned* p, unsigned v) { return __hip_atomic_fetch_add(p, v, __ATOMIC_RELAXED, __HIP_MEMORY_SCOPE_AGENT); }
DI unsigned xb_xcc_id() { return (unsigned)__builtin_amdgcn_s_getreg((3 << 11) | 20) & 0xFu; }
#define XB_SPIN(cond, bar) do { unsigned _sp = 0; while (cond) { __builtin_amdgcn_s_sleep(1); \
    if ((++_sp & 255u) == 0u) { if (xb_ld(&(bar)[XB_TMO])) break; if (_sp > XB_SPIN_CAP) { atomicAdd(&(bar)[XB_TMO], 1u); break; } } } } while (0)
struct XcdBarrier { unsigned* bar; unsigned x; volatile LAS unsigned* st; };
DI XcdBarrier xcd_barrier_post(unsigned* bar, volatile LAS unsigned* st) {
  XcdBarrier b; b.bar = bar; b.x = xb_xcc_id(); b.st = st;
  if (threadIdx.x == 0) (void)xb_add(&bar[XB_XCNT(b.x)], 1u);
  return b;
}
DI void xcd_barrier_complete(unsigned* bar, unsigned x, unsigned& nloc, unsigned& nx) {
  const unsigned G = gridDim.x * gridDim.y * gridDim.z;
  unsigned sum, cnt, mine, sp = 0u;
  for (;;) {
    sum = 0u; cnt = 0u; mine = 0u;
#pragma unroll
    for (unsigned j = 0; j < 16; ++j) { const unsigned c = xb_ld(&bar[XB_XCNT(j)]); sum += c; cnt += (c > 0u) ? 1u : 0u; mine = (j == x) ? c : mine; }
    if (sum == G) break;
    __builtin_amdgcn_s_sleep(1);
    if ((++sp & 255u) == 0u) { if (xb_ld(&bar[XB_TMO])) break; if (sp > XB_SPIN_CAP) { atomicAdd(&bar[XB_TMO], 1u); break; } }
  }
  nloc = mine > 0u ? mine : 1u; nx = cnt > 0u ? cnt : 1u;
}
DI void xcd_barrier(const XcdBarrier& b) {
  asm volatile("s_waitcnt vmcnt(0)" ::: "memory");
  __syncthreads();
  if (threadIdx.x == 0) {
    unsigned* bar = b.bar;
    __builtin_amdgcn_s_waitcnt(0);
    unsigned nloc = b.st[0], nx = b.st[1];
    if (nloc == 0u) { xcd_barrier_complete(bar, b.x, nloc, nx); b.st[0] = nloc; b.st[1] = nx; }
    const unsigned old = xb_add(&bar[XB_XSUB(b.x)], 1u);
    const unsigned gen = old / nloc;
    if (old + 1u == (gen + 1u) * nloc) {
      __builtin_amdgcn_fence(__ATOMIC_RELEASE, "agent");
      asm volatile("s_waitcnt vmcnt(0)" ::: "memory");
      const unsigned og = xb_add(&bar[XB_TOP], 1u);
      const unsigned tg = og / nx;
      if (og + 1u == (tg + 1u) * nx) xb_add(&bar[XB_TOPGEN], 1u);
      else XB_SPIN(xb_ld(&bar[XB_TOPGEN]) == tg, bar);
      __builtin_amdgcn_fence(__ATOMIC_ACQUIRE, "agent");
      xb_add(&bar[XB_XGEN(b.x)], 1u);
      asm volatile("s_waitcnt vmcnt(0)" ::: "memory");
    } else {
      XB_SPIN(xb_ld(&bar[XB_XGEN(b.x)]) == gen, bar);
      __builtin_amdgcn_fence(__ATOMIC_ACQUIRE, "agent");
      asm volatile("s_waitcnt vmcnt(0)" ::: "memory");
    }
  }
  __syncthreads();
}

struct LdFz {
  const bfr* pz;
  const GAS char* p[4];
  DI void init(int lrow, int lcol) {
#pragma unroll
    for (int i = 0; i < 4; ++i) { p[i] = (const GAS char*)(pz + (size_t)(lrow + 32 * i) * 512 + lcol); asm volatile("" : "+v"(p[i])); }
  }
  DI void advance(int adv) {
#pragma unroll
    for (int i = 0; i < 4; ++i) p[i] += 128 * adv;
  }
  DI uint4 load(int i) const {
    const GAS char* q = p[i];
    const uint4 a = gld16(q), b = gld16(q + (size_t)4096 * 512 * 2), c = gld16(q + (size_t)2 * 4096 * 512 * 2), d = gld16(q + (size_t)3 * 4096 * 512 * 2);
#define SUM4(f) pk2(bf2f(a.f & 0xffff) + bf2f(b.f & 0xffff) + bf2f(c.f & 0xffff) + bf2f(d.f & 0xffff), bf2f(a.f >> 16) + bf2f(b.f >> 16) + bf2f(c.f >> 16) + bf2f(d.f >> 16))
    return make_uint4(SUM4(x), SUM4(y), SUM4(z), SUM4(w));
#undef SUM4
  }
};

DI void transpose_tile(const float* W, int ldw, int kbase, int nbase, bfr* WT, int ldt, int trow, float* sm) {
  const int tid = threadIdx.x;
#pragma unroll
  for (int i = 0; i < 4; ++i) {
    const int r = (tid >> 4) + 16 * i, c = (tid & 15) * 4;
    const float4 v = *(const float4*)(W + (size_t)(kbase + r) * ldw + nbase + c);
    sm[r * 65 + c] = v.x; sm[r * 65 + c + 1] = v.y; sm[r * 65 + c + 2] = v.z; sm[r * 65 + c + 3] = v.w;
  }
  __syncthreads();
  const int n = tid >> 2, kc = (tid & 3) * 16;
  unsigned o[8];
#pragma unroll
  for (int j = 0; j < 8; ++j) o[j] = pk2(sm[(kc + 2 * j) * 65 + n], sm[(kc + 2 * j + 1) * 65 + n]);
  uint4* dst = (uint4*)(WT + (size_t)(trow + n) * ldt + kbase + kc);
  dst[0] = make_uint4(o[0], o[1], o[2], o[3]);
  dst[1] = make_uint4(o[4], o[5], o[6], o[7]);
}

DI void phase0(const Params& p, unsigned char* smem) {
  const int tid = threadIdx.x;
  float* smf = (float*)smem;
  unsigned char* ws = p.ws;
  constexpr int N_ADA = 192;
  constexpr int N_T0 = 16 * 36, N_TG = 64, N_TO0 = 256, N_T1A = 16 * 24, N_T1B = 16 * 8, N_TF = 64, N_TO1 = 256;
  constexpr int N_FOLD = 128, N_ALAT = 2048, N_ACTX = 256, N_CACHE = 64, N_SSM = 64, N_ZERO = 48, N_ROPE = 4;
  constexpr int B_T0 = N_ADA, B_TG = B_T0 + N_T0, B_TO0 = B_TG + N_TG, B_T1A = B_TO0 + N_TO0, B_T1B = B_T1A + N_T1A,
                B_TF = B_T1B + N_T1B, B_TO1 = B_TF + N_TF, B_FOLD = B_TO1 + N_TO1, B_ALAT = B_FOLD + N_FOLD,
                B_ACTX = B_ALAT + N_ALAT, B_CACHE = B_ACTX + N_ACTX, B_SSM = B_CACHE + N_CACHE, B_ZERO = B_SSM + N_SSM,
                B_ROPE = B_ZERO + N_ZERO, N_ALL = B_ROPE + N_ROPE;
  for (int it = blockIdx.x; it < N_ALL; it += gridDim.x) {
    __syncthreads();
    if (it < B_T0) {
      const int l = it / 96, cgp = it % 96;
      float* sc = smf;
      float* red = smf + 3072;
      for (int e = tid; e < 3072; e += 256) {
        const int ci = e >> 10, k = e & 1023;
        const float cv = ci == 0 ? p.in[6][k] : p.in[5][(ci - 1) * 1024 + k];
        sc[e] = silu_f(cv);
      }
      __syncthreads();
      const int cq = tid & 7, rg = tid >> 3;
      const float* w = p.in[7] + (size_t)l * 1024 * 3072 + cgp * 32 + cq * 4;
      float4 a0 = make_float4(0.f, 0.f, 0.f, 0.f), a1 = a0, a2 = a0;
#pragma unroll 16
      for (int k = rg; k < 1024; k += 32) {
        const float4 wv = *(const float4*)(w + (size_t)k * 3072);
        const float s0 = sc[k], s1 = sc[1024 + k], s2 = sc[2048 + k];
        a0.x += s0 * wv.x; a0.y += s0 * wv.y; a0.z += s0 * wv.z; a0.w += s0 * wv.w;
        a1.x += s1 * wv.x; a1.y += s1 * wv.y; a1.z += s1 * wv.z; a1.w += s1 * wv.w;
        a2.x += s2 * wv.x; a2.y += s2 * wv.y; a2.z += s2 * wv.z; a2.w += s2 * wv.w;
      }
      *(float4*)(red + (0 * 32 + rg) * 32 + cq * 4) = a0;
      *(float4*)(red + (1 * 32 + rg) * 32 + cq * 4) = a1;
      *(float4*)(red + (2 * 32 + rg) * 32 + cq * 4) = a2;
      __syncthreads();
      if (tid < 96) {
        const int c2 = tid & 31, ci = tid >> 5;
        float s = 0.f;
#pragma unroll
        for (int q = 0; q < 32; ++q) s += red[(ci * 32 + q) * 32 + c2];
        const int n2 = cgp * 32 + c2;
        ((float*)(ws + OFF_MOD))[(l * 3 + ci) * 3072 + n2] = s + p.in[8][l * 3072 + n2];
      }
    } else if (it < B_FOLD) {
      const float* W; int ldw, nbase_off = 0, trow_off = 0, ntn, ldt; bfr* WT; int r;
      if (it < B_TG)        { r = it - B_T0;  W = p.in[11]; ldw = 2304; ntn = 36; WT = (bfr*)(ws + OFF_WIN0); ldt = 1024; }
      else if (it < B_TO0)  { r = it - B_TG;  W = p.in[22]; ldw = 512;  ntn = 8;  WT = (bfr*)(ws + OFF_GLU); ldt = 512; }
      else if (it < B_T1A)  { r = it - B_TO0; W = p.in[24]; ldw = 1024; ntn = 16; WT = (bfr*)(ws + OFF_WOUT0); ldt = 1024; }
      else if (it < B_T1B)  { r = it - B_T1A; W = p.in[25]; ldw = 2560; ntn = 24; WT = (bfr*)(ws + OFF_WIN1); ldt = 1024; }
      else if (it < B_TF)   { r = it - B_T1B; W = p.in[25]; ldw = 2560; ntn = 8;  WT = (bfr*)(ws + OFF_WIN1); ldt = 1024; nbase_off = 2048; trow_off = 2560; }
      else if (it < B_TO1)  { r = it - B_TF;  W = p.in[29]; ldw = 512;  ntn = 8;  WT = (bfr*)(ws + OFF_FNET); ldt = 512; }
      else                  { r = it - B_TO1; W = p.in[30]; ldw = 1024; ntn = 16; WT = (bfr*)(ws + OFF_WOUT1); ldt = 1024; }
      const int kb = r / ntn, nb = r % ntn;
      transpose_tile(W, ldw, kb * 64, nbase_off + nb * 64, WT, ldt, trow_off + nb * 64, smf);
    } else if (it < B_ALAT) {
      const int r = it - B_FOLD, cs = r & 1, kb = (r >> 1) & 15, g = r >> 5;
      float* tile = smf;
      float* tw = smf + 128 * 68;
      const float* W = p.in[25];
      {
        const int c4 = (tid & 31) * 4, kr = tid >> 5;
#pragma unroll
        for (int i = 0; i < 8; ++i) {
          const int k = kr + 8 * i;
          const float4 v = *(const float4*)(W + (size_t)(kb * 64 + k) * 2560 + 1536 + g * 128 + c4);
          tile[(c4 + 0) * 68 + k] = v.x; tile[(c4 + 1) * 68 + k] = v.y; tile[(c4 + 2) * 68 + k] = v.z; tile[(c4 + 3) * 68 + k] = v.w;
        }
        if (tid < 128) {
          const float a = 2.f * (float)tid / 128.f;
          tw[tid] = (cs == 0 ? cospif(a) : sinpif(a)) * 0.08838834764831845f;
        }
      }
      __syncthreads();
      const int j = tid & 127, kg = tid >> 7;
      float acc[32];
#pragma unroll
      for (int i = 0; i < 32; ++i) acc[i] = 0.f;
      for (int c = 0; c < 128; ++c) {
        const float t = tw[(j * c) & 127];
        const float4* tp = (const float4*)(tile + c * 68 + kg * 32);
#pragma unroll
        for (int q = 0; q < 8; ++q) {
          const float4 v = tp[q];
          acc[4 * q + 0] += v.x * t; acc[4 * q + 1] += v.y * t; acc[4 * q + 2] += v.z * t; acc[4 * q + 3] += v.w * t;
        }
      }
      uint4* dst = (uint4*)((bfr*)(ws + OFF_WIN1) + (size_t)(1536 + cs * 512 + g * 128 + j) * 1024 + kb * 64 + kg * 32);
#pragma unroll
      for (int q = 0; q < 4; ++q)
        dst[q] = make_uint4(pk2(acc[8 * q], acc[8 * q + 1]), pk2(acc[8 * q + 2], acc[8 * q + 3]), pk2(acc[8 * q + 4], acc[8 * q + 5]), pk2(acc[8 * q + 6], acc[8 * q + 7]));
    } else if (it < B_ACTX) {
      const int t = it - B_ALAT;
      bfr* dst = (bfr*)(ws + OFF_ALAT) + (size_t)t * 4096;
      const float nrm = 0.02209708691207961f;
#pragma unroll
      for (int half = 0; half < 2; ++half) {
        const int k0 = half * 2048 + tid * 8;
        unsigned o[4];
#pragma unroll
        for (int j = 0; j < 4; ++j) {
          float v[2];
#pragma unroll
          for (int e = 0; e < 2; ++e) {
            const int k = k0 + 2 * j + e;
            const int m = (t * (k & 2047)) & 2047;
            const float a = (float)m * (2.f / 2048.f);
            v[e] = (k < 2048 ? cospif(a) : -sinpif(a)) * nrm;
          }
          o[j] = pk2(v[0], v[1]);
        }
        *(uint4*)(dst + k0) = make_uint4(o[0], o[1], o[2], o[3]);
      }
    } else if (it < B_CACHE) {
      const int t = it - B_ACTX;
      bfr* dst = (bfr*)(ws + OFF_ACTX) + (size_t)t * 512;
      const float nrm = 0.0625f;
      float v[2];
#pragma unroll
      for (int e = 0; e < 2; ++e) {
        const int k = tid * 2 + e;
        const int m = (t * (k & 255)) & 255;
        const float a = (float)m * (2.f / 256.f);
        v[e] = (k < 256 ? cospif(a) : -sinpif(a)) * nrm;
      }
      *(unsigned*)(dst + tid * 2) = pk2(v[0], v[1]);
    } else if (it < B_SSM) {
      const int r = it - B_CACHE;
#pragma unroll
      for (int i = 0; i < 8; ++i) {
        const int e = r * 2048 + tid + 256 * i;
        const int d = e & 63, kvh = (e >> 6) & 1, key = (e >> 7) & 511, b = e >> 16;
        ((bfr*)(ws + OFF_KL))[((size_t)(b * 2 + kvh) * 2560 + key) * 64 + d] = f2bf(p.in[2][e]);
        ((bfr*)(ws + OFF_VL))[((size_t)(b * 2 + kvh) * 64 + d) * 2560 + key] = f2bf(p.in[3][e]);
      }
    } else if (it < B_ZERO) {
      const int dg = it - B_SSM;
      const int pp = tid & 63, part = tid >> 6;
      const double lr = (double)p.in[14][dg * 64 + pp], li = (double)p.in[15][dg * 64 + pp];
      const double dt = (double)__expf(p.in[16][dg]) ;
      const float dtf = expf(p.in[16][dg]);
      const double dtd = (double)dtf;
      (void)dt;
      const double PI = 3.14159265358979323846;
      double ap = li * dtd / PI;
      double ar = ap - 2.0 * rint(ap * 0.5);
      const float er = expf((float)(lr * dtd));
      const double lbr = (double)er * (double)cospif((float)ar), lbi = (double)er * (double)sinpif((float)ar);
      double ap2 = ap * 256.0;
      double ar2 = ap2 - 2.0 * rint(ap2 * 0.5);
      const float er2 = expf((float)(lr * dtd * 256.0));
      if (part == 0) {
        ((float2*)(ws + OFF_LAMB))[dg * 64 + pp] = make_float2((float)lbr, (float)lbi);
        ((float2*)(ws + OFF_LAMP))[dg * 64 + pp] = make_float2(er2 * cospif((float)ar2), er2 * sinpif((float)ar2));
      }
      const double den = lr * lr + li * li;
      const double fr = ((lbr - 1.0) * lr + lbi * li) / den, fi = (lbi * lr - (lbr - 1.0) * li) / den;
      float* bb = (float*)(ws + OFF_BB) + (size_t)(dg * 64 + pp) * 32;
#pragma unroll
      for (int q = 0; q < 4; ++q) {
        const int c = part * 4 + q;
        const double br = (double)p.in[17][(size_t)(dg * 64 + pp) * 16 + c], bi = (double)p.in[18][(size_t)(dg * 64 + pp) * 16 + c];
        bb[c] = (float)(fr * br - fi * bi);
        bb[16 + c] = (float)(fr * bi + fi * br);
      }
      bfr* cm = (bfr*)(ws + OFF_CMB) + (size_t)dg * 2048;
#pragma unroll
      for (int q = 0; q < 8; ++q) {
        const int e = tid * 8 + q, c = e >> 7, k = e & 127;
        const float v = k < 64 ? p.in[19][(size_t)(dg * 16 + c) * 64 + k] : -p.in[20][(size_t)(dg * 16 + c) * 64 + (k - 64)];
        cm[e] = f2bf(v);
      }
    } else if (it < B_ROPE) {
      const int r = it - B_ZERO;
      ((float*)(ws + OFF_ROWSS))[r * 256 + tid] = 0.f;
    } else {
      const int e = (it - B_ROPE) * 256 + tid;
      const int n = e >> 4, pr = e & 15;
      const double q4[4] = {1.0, 0.5623413251903491, 0.31622776601683794, 0.1778279410038923};
      double inv = q4[0];
      if ((pr & 3) == 1) inv = q4[1]; else if ((pr & 3) == 2) inv = q4[2]; else if ((pr & 3) == 3) inv = q4[3];
      const int dec = pr >> 2;
      if (dec == 1) inv *= 0.1; else if (dec == 2) inv *= 0.01; else if (dec == 3) inv *= 0.001;
      const double ap = (double)n * inv / 3.14159265358979323846;
      const double ar = ap - 2.0 * rint(ap * 0.5);
      ((float2*)(ws + OFF_ROPE))[e] = make_float2(cospif((float)ar), sinpif((float)ar));
    }
  }
}

template <int MODE>
DI void phase_rows(const Params& p) {
  unsigned char* ws = p.ws;
  const int lane = threadIdx.x & 63, wave = threadIdx.x >> 6;
  const float* mod = (const float*)(ws + OFF_MOD);
  for (int it = blockIdx.x; it < NTOK / 4; it += gridDim.x) {
    const int T = it * 4 + wave;
    const int ci = cond_of(T);
    float4 xv[4];
    if (MODE == 2) {
      const bfr* xr = (const bfr*)(ws + OFF_X1) + (size_t)T * 1024 + lane * 4;
#pragma unroll
      for (int j = 0; j < 4; ++j) {
        const uint2 raw = *(const uint2*)(xr + 256 * j);
        xv[j].x = bf2f(raw.x & 0xffff); xv[j].y = bf2f(raw.x >> 16); xv[j].z = bf2f(raw.y & 0xffff); xv[j].w = bf2f(raw.y >> 16);
      }
    } else {
      const float4* xr = (const float4*)xrow(p, T) + lane;
#pragma unroll
      for (int j = 0; j < 4; ++j) xv[j] = xr[64 * j];
    }
    if (MODE >= 1) {
      const int l = MODE - 1;
      const bfr* orow = (const bfr*)(ws + OFF_O) + (size_t)T * 1024;
      float4 ov[4]; float ss = 0.f;
#pragma unroll
      for (int j = 0; j < 4; ++j) {
        const uint2 raw = *(const uint2*)(orow + lane * 4 + 256 * j);
        ov[j].x = bf2f(raw.x & 0xffff); ov[j].y = bf2f(raw.x >> 16); ov[j].z = bf2f(raw.y & 0xffff); ov[j].w = bf2f(raw.y >> 16);
        ss += ov[j].x * ov[j].x + ov[j].y * ov[j].y + ov[j].z * ov[j].z + ov[j].w * ov[j].w;
      }
      const float rinv = rsqrtf(wave_sum(ss) * (1.f / 1024.f) + EPS);
      const float* gate = mod + (l * 3 + ci) * 3072 + 2048;
      const float* gp = p.in[10] + l * 1024;
#pragma unroll
      for (int j = 0; j < 4; ++j) {
        const int k = lane * 4 + 256 * j;
        const float4 g4 = *(const float4*)(gate + k), n4 = *(const float4*)(gp + k);
        xv[j].x += g4.x * (ov[j].x * rinv * n4.x); xv[j].y += g4.y * (ov[j].y * rinv * n4.y);
        xv[j].z += g4.z * (ov[j].z * rinv * n4.z); xv[j].w += g4.w * (ov[j].w * rinv * n4.w);
      }
      if (MODE == 2) {
        float4* yr = (float4*)(p.out + OUT_Y + (size_t)T * 1024) + lane;
#pragma unroll
        for (int j = 0; j < 4; ++j) yr[64 * j] = xv[j];
      } else {
        bfr* x1r = (bfr*)(ws + OFF_X1) + (size_t)T * 1024 + lane * 4;
#pragma unroll
        for (int j = 0; j < 4; ++j) *(uint2*)(x1r + 256 * j) = make_uint2(pk2(xv[j].x, xv[j].y), pk2(xv[j].z, xv[j].w));
      }
    }
    if (MODE <= 1) {
      const int l = MODE;
      float ss = 0.f;
#pragma unroll
      for (int j = 0; j < 4; ++j) ss += xv[j].x * xv[j].x + xv[j].y * xv[j].y + xv[j].z * xv[j].z + xv[j].w * xv[j].w;
      const float rinv = rsqrtf(wave_sum(ss) * (1.f / 1024.f) + EPS);
      const float* shift = mod + (l * 3 + ci) * 3072;
      const float* scale = shift + 1024;
      const float* gp = p.in[9] + l * 1024;
      bfr* hr = (bfr*)(ws + OFF_HN) + (size_t)T * 1024;
#pragma unroll
      for (int j = 0; j < 4; ++j) {
        const int k = lane * 4 + 256 * j;
        const float4 s4 = *(const float4*)(shift + k), c4 = *(const float4*)(scale + k), n4 = *(const float4*)(gp + k);
        const float a = xv[j].x * rinv * n4.x * (1.f + c4.x) + s4.x;
        const float b = xv[j].y * rinv * n4.y * (1.f + c4.y) + s4.y;
        const float c = xv[j].z * rinv * n4.z * (1.f + c4.z) + s4.z;
        const float d = xv[j].w * rinv * n4.w * (1.f + c4.w) + s4.w;
        *(uint2*)(hr + k) = make_uint2(pk2(a, b), pk2(c, d));
      }
    }
  }
}

DI void phase_win0(const Params& p, unsigned char* smem) {
  unsigned char* ws = p.ws;
  const int lane = threadIdx.x & 63, wave = threadIdx.x >> 6, l32 = lane & 31, h = lane >> 5, wm = wave >> 1, wn = wave & 1;
  const bfr* A = (const bfr*)(ws + OFF_HN);
  const bfr* Bt = (const bfr*)(ws + OFF_WIN0);
  int tm, tn;
  if (!xcd_tile(0, 18, tm, tn)) return;
  LdBf al{A + (size_t)tm * 128 * 1024, 1024}, bl{Bt + (size_t)tn * 128 * 1024, 1024};
  for (int step = 0;; ++step) {
    const int m0 = tm * 128, n0 = tn * 128;
    int tm2 = 0, tn2 = 0;
    auto next_tile = [&]() {
      if (!xcd_tile(step + 1, 18, tm2, tn2)) return false;
      al.base = A + (size_t)tm2 * 128 * 1024; bl.base = Bt + (size_t)tn2 * 128 * 1024;
      return true;
    };
    auto ep = [&](f32x16 (&acc)[2][2]) {
      const int colbase = n0 + wn * 64, rbase = m0 + wm * 64;
      const bool lat = m0 >= NCTX;
      if (tn == 5) {
        const int hd = (colbase - 640) >> 6;
#pragma unroll
        for (int mi = 0; mi < 2; ++mi)
#pragma unroll
          for (int ni = 0; ni < 2; ++ni) {
            const int d = ni * 32 + l32;
#pragma unroll
            for (int i4 = 0; i4 < 4; ++i4) {
              const int r0 = rbase + mi * 32 + 8 * i4 + 4 * h;
              const float a = acc[mi][ni][4 * i4], b2 = acc[mi][ni][4 * i4 + 1], c = acc[mi][ni][4 * i4 + 2], e = acc[mi][ni][4 * i4 + 3];
              const uint2 pk = make_uint2(pk2(a, b2), pk2(c, e));
              if (!lat) {
                p.out[OUT_V + (size_t)(r0 + 0) * 128 + hd * 64 + d] = a;
                p.out[OUT_V + (size_t)(r0 + 1) * 128 + hd * 64 + d] = b2;
                p.out[OUT_V + (size_t)(r0 + 2) * 128 + hd * 64 + d] = c;
                p.out[OUT_V + (size_t)(r0 + 3) * 128 + hd * 64 + d] = e;
                const int b = r0 >> 8, l = r0 & 255;
                *(uint2*)((bfr*)(ws + OFF_VC) + ((size_t)(b * 2 + hd) * 64 + d) * 256 + l) = pk;
              } else {
                const int b = (r0 - NCTX) >> 11, l = (r0 - NCTX) & 2047;
                *(uint2*)((bfr*)(ws + OFF_VL) + ((size_t)(b * 2 + hd) * 64 + d) * 2560 + 512 + l) = pk;
              }
            }
          }
      } else if (colbase < 640) {
        const bool isq = colbase < 512;
        const float* gain = isq ? p.in[12] : p.in[13];
        const int hd = isq ? (colbase >> 6) : ((colbase - 512) >> 6);
        float4 gv[2][4];
#pragma unroll
        for (int mi = 0; mi < 2; ++mi)
#pragma unroll
          for (int i4 = 0; i4 < 4; ++i4) gv[mi][i4] = *(const float4*)(gain + mi * 32 + 8 * i4 + 4 * h);
#pragma unroll
        for (int ni = 0; ni < 2; ++ni) {
          const int T = rbase + ni * 32 + l32;
          float ss = 0.f;
#pragma unroll
          for (int mi = 0; mi < 2; ++mi)
#pragma unroll
            for (int i = 0; i < 16; ++i) ss += acc[mi][ni][i] * acc[mi][ni][i];
          ss += __shfl_xor(ss, 32);
          const float rinv = rsqrtf(ss * (1.f / 64.f) + EPS);
          float v[2][16];
#pragma unroll
          for (int mi = 0; mi < 2; ++mi)
#pragma unroll
            for (int i4 = 0; i4 < 4; ++i4) {
              v[mi][4 * i4 + 0] = acc[mi][ni][4 * i4 + 0] * rinv * gv[mi][i4].x;
              v[mi][4 * i4 + 1] = acc[mi][ni][4 * i4 + 1] * rinv * gv[mi][i4].y;
              v[mi][4 * i4 + 2] = acc[mi][ni][4 * i4 + 2] * rinv * gv[mi][i4].z;
              v[mi][4 * i4 + 3] = acc[mi][ni][4 * i4 + 3] * rinv * gv[mi][i4].w;
            }
          if (!lat && !isq) {
#pragma unroll
            for (int mi = 0; mi < 2; ++mi)
#pragma unroll
              for (int i4 = 0; i4 < 4; ++i4)
                *(float4*)(p.out + OUT_K + (size_t)T * 128 + hd * 64 + mi * 32 + 8 * i4 + 4 * h) = make_float4(v[mi][4 * i4], v[mi][4 * i4 + 1], v[mi][4 * i4 + 2], v[mi][4 * i4 + 3]);
          }
          if (lat) {
            const int pos = (T - NCTX) & 2047;
            const float* rope = (const float*)(ws + OFF_ROPE);
#pragma unroll
            for (int mi = 0; mi < 2; ++mi) {
              const float* rb = rope + ((mi == 0 ? (pos >> 6) : (pos & 63)) * 16 + 4 * h) * 2;
#pragma unroll
              for (int i4 = 0; i4 < 2; ++i4) {
                const float4 cs0 = *(const float4*)(rb + 16 * i4), cs1 = *(const float4*)(rb + 16 * i4 + 4);
                const float cc[4] = {cs0.x, cs0.z, cs1.x, cs1.z}, sn[4] = {cs0.y, cs0.w, cs1.y, cs1.w};
#pragma unroll
                for (int e = 0; e < 4; ++e) {
                  const float x1 = v[mi][4 * i4 + e], x2 = v[mi][4 * i4 + e + 8];
                  v[mi][4 * i4 + e] = x1 * cc[e] - x2 * sn[e];
                  v[mi][4 * i4 + e + 8] = x1 * sn[e] + x2 * cc[e];
                }
              }
            }
          }
          bfr* dst;
          float sc = 1.f;
          if (isq) { dst = (bfr*)(ws + OFF_QB) + (size_t)T * 512 + hd * 64; sc = 0.125f; }
          else if (!lat) { dst = (bfr*)(ws + OFF_KC) + ((size_t)((T >> 8) * 2 + hd) * 256 + (T & 255)) * 64; }
          else { dst = (bfr*)(ws + OFF_KL) + ((size_t)(((T - NCTX) >> 11) * 2 + hd) * 2560 + 512 + ((T - NCTX) & 2047)) * 64; }
#pragma unroll
          for (int mi = 0; mi < 2; ++mi)
#pragma unroll
            for (int i4 = 0; i4 < 4; ++i4)
              *(uint2*)(dst + mi * 32 + 8 * i4 + 4 * h) = make_uint2(pk2(v[mi][4 * i4] * sc, v[mi][4 * i4 + 1] * sc), pk2(v[mi][4 * i4 + 2] * sc, v[mi][4 * i4 + 3] * sc));
        }
      } else {
        const int sec = colbase < 1280 ? 0 : (colbase < 1792 ? 1 : 2);
        const int cb = colbase - (sec == 0 ? 768 : (sec == 1 ? 1280 : 1792));
#pragma unroll
        for (int ni = 0; ni < 2; ++ni) {
          const int T = rbase + ni * 32 + l32;
#pragma unroll
          for (int mi = 0; mi < 2; ++mi)
#pragma unroll
            for (int i4 = 0; i4 < 4; ++i4) {
              const int c = cb + mi * 32 + 8 * i4 + 4 * h;
              const float a = acc[mi][ni][4 * i4], b2 = acc[mi][ni][4 * i4 + 1], c2 = acc[mi][ni][4 * i4 + 2], e = acc[mi][ni][4 * i4 + 3];
              if (sec == 1) *(float4*)((float*)(ws + OFF_U) + (size_t)T * 512 + c) = make_float4(a, b2, c2, e);
              else *(uint2*)((bfr*)(ws + (sec == 0 ? OFF_GA : OFF_GB)) + (size_t)T * 512 + c) = make_uint2(pk2(silu_f(a), silu_f(b2)), pk2(silu_f(c2), silu_f(e)));
            }
        }
      }
    };
    al.base = A + (size_t)m0 * 1024; bl.base = Bt + (size_t)n0 * 1024;
    gemm_tile<128>(16, tn != 5, al, bl, ep, smem);
    if (!next_tile()) break;
    tm = tm2; tn = tn2;
  }
}

DI void attn_item(const Params& p, unsigned char* smem, int it) {
  unsigned char* ws = p.ws;
  const int tid = threadIdx.x, lane = tid & 63, wave = tid >> 6, l32 = lane & 31, h = lane >> 5;
  int T0, nkeys, ldv; const bfr *Kp, *Vp; int kvh;
  if (it < 256) {
    const int b = it >> 7, qt = it & 63; kvh = (it >> 6) & 1;
    T0 = NCTX + b * 2048 + qt * 32; nkeys = 2560; ldv = 2560;
    Kp = (const bfr*)(ws + OFF_KL) + (size_t)(b * 2 + kvh) * 2560 * 64;
    Vp = (const bfr*)(ws + OFF_VL) + (size_t)(b * 2 + kvh) * 64 * 2560;
  } else {
    const int i2 = it - 256; const int b = i2 >> 4, qt = i2 & 7; kvh = (i2 >> 3) & 1;
    T0 = b * 256 + qt * 32; nkeys = 256; ldv = 256;
    Kp = (const bfr*)(ws + OFF_KC) + (size_t)(b * 2 + kvh) * 256 * 64;
    Vp = (const bfr*)(ws + OFF_VC) + (size_t)(b * 2 + kvh) * 64 * 256;
  }
  const int head = kvh * 4 + wave;
  unsigned short* Ks = (unsigned short*)smem;
  unsigned short* Vs = Ks + 64 * 72;
  bf16x8 qf[4];
  {
    const bfr* q = (const bfr*)(ws + OFF_QB) + (size_t)(T0 + l32) * 512 + head * 64 + 8 * h;
#pragma unroll
    for (int ks = 0; ks < 4; ++ks) qf[ks] = *(const bf16x8*)(q + 16 * ks);
  }
  float m = -1e30f, lsum = 0.f;
  f32x16 O[2];
#pragma unroll
  for (int i = 0; i < 16; ++i) { O[0][i] = 0.f; O[1][i] = 0.f; }
  const int rr0 = tid >> 3, cc0 = (tid & 7) * 8;
  const bfr* kp0 = Kp + (size_t)rr0 * 64 + cc0;
  const bfr* vp0 = Vp + (size_t)rr0 * ldv + cc0;
  uint4 kreg0 = *(const uint4*)kp0, kreg1 = *(const uint4*)(kp0 + 32 * 64);
  uint4 vreg0 = *(const uint4*)vp0, vreg1 = *(const uint4*)(vp0 + (size_t)32 * ldv);
  for (int k0 = 0; k0 < nkeys; k0 += 64) {
    __syncthreads();
    *(uint4*)(Ks + rr0 * 72 + cc0) = kreg0; *(uint4*)(Ks + (rr0 + 32) * 72 + cc0) = kreg1;
    *(uint4*)(Vs + rr0 * 72 + cc0) = vreg0; *(uint4*)(Vs + (rr0 + 32) * 72 + cc0) = vreg1;
    __syncthreads();
    if (k0 + 64 < nkeys) {
      kreg0 = *(const uint4*)(kp0 + (size_t)(k0 + 64) * 64); kreg1 = *(const uint4*)(kp0 + (size_t)(k0 + 96) * 64);
      vreg0 = *(const uint4*)(vp0 + k0 + 64); vreg1 = *(const uint4*)(vp0 + (size_t)32 * ldv + k0 + 64);
    }
    f32x16 st[2];
#pragma unroll
    for (int kt = 0; kt < 2; ++kt) {
#pragma unroll
      for (int i = 0; i < 16; ++i) st[kt][i] = 0.f;
#pragma unroll
      for (int ks = 0; ks < 4; ++ks) {
        const bf16x8 a = *(const bf16x8*)(Ks + (32 * kt + l32) * 72 + 16 * ks + 8 * h);
        st[kt] = MFMA32(a, qf[ks], st[kt]);
      }
    }
    float mx = st[0][0];
#pragma unroll
    for (int i = 0; i < 16; ++i) { mx = fmaxf(mx, st[0][i]); mx = fmaxf(mx, st[1][i]); }
    mx = fmaxf(mx, __shfl_xor(mx, 32));
    const float mn = fmaxf(m, mx);
    const float alpha = __expf(m - mn);
    m = mn;
    float ps = 0.f;
#pragma unroll
    for (int kt = 0; kt < 2; ++kt)
#pragma unroll
      for (int i = 0; i < 16; ++i) { const float e = __expf(st[kt][i] - mn); st[kt][i] = e; ps += e; }
    lsum = lsum * alpha + ps;
#pragma unroll
    for (int i = 0; i < 16; ++i) { O[0][i] *= alpha; O[1][i] *= alpha; }
#pragma unroll
    for (int kt = 0; kt < 2; ++kt)
#pragma unroll
      for (int s = 0; s < 2; ++s) {
        const uint4 pu = make_uint4(pk2(st[kt][8 * s], st[kt][8 * s + 1]), pk2(st[kt][8 * s + 2], st[kt][8 * s + 3]),
                                    pk2(st[kt][8 * s + 4], st[kt][8 * s + 5]), pk2(st[kt][8 * s + 6], st[kt][8 * s + 7]));
        const bf16x8 pf = __builtin_bit_cast(bf16x8, pu);
#pragma unroll
        for (int dt = 0; dt < 2; ++dt) {
          const unsigned short* vr = Vs + (32 * dt + l32) * 72 + 32 * kt + 16 * s + 4 * h;
          const s16x4 lo = *(const s16x4*)vr, hi = *(const s16x4*)(vr + 8);
          const bf16x8 va = __builtin_shufflevector(lo, hi, 0, 1, 2, 3, 4, 5, 6, 7);
          O[dt] = MFMA32(va, pf, O[dt]);
        }
      }
  }
  const float ltot = lsum + __shfl_xor(lsum, 32);
  const float inv = 1.f / ltot;
  const int T = T0 + l32;
#pragma unroll
  for (int dt = 0; dt < 2; ++dt)
#pragma unroll
    for (int i4 = 0; i4 < 4; ++i4) {
      const int d = 32 * dt + 8 * i4 + 4 * h;
      const uint2 g = *(const uint2*)((const bfr*)(ws + OFF_GA) + (size_t)T * 512 + head * 64 + d);
      const float a = O[dt][4 * i4] * inv * bf2f(g.x & 0xffff), b = O[dt][4 * i4 + 1] * inv * bf2f(g.x >> 16);
      const float c = O[dt][4 * i4 + 2] * inv * bf2f(g.y & 0xffff), e = O[dt][4 * i4 + 3] * inv * bf2f(g.y >> 16);
      *(uint2*)((bfr*)(ws + OFF_MIX) + (size_t)T * 1024 + head * 64 + d) = make_uint2(pk2(a, b), pk2(c, e));
    }
}

DI void attn_lat_item(const Params& p, unsigned char* smem, int it) {
  unsigned char* ws = p.ws;
  const int tid = threadIdx.x, lane = tid & 63, wave = tid >> 6, l32 = lane & 31, h = lane >> 5;
  const int b = it >> 8, kvh = (it >> 7) & 1, qt = (it >> 1) & 63, hp = it & 1;
  const int hw = wave & 1, kh = wave >> 1;
  const int T0 = NCTX + b * 2048 + qt * 32;
  const int head = kvh * 4 + hp * 2 + hw;
  const bfr* Kp = (const bfr*)(ws + OFF_KL) + ((size_t)(b * 2 + kvh) * 2560 + kh * 1280) * 64;
  const bfr* Vp = (const bfr*)(ws + OFF_VL) + (size_t)(b * 2 + kvh) * 64 * 2560 + kh * 1280;
  unsigned short* Ks = (unsigned short*)smem + kh * (2 * 64 * 72);
  unsigned short* Vs = Ks + 64 * 72;
  bf16x8 qf[4];
  {
    const bfr* q = (const bfr*)(ws + OFF_QB) + (size_t)(T0 + l32) * 512 + head * 64 + 8 * h;
#pragma unroll
    for (int ks = 0; ks < 4; ++ks) qf[ks] = *(const bf16x8*)(q + 16 * ks);
  }
  float m = -1e30f, lsum = 0.f;
  f32x16 O[2];
#pragma unroll
  for (int i = 0; i < 16; ++i) { O[0][i] = 0.f; O[1][i] = 0.f; }
  const int t2 = tid & 127, rr0 = t2 >> 3, cc0 = (t2 & 7) * 8;
  const bfr* kp0 = Kp + (size_t)rr0 * 64 + cc0;
  const bfr* vp0 = Vp + (size_t)rr0 * 2560 + cc0;
  uint4 kr0 = *(const uint4*)kp0, kr1 = *(const uint4*)(kp0 + 16 * 64), kr2 = *(const uint4*)(kp0 + 32 * 64), kr3 = *(const uint4*)(kp0 + 48 * 64);
  uint4 vr0 = *(const uint4*)vp0, vr1 = *(const uint4*)(vp0 + (size_t)16 * 2560), vr2 = *(const uint4*)(vp0 + (size_t)32 * 2560), vr3 = *(const uint4*)(vp0 + (size_t)48 * 2560);
  for (int k0 = 0; k0 < 1280; k0 += 64) {
    __syncthreads();
    *(uint4*)(Ks + rr0 * 72 + cc0) = kr0; *(uint4*)(Ks + (rr0 + 16) * 72 + cc0) = kr1; *(uint4*)(Ks + (rr0 + 32) * 72 + cc0) = kr2; *(uint4*)(Ks + (rr0 + 48) * 72 + cc0) = kr3;
    *(uint4*)(Vs + rr0 * 72 + cc0) = vr0; *(uint4*)(Vs + (rr0 + 16) * 72 + cc0) = vr1; *(uint4*)(Vs + (rr0 + 32) * 72 + cc0) = vr2; *(uint4*)(Vs + (rr0 + 48) * 72 + cc0) = vr3;
    __syncthreads();
    if (k0 + 64 < 1280) {
      const bfr* kq = kp0 + (size_t)(k0 + 64) * 64; const bfr* vq = vp0 + k0 + 64;
      kr0 = *(const uint4*)kq; kr1 = *(const uint4*)(kq + 16 * 64); kr2 = *(const uint4*)(kq + 32 * 64); kr3 = *(const uint4*)(kq + 48 * 64);
      vr0 = *(const uint4*)vq; vr1 = *(const uint4*)(vq + (size_t)16 * 2560); vr2 = *(const uint4*)(vq + (size_t)32 * 2560); vr3 = *(const uint4*)(vq + (size_t)48 * 2560);
    }
    f32x16 st[2];
#pragma unroll
    for (int kt = 0; kt < 2; ++kt) {
#pragma unroll
      for (int i = 0; i < 16; ++i) st[kt][i] = 0.f;
#pragma unroll
      for (int ks = 0; ks < 4; ++ks) {
        const bf16x8 a = *(const bf16x8*)(Ks + (32 * kt + l32) * 72 + 16 * ks + 8 * h);
        st[kt] = MFMA32(a, qf[ks], st[kt]);
      }
    }
    float mx = st[0][0];
#pragma unroll
    for (int i = 0; i < 16; ++i) { mx = fmaxf(mx, st[0][i]); mx = fmaxf(mx, st[1][i]); }
    mx = fmaxf(mx, __shfl_xor(mx, 32));
    const float mn = fmaxf(m, mx);
    const float alpha = __expf(m - mn);
    m = mn;
    float ps = 0.f;
#pragma unroll
    for (int kt = 0; kt < 2; ++kt)
#pragma unroll
      for (int i = 0; i < 16; ++i) { const float e = __expf(st[kt][i] - mn); st[kt][i] = e; ps += e; }
    lsum = lsum * alpha + ps;
#pragma unroll
    for (int i = 0; i < 16; ++i) { O[0][i] *= alpha; O[1][i] *= alpha; }
#pragma unroll
    for (int kt = 0; kt < 2; ++kt)
#pragma unroll
      for (int s = 0; s < 2; ++s) {
        const uint4 pu = make_uint4(pk2(st[kt][8 * s], st[kt][8 * s + 1]), pk2(st[kt][8 * s + 2], st[kt][8 * s + 3]),
                                    pk2(st[kt][8 * s + 4], st[kt][8 * s + 5]), pk2(st[kt][8 * s + 6], st[kt][8 * s + 7]));
        const bf16x8 pf = __builtin_bit_cast(bf16x8, pu);
#pragma unroll
        for (int dt = 0; dt < 2; ++dt) {
          const unsigned short* vr = Vs + (32 * dt + l32) * 72 + 32 * kt + 16 * s + 4 * h;
          const s16x4 lo = *(const s16x4*)vr, hi = *(const s16x4*)(vr + 8);
          const bf16x8 va = __builtin_shufflevector(lo, hi, 0, 1, 2, 3, 4, 5, 6, 7);
          O[dt] = MFMA32(va, pf, O[dt]);
        }
      }
  }
  float ltot = lsum + __shfl_xor(lsum, 32);
  float* xb = (float*)smem + (hw * 64 + lane) * 36;
  __syncthreads();
  if (kh == 1) {
#pragma unroll
    for (int i = 0; i < 16; ++i) { xb[i] = O[0][i]; xb[16 + i] = O[1][i]; }
    xb[32] = m; xb[33] = ltot;
  }
  __syncthreads();
  if (kh == 0) {
    const float m2 = xb[32], l2 = xb[33];
    const float mm = fmaxf(m, m2), a1 = __expf(m - mm), a2 = __expf(m2 - mm);
    ltot = ltot * a1 + l2 * a2;
    const float inv = 1.f / ltot;
#pragma unroll
    for (int i = 0; i < 16; ++i) { O[0][i] = (O[0][i] * a1 + xb[i] * a2) * inv; O[1][i] = (O[1][i] * a1 + xb[16 + i] * a2) * inv; }
    const int T = T0 + l32;
#pragma unroll
    for (int dt = 0; dt < 2; ++dt)
#pragma unroll
      for (int i4 = 0; i4 < 4; ++i4) {
        const int d = 32 * dt + 8 * i4 + 4 * h;
        const uint2 g = *(const uint2*)((const bfr*)(ws + OFF_GA) + (size_t)T * 512 + head * 64 + d);
        const float a = O[dt][4 * i4] * bf2f(g.x & 0xffff), bq = O[dt][4 * i4 + 1] * bf2f(g.x >> 16);
        const float c = O[dt][4 * i4 + 2] * bf2f(g.y & 0xffff), e = O[dt][4 * i4 + 3] * bf2f(g.y >> 16);
        *(uint2*)((bfr*)(ws + OFF_MIX) + (size_t)T * 1024 + head * 64 + d) = make_uint2(pk2(a, bq), pk2(c, e));
      }
  }
}

DI int seg_T0(int seg) { return seg < 32 ? seg * 256 : NCTX + ((seg - 32) >> 3) * 2048 + ((seg - 32) & 7) * 256; }

DI void split_bf16(const float4& v0, const float4& v1, bf16x8& hi, bf16x8& lo) {
  const unsigned h0 = pk2(v0.x, v0.y), h1 = pk2(v0.z, v0.w), h2 = pk2(v1.x, v1.y), h3 = pk2(v1.z, v1.w);
  hi = __builtin_bit_cast(bf16x8, make_uint4(h0, h1, h2, h3));
  const unsigned l0 = pk2(v0.x - bf2f(h0 & 0xffff), v0.y - bf2f(h0 >> 16)), l1 = pk2(v0.z - bf2f(h1 & 0xffff), v0.w - bf2f(h1 >> 16));
  const unsigned l2 = pk2(v1.x - bf2f(h2 & 0xffff), v1.y - bf2f(h2 >> 16)), l3 = pk2(v1.z - bf2f(h3 & 0xffff), v1.w - bf2f(h3 >> 16));
  lo = __builtin_bit_cast(bf16x8, make_uint4(l0, l1, l2, l3));
}

DI void s5_wave(const Params& p, float* BU  , int it) {
  unsigned char* ws = p.ws;
  const int lane = threadIdx.x & 63, l32 = lane & 31, h = lane >> 5;
  const int di = it & 1, g = (it >> 1) & 31, seg = it >> 6;
  const int T0 = seg_T0(seg);
  const int dg = di * 32 + g;
  bf16x8 bhi[4], blo[4];
#pragma unroll
  for (int nt = 0; nt < 4; ++nt) {
    const float* bb = (const float*)(ws + OFF_BB) + (size_t)(dg * 64 + (nt & 1) * 32 + l32) * 32 + (nt >> 1) * 16 + 8 * h;
    split_bf16(*(const float4*)bb, *(const float4*)(bb + 4), bhi[nt], blo[nt]);
  }
  const float2 lam = ((const float2*)(ws + OFF_LAMB))[dg * 64 + lane];
  bf16x8 cmf[4];
  {
    const bfr* cm = (const bfr*)(ws + OFF_CMB) + (size_t)dg * 2048 + (lane & 15) * 128 + 8 * (lane >> 4);
#pragma unroll
    for (int ks = 0; ks < 4; ++ks) cmf[ks] = *(const bf16x8*)(cm + 32 * ks);
  }
  float hr = 0.f, hi = 0.f;
  bfr* yout = (bfr*)(ws + (di == 0 ? OFF_YF : OFF_YB));
  const float* ubase = (const float*)(ws + OFF_U) + g * 16 + 8 * h;
  float4 u0, u1;
  { const int T = di == 0 ? T0 + l32 : T0 + 255 - l32; const float* up = ubase + (size_t)T * 512; u0 = *(const float4*)up; u1 = *(const float4*)(up + 4); }
  for (int c = 0; c < 8; ++c) {
    bf16x8 ahi, alo;
    split_bf16(u0, u1, ahi, alo);
    if (c < 7) { const int sg = 32 * (c + 1) + l32; const int T = di == 0 ? T0 + sg : T0 + 255 - sg; const float* up = ubase + (size_t)T * 512; u0 = *(const float4*)up; u1 = *(const float4*)(up + 4); }
#pragma unroll
    for (int nt = 0; nt < 4; ++nt) {
      f32x16 acc;
#pragma unroll
      for (int i = 0; i < 16; ++i) acc[i] = 0.f;
      acc = MFMA32(ahi, bhi[nt], acc);
      acc = MFMA32(alo, bhi[nt], acc);
      acc = MFMA32(ahi, blo[nt], acc);
#pragma unroll
      for (int i = 0; i < 16; ++i) BU[crow(i, h) * 132 + 32 * nt + l32] = acc[i];
    }
    __builtin_amdgcn_wave_barrier();
#pragma unroll 8
    for (int sl = 0; sl < 32; ++sl) {
      const float br = BU[sl * 132 + lane], bi = BU[sl * 132 + 64 + lane];
      const float nr = lam.x * hr - lam.y * hi + br;
      const float ni = lam.x * hi + lam.y * hr + bi;
      hr = nr; hi = ni;
      BU[sl * 132 + lane] = hr; BU[sl * 132 + 64 + lane] = hi;
    }
    __builtin_amdgcn_wave_barrier();
#pragma unroll
    for (int tt = 0; tt < 2; ++tt) {
      f32x4 acc = {0.f, 0.f, 0.f, 0.f};
      const float* hrow = BU + (16 * tt + (lane & 15)) * 132 + 8 * (lane >> 4);
#pragma unroll
      for (int ks = 0; ks < 4; ++ks) {
        const float4 v0 = *(const float4*)(hrow + 32 * ks), v1 = *(const float4*)(hrow + 32 * ks + 4);
        const bf16x8 a = __builtin_bit_cast(bf16x8, make_uint4(pk2(v0.x, v0.y), pk2(v0.z, v0.w), pk2(v1.x, v1.y), pk2(v1.z, v1.w)));
        acc = MFMA16(a, cmf[ks], acc);
      }
#pragma unroll
      for (int i = 0; i < 4; ++i) {
        const int sg = 32 * c + 16 * tt + 4 * (lane >> 4) + i;
        const int T = di == 0 ? T0 + sg : T0 + 255 - sg;
        yout[(size_t)T * 512 + g * 16 + (lane & 15)] = f2bf(acc[i]);
      }
    }
    __builtin_amdgcn_wave_barrier();
  }
  ((float2*)(ws + OFF_E))[((size_t)(seg * 2 + di) * 32 + g) * 64 + lane] = make_float2(hr, hi);
  if (seg < 32) {
    float* so = p.out + OUT_S + (size_t)((seg * 2 + di) * 2) * 2048 + g * 64 + lane;
    so[0] = hr; so[2048] = hi;
  }
}

DI void phase_mix0(const Params& p, unsigned char* smem) {
  constexpr int N_S5 = 3072;
  const int b = blockIdx.x, G = gridDim.x, wave = threadIdx.x >> 6;
  float* BUw = (float*)smem + wave * (32 * 132);
  if (G == 512) {
    attn_lat_item(p, smem, b);
    __syncthreads();
    if (b < 256) { for (int r = 0; r < 2; ++r) s5_wave(p, BUw, b * 8 + r * 4 + wave); }
    else s5_wave(p, BUw, 2048 + (b - 256) * 4 + wave);
    __syncthreads();
    attn_item(p, smem, 256 + b);
  } else {
    for (int it = b * 4 + wave; it < N_S5; it += G * 4) s5_wave(p, BUw, it);
    for (int it = b; it < 512; it += G) { __syncthreads(); attn_lat_item(p, smem, it); }
    for (int it = b; it < 512; it += G) { __syncthreads(); attn_item(p, smem, 256 + it); }
  }
}

DI void phase_s5fix(const Params& p, unsigned char* smem) {
  unsigned char* ws = p.ws;
  const int tid = threadIdx.x, lane = tid & 63, wave = tid >> 6;
  float* ycorr = (float*)smem;
  float* HC = (float*)smem + 4096 + wave * (16 * 132);
  for (int it = blockIdx.x; it < 48 * 32; it += gridDim.x) {
    const int g = it & 31, seg = it >> 5;
    const int T0 = seg_T0(seg);
    __syncthreads();
    if (seg >= 32) {
      for (int e = tid; e < 4096; e += 256) ycorr[e] = 0.f;
      __syncthreads();
      const int b = (seg - 32) >> 3, j = (seg - 32) & 7;
      const int di = wave & 1, half = wave >> 1;
      const int dg = di * 32 + g;
      const float2 lam = ((const float2*)(ws + OFF_LAMB))[dg * 64 + lane];
      const float2 lp = ((const float2*)(ws + OFF_LAMP))[dg * 64 + lane];
      const float* st = p.in[4] + (size_t)((b * 2 + di) * 2) * 2048 + g * 64 + lane;
      float hr = st[0], hi = st[2048];
      const int nprev = di == 0 ? j : 7 - j;
      float2 ev[7];
#pragma unroll
      for (int q = 0; q < 7; ++q) {
        const int jj = di == 0 ? q : 7 - q;
        ev[q] = ((const float2*)(ws + OFF_E))[((size_t)((32 + b * 8 + jj) * 2 + di) * 32 + g) * 64 + lane];
      }
#pragma unroll
      for (int q = 0; q < 7; ++q) {
        if (q < nprev) {
          const float nr = lp.x * hr - lp.y * hi + ev[q].x, ni = lp.x * hi + lp.y * hr + ev[q].y;
          hr = nr; hi = ni;
        }
      }
      float cr = lam.x, cim = lam.y;
      if (half) {
        float sr = lam.x, si = lam.y;
#pragma unroll
        for (int q = 0; q < 7; ++q) { const float t = sr * sr - si * si; si = 2.f * sr * si; sr = t; }
        cr = sr * lam.x - si * lam.y; cim = sr * lam.y + si * lam.x;
      }
      bf16x8 cmf[4];
      {
        const bfr* cm = (const bfr*)(ws + OFF_CMB) + (size_t)dg * 2048 + (lane & 15) * 128 + 8 * (lane >> 4);
#pragma unroll
        for (int ks = 0; ks < 4; ++ks) cmf[ks] = *(const bf16x8*)(cm + 32 * ks);
      }
      for (int c = 0; c < 8; ++c) {
#pragma unroll 8
        for (int sl = 0; sl < 16; ++sl) {
          HC[sl * 132 + lane] = cr * hr - cim * hi;
          HC[sl * 132 + 64 + lane] = cr * hi + cim * hr;
          const float nr = cr * lam.x - cim * lam.y, ni = cr * lam.y + cim * lam.x;
          cr = nr; cim = ni;
        }
        __builtin_amdgcn_wave_barrier();
        f32x4 acc = {0.f, 0.f, 0.f, 0.f};
        const float* hrow = HC + (lane & 15) * 132 + 8 * (lane >> 4);
#pragma unroll
        for (int ks = 0; ks < 4; ++ks) {
          const float4 v0 = *(const float4*)(hrow + 32 * ks), v1 = *(const float4*)(hrow + 32 * ks + 4);
          const bf16x8 a = __builtin_bit_cast(bf16x8, make_uint4(pk2(v0.x, v0.y), pk2(v0.z, v0.w), pk2(v1.x, v1.y), pk2(v1.z, v1.w)));
          acc = MFMA16(a, cmf[ks], acc);
        }
#pragma unroll
        for (int i = 0; i < 4; ++i) {
          const int sg = 128 * half + 16 * c + 4 * (lane >> 4) + i;
          const int tl = di == 0 ? sg : 255 - sg;
          atomicAdd(&ycorr[tl * 16 + (lane & 15)], acc[i]);
        }
        __builtin_amdgcn_wave_barrier();
      }
      __syncthreads();
    }
    {
      const int T = T0 + tid;
      const float* up = (const float*)(ws + OFF_U) + (size_t)T * 512 + g * 16;
      const bfr* yf = (const bfr*)(ws + OFF_YF) + (size_t)T * 512 + g * 16;
      const bfr* yb = (const bfr*)(ws + OFF_YB) + (size_t)T * 512 + g * 16;
      const float* dsk = p.in[21] + g * 16;
      unsigned o[8];
#pragma unroll
      for (int q = 0; q < 2; ++q) {
        const uint4 f = *(const uint4*)(yf + 8 * q), bk = *(const uint4*)(yb + 8 * q);
        const float4 u0 = *(const float4*)(up + 8 * q), u1 = *(const float4*)(up + 8 * q + 4);
        const float4 d0 = *(const float4*)(dsk + 8 * q), d1 = *(const float4*)(dsk + 8 * q + 4);
        const float* yc = ycorr + tid * 16 + 8 * q;
        const float uu[8] = {u0.x, u0.y, u0.z, u0.w, u1.x, u1.y, u1.z, u1.w};
        const float dd[8] = {d0.x, d0.y, d0.z, d0.w, d1.x, d1.y, d1.z, d1.w};
        const unsigned ff[4] = {f.x, f.y, f.z, f.w}, bb[4] = {bk.x, bk.y, bk.z, bk.w};
        float y[8];
#pragma unroll
        for (int e = 0; e < 8; ++e) {
          const float a = (e & 1) ? bf2f(ff[e >> 1] >> 16) : bf2f(ff[e >> 1] & 0xffff);
          const float c2 = (e & 1) ? bf2f(bb[e >> 1] >> 16) : bf2f(bb[e >> 1] & 0xffff);
          y[e] = gelu_f(uu[e] * dd[e] + a + c2 + (seg >= 32 ? yc[e] : 0.f));
        }
#pragma unroll
        for (int e = 0; e < 4; ++e) o[4 * q + e] = pk2(y[2 * e], y[2 * e + 1]);
      }
      uint4* dst = (uint4*)((bfr*)(ws + OFF_YG) + (size_t)T * 512 + g * 16);
      dst[0] = make_uint4(o[0], o[1], o[2], o[3]);
      dst[1] = make_uint4(o[4], o[5], o[6], o[7]);
    }
  }
}

template <int MODE>
DI void phase_tokgemm(const Params& p, unsigned char* smem, int layer) {
  unsigned char* ws = p.ws;
  const int lane = threadIdx.x & 63, wave = threadIdx.x >> 6, l32 = lane & 31, h = lane >> 5, wm = wave >> 1, wn = wave & 1;
  constexpr int K = MODE == 1 ? 1024 : 512, N = MODE == 1 ? 1024 : 512;
  const bfr* A = (const bfr*)(ws + (MODE == 0 ? OFF_YG : (MODE == 1 ? OFF_MIX : OFF_FZ)));
  const bfr* Bt = (const bfr*)(ws + (MODE == 0 ? OFF_GLU : (MODE == 1 ? (layer == 0 ? OFF_WOUT0 : OFF_WOUT1) : OFF_FNET)));
  constexpr int TN = N / 128;
  int tm, tn;
  if (!xcd_tile(0, TN, tm, tn)) return;
  LdBf alp{A + (size_t)tm * 128 * K, (size_t)K}, bl{Bt + (size_t)tn * 128 * K, (size_t)K};
  GStage<128> gst;
  bool first = true;
  for (int step = 0;; ++step) {
    const int m0 = tm * 128, n0 = tn * 128;
    int tm2 = 0, tn2 = 0;
    auto next_tile = [&]() {
      if (!xcd_tile(step + 1, TN, tm2, tn2)) return false;
      alp.base = A + (size_t)tm2 * 128 * K; bl.base = Bt + (size_t)tn2 * 128 * K;
      return true;
    };
    auto ep = [&](f32x16 (&acc)[2][2]) {
#pragma unroll
      for (int ni = 0; ni < 2; ++ni) {
        const int T = m0 + wm * 64 + ni * 32 + l32;
#pragma unroll
        for (int mi = 0; mi < 2; ++mi)
#pragma unroll
          for (int i4 = 0; i4 < 4; ++i4) {
            const int n = n0 + wn * 64 + mi * 32 + 8 * i4 + 4 * h;
            float a = acc[mi][ni][4 * i4], b2 = acc[mi][ni][4 * i4 + 1], c2 = acc[mi][ni][4 * i4 + 2], e = acc[mi][ni][4 * i4 + 3];
            if (MODE == 0) {
              const uint2 y = *(const uint2*)((const bfr*)(ws + OFF_YG) + (size_t)T * 512 + n);
              const uint2 gb = *(const uint2*)((const bfr*)(ws + OFF_GB) + (size_t)T * 512 + n);
              const float4 bs = *(const float4*)(p.in[23] + n);
              a = bf2f(y.x & 0xffff) * sigmoid_f(a + bs.x) * bf2f(gb.x & 0xffff);
              b2 = bf2f(y.x >> 16) * sigmoid_f(b2 + bs.y) * bf2f(gb.x >> 16);
              c2 = bf2f(y.y & 0xffff) * sigmoid_f(c2 + bs.z) * bf2f(gb.y & 0xffff);
              e = bf2f(y.y >> 16) * sigmoid_f(e + bs.w) * bf2f(gb.y >> 16);
              *(uint2*)((bfr*)(ws + OFF_MIX) + (size_t)T * 1024 + 512 + n) = make_uint2(pk2(a, b2), pk2(c2, e));
            } else if (MODE == 1) {
              *(uint2*)((bfr*)(ws + OFF_O) + (size_t)T * 1024 + n) = make_uint2(pk2(a, b2), pk2(c2, e));
            } else {
              const uint2 gd = *(const uint2*)((const bfr*)(ws + OFF_GDS) + (size_t)T * 512 + n);
              a *= bf2f(gd.x & 0xffff); b2 *= bf2f(gd.x >> 16); c2 *= bf2f(gd.y & 0xffff); e *= bf2f(gd.y >> 16);
              *(uint2*)((bfr*)(ws + OFF_MIX) + (size_t)T * 1024 + 512 + n) = make_uint2(pk2(a, b2), pk2(c2, e));
            }
          }
      }
    };
    if constexpr (MODE == 2) {
      bl.base = Bt + (size_t)n0 * K;
      if (m0 < NCTX) {
        LdBf al{A + (size_t)m0 * K, (size_t)K};
        gemm_tile<128>(K / 64, true, al, bl, ep, smem);
      } else {
        LdFz al{(const bfr*)(ws + OFF_HN) + (size_t)(m0 - NCTX) * 512};
        gemm_tile<128, false>(K / 64, true, al, bl, ep, smem);
      }
      if (!next_tile()) break;
    } else {
      const bool more = gemm_tile_pf<128>(K / 64, true, first, alp, bl, gst, ep, next_tile, smem);
      first = false;
      if (!more) break;
    }
    tm = tm2; tn = tn2;
  }
}

DI void phase_win1(const Params& p, unsigned char* smem) {
  unsigned char* ws = p.ws;
  const int lane = threadIdx.x & 63, wave = threadIdx.x >> 6, l32 = lane & 31, h = lane >> 5, wm = wave >> 1, wn = wave & 1;
  const bfr* A = (const bfr*)(ws + OFF_HN);
  const bfr* Bt = (const bfr*)(ws + OFF_WIN1);
  int tm, tn;
  if (!xcd_tile(0, 24, tm, tn)) return;
  LdBf al{A + (size_t)tm * 128 * 1024, 1024}, bl{Bt + (size_t)tn * 128 * 1024, 1024};
  GStage<128> gst;
  bool first = true;
  for (int step = 0;; ++step) {
    const int m0 = tm * 128, n0 = tn * 128;
    int tm2 = 0, tn2 = 0;
    auto next_tile = [&]() {
      if (!xcd_tile(step + 1, 24, tm2, tn2)) return false;
      al.base = A + (size_t)tm2 * 128 * 1024; bl.base = Bt + (size_t)tn2 * 128 * 1024;
      return true;
    };
    auto ep = [&](f32x16 (&acc)[2][2]) {
      const int colbase = n0 + wn * 64, rbase = m0 + wm * 64;
      const int sec = colbase >> 9;
      const int cb = colbase & 511;
      const bool lat = m0 >= NCTX;
      if (sec == 0 || sec == 2 || sec == 5) {
        bfr* dst = (bfr*)(ws + (sec == 0 ? OFF_CUG : (sec == 2 ? OFF_GCS : OFF_GDS)));
#pragma unroll
        for (int ni = 0; ni < 2; ++ni) {
          const int T = rbase + ni * 32 + l32;
#pragma unroll
          for (int mi = 0; mi < 2; ++mi)
#pragma unroll
            for (int i4 = 0; i4 < 4; ++i4) {
              const float a = acc[mi][ni][4 * i4], b2 = acc[mi][ni][4 * i4 + 1], c2 = acc[mi][ni][4 * i4 + 2], e = acc[mi][ni][4 * i4 + 3];
              const uint2 o = sec == 0 ? make_uint2(pk2(gelu_f(a), gelu_f(b2)), pk2(gelu_f(c2), gelu_f(e))) : make_uint2(pk2(silu_f(a), silu_f(b2)), pk2(silu_f(c2), silu_f(e)));
              *(uint2*)(dst + (size_t)T * 512 + cb + mi * 32 + 8 * i4 + 4 * h) = o;
            }
        }
      } else if (sec == 1) {
        float* rowss = (float*)(ws + OFF_ROWSS);
#pragma unroll
        for (int mi = 0; mi < 2; ++mi) {
#pragma unroll
          for (int i = 0; i < 16; ++i) {
            const float g0 = gelu_f(acc[mi][0][i]), g1 = gelu_f(acc[mi][1][i]);
            acc[mi][0][i] = g0; acc[mi][1][i] = g1;
            const float ss = half_sum32(g0 * g0 + g1 * g1);
            if (l32 == 0) atomicAdd(rowss + rbase + mi * 32 + crow(i, h), ss);
          }
#pragma unroll
          for (int ni = 0; ni < 2; ++ni)
#pragma unroll
            for (int i4 = 0; i4 < 4; ++i4) {
              const int r0 = rbase + mi * 32 + 8 * i4 + 4 * h;
              const int n = cb + ni * 32 + l32;
              *(uint2*)((bfr*)(ws + OFF_CVT) + (size_t)n * NTOK + r0) =
                  make_uint2(pk2(acc[mi][ni][4 * i4], acc[mi][ni][4 * i4 + 1]), pk2(acc[mi][ni][4 * i4 + 2], acc[mi][ni][4 * i4 + 3]));
            }
        }
      } else {
        const int isz = sec - 3;
#pragma unroll
        for (int mi = 0; mi < 2; ++mi)
#pragma unroll
          for (int ni = 0; ni < 2; ++ni)
#pragma unroll
            for (int i4 = 0; i4 < 4; ++i4) {
              const int r0 = rbase + mi * 32 + 8 * i4 + 4 * h;
              const int n = cb + ni * 32 + l32;
              const uint2 pk = make_uint2(pk2(acc[mi][ni][4 * i4], acc[mi][ni][4 * i4 + 1]), pk2(acc[mi][ni][4 * i4 + 2], acc[mi][ni][4 * i4 + 3]));
              if (!lat) {
                const int b = r0 >> 8, s = r0 & 255;
                *(uint2*)((bfr*)(ws + OFF_ZTC) + ((size_t)(b * 512 + n)) * 512 + isz * 256 + s) = pk;
              } else {
                const int b = (r0 - NCTX) >> 11, s = (r0 - NCTX) & 2047;
                *(uint2*)((bfr*)(ws + OFF_ZTL) + ((size_t)(b * 512 + n)) * 4096 + isz * 2048 + s) = pk;
              }
            }
      }
    };
    const int sec0 = n0 >> 9;
    const bool more = gemm_tile_pf<128>(16, sec0 == 0 || sec0 == 2 || sec0 == 5, first, al, bl, gst, ep, next_tile, smem);
    first = false;
    if (!more) break;
    tm = tm2; tn = tn2;
  }
}

struct LdWs {
  const float* w; const float* rowss;
  const float* p[4]; const float* rp;
  DI void init(int lrow, int lcol) {
#pragma unroll
    for (int i = 0; i < 4; ++i) p[i] = w + (lrow + 32 * i) * 128 + lcol;
    rp = rowss + lcol;
  }
  DI void advance(int adv) {
#pragma unroll
    for (int i = 0; i < 4; ++i) p[i] += 64 * adv;
    rp += 64 * adv;
  }
  DI uint4 load(int i) const {
    const float* wp = p[i];
    const float4 a = *(const float4*)wp, b = *(const float4*)(wp + 4);
    const float4 s0 = *(const float4*)rp, s1 = *(const float4*)(rp + 4);
    const float r0 = rsqrtf(s0.x * (1.f / 512.f) + EPS), r1 = rsqrtf(s0.y * (1.f / 512.f) + EPS), r2 = rsqrtf(s0.z * (1.f / 512.f) + EPS), r3 = rsqrtf(s0.w * (1.f / 512.f) + EPS);
    const float r4 = rsqrtf(s1.x * (1.f / 512.f) + EPS), r5 = rsqrtf(s1.y * (1.f / 512.f) + EPS), r6 = rsqrtf(s1.z * (1.f / 512.f) + EPS), r7 = rsqrtf(s1.w * (1.f / 512.f) + EPS);
    return make_uint4(pk2(a.x * r0, a.y * r1), pk2(a.z * r2, a.w * r3), pk2(b.x * r4, b.y * r5), pk2(b.z * r6, b.w * r7));
  }
};

DI void phase_mix1(const Params& p, unsigned char* smem) {
  unsigned char* ws = p.ws;
  const int lane = threadIdx.x & 63, wave = threadIdx.x >> 6, l32 = lane & 31, h = lane >> 5, wm = wave >> 1, wn = wave & 1;
  constexpr int N_FL = 512, N_FC = 256, N_G = 768;
  for (int it = blockIdx.x; it < N_FL + N_FC + N_G; it += gridDim.x) {
    if (it < N_FL + N_FC) {
      const bfr *A, *Bt; int K, Tbase, tm, tn;
      int kq = 0; bool isl = it < N_FL;
      if (isl) {
        const int b = it >> 8; kq = it & 3; tn = (it >> 2) & 3; tm = (it >> 4) & 15; K = 4096;
        A = (const bfr*)(ws + OFF_ALAT) + kq * 1024; Bt = (const bfr*)(ws + OFF_ZTL) + (size_t)b * 512 * 4096 + kq * 1024; Tbase = NCTX + b * 2048;
      } else {
        const int i2 = it - N_FL; const int b = i2 >> 3; tm = (i2 >> 2) & 1; tn = i2 & 3; K = 512;
        A = (const bfr*)(ws + OFF_ACTX); Bt = (const bfr*)(ws + OFF_ZTC) + (size_t)b * 512 * 512; Tbase = b * 256;
      }
      LdBf al{A + (size_t)tm * 128 * K, (size_t)K}, bl{Bt + (size_t)tn * 128 * K, (size_t)K};
      auto ep = [&](f32x16 (&acc)[2][2]) {
#pragma unroll
        for (int mi = 0; mi < 2; ++mi)
#pragma unroll
          for (int ni = 0; ni < 2; ++ni)
#pragma unroll
            for (int i = 0; i < 16; ++i) {
              const int T = Tbase + tm * 128 + wm * 64 + mi * 32 + crow(i, h);
              const int n = tn * 128 + wn * 64 + ni * 32 + l32;
              if (!isl) ((bfr*)(ws + OFF_FZ))[(size_t)T * 512 + n] = f2bf(acc[mi][ni][i]);
              else ((bfr*)(ws + OFF_HN))[((size_t)kq * 4096 + (T - NCTX)) * 512 + n] = f2bf(acc[mi][ni][i]);
            }
      };
      gemm_tile<128>(isl ? 16 : K / 64, false, al, bl, ep, smem);
    } else {
      const int i2 = it - N_FL - N_FC; const int hg = i2 & 7, chunk = i2 >> 3;
      LdWs al{p.in[27] + (size_t)hg * 128 * 128, (const float*)(ws + OFF_ROWSS) + chunk * 128};
      LdBf bl{(const bfr*)(ws + OFF_CVT) + (size_t)(hg * 64) * NTOK + chunk * 128, (size_t)NTOK};
      auto ep = [&](f32x16 (&acc)[2][1]) {
        const int c = hg * 64 + wn * 32 + l32;
        const float vg = p.in[26][c];
#pragma unroll
        for (int mi = 0; mi < 2; ++mi)
#pragma unroll
          for (int i = 0; i < 16; ++i) {
            const int t = wm * 64 + mi * 32 + crow(i, h);
            const int T = chunk * 128 + t;
            const float sp = acc[mi][0][i] * vg + p.in[28][hg * 128 + t];
            const float cu = bf2f(((const bfr*)(ws + OFF_CUG))[(size_t)T * 512 + c]);
            const float gc = bf2f(((const bfr*)(ws + OFF_GCS))[(size_t)T * 512 + c]);
            ((bfr*)(ws + OFF_MIX))[(size_t)T * 1024 + c] = f2bf(cu * sp * gc);
          }
      };
      gemm_tile<64>(2, false, al, bl, ep, smem);
    }
  }
}

constexpr int NPHASE = 13;
#ifndef DOUBLE_MASK
#define DOUBLE_MASK 0
#endif
template <int PH>
DI void run_phase(const Params& p, unsigned char* smem) {
  if constexpr (PH == 0) phase0(p, smem);
  else if constexpr (PH == 1) phase_rows<0>(p);
  else if constexpr (PH == 2) phase_win0(p, smem);
  else if constexpr (PH == 3) phase_mix0(p, smem);
  else if constexpr (PH == 4) phase_s5fix(p, smem);
  else if constexpr (PH == 5) phase_tokgemm<0>(p, smem, 0);
  else if constexpr (PH == 6) phase_tokgemm<1>(p, smem, 0);
  else if constexpr (PH == 7) phase_rows<1>(p);
  else if constexpr (PH == 8) phase_win1(p, smem);
  else if constexpr (PH == 9) phase_mix1(p, smem);
  else if constexpr (PH == 10) phase_tokgemm<2>(p, smem, 1);
  else if constexpr (PH == 11) phase_tokgemm<1>(p, smem, 1);
  else if constexpr (PH == 12) phase_rows<2>(p);
}
template <int LO, int HI>
DI void run_range(const Params& p, unsigned char* smem, const XcdBarrier& xb) {
  if constexpr (LO < HI) {
    run_phase<LO>(p, smem);
    if constexpr (((DOUBLE_MASK) >> LO) & 1) { xcd_barrier(xb); run_phase<LO>(p, smem); }
    if constexpr (LO + 1 < HI) { xcd_barrier(xb); run_range<LO + 1, HI>(p, smem, xb); }
  }
}
template <int LO, int HI>
__global__ void __launch_bounds__(256, 2) mega(Params p) {
  __shared__ __attribute__((aligned(16))) unsigned char smem[73728];
  __shared__ uint4 xb_words;
  if (threadIdx.x == 0) xb_words = make_uint4(0u, 0u, 0u, 0u);
  __syncthreads();
  XcdBarrier xb = xcd_barrier_post((unsigned*)(p.ws + OFF_BAR), (volatile LAS unsigned*)&xb_words);
  run_range<LO, HI>(p, smem, xb);
  if (p.ph_lo != 0) cg::this_grid().sync();
}

#ifndef ONE_LAUNCH
#define ONE_LAUNCH 1
#endif
#if !ONE_LAUNCH
template <int PH>
static void launch_phases(Params& p, int grid, hipStream_t stream) {
  if constexpr (PH < NPHASE) {
    hipLaunchKernelGGL((mega<PH, PH + 1>), dim3(grid), dim3(256), 0, stream, p);
    launch_phases<PH + 1>(p, grid, stream);
  }
}
#endif

#ifndef ONE_LAUNCH
#define ONE_LAUNCH 1
#endif

extern "C" void kernel_launch(void* const* d_in, const int* in_sizes, int n_in, void* d_out, int out_size, void* d_ws, size_t ws_size, hipStream_t stream) {
  static int grid_blocks = 0;
  if (!grid_blocks) {
    int dev = 0, cus = 0, per_cu = 0;
    (void)hipGetDevice(&dev);
    (void)hipDeviceGetAttribute(&cus, hipDeviceAttributeMultiprocessorCount, dev);
    (void)hipOccupancyMaxActiveBlocksPerMultiprocessor(&per_cu, mega<0, NPHASE>, 256, 0);
    if (per_cu > 2) per_cu = 2;
    if (per_cu < 1) per_cu = 1;
    grid_blocks = cus * per_cu;
    if (n_in != 31 || ws_size < WS_TOTAL) fprintf(stderr, "kernel_launch: unexpected n_in %d or ws_size %zu (need %zu)\n", n_in, ws_size, (size_t)WS_TOTAL);
  }
  Params p{};
  for (int i = 0; i < 31; ++i) p.in[i] = (const float*)d_in[i];
  p.out = (float*)d_out; p.ws = (unsigned char*)d_ws;
  (void)hipMemsetAsync((unsigned char*)d_ws + OFF_BAR, 0, 16384, stream);
#if ONE_LAUNCH
  p.ph_lo = 0; p.ph_hi = NPHASE;
  void* args[] = {&p};
  hipError_t e = hipLaunchCooperativeKernel((void*)mega<0, NPHASE>, dim3(grid_blocks), dim3(256), args, 0, stream);
  if (e != hipSuccess) fprintf(stderr, "cooperative launch failed: %s (grid %d)\n", hipGetErrorString(e), grid_blocks);
#else
  launch_phases<0>(p, grid_blocks, stream);
#endif
}
```

```cpp
#include <hip/hip_runtime.h>
#include <hip/hip_cooperative_groups.h>
#include <cstdio>
#include <cstdint>
namespace cg = cooperative_groups;

#define DI __device__ __forceinline__
typedef unsigned short bfr;
using bf16x8 = __attribute__((ext_vector_type(8))) short;
using s16x4  = __attribute__((ext_vector_type(4))) short;
using f32x16 = __attribute__((ext_vector_type(16))) float;
using f32x4  = __attribute__((ext_vector_type(4))) float;

#define MFMA32(a, b, c) __builtin_amdgcn_mfma_f32_32x32x16_bf16((a), (b), (c), 0, 0, 0)
#define MFMA16(a, b, c) __builtin_amdgcn_mfma_f32_16x16x32_bf16((a), (b), (c), 0, 0, 0)

constexpr int NTOK = 12288, NCTX = 8192;
constexpr float EPS = 1e-6f;

constexpr size_t OFF_MOD   = 0;
constexpr size_t OFF_ROWSS = OFF_MOD + 73728;
constexpr size_t OFF_ROPE  = OFF_ROWSS + 49152;
constexpr size_t OFF_LAMB  = OFF_ROPE + 8192;
constexpr size_t OFF_LAMP  = OFF_LAMB + 32768;
constexpr size_t OFF_BB    = OFF_LAMP + 32768;
constexpr size_t OFF_CMB   = OFF_BB + 524288;
constexpr size_t OFF_E     = OFF_CMB + 262144;
constexpr size_t OFF_WIN0  = OFF_E + 1572864;
constexpr size_t OFF_GLU   = OFF_WIN0 + 4718592;
constexpr size_t OFF_WOUT0 = OFF_GLU + 524288;
constexpr size_t OFF_WIN1  = OFF_WOUT0 + 2097152;
constexpr size_t OFF_FNET  = OFF_WIN1 + 6291456;
constexpr size_t OFF_WOUT1 = OFF_FNET + 524288;
constexpr size_t OFF_ACTX  = OFF_WOUT1 + 2097152;
constexpr size_t OFF_ALAT  = OFF_ACTX + 262144;
constexpr size_t OFF_X1    = OFF_ALAT + 16777216;
constexpr size_t OFF_HN    = OFF_X1 + 50331648;
constexpr size_t OFF_MIX   = OFF_HN + 25165824;
constexpr size_t OFF_O     = OFF_MIX + 25165824;
constexpr size_t OFF_U     = OFF_O;
constexpr size_t OFF_R     = OFF_O + 25165824;
constexpr size_t OFF_QB = OFF_R;
constexpr size_t OFF_KC = OFF_QB + 12582912;
constexpr size_t OFF_KL = OFF_KC + 2097152;
constexpr size_t OFF_VC = OFF_KL + 1310720;
constexpr size_t OFF_VL = OFF_VC + 2097152;
constexpr size_t OFF_GA = OFF_VL + 1310720;
constexpr size_t OFF_GB = OFF_GA + 12582912;
constexpr size_t OFF_YF = OFF_GB + 12582912;
constexpr size_t OFF_YB = OFF_YF + 12582912;
constexpr size_t OFF_YG = OFF_YB + 12582912;
constexpr size_t END_L0 = OFF_YG + 12582912;
constexpr size_t OFF_CUG = OFF_R;
constexpr size_t OFF_GCS = OFF_CUG + 12582912;
constexpr size_t OFF_GDS = OFF_GCS + 12582912;
constexpr size_t OFF_CVT = OFF_GDS + 12582912;
constexpr size_t OFF_FZ  = OFF_CVT + 12582912;
constexpr size_t OFF_ZTC = OFF_FZ + 12582912;
constexpr size_t OFF_ZTL = OFF_ZTC + 16777216;
constexpr size_t END_L1 = OFF_ZTL + 8388608;
constexpr size_t WS_NEED = (END_L0 > END_L1 ? END_L0 : END_L1);
constexpr size_t OFF_BAR = WS_NEED;
constexpr size_t WS_TOTAL = OFF_BAR + 16384;
static_assert(WS_TOTAL <= (size_t)256 * 1024 * 1024, "workspace too large");

constexpr size_t OUT_Y = 0, OUT_K = 12582912, OUT_V = 13631488, OUT_S = 14680064;

struct Params {
  const float* in[31];
  float* out;
  unsigned char* ws;
  int ph_lo, ph_hi;
};

typedef __bf16 hbf2 __attribute__((ext_vector_type(2)));
typedef float hfl2 __attribute__((ext_vector_type(2)));
DI unsigned pk2(float lo, float hi) { hfl2 v = {lo, hi}; hbf2 r = __builtin_convertvector(v, hbf2); return __builtin_bit_cast(unsigned, r); }
DI unsigned short f2bf(float x) { return (unsigned short)(pk2(x, 0.f) & 0xffffu); }
DI float bf2f(unsigned short b) { return __uint_as_float(((unsigned)b) << 16); }
DI float wave_sum(float v) {
#pragma unroll
  for (int o = 1; o < 64; o <<= 1) v += __shfl_xor(v, o);
  return v;
}
DI float half_sum32(float v) {
#pragma unroll
  for (int o = 1; o < 32; o <<= 1) v += __shfl_xor(v, o);
  return v;
}
DI float silu_f(float x) { return x / (1.f + __expf(-x)); }
DI float sigmoid_f(float x) { return 1.f / (1.f + __expf(-x)); }
DI float gelu_f(float x) { float z = 0.7978845608028654f * (x + 0.044715f * x * x * x); return x / (1.f + __expf(-2.f * z)); }
DI int crow(int i, int h) { return (i & 3) + 8 * (i >> 2) + 4 * h; }
DI const float* xrow(const Params& p, int T) { return T < NCTX ? p.in[0] + (size_t)T * 1024 : p.in[1] + (size_t)(T - NCTX) * 1024; }
DI int cond_of(int T) { return T < NCTX ? 0 : 1 + ((T - NCTX) >> 11); }

template <int BN, bool D2 = true, class AL, class BL, class EP>
DI void gemm_tile(int nk, bool swp, AL al, BL bl, EP ep, unsigned char* smem) {
  constexpr int NI = BN / 64;
  constexpr int NB = BN / 32;
  constexpr int STG = (128 + BN) * 72;
  unsigned short* S0 = (unsigned short*)smem;
  const int tid = threadIdx.x, lane = tid & 63, wave = tid >> 6, l32 = lane & 31, h = lane >> 5;
  const int wm = wave >> 1, wn = wave & 1;
  const int xoff = (swp ? 128 * 72 + (wn * 64 + l32) * 72 : (wm * 64 + l32) * 72) + h * 8;
  const int yoff = (swp ? (wm * 64 + l32) * 72 : 128 * 72 + (wn * (BN / 2) + l32) * 72) + h * 8;
  f32x16 acc[2][NI];
#pragma unroll
  for (int mi = 0; mi < 2; ++mi)
#pragma unroll
    for (int ni = 0; ni < NI; ++ni)
#pragma unroll
      for (int i = 0; i < 16; ++i) acc[mi][ni][i] = 0.f;
  uint4 ra[2][4], rb[2][NB];
  const int lrow = tid >> 3, lcol = (tid & 7) * 8;
  al.init(lrow, lcol); bl.init(lrow, lcol);
  int nxt = 0;
  auto gload = [&](uint4 (&a4)[4], uint4 (&b4)[NB]) {
#pragma unroll
    for (int i = 0; i < 4; ++i) a4[i] = al.load(i);
#pragma unroll
    for (int i = 0; i < NB; ++i) b4[i] = bl.load(i);
    const int adv = (nxt + 1 < nk) ? 1 : 0;
    al.advance(adv); bl.advance(adv); nxt += adv;
  };
  auto lstore = [&](const uint4 (&a4)[4], const uint4 (&b4)[NB], unsigned short* st) {
#pragma unroll
    for (int i = 0; i < 4; ++i) *(uint4*)(st + (lrow + 32 * i) * 72 + lcol) = a4[i];
#pragma unroll
    for (int i = 0; i < NB; ++i) *(uint4*)(st + 128 * 72 + (lrow + 32 * i) * 72 + lcol) = b4[i];
  };
  auto compute = [&](const unsigned short* st) {
#pragma unroll
    for (int ks = 0; ks < 4; ++ks) {
      bf16x8 x[2], y[NI];
#pragma unroll
      for (int mi = 0; mi < 2; ++mi) x[mi] = *(const bf16x8*)(st + xoff + mi * 32 * 72 + ks * 16);
#pragma unroll
      for (int ni = 0; ni < NI; ++ni) y[ni] = *(const bf16x8*)(st + yoff + ni * 32 * 72 + ks * 16);
#pragma unroll
      for (int mi = 0; mi < 2; ++mi)
#pragma unroll
        for (int ni = 0; ni < NI; ++ni) acc[mi][ni] = MFMA32(x[mi], y[ni], acc[mi][ni]);
    }
  };
  if constexpr (D2) {
    gload(ra[0], rb[0]);
    gload(ra[1], rb[1]);
    __syncthreads();
    lstore(ra[0], rb[0], S0);
    gload(ra[0], rb[0]);
    __syncthreads();
    for (int kt = 0; kt < nk; kt += 2) {
      compute(S0);
      lstore(ra[1], rb[1], S0 + STG);
      gload(ra[1], rb[1]);
      __syncthreads();
      compute(S0 + STG);
      if (kt + 2 < nk) lstore(ra[0], rb[0], S0);
      gload(ra[0], rb[0]);
      __syncthreads();
    }
  } else {
    gload(ra[0], rb[0]);
    __syncthreads();
    lstore(ra[0], rb[0], S0);
    gload(ra[0], rb[0]);
    __syncthreads();
    for (int kt = 0; kt < nk; kt += 2) {
      compute(S0);
      lstore(ra[0], rb[0], S0 + STG);
      gload(ra[0], rb[0]);
      __syncthreads();
      compute(S0 + STG);
      if (kt + 2 < nk) lstore(ra[0], rb[0], S0);
      gload(ra[0], rb[0]);
      __syncthreads();
    }
  }
  ep(acc);
}

template <int BN> struct GStage { uint4 ra[2][4]; uint4 rb[2][BN / 32]; int nxt; };
template <int BN, class AL, class BL, class EP, class NX>
DI bool gemm_tile_pf(int nk, bool swp, bool first, AL& al, BL& bl, GStage<BN>& st, EP ep, NX next_tile, unsigned char* smem) {
  constexpr int NI = BN / 64;
  constexpr int NB = BN / 32;
  constexpr int STG = (128 + BN) * 72;
  unsigned short* S0 = (unsigned short*)smem;
  const int tid = threadIdx.x, lane = tid & 63, wave = tid >> 6, l32 = lane & 31, h = lane >> 5;
  const int wm = wave >> 1, wn = wave & 1;
  const int xoff = (swp ? 128 * 72 + (wn * 64 + l32) * 72 : (wm * 64 + l32) * 72) + h * 8;
  const int yoff = (swp ? (wm * 64 + l32) * 72 : 128 * 72 + (wn * (BN / 2) + l32) * 72) + h * 8;
  f32x16 acc[2][NI];
#pragma unroll
  for (int mi = 0; mi < 2; ++mi)
#pragma unroll
    for (int ni = 0; ni < NI; ++ni)
#pragma unroll
      for (int i = 0; i < 16; ++i) acc[mi][ni][i] = 0.f;
  const int lrow = tid >> 3, lcol = (tid & 7) * 8;
  auto gload = [&](uint4 (&a4)[4], uint4 (&b4)[NB]) {
#pragma unroll
    for (int i = 0; i < 4; ++i) a4[i] = al.load(i);
#pragma unroll
    for (int i = 0; i < NB; ++i) b4[i] = bl.load(i);
    const int adv = (st.nxt + 1 < nk) ? 1 : 0;
    al.advance(adv); bl.advance(adv); st.nxt += adv;
  };
  auto lstore = [&](const uint4 (&a4)[4], const uint4 (&b4)[NB], unsigned short* sp) {
#pragma unroll
    for (int i = 0; i < 4; ++i) *(uint4*)(sp + (lrow + 32 * i) * 72 + lcol) = a4[i];
#pragma unroll
    for (int i = 0; i < NB; ++i) *(uint4*)(sp + 128 * 72 + (lrow + 32 * i) * 72 + lcol) = b4[i];
  };
  auto compute = [&](const unsigned short* sp) {
#pragma unroll
    for (int ks = 0; ks < 4; ++ks) {
      bf16x8 x[2], y[NI];
#pragma unroll
      for (int mi = 0; mi < 2; ++mi) x[mi] = *(const bf16x8*)(sp + xoff + mi * 32 * 72 + ks * 16);
#pragma unroll
      for (int ni = 0; ni < NI; ++ni) y[ni] = *(const bf16x8*)(sp + yoff + ni * 32 * 72 + ks * 16);
#pragma unroll
      for (int mi = 0; mi < 2; ++mi)
#pragma unroll
        for (int ni = 0; ni < NI; ++ni) acc[mi][ni] = MFMA32(x[mi], y[ni], acc[mi][ni]);
    }
  };
  if (first) {
    al.init(lrow, lcol); bl.init(lrow, lcol); st.nxt = 0;
    gload(st.ra[0], st.rb[0]);
    gload(st.ra[1], st.rb[1]);
  }
  __syncthreads();
  lstore(st.ra[0], st.rb[0], S0);
  gload(st.ra[0], st.rb[0]);
  __syncthreads();
  for (int kt = 0; kt < nk; kt += 2) {
    compute(S0);
    lstore(st.ra[1], st.rb[1], S0 + STG);
    gload(st.ra[1], st.rb[1]);
    __syncthreads();
    compute(S0 + STG);
    if (kt + 2 < nk) lstore(st.ra[0], st.rb[0], S0);
    gload(st.ra[0], st.rb[0]);
    __syncthreads();
  }
  const bool more = next_tile();
  if (more) {
    al.init(lrow, lcol); bl.init(lrow, lcol); st.nxt = 0;
    gload(st.ra[0], st.rb[0]);
    gload(st.ra[1], st.rb[1]);
  }
  ep(acc);
  return more;
}

DI bool xcd_tile(int step, int ntn, int& tm, int& tn) {
  const int G = gridDim.x;
  if ((G & 7) == 0) {
    const int x = blockIdx.x & 7, loc = blockIdx.x >> 3, per = G >> 3;
    const int j = loc + step * per;
    if (j >= 12 * ntn) return false;
    tn = j / 12; tm = 12 * x + j % 12;
    return true;
  }
  const int it = blockIdx.x + step * G;
  if (it >= 96 * ntn) return false;
  tm = it / ntn; tn = it % ntn;
  return true;
}

#define GAS __attribute__((address_space(1)))
typedef unsigned u32x4 __attribute__((ext_vector_type(4)));
DI uint4 gld16(const GAS char* q) { const u32x4 v = *(const GAS u32x4*)q; return make_uint4(v.x, v.y, v.z, v.w); }
struct LdBf {
  const bfr* base; size_t ld;
  const GAS char* p[4];
  DI void init(int lrow, int lcol) {
#pragma unroll
    for (int i = 0; i < 4; ++i) { p[i] = (const GAS char*)(base + (size_t)(lrow + 32 * i) * ld + lcol); asm volatile("" : "+v"(p[i])); }
  }
  DI uint4 load(int i) const { return gld16(p[i]); }
  DI void advance(int adv) {
#pragma unroll
    for (int i = 0; i < 4; ++i) p[i] += 128 * adv;
  }
};
#define XB_TMO      128
#define XB_XCNT(j)  (256  + 64 * (j))
#define XB_XSUB(j)  (1280 + 64 * (j))
#define XB_XGEN(j)  (2304 + 64 * (j))
#define XB_TOP      3328
#define XB_TOPGEN   3392
#define XCD_BAR_WORDS 3456
#define XB_SPIN_CAP (1u << 20)
#define LAS __attribute__((address_space(3)))
DI unsigned xb_ld(unsigned* p)              { return __hip_atomic_load(p, __ATOMIC_RELAXED, __HIP_MEMORY_SCOPE_AGENT); }
DI unsigned xb_add(unsigned* p, unsigned v) { return __hip_atomic_fetch_add(p, v, __ATOMIC_RELAXED, __HIP_MEMORY_SCOPE_AGENT); }
DI unsigned xb_xcc_id() { return (unsigned)__builtin_amdgcn_s_getreg((3 << 11) | 20) & 0xFu; }
#define XB_SPIN(cond, bar) do { unsigned _sp = 0; while (cond) { __builtin_amdgcn_s_sleep(1); \
    if ((++_sp & 255u) == 0u) { if (xb_ld(&(bar)[XB_TMO])) break; if (_sp > XB_SPIN_CAP) { atomicAdd(&(bar)[XB_TMO], 1u); break; } } } } while (0)
struct XcdBarrier { unsigned* bar; unsigned x; volatile LAS unsigned* st; };
DI XcdBarrier xcd_barrier_post(unsigned* bar, volatile LAS unsigned* st) {
  XcdBarrier b; b.bar = bar; b.x = xb_xcc_id(); b.st = st;
  if (threadIdx.x == 0) (void)xb_add(&bar[XB_XCNT(b.x)], 1u);
  return b;
}
DI void xcd_barrier_complete(unsigned* bar, unsigned x, unsigned& nloc, unsigned& nx) {
  const unsigned G = gridDim.x * gridDim.y * gridDim.z;
  unsigned sum, cnt, mine, sp = 0u;
  for (;;) {
    sum = 0u; cnt = 0u; mine = 0u;
#pragma unroll
    for (unsigned j = 0; j < 16; ++j) { const unsigned c = xb_ld(&bar[XB_XCNT(j)]); sum += c; cnt += (c > 0u) ? 1u : 0u; mine = (j == x) ? c : mine; }
    if (sum == G) break;
    __builtin_amdgcn_s_sleep(1);
    if ((++sp & 255u) == 0u) { if (xb_ld(&bar[XB_TMO])) break; if (sp > XB_SPIN_CAP) { atomicAdd(&bar[XB_TMO], 1u); break; } }
  }
  nloc = mine > 0u ? mine : 1u; nx = cnt > 0u ? cnt : 1u;
}
DI void xcd_barrier(const XcdBarrier& b) {
  asm volatile("s_waitcnt vmcnt(0)" ::: "memory");
  __syncthreads();
  if (threadIdx.x == 0) {
    unsigned* bar = b.bar;
    __builtin_amdgcn_s_waitcnt(0);
    unsigned nloc = b.st[0], nx = b.st[1];
    if (nloc == 0u) { xcd_barrier_complete(bar, b.x, nloc, nx); b.st[0] = nloc; b.st[1] = nx; }
    const unsigned old = xb_add(&bar[XB_XSUB(b.x)], 1u);
    const unsigned gen = old / nloc;
    if (old + 1u == (gen + 1u) * nloc) {
      __builtin_amdgcn_fence(__ATOMIC_RELEASE, "agent");
      asm volatile("s_waitcnt vmcnt(0)" ::: "memory");
      const unsigned og = xb_add(&bar[XB_TOP], 1u);
      const unsigned tg = og / nx;
      if (og + 1u == (tg + 1u) * nx) xb_add(&bar[XB_TOPGEN], 1u);
      else XB_SPIN(xb_ld(&bar[XB_TOPGEN]) == tg, bar);
      __builtin_amdgcn_fence(__ATOMIC_ACQUIRE, "agent");
      xb_add(&bar[XB_XGEN(b.x)], 1u);
      asm volatile("s_waitcnt vmcnt(0)" ::: "memory");
    } else {
      XB_SPIN(xb_ld(&bar[XB_XGEN(b.x)]) == gen, bar);
      __builtin_amdgcn_fence(__ATOMIC_ACQUIRE, "agent");
      asm volatile("s_waitcnt vmcnt(0)" ::: "memory");
    }
  }
  __syncthreads();
}

struct LdFz {
  const bfr* pz;
  const GAS char* p[4];
  DI void init(int lrow, int lcol) {
#pragma unroll
    for (int i = 0; i < 4; ++i) { p[i] = (const GAS char*)(pz + (size_t)(lrow + 32 * i) * 512 + lcol); asm volatile("" : "+v"(p[i])); }
  }
  DI void advance(int adv) {
#pragma unroll
    for (int i = 0; i < 4; ++i) p[i] += 128 * adv;
  }
  DI uint4 load(int i) const {
    const GAS char* q = p[i];
    const uint4 a = gld16(q), b = gld16(q + (size_t)4096 * 512 * 2), c = gld16(q + (size_t)2 * 4096 * 512 * 2), d = gld16(q + (size_t)3 * 4096 * 512 * 2);
#define SUM4(f) pk2(bf2f(a.f & 0xffff) + bf2f(b.f & 0xffff) + bf2f(c.f & 0xffff) + bf2f(d.f & 0xffff), bf2f(a.f >> 16) + bf2f(b.f >> 16) + bf2f(c.f >> 16) + bf2f(d.f >> 16))
    return make_uint4(SUM4(x), SUM4(y), SUM4(z), SUM4(w));
#undef SUM4
  }
};

DI void transpose_tile(const float* W, int ldw, int kbase, int nbase, bfr* WT, int ldt, int trow, float* sm) {
  const int tid = threadIdx.x;
#pragma unroll
  for (int i = 0; i < 4; ++i) {
    const int r = (tid >> 4) + 16 * i, c = (tid & 15) * 4;
    const float4 v = *(const float4*)(W + (size_t)(kbase + r) * ldw + nbase + c);
    sm[r * 65 + c] = v.x; sm[r * 65 + c + 1] = v.y; sm[r * 65 + c + 2] = v.z; sm[r * 65 + c + 3] = v.w;
  }
  __syncthreads();
  const int n = tid >> 2, kc = (tid & 3) * 16;
  unsigned o[8];
#pragma unroll
  for (int j = 0; j < 8; ++j) o[j] = pk2(sm[(kc + 2 * j) * 65 + n], sm[(kc + 2 * j + 1) * 65 + n]);
  uint4* dst = (uint4*)(WT + (size_t)(trow + n) * ldt + kbase + kc);
  dst[0] = make_uint4(o[0], o[1], o[2], o[3]);
  dst[1] = make_uint4(o[4], o[5], o[6], o[7]);
}

DI void phase0(const Params& p, unsigned char* smem) {
  const int tid = threadIdx.x;
  float* smf = (float*)smem;
  unsigned char* ws = p.ws;
  constexpr int N_ADA = 192;
  constexpr int N_T0 = 16 * 36, N_TG = 64, N_TO0 = 256, N_T1A = 16 * 24, N_T1B = 16 * 8, N_TF = 64, N_TO1 = 256;
  constexpr int N_FOLD = 128, N_ALAT = 2048, N_ACTX = 256, N_CACHE = 64, N_SSM = 64, N_ZERO = 48, N_ROPE = 4;
  constexpr int B_T0 = N_ADA, B_TG = B_T0 + N_T0, B_TO0 = B_TG + N_TG, B_T1A = B_TO0 + N_TO0, B_T1B = B_T1A + N_T1A,
                B_TF = B_T1B + N_T1B, B_TO1 = B_TF + N_TF, B_FOLD = B_TO1 + N_TO1, B_ALAT = B_FOLD + N_FOLD,
                B_ACTX = B_ALAT + N_ALAT, B_CACHE = B_ACTX + N_ACTX, B_SSM = B_CACHE + N_CACHE, B_ZERO = B_SSM + N_SSM,
                B_ROPE = B_ZERO + N_ZERO, N_ALL = B_ROPE + N_ROPE;
  for (int it = blockIdx.x; it < N_ALL; it += gridDim.x) {
    __syncthreads();
    if (it < B_T0) {
      const int l = it / 96, cgp = it % 96;
      float* sc = smf;
      float* red = smf + 3072;
      for (int e = tid; e < 3072; e += 256) {
        const int ci = e >> 10, k = e & 1023;
        const float cv = ci == 0 ? p.in[6][k] : p.in[5][(ci - 1) * 1024 + k];
        sc[e] = silu_f(cv);
      }
      __syncthreads();
      const int cq = tid & 7, rg = tid >> 3;
      const float* w = p.in[7] + (size_t)l * 1024 * 3072 + cgp * 32 + cq * 4;
      float4 a0 = make_float4(0.f, 0.f, 0.f, 0.f), a1 = a0, a2 = a0;
#pragma unroll 16
      for (int k = rg; k < 1024; k += 32) {
        const float4 wv = *(const float4*)(w + (size_t)k * 3072);
        const float s0 = sc[k], s1 = sc[1024 + k], s2 = sc[2048 + k];
        a0.x += s0 * wv.x; a0.y += s0 * wv.y; a0.z += s0 * wv.z; a0.w += s0 * wv.w;
        a1.x += s1 * wv.x; a1.y += s1 * wv.y; a1.z += s1 * wv.z; a1.w += s1 * wv.w;
        a2.x += s2 * wv.x; a2.y += s2 * wv.y; a2.z += s2 * wv.z; a2.w += s2 * wv.w;
      }
      *(float4*)(red + (0 * 32 + rg) * 32 + cq * 4) = a0;
      *(float4*)(red + (1 * 32 + rg) * 32 + cq * 4) = a1;
      *(float4*)(red + (2 * 32 + rg) * 32 + cq * 4) = a2;
      __syncthreads();
      if (tid < 96) {
        const int c2 = tid & 31, ci = tid >> 5;
        float s = 0.f;
#pragma unroll
        for (int q = 0; q < 32; ++q) s += red[(ci * 32 + q) * 32 + c2];
        const int n2 = cgp * 32 + c2;
        ((float*)(ws + OFF_MOD))[(l * 3 + ci) * 3072 + n2] = s + p.in[8][l * 3072 + n2];
      }
    } else if (it < B_FOLD) {
      const float* W; int ldw, nbase_off = 0, trow_off = 0, ntn, ldt; bfr* WT; int r;
      if (it < B_TG)        { r = it - B_T0;  W = p.in[11]; ldw = 2304; ntn = 36; WT = (bfr*)(ws + OFF_WIN0); ldt = 1024; }
      else if (it < B_TO0)  { r = it - B_TG;  W = p.in[22]; ldw = 512;  ntn = 8;  WT = (bfr*)(ws + OFF_GLU); ldt = 512; }
      else if (it < B_T1A)  { r = it - B_TO0; W = p.in[24]; ldw = 1024; ntn = 16; WT = (bfr*)(ws + OFF_WOUT0); ldt = 1024; }
      else if (it < B_T1B)  { r = it - B_T1A; W = p.in[25]; ldw = 2560; ntn = 24; WT = (bfr*)(ws + OFF_WIN1); ldt = 1024; }
      else if (it < B_TF)   { r = it - B_T1B; W = p.in[25]; ldw = 2560; ntn = 8;  WT = (bfr*)(ws + OFF_WIN1); ldt = 1024; nbase_off = 2048; trow_off = 2560; }
      else if (it < B_TO1)  { r = it - B_TF;  W = p.in[29]; ldw = 512;  ntn = 8;  WT = (bfr*)(ws + OFF_FNET); ldt = 512; }
      else                  { r = it - B_TO1; W = p.in[30]; ldw = 1024; ntn = 16; WT = (bfr*)(ws + OFF_WOUT1); ldt = 1024; }
      const int kb = r / ntn, nb = r % ntn;
      transpose_tile(W, ldw, kb * 64, nbase_off + nb * 64, WT, ldt, trow_off + nb * 64, smf);
    } else if (it < B_ALAT) {
      const int r = it - B_FOLD, cs = r & 1, kb = (r >> 1) & 15, g = r >> 5;
      float* tile = smf;
      float* tw = smf + 128 * 68;
      const float* W = p.in[25];
      {
        const int c4 = (tid & 31) * 4, kr = tid >> 5;
#pragma unroll
        for (int i = 0; i < 8; ++i) {
          const int k = kr + 8 * i;
          const float4 v = *(const float4*)(W + (size_t)(kb * 64 + k) * 2560 + 1536 + g * 128 + c4);
          tile[(c4 + 0) * 68 + k] = v.x; tile[(c4 + 1) * 68 + k] = v.y; tile[(c4 + 2) * 68 + k] = v.z; tile[(c4 + 3) * 68 + k] = v.w;
        }
        if (tid < 128) {
          const float a = 2.f * (float)tid / 128.f;
          tw[tid] = (cs == 0 ? cospif(a) : sinpif(a)) * 0.08838834764831845f;
        }
      }
      __syncthreads();
      const int j = tid & 127, kg = tid >> 7;
      float acc[32];
#pragma unroll
      for (int i = 0; i < 32; ++i) acc[i] = 0.f;
      for (int c = 0; c < 128; ++c) {
        const float t = tw[(j * c) & 127];
        const float4* tp = (const float4*)(tile + c * 68 + kg * 32);
#pragma unroll
        for (int q = 0; q < 8; ++q) {
          const float4 v = tp[q];
          acc[4 * q + 0] += v.x * t; acc[4 * q + 1] += v.y * t; acc[4 * q + 2] += v.z * t; acc[4 * q + 3] += v.w * t;
        }
      }
      uint4* dst = (uint4*)((bfr*)(ws + OFF_WIN1) + (size_t)(1536 + cs * 512 + g * 128 + j) * 1024 + kb * 64 + kg * 32);
#pragma unroll
      for (int q = 0; q < 4; ++q)
        dst[q] = make_uint4(pk2(acc[8 * q], acc[8 * q + 1]), pk2(acc[8 * q + 2], acc[8 * q + 3]), pk2(acc[8 * q + 4], acc[8 * q + 5]), pk2(acc[8 * q + 6], acc[8 * q + 7]));
    } else if (it < B_ACTX) {
      const int t = it - B_ALAT;
      bfr* dst = (bfr*)(ws + OFF_ALAT) + (size_t)t * 4096;
      const float nrm = 0.02209708691207961f;
#pragma unroll
      for (int half = 0; half < 2; ++half) {
        const int k0 = half * 2048 + tid * 8;
        unsigned o[4];
#pragma unroll
        for (int j = 0; j < 4; ++j) {
          float v[2];
#pragma unroll
          for (int e = 0; e < 2; ++e) {
            const int k = k0 + 2 * j + e;
            const int m = (t * (k & 2047)) & 2047;
            const float a = (float)m * (2.f / 2048.f);
            v[e] = (k < 2048 ? cospif(a) : -sinpif(a)) * nrm;
          }
          o[j] = pk2(v[0], v[1]);
        }
        *(uint4*)(dst + k0) = make_uint4(o[0], o[1], o[2], o[3]);
      }
    } else if (it < B_CACHE) {
      const int t = it - B_ACTX;
      bfr* dst = (bfr*)(ws + OFF_ACTX) + (size_t)t * 512;
      const float nrm = 0.0625f;
      float v[2];
#pragma unroll
      for (int e = 0; e < 2; ++e) {
        const int k = tid * 2 + e;
        const int m = (t * (k & 255)) & 255;
        const float a = (float)m * (2.f / 256.f);
        v[e] = (k < 256 ? cospif(a) : -sinpif(a)) * nrm;
      }
      *(unsigned*)(dst + tid * 2) = pk2(v[0], v[1]);
    } else if (it < B_SSM) {
      const int r = it - B_CACHE;
#pragma unroll
      for (int i = 0; i < 8; ++i) {
        const int e = r * 2048 + tid + 256 * i;
        const int d = e & 63, kvh = (e >> 6) & 1, key = (e >> 7) & 511, b = e >> 16;
        ((bfr*)(ws + OFF_KL))[((size_t)(b * 2 + kvh) * 2560 + key) * 64 + d] = f2bf(p.in[2][e]);
        ((bfr*)(ws + OFF_VL))[((size_t)(b * 2 + kvh) * 64 + d) * 2560 + key] = f2bf(p.in[3][e]);
      }
    } else if (it < B_ZERO) {
      const int dg = it - B_SSM;
      const int pp = tid & 63, part = tid >> 6;
      const double lr = (double)p.in[14][dg * 64 + pp], li = (double)p.in[15][dg * 64 + pp];
      const double dt = (double)__expf(p.in[16][dg]) ;
      const float dtf = expf(p.in[16][dg]);
      const double dtd = (double)dtf;
      (void)dt;
      const double PI = 3.14159265358979323846;
      double ap = li * dtd / PI;
      double ar = ap - 2.0 * rint(ap * 0.5);
      const float er = expf((float)(lr * dtd));
      const double lbr = (double)er * (double)cospif((float)ar), lbi = (double)er * (double)sinpif((float)ar);
      double ap2 = ap * 256.0;
      double ar2 = ap2 - 2.0 * rint(ap2 * 0.5);
      const float er2 = expf((float)(lr * dtd * 256.0));
      if (part == 0) {
        ((float2*)(ws + OFF_LAMB))[dg * 64 + pp] = make_float2((float)lbr, (float)lbi);
        ((float2*)(ws + OFF_LAMP))[dg * 64 + pp] = make_float2(er2 * cospif((float)ar2), er2 * sinpif((float)ar2));
      }
      const double den = lr * lr + li * li;
      const double fr = ((lbr - 1.0) * lr + lbi * li) / den, fi = (lbi * lr - (lbr - 1.0) * li) / den;
      float* bb = (float*)(ws + OFF_BB) + (size_t)(dg * 64 + pp) * 32;
#pragma unroll
      for (int q = 0; q < 4; ++q) {
        const int c = part * 4 + q;
        const double br = (double)p.in[17][(size_t)(dg * 64 + pp) * 16 + c], bi = (double)p.in[18][(size_t)(dg * 64 + pp) * 16 + c];
        bb[c] = (float)(fr * br - fi * bi);
        bb[16 + c] = (float)(fr * bi + fi * br);
      }
      bfr* cm = (bfr*)(ws + OFF_CMB) + (size_t)dg * 2048;
#pragma unroll
      for (int q = 0; q < 8; ++q) {
        const int e = tid * 8 + q, c = e >> 7, k = e & 127;
        const float v = k < 64 ? p.in[19][(size_t)(dg * 16 + c) * 64 + k] : -p.in[20][(size_t)(dg * 16 + c) * 64 + (k - 64)];
        cm[e] = f2bf(v);
      }
    } else if (it < B_ROPE) {
      const int r = it - B_ZERO;
      ((float*)(ws + OFF_ROWSS))[r * 256 + tid] = 0.f;
    } else {
      const int e = (it - B_ROPE) * 256 + tid;
      const int n = e >> 4, pr = e & 15;
      const double q4[4] = {1.0, 0.5623413251903491, 0.31622776601683794, 0.1778279410038923};
      double inv = q4[0];
      if ((pr & 3) == 1) inv = q4[1]; else if ((pr & 3) == 2) inv = q4[2]; else if ((pr & 3) == 3) inv = q4[3];
      const int dec = pr >> 2;
      if (dec == 1) inv *= 0.1; else if (dec == 2) inv *= 0.01; else if (dec == 3) inv *= 0.001;
      const double ap = (double)n * inv / 3.14159265358979323846;
      const double ar = ap - 2.0 * rint(ap * 0.5);
      ((float2*)(ws + OFF_ROPE))[e] = make_float2(cospif((float)ar), sinpif((float)ar));
    }
  }
}

template <int MODE>
DI void phase_rows(const Params& p) {
  unsigned char* ws = p.ws;
  const int lane = threadIdx.x & 63, wave = threadIdx.x >> 6;
  const float* mod = (const float*)(ws + OFF_MOD);
  for (int it = blockIdx.x; it < NTOK / 4; it += gridDim.x) {
    const int T = it * 4 + wave;
    const int ci = cond_of(T);
    float4 xv[4];
    if (MODE == 2) {
      const bfr* xr = (const bfr*)(ws + OFF_X1) + (size_t)T * 1024 + lane * 4;
#pragma unroll
      for (int j = 0; j < 4; ++j) {
        const uint2 raw = *(const uint2*)(xr + 256 * j);
        xv[j].x = bf2f(raw.x & 0xffff); xv[j].y = bf2f(raw.x >> 16); xv[j].z = bf2f(raw.y & 0xffff); xv[j].w = bf2f(raw.y >> 16);
      }
    } else {
      const float4* xr = (const float4*)xrow(p, T) + lane;
#pragma unroll
      for (int j = 0; j < 4; ++j) xv[j] = xr[64 * j];
    }
    if (MODE >= 1) {
      const int l = MODE - 1;
      const bfr* orow = (const bfr*)(ws + OFF_O) + (size_t)T * 1024;
      float4 ov[4]; float ss = 0.f;
#pragma unroll
      for (int j = 0; j < 4; ++j) {
        const uint2 raw = *(const uint2*)(orow + lane * 4 + 256 * j);
        ov[j].x = bf2f(raw.x & 0xffff); ov[j].y = bf2f(raw.x >> 16); ov[j].z = bf2f(raw.y & 0xffff); ov[j].w = bf2f(raw.y >> 16);
        ss += ov[j].x * ov[j].x + ov[j].y * ov[j].y + ov[j].z * ov[j].z + ov[j].w * ov[j].w;
      }
      const float rinv = rsqrtf(wave_sum(ss) * (1.f / 1024.f) + EPS);
      const float* gate = mod + (l * 3 + ci) * 3072 + 2048;
      const float* gp = p.in[10] + l * 1024;
#pragma unroll
      for (int j = 0; j < 4; ++j) {
        const int k = lane * 4 + 256 * j;
        const float4 g4 = *(const float4*)(gate + k), n4 = *(const float4*)(gp + k);
        xv[j].x += g4.x * (ov[j].x * rinv * n4.x); xv[j].y += g4.y * (ov[j].y * rinv * n4.y);
        xv[j].z += g4.z * (ov[j].z * rinv * n4.z); xv[j].w += g4.w * (ov[j].w * rinv * n4.w);
      }
      if (MODE == 2) {
        float4* yr = (float4*)(p.out + OUT_Y + (size_t)T * 1024) + lane;
#pragma unroll
        for (int j = 0; j < 4; ++j) yr[64 * j] = xv[j];
      } else {
        bfr* x1r = (bfr*)(ws + OFF_X1) + (size_t)T * 1024 + lane * 4;
#pragma unroll
        for (int j = 0; j < 4; ++j) *(uint2*)(x1r + 256 * j) = make_uint2(pk2(xv[j].x, xv[j].y), pk2(xv[j].z, xv[j].w));
      }
    }
    if (MODE <= 1) {
      const int l = MODE;
      float ss = 0.f;
#pragma unroll
      for (int j = 0; j < 4; ++j) ss += xv[j].x * xv[j].x + xv[j].y * xv[j].y + xv[j].z * xv[j].z + xv[j].w * xv[j].w;
      const float rinv = rsqrtf(wave_sum(ss) * (1.f / 1024.f) + EPS);
      const float* shift = mod + (l * 3 + ci) * 3072;
      const float* scale = shift + 1024;
      const float* gp = p.in[9] + l * 1024;
      bfr* hr = (bfr*)(ws + OFF_HN) + (size_t)T * 1024;
#pragma unroll
      for (int j = 0; j < 4; ++j) {
        const int k = lane * 4 + 256 * j;
        const float4 s4 = *(const float4*)(shift + k), c4 = *(const float4*)(scale + k), n4 = *(const float4*)(gp + k);
        const float a = xv[j].x * rinv * n4.x * (1.f + c4.x) + s4.x;
        const float b = xv[j].y * rinv * n4.y * (1.f + c4.y) + s4.y;
        const float c = xv[j].z * rinv * n4.z * (1.f + c4.z) + s4.z;
        const float d = xv[j].w * rinv * n4.w * (1.f + c4.w) + s4.w;
        *(uint2*)(hr + k) = make_uint2(pk2(a, b), pk2(c, d));
      }
    }
  }
}

DI void phase_win0(const Params& p, unsigned char* smem) {
  unsigned char* ws = p.ws;
  const int lane = threadIdx.x & 63, wave = threadIdx.x >> 6, l32 = lane & 31, h = lane >> 5, wm = wave >> 1, wn = wave & 1;
  const bfr* A = (const bfr*)(ws + OFF_HN);
  const bfr* Bt = (const bfr*)(ws + OFF_WIN0);
  int tm, tn;
  if (!xcd_tile(0, 18, tm, tn)) return;
  LdBf al{A + (size_t)tm * 128 * 1024, 1024}, bl{Bt + (size_t)tn * 128 * 1024, 1024};
  for (int step = 0;; ++step) {
    const int m0 = tm * 128, n0 = tn * 128;
    int tm2 = 0, tn2 = 0;
    auto next_tile = [&]() {
      if (!xcd_tile(step + 1, 18, tm2, tn2)) return false;
      al.base = A + (size_t)tm2 * 128 * 1024; bl.base = Bt + (size_t)tn2 * 128 * 1024;
      return true;
    };
    auto ep = [&](f32x16 (&acc)[2][2]) {
      const int colbase = n0 + wn * 64, rbase = m0 + wm * 64;
      const bool lat = m0 >= NCTX;
      if (tn == 5) {
        const int hd = (colbase - 640) >> 6;
#pragma unroll
        for (int mi = 0; mi < 2; ++mi)
#pragma unroll
          for (int ni = 0; ni < 2; ++ni) {
            const int d = ni * 32 + l32;
#pragma unroll
            for (int i4 = 0; i4 < 4; ++i4) {
              const int r0 = rbase + mi * 32 + 8 * i4 + 4 * h;
              const float a = acc[mi][ni][4 * i4], b2 = acc[mi][ni][4 * i4 + 1], c = acc[mi][ni][4 * i4 + 2], e = acc[mi][ni][4 * i4 + 3];
              const uint2 pk = make_uint2(pk2(a, b2), pk2(c, e));
              if (!lat) {
                p.out[OUT_V + (size_t)(r0 + 0) * 128 + hd * 64 + d] = a;
                p.out[OUT_V + (size_t)(r0 + 1) * 128 + hd * 64 + d] = b2;
                p.out[OUT_V + (size_t)(r0 + 2) * 128 + hd * 64 + d] = c;
                p.out[OUT_V + (size_t)(r0 + 3) * 128 + hd * 64 + d] = e;
                const int b = r0 >> 8, l = r0 & 255;
                *(uint2*)((bfr*)(ws + OFF_VC) + ((size_t)(b * 2 + hd) * 64 + d) * 256 + l) = pk;
              } else {
                const int b = (r0 - NCTX) >> 11, l = (r0 - NCTX) & 2047;
                *(uint2*)((bfr*)(ws + OFF_VL) + ((size_t)(b * 2 + hd) * 64 + d) * 2560 + 512 + l) = pk;
              }
            }
          }
      } else if (colbase < 640) {
        const bool isq = colbase < 512;
        const float* gain = isq ? p.in[12] : p.in[13];
        const int hd = isq ? (colbase >> 6) : ((colbase - 512) >> 6);
        float4 gv[2][4];
#pragma unroll
        for (int mi = 0; mi < 2; ++mi)
#pragma unroll
          for (int i4 = 0; i4 < 4; ++i4) gv[mi][i4] = *(const float4*)(gain + mi * 32 + 8 * i4 + 4 * h);
#pragma unroll
        for (int ni = 0; ni < 2; ++ni) {
          const int T = rbase + ni * 32 + l32;
          float ss = 0.f;
#pragma unroll
          for (int mi = 0; mi < 2; ++mi)
#pragma unroll
            for (int i = 0; i < 16; ++i) ss += acc[mi][ni][i] * acc[mi][ni][i];
          ss += __shfl_xor(ss, 32);
          const float rinv = rsqrtf(ss * (1.f / 64.f) + EPS);
          float v[2][16];
#pragma unroll
          for (int mi = 0; mi < 2; ++mi)
#pragma unroll
            for (int i4 = 0; i4 < 4; ++i4) {
              v[mi][4 * i4 + 0] = acc[mi][ni][4 * i4 + 0] * rinv * gv[mi][i4].x;
              v[mi][4 * i4 + 1] = acc[mi][ni][4 * i4 + 1] * rinv * gv[mi][i4].y;
              v[mi][4 * i4 + 2] = acc[mi][ni][4 * i4 + 2] * rinv * gv[mi][i4].z;
              v[mi][4 * i4 + 3] = acc[mi][ni][4 * i4 + 3] * rinv * gv[mi][i4].w;
            }
          if (!lat && !isq) {
#pragma unroll
            for (int mi = 0; mi < 2; ++mi)
#pragma unroll
              for (int i4 = 0; i4 < 4; ++i4)
                *(float4*)(p.out + OUT_K + (size_t)T * 128 + hd * 64 + mi * 32 + 8 * i4 + 4 * h) = make_float4(v[mi][4 * i4], v[mi][4 * i4 + 1], v[mi][4 * i4 + 2], v[mi][4 * i4 + 3]);
          }
          if (lat) {
            const int pos = (T - NCTX) & 2047;
            const float* rope = (const float*)(ws + OFF_ROPE);
#pragma unroll
            for (int mi = 0; mi < 2; ++mi) {
              const float* rb = rope + ((mi == 0 ? (pos >> 6) : (pos & 63)) * 16 + 4 * h) * 2;
#pragma unroll
              for (int i4 = 0; i4 < 2; ++i4) {
                const float4 cs0 = *(const float4*)(rb + 16 * i4), cs1 = *(const float4*)(rb + 16 * i4 + 4);
                const float cc[4] = {cs0.x, cs0.z, cs1.x, cs1.z}, sn[4] = {cs0.y, cs0.w, cs1.y, cs1.w};
#pragma unroll
                for (int e = 0; e < 4; ++e) {
                  const float x1 = v[mi][4 * i4 + e], x2 = v[mi][4 * i4 + e + 8];
                  v[mi][4 * i4 + e] = x1 * cc[e] - x2 * sn[e];
                  v[mi][4 * i4 + e + 8] = x1 * sn[e] + x2 * cc[e];
                }
              }
            }
          }
          bfr* dst;
          float sc = 1.f;
          if (isq) { dst = (bfr*)(ws + OFF_QB) + (size_t)T * 512 + hd * 64; sc = 0.125f; }
          else if (!lat) { dst = (bfr*)(ws + OFF_KC) + ((size_t)((T >> 8) * 2 + hd) * 256 + (T & 255)) * 64; }
          else { dst = (bfr*)(ws + OFF_KL) + ((size_t)(((T - NCTX) >> 11) * 2 + hd) * 2560 + 512 + ((T - NCTX) & 2047)) * 64; }
#pragma unroll
          for (int mi = 0; mi < 2; ++mi)
#pragma unroll
            for (int i4 = 0; i4 < 4; ++i4)
              *(uint2*)(dst + mi * 32 + 8 * i4 + 4 * h) = make_uint2(pk2(v[mi][4 * i4] * sc, v[mi][4 * i4 + 1] * sc), pk2(v[mi][4 * i4 + 2] * sc, v[mi][4 * i4 + 3] * sc));
        }
      } else {
        const int sec = colbase < 1280 ? 0 : (colbase < 1792 ? 1 : 2);
        const int cb = colbase - (sec == 0 ? 768 : (sec == 1 ? 1280 : 1792));
        if (sec == 1) {
#pragma unroll
          for (int ni = 0; ni < 2; ++ni) {
            const int T = rbase + ni * 32 + l32;
#pragma unroll
            for (int mi = 0; mi < 2; ++mi)
#pragma unroll
              for (int i4 = 0; i4 < 4; ++i4)
                *(float4*)((float*)(ws + OFF_U) + (size_t)T * 512 + cb + mi * 32 + 8 * i4 + 4 * h) =
                    make_float4(acc[mi][ni][4 * i4], acc[mi][ni][4 * i4 + 1], acc[mi][ni][4 * i4 + 2], acc[mi][ni][4 * i4 + 3]);
          }
        } else {
          unsigned short* stg = (unsigned short*)smem;
#pragma unroll
          for (int ni = 0; ni < 2; ++ni) {
            const int row = wm * 64 + ni * 32 + l32;
#pragma unroll
            for (int mi = 0; mi < 2; ++mi)
#pragma unroll
              for (int i4 = 0; i4 < 4; ++i4) {
                const float a = acc[mi][ni][4 * i4], b2 = acc[mi][ni][4 * i4 + 1], c2 = acc[mi][ni][4 * i4 + 2], e = acc[mi][ni][4 * i4 + 3];
                *(uint2*)(stg + row * 136 + wn * 64 + mi * 32 + 8 * i4 + 4 * h) = make_uint2(pk2(silu_f(a), silu_f(b2)), pk2(silu_f(c2), silu_f(e)));
              }
          }
          __syncthreads();
          bfr* dbase = (bfr*)(ws + (sec == 0 ? OFF_GA : OFF_GB)) + (size_t)m0 * 512 + (n0 - (sec == 0 ? 768 : 1792));
#pragma unroll
          for (int i = 0; i < 8; ++i) {
            const int id = threadIdx.x + 256 * i, r = id >> 4, c16 = id & 15;
            *(uint4*)(dbase + (size_t)r * 512 + c16 * 8) = *(const uint4*)(stg + r * 136 + c16 * 8);
          }
        }
      }
    };
    al.base = A + (size_t)m0 * 1024; bl.base = Bt + (size_t)n0 * 1024;
    gemm_tile<128>(16, tn != 5, al, bl, ep, smem);
    if (!next_tile()) break;
    tm = tm2; tn = tn2;
  }
}

DI void attn_item(const Params& p, unsigned char* smem, int it) {
  unsigned char* ws = p.ws;
  const int tid = threadIdx.x, lane = tid & 63, wave = tid >> 6, l32 = lane & 31, h = lane >> 5;
  int T0, nkeys, ldv; const bfr *Kp, *Vp; int kvh;
  if (it < 256) {
    const int b = it >> 7, qt = it & 63; kvh = (it >> 6) & 1;
    T0 = NCTX + b * 2048 + qt * 32; nkeys = 2560; ldv = 2560;
    Kp = (const bfr*)(ws + OFF_KL) + (size_t)(b * 2 + kvh) * 2560 * 64;
    Vp = (const bfr*)(ws + OFF_VL) + (size_t)(b * 2 + kvh) * 64 * 2560;
  } else {
    const int i2 = it - 256; const int b = i2 >> 4, qt = i2 & 7; kvh = (i2 >> 3) & 1;
    T0 = b * 256 + qt * 32; nkeys = 256; ldv = 256;
    Kp = (const bfr*)(ws + OFF_KC) + (size_t)(b * 2 + kvh) * 256 * 64;
    Vp = (const bfr*)(ws + OFF_VC) + (size_t)(b * 2 + kvh) * 64 * 256;
  }
  const int head = kvh * 4 + wave;
  unsigned short* Ks = (unsigned short*)smem;
  unsigned short* Vs = Ks + 64 * 72;
  bf16x8 qf[4];
  {
    const bfr* q = (const bfr*)(ws + OFF_QB) + (size_t)(T0 + l32) * 512 + head * 64 + 8 * h;
#pragma unroll
    for (int ks = 0; ks < 4; ++ks) qf[ks] = *(const bf16x8*)(q + 16 * ks);
  }
  float m = -1e30f, lsum = 0.f;
  f32x16 O[2];
#pragma unroll
  for (int i = 0; i < 16; ++i) { O[0][i] = 0.f; O[1][i] = 0.f; }
  const int rr0 = tid >> 3, cc0 = (tid & 7) * 8;
  const bfr* kp0 = Kp + (size_t)rr0 * 64 + cc0;
  const bfr* vp0 = Vp + (size_t)rr0 * ldv + cc0;
  uint4 kreg0 = *(const uint4*)kp0, kreg1 = *(const uint4*)(kp0 + 32 * 64);
  uint4 vreg0 = *(const uint4*)vp0, vreg1 = *(const uint4*)(vp0 + (size_t)32 * ldv);
  for (int k0 = 0; k0 < nkeys; k0 += 64) {
    __syncthreads();
    *(uint4*)(Ks + rr0 * 72 + cc0) = kreg0; *(uint4*)(Ks + (rr0 + 32) * 72 + cc0) = kreg1;
    *(uint4*)(Vs + rr0 * 72 + cc0) = vreg0; *(uint4*)(Vs + (rr0 + 32) * 72 + cc0) = vreg1;
    __syncthreads();
    if (k0 + 64 < nkeys) {
      kreg0 = *(const uint4*)(kp0 + (size_t)(k0 + 64) * 64); kreg1 = *(const uint4*)(kp0 + (size_t)(k0 + 96) * 64);
      vreg0 = *(const uint4*)(vp0 + k0 + 64); vreg1 = *(const uint4*)(vp0 + (size_t)32 * ldv + k0 + 64);
    }
    f32x16 st[2];
#pragma unroll
    for (int kt = 0; kt < 2; ++kt) {
#pragma unroll
      for (int i = 0; i < 16; ++i) st[kt][i] = 0.f;
#pragma unroll
      for (int ks = 0; ks < 4; ++ks) {
        const bf16x8 a = *(const bf16x8*)(Ks + (32 * kt + l32) * 72 + 16 * ks + 8 * h);
        st[kt] = MFMA32(a, qf[ks], st[kt]);
      }
    }
    float mx = st[0][0];
#pragma unroll
    for (int i = 0; i < 16; ++i) { mx = fmaxf(mx, st[0][i]); mx = fmaxf(mx, st[1][i]); }
    mx = fmaxf(mx, __shfl_xor(mx, 32));
    const float mn = fmaxf(m, mx);
    const float alpha = __expf(m - mn);
    m = mn;
    float ps = 0.f;
#pragma unroll
    for (int kt = 0; kt < 2; ++kt)
#pragma unroll
      for (int i = 0; i < 16; ++i) { const float e = __expf(st[kt][i] - mn); st[kt][i] = e; ps += e; }
    lsum = lsum * alpha + ps;
#pragma unroll
    for (int i = 0; i < 16; ++i) { O[0][i] *= alpha; O[1][i] *= alpha; }
#pragma unroll
    for (int kt = 0; kt < 2; ++kt)
#pragma unroll
      for (int s = 0; s < 2; ++s) {
        const uint4 pu = make_uint4(pk2(st[kt][8 * s], st[kt][8 * s + 1]), pk2(st[kt][8 * s + 2], st[kt][8 * s + 3]),
                                    pk2(st[kt][8 * s + 4], st[kt][8 * s + 5]), pk2(st[kt][8 * s + 6], st[kt][8 * s + 7]));
        const bf16x8 pf = __builtin_bit_cast(bf16x8, pu);
#pragma unroll
        for (int dt = 0; dt < 2; ++dt) {
          const unsigned short* vr = Vs + (32 * dt + l32) * 72 + 32 * kt + 16 * s + 4 * h;
          const s16x4 lo = *(const s16x4*)vr, hi = *(const s16x4*)(vr + 8);
          const bf16x8 va = __builtin_shufflevector(lo, hi, 0, 1, 2, 3, 4, 5, 6, 7);
          O[dt] = MFMA32(va, pf, O[dt]);
        }
      }
  }
  const float ltot = lsum + __shfl_xor(lsum, 32);
  const float inv = 1.f / ltot;
  const int T = T0 + l32;
#pragma unroll
  for (int dt = 0; dt < 2; ++dt)
#pragma unroll
    for (int i4 = 0; i4 < 4; ++i4) {
      const int d = 32 * dt + 8 * i4 + 4 * h;
      const uint2 g = *(const uint2*)((const bfr*)(ws + OFF_GA) + (size_t)T * 512 + head * 64 + d);
      const float a = O[dt][4 * i4] * inv * bf2f(g.x & 0xffff), b = O[dt][4 * i4 + 1] * inv * bf2f(g.x >> 16);
      const float c = O[dt][4 * i4 + 2] * inv * bf2f(g.y & 0xffff), e = O[dt][4 * i4 + 3] * inv * bf2f(g.y >> 16);
      *(uint2*)((bfr*)(ws + OFF_MIX) + (size_t)T * 1024 + head * 64 + d) = make_uint2(pk2(a, b), pk2(c, e));
    }
}

DI void attn_lat_item(const Params& p, unsigned char* smem, int it) {
  unsigned char* ws = p.ws;
  const int tid = threadIdx.x, lane = tid & 63, wave = tid >> 6, l32 = lane & 31, h = lane >> 5;
  const int b = it >> 8, kvh = (it >> 7) & 1, qt = (it >> 1) & 63, hp = it & 1;
  const int hw = wave & 1, kh = wave >> 1;
  const int T0 = NCTX + b * 2048 + qt * 32;
  const int head = kvh * 4 + hp * 2 + hw;
  const bfr* Kp = (const bfr*)(ws + OFF_KL) + ((size_t)(b * 2 + kvh) * 2560 + kh * 1280) * 64;
  const bfr* Vp = (const bfr*)(ws + OFF_VL) + (size_t)(b * 2 + kvh) * 64 * 2560 + kh * 1280;
  unsigned short* Ks = (unsigned short*)smem + kh * (2 * 64 * 72);
  unsigned short* Vs = Ks + 64 * 72;
  bf16x8 qf[4];
  {
    const bfr* q = (const bfr*)(ws + OFF_QB) + (size_t)(T0 + l32) * 512 + head * 64 + 8 * h;
#pragma unroll
    for (int ks = 0; ks < 4; ++ks) qf[ks] = *(const bf16x8*)(q + 16 * ks);
  }
  float m = -1e30f, lsum = 0.f;
  f32x16 O[2];
#pragma unroll
  for (int i = 0; i < 16; ++i) { O[0][i] = 0.f; O[1][i] = 0.f; }
  const int t2 = tid & 127, rr0 = t2 >> 3, cc0 = (t2 & 7) * 8;
  const bfr* kp0 = Kp + (size_t)rr0 * 64 + cc0;
  const bfr* vp0 = Vp + (size_t)rr0 * 2560 + cc0;
  uint4 kr0 = *(const uint4*)kp0, kr1 = *(const uint4*)(kp0 + 16 * 64), kr2 = *(const uint4*)(kp0 + 32 * 64), kr3 = *(const uint4*)(kp0 + 48 * 64);
  uint4 vr0 = *(const uint4*)vp0, vr1 = *(const uint4*)(vp0 + (size_t)16 * 2560), vr2 = *(const uint4*)(vp0 + (size_t)32 * 2560), vr3 = *(const uint4*)(vp0 + (size_t)48 * 2560);
  for (int k0 = 0; k0 < 1280; k0 += 64) {
    __syncthreads();
    *(uint4*)(Ks + rr0 * 72 + cc0) = kr0; *(uint4*)(Ks + (rr0 + 16) * 72 + cc0) = kr1; *(uint4*)(Ks + (rr0 + 32) * 72 + cc0) = kr2; *(uint4*)(Ks + (rr0 + 48) * 72 + cc0) = kr3;
    *(uint4*)(Vs + rr0 * 72 + cc0) = vr0; *(uint4*)(Vs + (rr0 + 16) * 72 + cc0) = vr1; *(uint4*)(Vs + (rr0 + 32) * 72 + cc0) = vr2; *(uint4*)(Vs + (rr0 + 48) * 72 + cc0) = vr3;
    __syncthreads();
    if (k0 + 64 < 1280) {
      const bfr* kq = kp0 + (size_t)(k0 + 64) * 64; const bfr* vq = vp0 + k0 + 64;
      kr0 = *(const uint4*)kq; kr1 = *(const uint4*)(kq + 16 * 64); kr2 = *(const uint4*)(kq + 32 * 64); kr3 = *(const uint4*)(kq + 48 * 64);
      vr0 = *(const uint4*)vq; vr1 = *(const uint4*)(vq + (size_t)16 * 2560); vr2 = *(const uint4*)(vq + (size_t)32 * 2560); vr3 = *(const uint4*)(vq + (size_t)48 * 2560);
    }
    f32x16 st[2];
#pragma unroll
    for (int kt = 0; kt < 2; ++kt) {
#pragma unroll
      for (int i = 0; i < 16; ++i) st[kt][i] = 0.f;
#pragma unroll
      for (int ks = 0; ks < 4; ++ks) {
        const bf16x8 a = *(const bf16x8*)(Ks + (32 * kt + l32) * 72 + 16 * ks + 8 * h);
        st[kt] = MFMA32(a, qf[ks], st[kt]);
      }
    }
    float mx = st[0][0];
#pragma unroll
    for (int i = 0; i < 16; ++i) { mx = fmaxf(mx, st[0][i]); mx = fmaxf(mx, st[1][i]); }
    mx = fmaxf(mx, __shfl_xor(mx, 32));
    const float mn = fmaxf(m, mx);
    const float alpha = __expf(m - mn);
    m = mn;
    float ps = 0.f;
#pragma unroll
    for (int kt = 0; kt < 2; ++kt)
#pragma unroll
      for (int i = 0; i < 16; ++i) { const float e = __expf(st[kt][i] - mn); st[kt][i] = e; ps += e; }
    lsum = lsum * alpha + ps;
#pragma unroll
    for (int i = 0; i < 16; ++i) { O[0][i] *= alpha; O[1][i] *= alpha; }
#pragma unroll
    for (int kt = 0; kt < 2; ++kt)
#pragma unroll
      for (int s = 0; s < 2; ++s) {
        const uint4 pu = make_uint4(pk2(st[kt][8 * s], st[kt][8 * s + 1]), pk2(st[kt][8 * s + 2], st[kt][8 * s + 3]),
                                    pk2(st[kt][8 * s + 4], st[kt][8 * s + 5]), pk2(st[kt][8 * s + 6], st[kt][8 * s + 7]));
        const bf16x8 pf = __builtin_bit_cast(bf16x8, pu);
#pragma unroll
        for (int dt = 0; dt < 2; ++dt) {
          const unsigned short* vr = Vs + (32 * dt + l32) * 72 + 32 * kt + 16 * s + 4 * h;
          const s16x4 lo = *(const s16x4*)vr, hi = *(const s16x4*)(vr + 8);
          const bf16x8 va = __builtin_shufflevector(lo, hi, 0, 1, 2, 3, 4, 5, 6, 7);
          O[dt] = MFMA32(va, pf, O[dt]);
        }
      }
  }
  float ltot = lsum + __shfl_xor(lsum, 32);
  float* xb = (float*)smem + (hw * 64 + lane) * 36;
  __syncthreads();
  if (kh == 1) {
#pragma unroll
    for (int i = 0; i < 16; ++i) { xb[i] = O[0][i]; xb[16 + i] = O[1][i]; }
    xb[32] = m; xb[33] = ltot;
  }
  __syncthreads();
  if (kh == 0) {
    const float m2 = xb[32], l2 = xb[33];
    const float mm = fmaxf(m, m2), a1 = __expf(m - mm), a2 = __expf(m2 - mm);
    ltot = ltot * a1 + l2 * a2;
    const float inv = 1.f / ltot;
#pragma unroll
    for (int i = 0; i < 16; ++i) { O[0][i] = (O[0][i] * a1 + xb[i] * a2) * inv; O[1][i] = (O[1][i] * a1 + xb[16 + i] * a2) * inv; }
    const int T = T0 + l32;
#pragma unroll
    for (int dt = 0; dt < 2; ++dt)
#pragma unroll
      for (int i4 = 0; i4 < 4; ++i4) {
        const int d = 32 * dt + 8 * i4 + 4 * h;
        const uint2 g = *(const uint2*)((const bfr*)(ws + OFF_GA) + (size_t)T * 512 + head * 64 + d);
        const float a = O[dt][4 * i4] * bf2f(g.x & 0xffff), bq = O[dt][4 * i4 + 1] * bf2f(g.x >> 16);
        const float c = O[dt][4 * i4 + 2] * bf2f(g.y & 0xffff), e = O[dt][4 * i4 + 3] * bf2f(g.y >> 16);
        *(uint2*)((bfr*)(ws + OFF_MIX) + (size_t)T * 1024 + head * 64 + d) = make_uint2(pk2(a, bq), pk2(c, e));
      }
  }
}

DI int seg_T0(int seg) { return seg < 32 ? seg * 256 : NCTX + ((seg - 32) >> 3) * 2048 + ((seg - 32) & 7) * 256; }

DI void split_bf16(const float4& v0, const float4& v1, bf16x8& hi, bf16x8& lo) {
  const unsigned h0 = pk2(v0.x, v0.y), h1 = pk2(v0.z, v0.w), h2 = pk2(v1.x, v1.y), h3 = pk2(v1.z, v1.w);
  hi = __builtin_bit_cast(bf16x8, make_uint4(h0, h1, h2, h3));
  const unsigned l0 = pk2(v0.x - bf2f(h0 & 0xffff), v0.y - bf2f(h0 >> 16)), l1 = pk2(v0.z - bf2f(h1 & 0xffff), v0.w - bf2f(h1 >> 16));
  const unsigned l2 = pk2(v1.x - bf2f(h2 & 0xffff), v1.y - bf2f(h2 >> 16)), l3 = pk2(v1.z - bf2f(h3 & 0xffff), v1.w - bf2f(h3 >> 16));
  lo = __builtin_bit_cast(bf16x8, make_uint4(l0, l1, l2, l3));
}

DI void s5_wave(const Params& p, float* BU  , int it) {
  unsigned char* ws = p.ws;
  const int lane = threadIdx.x & 63, l32 = lane & 31, h = lane >> 5;
  const int di = it & 1, g = (it >> 1) & 31, seg = it >> 6;
  const int T0 = seg_T0(seg);
  const int dg = di * 32 + g;
  bf16x8 bhi[4], blo[4];
#pragma unroll
  for (int nt = 0; nt < 4; ++nt) {
    const float* bb = (const float*)(ws + OFF_BB) + (size_t)(dg * 64 + (nt & 1) * 32 + l32) * 32 + (nt >> 1) * 16 + 8 * h;
    split_bf16(*(const float4*)bb, *(const float4*)(bb + 4), bhi[nt], blo[nt]);
  }
  const float2 lam = ((const float2*)(ws + OFF_LAMB))[dg * 64 + lane];
  bf16x8 cmf[4];
  {
    const bfr* cm = (const bfr*)(ws + OFF_CMB) + (size_t)dg * 2048 + (lane & 15) * 128 + 8 * (lane >> 4);
#pragma unroll
    for (int ks = 0; ks < 4; ++ks) cmf[ks] = *(const bf16x8*)(cm + 32 * ks);
  }
  float hr = 0.f, hi = 0.f;
  bfr* yout = (bfr*)(ws + (di == 0 ? OFF_YF : OFF_YB));
  const float* ubase = (const float*)(ws + OFF_U) + g * 16 + 8 * h;
  float4 u0, u1;
  { const int T = di == 0 ? T0 + l32 : T0 + 255 - l32; const float* up = ubase + (size_t)T * 512; u0 = *(const float4*)up; u1 = *(const float4*)(up + 4); }
  for (int c = 0; c < 8; ++c) {
    bf16x8 ahi, alo;
    split_bf16(u0, u1, ahi, alo);
    if (c < 7) { const int sg = 32 * (c + 1) + l32; const int T = di == 0 ? T0 + sg : T0 + 255 - sg; const float* up = ubase + (size_t)T * 512; u0 = *(const float4*)up; u1 = *(const float4*)(up + 4); }
#pragma unroll
    for (int nt = 0; nt < 4; ++nt) {
      f32x16 acc;
#pragma unroll
      for (int i = 0; i < 16; ++i) acc[i] = 0.f;
      acc = MFMA32(ahi, bhi[nt], acc);
      acc = MFMA32(alo, bhi[nt], acc);
      acc = MFMA32(ahi, blo[nt], acc);
#pragma unroll
      for (int i = 0; i < 16; ++i) BU[crow(i, h) * 132 + 32 * nt + l32] = acc[i];
    }
    __builtin_amdgcn_wave_barrier();
#pragma unroll 8
    for (int sl = 0; sl < 32; ++sl) {
      const float br = BU[sl * 132 + lane], bi = BU[sl * 132 + 64 + lane];
      const float nr = lam.x * hr - lam.y * hi + br;
      const float ni = lam.x * hi + lam.y * hr + bi;
      hr = nr; hi = ni;
      BU[sl * 132 + lane] = hr; BU[sl * 132 + 64 + lane] = hi;
    }
    __builtin_amdgcn_wave_barrier();
#pragma unroll
    for (int tt = 0; tt < 2; ++tt) {
      f32x4 acc = {0.f, 0.f, 0.f, 0.f};
      const float* hrow = BU + (16 * tt + (lane & 15)) * 132 + 8 * (lane >> 4);
#pragma unroll
      for (int ks = 0; ks < 4; ++ks) {
        const float4 v0 = *(const float4*)(hrow + 32 * ks), v1 = *(const float4*)(hrow + 32 * ks + 4);
        const bf16x8 a = __builtin_bit_cast(bf16x8, make_uint4(pk2(v0.x, v0.y), pk2(v0.z, v0.w), pk2(v1.x, v1.y), pk2(v1.z, v1.w)));
        acc = MFMA16(a, cmf[ks], acc);
      }
#pragma unroll
      for (int i = 0; i < 4; ++i) {
        const int sg = 32 * c + 16 * tt + 4 * (lane >> 4) + i;
        const int T = di == 0 ? T0 + sg : T0 + 255 - sg;
        yout[(size_t)T * 512 + g * 16 + (lane & 15)] = f2bf(acc[i]);
      }
    }
    __builtin_amdgcn_wave_barrier();
  }
  ((float2*)(ws + OFF_E))[((size_t)(seg * 2 + di) * 32 + g) * 64 + lane] = make_float2(hr, hi);
  if (seg < 32) {
    float* so = p.out + OUT_S + (size_t)((seg * 2 + di) * 2) * 2048 + g * 64 + lane;
    so[0] = hr; so[2048] = hi;
  }
}

DI void phase_mix0(const Params& p, unsigned char* smem) {
  constexpr int N_S5 = 3072;
  const int b = blockIdx.x, G = gridDim.x, wave = threadIdx.x >> 6;
  float* BUw = (float*)smem + wave * (32 * 132);
  if (G == 512) {
    attn_lat_item(p, smem, b);
    __syncthreads();
    if (b < 256) { for (int r = 0; r < 2; ++r) s5_wave(p, BUw, b * 8 + r * 4 + wave); }
    else s5_wave(p, BUw, 2048 + (b - 256) * 4 + wave);
    __syncthreads();
    attn_item(p, smem, 256 + b);
  } else {
    for (int it = b * 4 + wave; it < N_S5; it += G * 4) s5_wave(p, BUw, it);
    for (int it = b; it < 512; it += G) { __syncthreads(); attn_lat_item(p, smem, it); }
    for (int it = b; it < 512; it += G) { __syncthreads(); attn_item(p, smem, 256 + it); }
  }
}

DI void phase_s5fix(const Params& p, unsigned char* smem) {
  unsigned char* ws = p.ws;
  const int tid = threadIdx.x, lane = tid & 63, wave = tid >> 6;
  float* ycorr = (float*)smem;
  float* HC = (float*)smem + 4096 + wave * (16 * 132);
  for (int it = blockIdx.x; it < 48 * 32; it += gridDim.x) {
    const int g = it & 31, seg = it >> 5;
    const int T0 = seg_T0(seg);
    __syncthreads();
    if (seg >= 32) {
      for (int e = tid; e < 4096; e += 256) ycorr[e] = 0.f;
      __syncthreads();
      const int b = (seg - 32) >> 3, j = (seg - 32) & 7;
      const int di = wave & 1, half = wave >> 1;
      const int dg = di * 32 + g;
      const float2 lam = ((const float2*)(ws + OFF_LAMB))[dg * 64 + lane];
      const float2 lp = ((const float2*)(ws + OFF_LAMP))[dg * 64 + lane];
      const float* st = p.in[4] + (size_t)((b * 2 + di) * 2) * 2048 + g * 64 + lane;
      float hr = st[0], hi = st[2048];
      const int nprev = di == 0 ? j : 7 - j;
      float2 ev[7];
#pragma unroll
      for (int q = 0; q < 7; ++q) {
        const int jj = di == 0 ? q : 7 - q;
        ev[q] = ((const float2*)(ws + OFF_E))[((size_t)((32 + b * 8 + jj) * 2 + di) * 32 + g) * 64 + lane];
      }
#pragma unroll
      for (int q = 0; q < 7; ++q) {
        if (q < nprev) {
          const float nr = lp.x * hr - lp.y * hi + ev[q].x, ni = lp.x * hi + lp.y * hr + ev[q].y;
          hr = nr; hi = ni;
        }
      }
      float cr = lam.x, cim = lam.y;
      if (half) {
        float sr = lam.x, si = lam.y;
#pragma unroll
        for (int q = 0; q < 7; ++q) { const float t = sr * sr - si * si; si = 2.f * sr * si; sr = t; }
        cr = sr * lam.x - si * lam.y; cim = sr * lam.y + si * lam.x;
      }
      bf16x8 cmf[4];
      {
        const bfr* cm = (const bfr*)(ws + OFF_CMB) + (size_t)dg * 2048 + (lane & 15) * 128 + 8 * (lane >> 4);
#pragma unroll
        for (int ks = 0; ks < 4; ++ks) cmf[ks] = *(const bf16x8*)(cm + 32 * ks);
      }
      for (int c = 0; c < 8; ++c) {
#pragma unroll 8
        for (int sl = 0; sl < 16; ++sl) {
          HC[sl * 132 + lane] = cr * hr - cim * hi;
          HC[sl * 132 + 64 + lane] = cr * hi + cim * hr;
          const float nr = cr * lam.x - cim * lam.y, ni = cr * lam.y + cim * lam.x;
          cr = nr; cim = ni;
        }
        __builtin_amdgcn_wave_barrier();
        f32x4 acc = {0.f, 0.f, 0.f, 0.f};
        const float* hrow = HC + (lane & 15) * 132 + 8 * (lane >> 4);
#pragma unroll
        for (int ks = 0; ks < 4; ++ks) {
          const float4 v0 = *(const float4*)(hrow + 32 * ks), v1 = *(const float4*)(hrow + 32 * ks + 4);
          const bf16x8 a = __builtin_bit_cast(bf16x8, make_uint4(pk2(v0.x, v0.y), pk2(v0.z, v0.w), pk2(v1.x, v1.y), pk2(v1.z, v1.w)));
          acc = MFMA16(a, cmf[ks], acc);
        }
#pragma unroll
        for (int i = 0; i < 4; ++i) {
          const int sg = 128 * half + 16 * c + 4 * (lane >> 4) + i;
          const int tl = di == 0 ? sg : 255 - sg;
          atomicAdd(&ycorr[tl * 16 + (lane & 15)], acc[i]);
        }
        __builtin_amdgcn_wave_barrier();
      }
      __syncthreads();
    }
    {
      const int T = T0 + tid;
      const float* up = (const float*)(ws + OFF_U) + (size_t)T * 512 + g * 16;
      const bfr* yf = (const bfr*)(ws + OFF_YF) + (size_t)T * 512 + g * 16;
      const bfr* yb = (const bfr*)(ws + OFF_YB) + (size_t)T * 512 + g * 16;
      const float* dsk = p.in[21] + g * 16;
      unsigned o[8];
#pragma unroll
      for (int q = 0; q < 2; ++q) {
        const uint4 f = *(const uint4*)(yf + 8 * q), bk = *(const uint4*)(yb + 8 * q);
        const float4 u0 = *(const float4*)(up + 8 * q), u1 = *(const float4*)(up + 8 * q + 4);
        const float4 d0 = *(const float4*)(dsk + 8 * q), d1 = *(const float4*)(dsk + 8 * q + 4);
        const float* yc = ycorr + tid * 16 + 8 * q;
        const float uu[8] = {u0.x, u0.y, u0.z, u0.w, u1.x, u1.y, u1.z, u1.w};
        const float dd[8] = {d0.x, d0.y, d0.z, d0.w, d1.x, d1.y, d1.z, d1.w};
        const unsigned ff[4] = {f.x, f.y, f.z, f.w}, bb[4] = {bk.x, bk.y, bk.z, bk.w};
        float y[8];
#pragma unroll
        for (int e = 0; e < 8; ++e) {
          const float a = (e & 1) ? bf2f(ff[e >> 1] >> 16) : bf2f(ff[e >> 1] & 0xffff);
          const float c2 = (e & 1) ? bf2f(bb[e >> 1] >> 16) : bf2f(bb[e >> 1] & 0xffff);
          y[e] = gelu_f(uu[e] * dd[e] + a + c2 + (seg >= 32 ? yc[e] : 0.f));
        }
#pragma unroll
        for (int e = 0; e < 4; ++e) o[4 * q + e] = pk2(y[2 * e], y[2 * e + 1]);
      }
      uint4* dst = (uint4*)((bfr*)(ws + OFF_YG) + (size_t)T * 512 + g * 16);
      dst[0] = make_uint4(o[0], o[1], o[2], o[3]);
      dst[1] = make_uint4(o[4], o[5], o[6], o[7]);
    }
  }
}

template <int MODE>
DI void phase_tokgemm(const Params& p, unsigned char* smem, int layer) {
  unsigned char* ws = p.ws;
  const int lane = threadIdx.x & 63, wave = threadIdx.x >> 6, l32 = lane & 31, h = lane >> 5, wm = wave >> 1, wn = wave & 1;
  constexpr int K = MODE == 1 ? 1024 : 512, N = MODE == 1 ? 1024 : 512;
  const bfr* A = (const bfr*)(ws + (MODE == 0 ? OFF_YG : (MODE == 1 ? OFF_MIX : OFF_FZ)));
  const bfr* Bt = (const bfr*)(ws + (MODE == 0 ? OFF_GLU : (MODE == 1 ? (layer == 0 ? OFF_WOUT0 : OFF_WOUT1) : OFF_FNET)));
  constexpr int TN = N / 128;
  int tm, tn;
  if (!xcd_tile(0, TN, tm, tn)) return;
  LdBf alp{A + (size_t)tm * 128 * K, (size_t)K}, bl{Bt + (size_t)tn * 128 * K, (size_t)K};
  GStage<128> gst;
  bool first = true;
  for (int step = 0;; ++step) {
    const int m0 = tm * 128, n0 = tn * 128;
    int tm2 = 0, tn2 = 0;
    auto next_tile = [&]() {
      if (!xcd_tile(step + 1, TN, tm2, tn2)) return false;
      alp.base = A + (size_t)tm2 * 128 * K; bl.base = Bt + (size_t)tn2 * 128 * K;
      return true;
    };
    auto ep_direct = [&](f32x16 (&acc)[2][2]) {
#pragma unroll
      for (int ni = 0; ni < 2; ++ni) {
        const int T = m0 + wm * 64 + ni * 32 + l32;
#pragma unroll
        for (int mi = 0; mi < 2; ++mi)
#pragma unroll
          for (int i4 = 0; i4 < 4; ++i4) {
            const int n = n0 + wn * 64 + mi * 32 + 8 * i4 + 4 * h;
            float a = acc[mi][ni][4 * i4], b2 = acc[mi][ni][4 * i4 + 1], c2 = acc[mi][ni][4 * i4 + 2], e = acc[mi][ni][4 * i4 + 3];
            if (MODE == 0) {
              const uint2 y = *(const uint2*)((const bfr*)(ws + OFF_YG) + (size_t)T * 512 + n);
              const uint2 gb = *(const uint2*)((const bfr*)(ws + OFF_GB) + (size_t)T * 512 + n);
              const float4 bs = *(const float4*)(p.in[23] + n);
              a = bf2f(y.x & 0xffff) * sigmoid_f(a + bs.x) * bf2f(gb.x & 0xffff);
              b2 = bf2f(y.x >> 16) * sigmoid_f(b2 + bs.y) * bf2f(gb.x >> 16);
              c2 = bf2f(y.y & 0xffff) * sigmoid_f(c2 + bs.z) * bf2f(gb.y & 0xffff);
              e = bf2f(y.y >> 16) * sigmoid_f(e + bs.w) * bf2f(gb.y >> 16);
              *(uint2*)((bfr*)(ws + OFF_MIX) + (size_t)T * 1024 + 512 + n) = make_uint2(pk2(a, b2), pk2(c2, e));
            } else if (MODE == 1) {
              *(uint2*)((bfr*)(ws + OFF_O) + (size_t)T * 1024 + n) = make_uint2(pk2(a, b2), pk2(c2, e));
            } else {
              const uint2 gd = *(const uint2*)((const bfr*)(ws + OFF_GDS) + (size_t)T * 512 + n);
              a *= bf2f(gd.x & 0xffff); b2 *= bf2f(gd.x >> 16); c2 *= bf2f(gd.y & 0xffff); e *= bf2f(gd.y >> 16);
              *(uint2*)((bfr*)(ws + OFF_MIX) + (size_t)T * 1024 + 512 + n) = make_uint2(pk2(a, b2), pk2(c2, e));
            }
          }
      }
    };
    auto ep_staged = [&](f32x16 (&acc)[2][2]) {
      unsigned short* stg = (unsigned short*)smem;
#pragma unroll
      for (int ni = 0; ni < 2; ++ni) {
        const int row = wm * 64 + ni * 32 + l32;
        const int T = m0 + row;
#pragma unroll
        for (int mi = 0; mi < 2; ++mi)
#pragma unroll
          for (int i4 = 0; i4 < 4; ++i4) {
            const int cl = wn * 64 + mi * 32 + 8 * i4 + 4 * h;
            const int n = n0 + cl;
            float a = acc[mi][ni][4 * i4], b2 = acc[mi][ni][4 * i4 + 1], c2 = acc[mi][ni][4 * i4 + 2], e = acc[mi][ni][4 * i4 + 3];
            if (MODE == 0) {
              const uint2 y = *(const uint2*)((const bfr*)(ws + OFF_YG) + (size_t)T * 512 + n);
              const uint2 gb = *(const uint2*)((const bfr*)(ws + OFF_GB) + (size_t)T * 512 + n);
              const float4 bs = *(const float4*)(p.in[23] + n);
              a = bf2f(y.x & 0xffff) * sigmoid_f(a + bs.x) * bf2f(gb.x & 0xffff);
              b2 = bf2f(y.x >> 16) * sigmoid_f(b2 + bs.y) * bf2f(gb.x >> 16);
              c2 = bf2f(y.y & 0xffff) * sigmoid_f(c2 + bs.z) * bf2f(gb.y & 0xffff);
              e = bf2f(y.y >> 16) * sigmoid_f(e + bs.w) * bf2f(gb.y >> 16);
            } else if (MODE == 2) {
              const uint2 gd = *(const uint2*)((const bfr*)(ws + OFF_GDS) + (size_t)T * 512 + n);
              a *= bf2f(gd.x & 0xffff); b2 *= bf2f(gd.x >> 16); c2 *= bf2f(gd.y & 0xffff); e *= bf2f(gd.y >> 16);
            }
            *(uint2*)(stg + row * 136 + cl) = make_uint2(pk2(a, b2), pk2(c2, e));
          }
      }
      __syncthreads();
      bfr* dbase = MODE == 1 ? (bfr*)(ws + OFF_O) + (size_t)m0 * 1024 + n0 : (bfr*)(ws + OFF_MIX) + (size_t)m0 * 1024 + 512 + n0;
#pragma unroll
      for (int i = 0; i < 8; ++i) {
        const int id = threadIdx.x + 256 * i, r = id >> 4, c16 = id & 15;
        *(uint4*)(dbase + (size_t)r * 1024 + c16 * 8) = *(const uint4*)(stg + r * 136 + c16 * 8);
      }
    };
    auto ep = [&](f32x16 (&acc)[2][2]) { if constexpr (MODE == 1) ep_staged(acc); else ep_direct(acc); };
    if constexpr (MODE == 2) {
      bl.base = Bt + (size_t)n0 * K;
      if (m0 < NCTX) {
        LdBf al{A + (size_t)m0 * K, (size_t)K};
        gemm_tile<128>(K / 64, true, al, bl, ep, smem);
      } else {
        LdFz al{(const bfr*)(ws + OFF_HN) + (size_t)(m0 - NCTX) * 512};
        gemm_tile<128, false>(K / 64, true, al, bl, ep, smem);
      }
      if (!next_tile()) break;
    } else {
      const bool more = gemm_tile_pf<128>(K / 64, true, first, alp, bl, gst, ep, next_tile, smem);
      first = false;
      if (!more) break;
    }
    tm = tm2; tn = tn2;
  }
}

DI void phase_win1(const Params& p, unsigned char* smem) {
  unsigned char* ws = p.ws;
  const int lane = threadIdx.x & 63, wave = threadIdx.x >> 6, l32 = lane & 31, h = lane >> 5, wm = wave >> 1, wn = wave & 1;
  const bfr* A = (const bfr*)(ws + OFF_HN);
  const bfr* Bt = (const bfr*)(ws + OFF_WIN1);
  int tm, tn;
  if (!xcd_tile(0, 24, tm, tn)) return;
  LdBf al{A + (size_t)tm * 128 * 1024, 1024}, bl{Bt + (size_t)tn * 128 * 1024, 1024};
  for (int step = 0;; ++step) {
    const int m0 = tm * 128, n0 = tn * 128;
    int tm2 = 0, tn2 = 0;
    auto next_tile = [&]() {
      if (!xcd_tile(step + 1, 24, tm2, tn2)) return false;
      al.base = A + (size_t)tm2 * 128 * 1024; bl.base = Bt + (size_t)tn2 * 128 * 1024;
      return true;
    };
    auto ep = [&](f32x16 (&acc)[2][2]) {
      const int colbase = n0 + wn * 64, rbase = m0 + wm * 64;
      const int sec = colbase >> 9;
      const int cbt = n0 & 511;
      const bool lat = m0 >= NCTX;
      unsigned short* stg = (unsigned short*)smem;
      if (sec == 0 || sec == 2 || sec == 5) {
#pragma unroll
        for (int ni = 0; ni < 2; ++ni) {
          const int row = wm * 64 + ni * 32 + l32;
#pragma unroll
          for (int mi = 0; mi < 2; ++mi)
#pragma unroll
            for (int i4 = 0; i4 < 4; ++i4) {
              const float a = acc[mi][ni][4 * i4], b2 = acc[mi][ni][4 * i4 + 1], c2 = acc[mi][ni][4 * i4 + 2], e = acc[mi][ni][4 * i4 + 3];
              const uint2 o = sec == 0 ? make_uint2(pk2(gelu_f(a), gelu_f(b2)), pk2(gelu_f(c2), gelu_f(e))) : make_uint2(pk2(silu_f(a), silu_f(b2)), pk2(silu_f(c2), silu_f(e)));
              *(uint2*)(stg + row * 136 + wn * 64 + mi * 32 + 8 * i4 + 4 * h) = o;
            }
        }
      } else {
        if (sec == 1) {
          float* rowss = (float*)(ws + OFF_ROWSS);
#pragma unroll
          for (int mi = 0; mi < 2; ++mi)
#pragma unroll
            for (int i = 0; i < 16; ++i) {
              const float g0 = gelu_f(acc[mi][0][i]), g1 = gelu_f(acc[mi][1][i]);
              acc[mi][0][i] = g0; acc[mi][1][i] = g1;
              const float ss = half_sum32(g0 * g0 + g1 * g1);
              if (l32 == 0) atomicAdd(rowss + rbase + mi * 32 + crow(i, h), ss);
            }
        }
#pragma unroll
        for (int mi = 0; mi < 2; ++mi)
#pragma unroll
          for (int ni = 0; ni < 2; ++ni)
#pragma unroll
            for (int i4 = 0; i4 < 4; ++i4)
              *(uint2*)(stg + (wn * 64 + ni * 32 + l32) * 136 + wm * 64 + mi * 32 + 8 * i4 + 4 * h) =
                  make_uint2(pk2(acc[mi][ni][4 * i4], acc[mi][ni][4 * i4 + 1]), pk2(acc[mi][ni][4 * i4 + 2], acc[mi][ni][4 * i4 + 3]));
      }
      __syncthreads();
      bfr* dbase; size_t dld;
      if (sec == 0 || sec == 2 || sec == 5) { dbase = (bfr*)(ws + (sec == 0 ? OFF_CUG : (sec == 2 ? OFF_GCS : OFF_GDS))) + (size_t)m0 * 512 + cbt; dld = 512; }
      else if (sec == 1) { dbase = (bfr*)(ws + OFF_CVT) + (size_t)cbt * NTOK + m0; dld = NTOK; }
      else if (!lat) { dbase = (bfr*)(ws + OFF_ZTC) + ((size_t)((m0 >> 8) * 512 + cbt)) * 512 + (sec - 3) * 256 + (m0 & 255); dld = 512; }
      else { dbase = (bfr*)(ws + OFF_ZTL) + ((size_t)(((m0 - NCTX) >> 11) * 512 + cbt)) * 4096 + (sec - 3) * 2048 + ((m0 - NCTX) & 2047); dld = 4096; }
#pragma unroll
      for (int i = 0; i < 8; ++i) {
        const int id = threadIdx.x + 256 * i, r = id >> 4, c16 = id & 15;
        *(uint4*)(dbase + (size_t)r * dld + c16 * 8) = *(const uint4*)(stg + r * 136 + c16 * 8);
      }
    };
    const int sec0 = n0 >> 9;
    al.base = A + (size_t)m0 * 1024; bl.base = Bt + (size_t)n0 * 1024;
    gemm_tile<128>(16, sec0 == 0 || sec0 == 2 || sec0 == 5, al, bl, ep, smem);
    if (!next_tile()) break;
    tm = tm2; tn = tn2;
  }
}

struct LdWs {
  const float* w; const float* rowss;
  const float* p[4]; const float* rp;
  DI void init(int lrow, int lcol) {
#pragma unroll
    for (int i = 0; i < 4; ++i) p[i] = w + (lrow + 32 * i) * 128 + lcol;
    rp = rowss + lcol;
  }
  DI void advance(int adv) {
#pragma unroll
    for (int i = 0; i < 4; ++i) p[i] += 64 * adv;
    rp += 64 * adv;
  }
  DI uint4 load(int i) const {
    const float* wp = p[i];
    const float4 a = *(const float4*)wp, b = *(const float4*)(wp + 4);
    const float4 s0 = *(const float4*)rp, s1 = *(const float4*)(rp + 4);
    const float r0 = rsqrtf(s0.x * (1.f / 512.f) + EPS), r1 = rsqrtf(s0.y * (1.f / 512.f) + EPS), r2 = rsqrtf(s0.z * (1.f / 512.f) + EPS), r3 = rsqrtf(s0.w * (1.f / 512.f) + EPS);
    const float r4 = rsqrtf(s1.x * (1.f / 512.f) + EPS), r5 = rsqrtf(s1.y * (1.f / 512.f) + EPS), r6 = rsqrtf(s1.z * (1.f / 512.f) + EPS), r7 = rsqrtf(s1.w * (1.f / 512.f) + EPS);
    return make_uint4(pk2(a.x * r0, a.y * r1), pk2(a.z * r2, a.w * r3), pk2(b.x * r4, b.y * r5), pk2(b.z * r6, b.w * r7));
  }
};

DI void phase_mix1(const Params& p, unsigned char* smem) {
  unsigned char* ws = p.ws;
  const int lane = threadIdx.x & 63, wave = threadIdx.x >> 6, l32 = lane & 31, h = lane >> 5, wm = wave >> 1, wn = wave & 1;
  constexpr int N_FL = 512, N_FC = 256, N_G = 768;
  for (int it = blockIdx.x; it < N_FL + N_FC + N_G; it += gridDim.x) {
    if (it < N_FL + N_FC) {
      const bfr *A, *Bt; int K, Tbase, tm, tn;
      int kq = 0; bool isl = it < N_FL;
      if (isl) {
        const int b = it >> 8; kq = it & 3; tn = (it >> 2) & 3; tm = (it >> 4) & 15; K = 4096;
        A = (const bfr*)(ws + OFF_ALAT) + kq * 1024; Bt = (const bfr*)(ws + OFF_ZTL) + (size_t)b * 512 * 4096 + kq * 1024; Tbase = NCTX + b * 2048;
      } else {
        const int i2 = it - N_FL; const int b = i2 >> 3; tm = (i2 >> 2) & 1; tn = i2 & 3; K = 512;
        A = (const bfr*)(ws + OFF_ACTX); Bt = (const bfr*)(ws + OFF_ZTC) + (size_t)b * 512 * 512; Tbase = b * 256;
      }
      LdBf al{A + (size_t)tm * 128 * K, (size_t)K}, bl{Bt + (size_t)tn * 128 * K, (size_t)K};
      auto ep = [&](f32x16 (&acc)[2][2]) {
#pragma unroll
        for (int mi = 0; mi < 2; ++mi)
#pragma unroll
          for (int ni = 0; ni < 2; ++ni)
#pragma unroll
            for (int i = 0; i < 16; ++i) {
              const int T = Tbase + tm * 128 + wm * 64 + mi * 32 + crow(i, h);
              const int n = tn * 128 + wn * 64 + ni * 32 + l32;
              if (!isl) ((bfr*)(ws + OFF_FZ))[(size_t)T * 512 + n] = f2bf(acc[mi][ni][i]);
              else ((bfr*)(ws + OFF_HN))[((size_t)kq * 4096 + (T - NCTX)) * 512 + n] = f2bf(acc[mi][ni][i]);
            }
      };
      gemm_tile<128>(isl ? 16 : K / 64, false, al, bl, ep, smem);
    } else {
      const int i2 = it - N_FL - N_FC; const int hg = i2 & 7, chunk = i2 >> 3;
      LdWs al{p.in[27] + (size_t)hg * 128 * 128, (const float*)(ws + OFF_ROWSS) + chunk * 128};
      LdBf bl{(const bfr*)(ws + OFF_CVT) + (size_t)(hg * 64) * NTOK + chunk * 128, (size_t)NTOK};
      auto ep = [&](f32x16 (&acc)[2][1]) {
        const int c = hg * 64 + wn * 32 + l32;
        const float vg = p.in[26][c];
#pragma unroll
        for (int mi = 0; mi < 2; ++mi)
#pragma unroll
          for (int i = 0; i < 16; ++i) {
            const int t = wm * 64 + mi * 32 + crow(i, h);
            const int T = chunk * 128 + t;
            const float sp = acc[mi][0][i] * vg + p.in[28][hg * 128 + t];
            const float cu = bf2f(((const bfr*)(ws + OFF_CUG))[(size_t)T * 512 + c]);
            const float gc = bf2f(((const bfr*)(ws + OFF_GCS))[(size_t)T * 512 + c]);
            ((bfr*)(ws + OFF_MIX))[(size_t)T * 1024 + c] = f2bf(cu * sp * gc);
          }
      };
      gemm_tile<64>(2, false, al, bl, ep, smem);
    }
  }
}

constexpr int NPHASE = 13;
#ifndef DOUBLE_MASK
#define DOUBLE_MASK 0
#endif
template <int PH>
DI void run_phase(const Params& p, unsigned char* smem) {
  if constexpr (PH == 0) phase0(p, smem);
  else if constexpr (PH == 1) phase_rows<0>(p);
  else if constexpr (PH == 2) phase_win0(p, smem);
  else if constexpr (PH == 3) phase_mix0(p, smem);
  else if constexpr (PH == 4) phase_s5fix(p, smem);
  else if constexpr (PH == 5) phase_tokgemm<0>(p, smem, 0);
  else if constexpr (PH == 6) phase_tokgemm<1>(p, smem, 0);
  else if constexpr (PH == 7) phase_rows<1>(p);
  else if constexpr (PH == 8) phase_win1(p, smem);
  else if constexpr (PH == 9) phase_mix1(p, smem);
  else if constexpr (PH == 10) phase_tokgemm<2>(p, smem, 1);
  else if constexpr (PH == 11) phase_tokgemm<1>(p, smem, 1);
  else if constexpr (PH == 12) phase_rows<2>(p);
}
template <int LO, int HI>
DI void run_range(const Params& p, unsigned char* smem, const XcdBarrier& xb) {
  if constexpr (LO < HI) {
    run_phase<LO>(p, smem);
    if constexpr (((DOUBLE_MASK) >> LO) & 1) { xcd_barrier(xb); run_phase<LO>(p, smem); }
    if constexpr (LO + 1 < HI) { xcd_barrier(xb); run_range<LO + 1, HI>(p, smem, xb); }
  }
}
template <int LO, int HI>
__global__ void __launch_bounds__(256, 2) mega(Params p) {
  __shared__ __attribute__((aligned(16))) unsigned char smem[73728];
  __shared__ uint4 xb_words;
  if (threadIdx.x == 0) xb_words = make_uint4(0u, 0u, 0u, 0u);
  __syncthreads();
  XcdBarrier xb = xcd_barrier_post((unsigned*)(p.ws + OFF_BAR), (volatile LAS unsigned*)&xb_words);
  run_range<LO, HI>(p, smem, xb);
  if (p.ph_lo != 0) cg::this_grid().sync();
}

#ifndef ONE_LAUNCH
#define ONE_LAUNCH 1
#endif
#if !ONE_LAUNCH
template <int PH>
static void launch_phases(Params& p, int grid, hipStream_t stream) {
  if constexpr (PH < NPHASE) {
    hipLaunchKernelGGL((mega<PH, PH + 1>), dim3(grid), dim3(256), 0, stream, p);
    launch_phases<PH + 1>(p, grid, stream);
  }
}
#endif

#ifndef ONE_LAUNCH
#define ONE_LAUNCH 1
#endif

extern "C" void kernel_launch(void* const* d_in, const int* in_sizes, int n_in, void* d_out, int out_size, void* d_ws, size_t ws_size, hipStream_t stream) {
  static int grid_blocks = 0;
  if (!grid_blocks) {
    int dev = 0, cus = 0, per_cu = 0;
    (void)hipGetDevice(&dev);
    (void)hipDeviceGetAttribute(&cus, hipDeviceAttributeMultiprocessorCount, dev);
    (void)hipOccupancyMaxActiveBlocksPerMultiprocessor(&per_cu, mega<0, NPHASE>, 256, 0);
    if (per_cu > 2) per_cu = 2;
    if (per_cu < 1) per_cu = 1;
    grid_blocks = cus * per_cu;
    if (n_in != 31 || ws_size < WS_TOTAL) fprintf(stderr, "kernel_launch: unexpected n_in %d or ws_size %zu (need %zu)\n", n_in, ws_size, (size_t)WS_TOTAL);
  }
  Params p{};
  for (int i = 0; i < 31; ++i) p.in[i] = (const float*)d_in[i];
  p.out = (float*)d_out; p.ws = (unsigned char*)d_ws;
  (void)hipMemsetAsync((unsigned char*)d_ws + OFF_BAR, 0, 16384, stream);
#if ONE_LAUNCH
  p.ph_lo = 0; p.ph_hi = NPHASE;
  void* args[] = {&p};
  hipError_t e = hipLaunchCooperativeKernel((void*)mega<0, NPHASE>, dim3(grid_blocks), dim3(256), args, 0, stream);
  if (e != hipSuccess) fprintf(stderr, "cooperative launch failed: %s (grid %d)\n", hipGetErrorString(e), grid_blocks);
#else
  launch_phases<0>(p, grid_blocks, stream);
#endif
}
```

```cpp
#include <hip/hip_runtime.h>
#include <hip/hip_cooperative_groups.h>
#include <cstdio>
#include <cstdint>
namespace cg = cooperative_groups;

#define DI __device__ __forceinline__
typedef unsigned short bfr;
using bf16x8 = __attribute__((ext_vector_type(8))) short;
using s16x4  = __attribute__((ext_vector_type(4))) short;
using f32x16 = __attribute__((ext_vector_type(16))) float;
using f32x4  = __attribute__((ext_vector_type(4))) float;

#define MFMA32(a, b, c) __builtin_amdgcn_mfma_f32_32x32x16_bf16((a), (b), (c), 0, 0, 0)
#define MFMA16(a, b, c) __builtin_amdgcn_mfma_f32_16x16x32_bf16((a), (b), (c), 0, 0, 0)

constexpr int NTOK = 12288, NCTX = 8192;
constexpr float EPS = 1e-6f;

constexpr size_t OFF_MOD   = 0;
constexpr size_t OFF_ROWSS = OFF_MOD + 73728;
constexpr size_t OFF_ROPE  = OFF_ROWSS + 49152;
constexpr size_t OFF_LAMB  = OFF_ROPE + 8192;
constexpr size_t OFF_LAMP  = OFF_LAMB + 32768;
constexpr size_t OFF_BB    = OFF_LAMP + 32768;
constexpr size_t OFF_CMB   = OFF_BB + 524288;
constexpr size_t OFF_E     = OFF_CMB + 262144;
constexpr size_t OFF_WIN0  = OFF_E + 1572864;
constexpr size_t OFF_GLU   = OFF_WIN0 + 4718592;
constexpr size_t OFF_WOUT0 = OFF_GLU + 524288;
constexpr size_t OFF_WIN1  = OFF_WOUT0 + 2097152;
constexpr size_t OFF_FNET  = OFF_WIN1 + 6291456;
constexpr size_t OFF_WOUT1 = OFF_FNET + 524288;
constexpr size_t OFF_ACTX  = OFF_WOUT1 + 2097152;
constexpr size_t OFF_ALAT  = OFF_ACTX + 262144;
constexpr size_t OFF_X1    = OFF_ALAT + 16777216;
constexpr size_t OFF_HN    = OFF_X1 + 50331648;
constexpr size_t OFF_MIX   = OFF_HN + 25165824;
constexpr size_t OFF_O     = OFF_MIX + 25165824;
constexpr size_t OFF_U     = OFF_O;
constexpr size_t OFF_R     = OFF_O + 25165824;
constexpr size_t OFF_QB = OFF_R;
constexpr size_t OFF_KC = OFF_QB + 12582912;
constexpr size_t OFF_KL = OFF_KC + 2097152;
constexpr size_t OFF_VC = OFF_KL + 1310720;
constexpr size_t OFF_VL = OFF_VC + 2097152;
constexpr size_t OFF_GA = OFF_VL + 1310720;
constexpr size_t OFF_GB = OFF_GA + 12582912;
constexpr size_t OFF_YF = OFF_GB + 12582912;
constexpr size_t OFF_YB = OFF_YF + 12582912;
constexpr size_t OFF_YG = OFF_YB + 12582912;
constexpr size_t END_L0 = OFF_YG + 12582912;
constexpr size_t OFF_CUG = OFF_R;
constexpr size_t OFF_GCS = OFF_CUG + 12582912;
constexpr size_t OFF_GDS = OFF_GCS + 12582912;
constexpr size_t OFF_CVT = OFF_GDS + 12582912;
constexpr size_t OFF_FZ  = OFF_CVT + 12582912;
constexpr size_t OFF_ZTC = OFF_FZ + 12582912;
constexpr size_t OFF_ZTL = OFF_ZTC + 16777216;
constexpr size_t END_L1 = OFF_ZTL + 8388608;
constexpr size_t WS_NEED = (END_L0 > END_L1 ? END_L0 : END_L1);
constexpr size_t OFF_BAR = WS_NEED;
constexpr size_t WS_TOTAL = OFF_BAR + 16384;
static_assert(WS_TOTAL <= (size_t)256 * 1024 * 1024, "workspace too large");

constexpr size_t OUT_Y = 0, OUT_K = 12582912, OUT_V = 13631488, OUT_S = 14680064;

struct Params {
  const float* in[31];
  float* out;
  unsigned char* ws;
  int ph_lo, ph_hi;
};

typedef __bf16 hbf2 __attribute__((ext_vector_type(2)));
typedef float hfl2 __attribute__((ext_vector_type(2)));
DI unsigned pk2(float lo, float hi) { hfl2 v = {lo, hi}; hbf2 r = __builtin_convertvector(v, hbf2); return __builtin_bit_cast(unsigned, r); }
DI unsigned short f2bf(float x) { return (unsigned short)(pk2(x, 0.f) & 0xffffu); }
DI float bf2f(unsigned short b) { return __uint_as_float(((unsigned)b) << 16); }
DI float wave_sum(float v) {
#pragma unroll
  for (int o = 1; o < 64; o <<= 1) v += __shfl_xor(v, o);
  return v;
}
DI float half_sum32(float v) {
#pragma unroll
  for (int o = 1; o < 32; o <<= 1) v += __shfl_xor(v, o);
  return v;
}
DI float silu_f(float x) { return x / (1.f + __expf(-x)); }
DI float sigmoid_f(float x) { return 1.f / (1.f + __expf(-x)); }
DI float gelu_f(float x) { float z = 0.7978845608028654f * (x + 0.044715f * x * x * x); return x / (1.f + __expf(-2.f * z)); }
DI int crow(int i, int h) { return (i & 3) + 8 * (i >> 2) + 4 * h; }
DI const float* xrow(const Params& p, int T) { return T < NCTX ? p.in[0] + (size_t)T * 1024 : p.in[1] + (size_t)(T - NCTX) * 1024; }
DI int cond_of(int T) { return T < NCTX ? 0 : 1 + ((T - NCTX) >> 11); }

template <int BN, bool D2 = false, class AL, class BL, class EP>
DI void gemm_tile(int nk, bool swp, AL al, BL bl, EP ep, unsigned char* smem) {
  constexpr int NI = BN / 64;
  constexpr int NB = BN / 32;
  constexpr int STG = (128 + BN) * 72;
  unsigned short* S0 = (unsigned short*)smem;
  const int tid = threadIdx.x, lane = tid & 63, wave = tid >> 6, l32 = lane & 31, h = lane >> 5;
  const int wm = wave >> 1, wn = wave & 1;
  const int xoff = (swp ? 128 * 72 + (wn * 64 + l32) * 72 : (wm * 64 + l32) * 72) + h * 8;
  const int yoff = (swp ? (wm * 64 + l32) * 72 : 128 * 72 + (wn * (BN / 2) + l32) * 72) + h * 8;
  f32x16 acc[2][NI];
#pragma unroll
  for (int mi = 0; mi < 2; ++mi)
#pragma unroll
    for (int ni = 0; ni < NI; ++ni)
#pragma unroll
      for (int i = 0; i < 16; ++i) acc[mi][ni][i] = 0.f;
  uint4 ra[2][4], rb[2][NB];
  const int lrow = tid >> 3, lcol = (tid & 7) * 8;
  al.init(lrow, lcol); bl.init(lrow, lcol);
  int nxt = 0;
  auto gload = [&](uint4 (&a4)[4], uint4 (&b4)[NB]) {
#pragma unroll
    for (int i = 0; i < 4; ++i) a4[i] = al.load(i);
#pragma unroll
    for (int i = 0; i < NB; ++i) b4[i] = bl.load(i);
    const int adv = (nxt + 1 < nk) ? 1 : 0;
    al.advance(adv); bl.advance(adv); nxt += adv;
  };
  auto lstore = [&](const uint4 (&a4)[4], const uint4 (&b4)[NB], unsigned short* st) {
#pragma unroll
    for (int i = 0; i < 4; ++i) *(uint4*)(st + (lrow + 32 * i) * 72 + lcol) = a4[i];
#pragma unroll
    for (int i = 0; i < NB; ++i) *(uint4*)(st + 128 * 72 + (lrow + 32 * i) * 72 + lcol) = b4[i];
  };
  auto compute = [&](const unsigned short* st) {
#pragma unroll
    for (int ks = 0; ks < 4; ++ks) {
      bf16x8 x[2], y[NI];
#pragma unroll
      for (int mi = 0; mi < 2; ++mi) x[mi] = *(const bf16x8*)(st + xoff + mi * 32 * 72 + ks * 16);
#pragma unroll
      for (int ni = 0; ni < NI; ++ni) y[ni] = *(const bf16x8*)(st + yoff + ni * 32 * 72 + ks * 16);
#pragma unroll
      for (int mi = 0; mi < 2; ++mi)
#pragma unroll
        for (int ni = 0; ni < NI; ++ni) acc[mi][ni] = MFMA32(x[mi], y[ni], acc[mi][ni]);
    }
  };
  if constexpr (D2) {
    gload(ra[0], rb[0]);
    gload(ra[1], rb[1]);
    __syncthreads();
    lstore(ra[0], rb[0], S0);
    gload(ra[0], rb[0]);
    __syncthreads();
    for (int kt = 0; kt < nk; kt += 2) {
      compute(S0);
      lstore(ra[1], rb[1], S0 + STG);
      gload(ra[1], rb[1]);
      __syncthreads();
      compute(S0 + STG);
      if (kt + 2 < nk) lstore(ra[0], rb[0], S0);
      gload(ra[0], rb[0]);
      __syncthreads();
    }
  } else {
    gload(ra[0], rb[0]);
    __syncthreads();
    lstore(ra[0], rb[0], S0);
    gload(ra[0], rb[0]);
    __syncthreads();
    for (int kt = 0; kt < nk; kt += 2) {
      compute(S0);
      lstore(ra[0], rb[0], S0 + STG);
      gload(ra[0], rb[0]);
      __syncthreads();
      compute(S0 + STG);
      if (kt + 2 < nk) lstore(ra[0], rb[0], S0);
      gload(ra[0], rb[0]);
      __syncthreads();
    }
  }
  ep(acc);
}

template <int BN> struct GStage { uint4 ra[2][4]; uint4 rb[2][BN / 32]; int nxt; };
template <int BN, class AL, class BL, class EP, class NX>
DI bool gemm_tile_pf(int nk, bool swp, bool first, AL& al, BL& bl, GStage<BN>& st, EP ep, NX next_tile, unsigned char* smem) {
  constexpr int NI = BN / 64;
  constexpr int NB = BN / 32;
  constexpr int STG = (128 + BN) * 72;
  unsigned short* S0 = (unsigned short*)smem;
  const int tid = threadIdx.x, lane = tid & 63, wave = tid >> 6, l32 = lane & 31, h = lane >> 5;
  const int wm = wave >> 1, wn = wave & 1;
  const int xoff = (swp ? 128 * 72 + (wn * 64 + l32) * 72 : (wm * 64 + l32) * 72) + h * 8;
  const int yoff = (swp ? (wm * 64 + l32) * 72 : 128 * 72 + (wn * (BN / 2) + l32) * 72) + h * 8;
  f32x16 acc[2][NI];
#pragma unroll
  for (int mi = 0; mi < 2; ++mi)
#pragma unroll
    for (int ni = 0; ni < NI; ++ni)
#pragma unroll
      for (int i = 0; i < 16; ++i) acc[mi][ni][i] = 0.f;
  const int lrow = tid >> 3, lcol = (tid & 7) * 8;
  auto gload = [&](uint4 (&a4)[4], uint4 (&b4)[NB]) {
#pragma unroll
    for (int i = 0; i < 4; ++i) a4[i] = al.load(i);
#pragma unroll
    for (int i = 0; i < NB; ++i) b4[i] = bl.load(i);
    const int adv = (st.nxt + 1 < nk) ? 1 : 0;
    al.advance(adv); bl.advance(adv); st.nxt += adv;
  };
  auto lstore = [&](const uint4 (&a4)[4], const uint4 (&b4)[NB], unsigned short* sp) {
#pragma unroll
    for (int i = 0; i < 4; ++i) *(uint4*)(sp + (lrow + 32 * i) * 72 + lcol) = a4[i];
#pragma unroll
    for (int i = 0; i < NB; ++i) *(uint4*)(sp + 128 * 72 + (lrow + 32 * i) * 72 + lcol) = b4[i];
  };
  auto compute = [&](const unsigned short* sp) {
#pragma unroll
    for (int ks = 0; ks < 4; ++ks) {
      bf16x8 x[2], y[NI];
#pragma unroll
      for (int mi = 0; mi < 2; ++mi) x[mi] = *(const bf16x8*)(sp + xoff + mi * 32 * 72 + ks * 16);
#pragma unroll
      for (int ni = 0; ni < NI; ++ni) y[ni] = *(const bf16x8*)(sp + yoff + ni * 32 * 72 + ks * 16);
#pragma unroll
      for (int mi = 0; mi < 2; ++mi)
#pragma unroll
        for (int ni = 0; ni < NI; ++ni) acc[mi][ni] = MFMA32(x[mi], y[ni], acc[mi][ni]);
    }
  };
  if (first) {
    al.init(lrow, lcol); bl.init(lrow, lcol); st.nxt = 0;
    gload(st.ra[0], st.rb[0]);
    gload(st.ra[1], st.rb[1]);
  }
  __syncthreads();
  lstore(st.ra[0], st.rb[0], S0);
  gload(st.ra[0], st.rb[0]);
  __syncthreads();
  for (int kt = 0; kt < nk; kt += 2) {
    compute(S0);
    lstore(st.ra[1], st.rb[1], S0 + STG);
    gload(st.ra[1], st.rb[1]);
    __syncthreads();
    compute(S0 + STG);
    if (kt + 2 < nk) lstore(st.ra[0], st.rb[0], S0);
    gload(st.ra[0], st.rb[0]);
    __syncthreads();
  }
  const bool more = next_tile();
  if (more) {
    al.init(lrow, lcol); bl.init(lrow, lcol); st.nxt = 0;
    gload(st.ra[0], st.rb[0]);
    gload(st.ra[1], st.rb[1]);
  }
  ep(acc);
  return more;
}

DI bool xcd_tile(int step, int ntn, int& tm, int& tn) {
  const int G = gridDim.x;
  if ((G & 7) == 0) {
    const int x = blockIdx.x & 7, loc = blockIdx.x >> 3, per = G >> 3;
    const int j = loc + step * per;
    if (j >= 12 * ntn) return false;
    tn = j / 12; tm = 12 * x + j % 12;
    return true;
  }
  const int it = blockIdx.x + step * G;
  if (it >= 96 * ntn) return false;
  tm = it / ntn; tn = it % ntn;
  return true;
}

#define GAS __attribute__((address_space(1)))
typedef unsigned u32x4 __attribute__((ext_vector_type(4)));
DI uint4 gld16(const GAS char* q) { const u32x4 v = *(const GAS u32x4*)q; return make_uint4(v.x, v.y, v.z, v.w); }
struct LdBf {
  const bfr* base; size_t ld;
  const GAS char* p[4];
  DI void init(int lrow, int lcol) {
#pragma unroll
    for (int i = 0; i < 4; ++i) { p[i] = (const GAS char*)(base + (size_t)(lrow + 32 * i) * ld + lcol); asm volatile("" : "+v"(p[i])); }
  }
  DI uint4 load(int i) const { return gld16(p[i]); }
  DI void advance(int adv) {
#pragma unroll
    for (int i = 0; i < 4; ++i) p[i] += 128 * adv;
  }
};
#define XB_TMO      128
#define XB_XCNT(j)  (256  + 64 * (j))
#define XB_XSUB(j)  (1280 + 64 * (j))
#define XB_XGEN(j)  (2304 + 64 * (j))
#define XB_TOP      3328
#define XB_TOPGEN   3392
#define XCD_BAR_WORDS 3456
#define XB_SPIN_CAP (1u << 20)
#define LAS __attribute__((address_space(3)))
DI unsigned xb_ld(unsigned* p)              { return __hip_atomic_load(p, __ATOMIC_RELAXED, __HIP_MEMORY_SCOPE_AGENT); }
DI unsigned xb_add(unsigned* p, unsigned v) { return __hip_atomic_fetch_add(p, v, __ATOMIC_RELAXED, __HIP_MEMORY_SCOPE_AGENT); }
DI unsigned xb_xcc_id() { return (unsigned)__builtin_amdgcn_s_getreg((3 << 11) | 20) & 0xFu; }
#define XB_SPIN(cond, bar) do { unsigned _sp = 0; while (cond) { __builtin_amdgcn_s_sleep(1); \
    if ((++_sp & 255u) == 0u) { if (xb_ld(&(bar)[XB_TMO])) break; if (_sp > XB_SPIN_CAP) { atomicAdd(&(bar)[XB_TMO], 1u); break; } } } } while (0)
struct XcdBarrier { unsigned* bar; unsigned x; volatile LAS unsigned* st; };
DI XcdBarrier xcd_barrier_post(unsigned* bar, volatile LAS unsigned* st) {
  XcdBarrier b; b.bar = bar; b.x = xb_xcc_id(); b.st = st;
  if (threadIdx.x == 0) (void)xb_add(&bar[XB_XCNT(b.x)], 1u);
  return b;
}
DI void xcd_barrier_complete(unsigned* bar, unsigned x, unsigned& nloc, unsigned& nx) {
  const unsigned G = gridDim.x * gridDim.y * gridDim.z;
  unsigned sum, cnt, mine, sp = 0u;
  for (;;) {
    sum = 0u; cnt = 0u; mine = 0u;
#pragma unroll
    for (unsigned j = 0; j < 16; ++j) { const unsigned c = xb_ld(&bar[XB_XCNT(j)]); sum += c; cnt += (c > 0u) ? 1u : 0u; mine = (j == x) ? c : mine; }
    if (sum == G) break;
    __builtin_amdgcn_s_sleep(1);
    if ((++sp & 255u) == 0u) { if (xb_ld(&bar[XB_TMO])) break; if (sp > XB_SPIN_CAP) { atomicAdd(&bar[XB_TMO], 1u); break; } }
  }
  nloc = mine > 0u ? mine : 1u; nx = cnt > 0u ? cnt : 1u;
}
DI void xcd_barrier(const XcdBarrier& b) {
  asm volatile("s_waitcnt vmcnt(0)" ::: "memory");
  __syncthreads();
  if (threadIdx.x == 0) {
    unsigned* bar = b.bar;
    __builtin_amdgcn_s_waitcnt(0);
    unsigned nloc = b.st[0], nx = b.st[1];
    if (nloc == 0u) { xcd_barrier_complete(bar, b.x, nloc, nx); b.st[0] = nloc; b.st[1] = nx; }
    const unsigned old = xb_add(&bar[XB_XSUB(b.x)], 1u);
    const unsigned gen = old / nloc;
    if (old + 1u == (gen + 1u) * nloc) {
      __builtin_amdgcn_fence(__ATOMIC_RELEASE, "agent");
      asm volatile("s_waitcnt vmcnt(0)" ::: "memory");
      const unsigned og = xb_add(&bar[XB_TOP], 1u);
      const unsigned tg = og / nx;
      if (og + 1u == (tg + 1u) * nx) xb_add(&bar[XB_TOPGEN], 1u);
      else XB_SPIN(xb_ld(&bar[XB_TOPGEN]) == tg, bar);
      __builtin_amdgcn_fence(__ATOMIC_ACQUIRE, "agent");
      xb_add(&bar[XB_XGEN(b.x)], 1u);
      asm volatile("s_waitcnt vmcnt(0)" ::: "memory");
    } else {
      XB_SPIN(xb_ld(&bar[XB_XGEN(b.x)]) == gen, bar);
      __builtin_amdgcn_fence(__ATOMIC_ACQUIRE, "agent");
      asm volatile("s_waitcnt vmcnt(0)" ::: "memory");
    }
  }
  __syncthreads();
}

struct LdFz {
  const bfr* pz;
  const GAS char* p[4];
  DI void init(int lrow, int lcol) {
#pragma unroll
    for (int i = 0; i < 4; ++i) { p[i] = (const GAS char*)(pz + (size_t)(lrow + 32 * i) * 512 + lcol); asm volatile("" : "+v"(p[i])); }
  }
  DI void advance(int adv) {
#pragma unroll
    for (int i = 0; i < 4; ++i) p[i] += 128 * adv;
  }
  DI uint4 load(int i) const {
    const GAS char* q = p[i];
    const uint4 a = gld16(q), b = gld16(q + (size_t)4096 * 512 * 2), c = gld16(q + (size_t)2 * 4096 * 512 * 2), d = gld16(q + (size_t)3 * 4096 * 512 * 2);
#define SUM4(f) pk2(bf2f(a.f & 0xffff) + bf2f(b.f & 0xffff) + bf2f(c.f & 0xffff) + bf2f(d.f & 0xffff), bf2f(a.f >> 16) + bf2f(b.f >> 16) + bf2f(c.f >> 16) + bf2f(d.f >> 16))
    return make_uint4(SUM4(x), SUM4(y), SUM4(z), SUM4(w));
#undef SUM4
  }
};

DI void transpose_tile(const float* W, int ldw, int kbase, int nbase, bfr* WT, int ldt, int trow, float* sm) {
  const int tid = threadIdx.x;
#pragma unroll
  for (int i = 0; i < 4; ++i) {
    const int r = (tid >> 4) + 16 * i, c = (tid & 15) * 4;
    const float4 v = *(const float4*)(W + (size_t)(kbase + r) * ldw + nbase + c);
    sm[r * 65 + c] = v.x; sm[r * 65 + c + 1] = v.y; sm[r * 65 + c + 2] = v.z; sm[r * 65 + c + 3] = v.w;
  }
  __syncthreads();
  const int n = tid >> 2, kc = (tid & 3) * 16;
  unsigned o[8];
#pragma unroll
  for (int j = 0; j < 8; ++j) o[j] = pk2(sm[(kc + 2 * j) * 65 + n], sm[(kc + 2 * j + 1) * 65 + n]);
  uint4* dst = (uint4*)(WT + (size_t)(trow + n) * ldt + kbase + kc);
  dst[0] = make_uint4(o[0], o[1], o[2], o[3]);
  dst[1] = make_uint4(o[4], o[5], o[6], o[7]);
}

DI void phase0(const Params& p, unsigned char* smem) {
  const int tid = threadIdx.x;
  float* smf = (float*)smem;
  unsigned char* ws = p.ws;
  constexpr int N_ADA = 192;
  constexpr int N_T0 = 16 * 36, N_TG = 64, N_TO0 = 256, N_T1A = 16 * 24, N_T1B = 16 * 8, N_TF = 64, N_TO1 = 256;
  constexpr int N_FOLD = 128, N_ALAT = 2048, N_ACTX = 256, N_CACHE = 64, N_SSM = 64, N_ZERO = 48, N_ROPE = 4;
  constexpr int B_T0 = N_ADA, B_TG = B_T0 + N_T0, B_TO0 = B_TG + N_TG, B_T1A = B_TO0 + N_TO0, B_T1B = B_T1A + N_T1A,
                B_TF = B_T1B + N_T1B, B_TO1 = B_TF + N_TF, B_FOLD = B_TO1 + N_TO1, B_ALAT = B_FOLD + N_FOLD,
                B_ACTX = B_ALAT + N_ALAT, B_CACHE = B_ACTX + N_ACTX, B_SSM = B_CACHE + N_CACHE, B_ZERO = B_SSM + N_SSM,
                B_ROPE = B_ZERO + N_ZERO, N_ALL = B_ROPE + N_ROPE;
  for (int it = blockIdx.x; it < N_ALL; it += gridDim.x) {
    __syncthreads();
    if (it < B_T0) {
      const int l = it / 96, cgp = it % 96;
      float* sc = smf;
      float* red = smf + 3072;
      for (int e = tid; e < 3072; e += 256) {
        const int ci = e >> 10, k = e & 1023;
        const float cv = ci == 0 ? p.in[6][k] : p.in[5][(ci - 1) * 1024 + k];
        sc[e] = silu_f(cv);
      }
      __syncthreads();
      const int cq = tid & 7, rg = tid >> 3;
      const float* w = p.in[7] + (size_t)l * 1024 * 3072 + cgp * 32 + cq * 4;
      float4 a0 = make_float4(0.f, 0.f, 0.f, 0.f), a1 = a0, a2 = a0;
#pragma unroll 16
      for (int k = rg; k < 1024; k += 32) {
        const float4 wv = *(const float4*)(w + (size_t)k * 3072);
        const float s0 = sc[k], s1 = sc[1024 + k], s2 = sc[2048 + k];
        a0.x += s0 * wv.x; a0.y += s0 * wv.y; a0.z += s0 * wv.z; a0.w += s0 * wv.w;
        a1.x += s1 * wv.x; a1.y += s1 * wv.y; a1.z += s1 * wv.z; a1.w += s1 * wv.w;
        a2.x += s2 * wv.x; a2.y += s2 * wv.y; a2.z += s2 * wv.z; a2.w += s2 * wv.w;
      }
      *(float4*)(red + (0 * 32 + rg) * 32 + cq * 4) = a0;
      *(float4*)(red + (1 * 32 + rg) * 32 + cq * 4) = a1;
      *(float4*)(red + (2 * 32 + rg) * 32 + cq * 4) = a2;
      __syncthreads();
      if (tid < 96) {
        const int c2 = tid & 31, ci = tid >> 5;
        float s = 0.f;
#pragma unroll
        for (int q = 0; q < 32; ++q) s += red[(ci * 32 + q) * 32 + c2];
        const int n2 = cgp * 32 + c2;
        ((float*)(ws + OFF_MOD))[(l * 3 + ci) * 3072 + n2] = s + p.in[8][l * 3072 + n2];
      }
    } else if (it < B_FOLD) {
      const float* W; int ldw, nbase_off = 0, trow_off = 0, ntn, ldt; bfr* WT; int r;
      if (it < B_TG)        { r = it - B_T0;  W = p.in[11]; ldw = 2304; ntn = 36; WT = (bfr*)(ws + OFF_WIN0); ldt = 1024; }
      else if (it < B_TO0)  { r = it - B_TG;  W = p.in[22]; ldw = 512;  ntn = 8;  WT = (bfr*)(ws + OFF_GLU); ldt = 512; }
      else if (it < B_T1A)  { r = it - B_TO0; W = p.in[24]; ldw = 1024; ntn = 16; WT = (bfr*)(ws + OFF_WOUT0); ldt = 1024; }
      else if (it < B_T1B)  { r = it - B_T1A; W = p.in[25]; ldw = 2560; ntn = 24; WT = (bfr*)(ws + OFF_WIN1); ldt = 1024; }
      else if (it < B_TF)   { r = it - B_T1B; W = p.in[25]; ldw = 2560; ntn = 8;  WT = (bfr*)(ws + OFF_WIN1); ldt = 1024; nbase_off = 2048; trow_off = 2560; }
      else if (it < B_TO1)  { r = it - B_TF;  W = p.in[29]; ldw = 512;  ntn = 8;  WT = (bfr*)(ws + OFF_FNET); ldt = 512; }
      else                  { r = it - B_TO1; W = p.in[30]; ldw = 1024; ntn = 16; WT = (bfr*)(ws + OFF_WOUT1); ldt = 1024; }
      const int kb = r / ntn, nb = r % ntn;
      transpose_tile(W, ldw, kb * 64, nbase_off + nb * 64, WT, ldt, trow_off + nb * 64, smf);
    } else if (it < B_ALAT) {
      const int r = it - B_FOLD, cs = r & 1, kb = (r >> 1) & 15, g = r >> 5;
      float* tile = smf;
      float* tw = smf + 128 * 68;
      const float* W = p.in[25];
      {
        const int c4 = (tid & 31) * 4, kr = tid >> 5;
#pragma unroll
        for (int i = 0; i < 8; ++i) {
          const int k = kr + 8 * i;
          const float4 v = *(const float4*)(W + (size_t)(kb * 64 + k) * 2560 + 1536 + g * 128 + c4);
          tile[(c4 + 0) * 68 + k] = v.x; tile[(c4 + 1) * 68 + k] = v.y; tile[(c4 + 2) * 68 + k] = v.z; tile[(c4 + 3) * 68 + k] = v.w;
        }
        if (tid < 128) {
          const float a = 2.f * (float)tid / 128.f;
          tw[tid] = (cs == 0 ? cospif(a) : sinpif(a)) * 0.08838834764831845f;
        }
      }
      __syncthreads();
      const int j = tid & 127, kg = tid >> 7;
      float acc[32];
#pragma unroll
      for (int i = 0; i < 32; ++i) acc[i] = 0.f;
      for (int c = 0; c < 128; ++c) {
        const float t = tw[(j * c) & 127];
        const float4* tp = (const float4*)(tile + c * 68 + kg * 32);
#pragma unroll
        for (int q = 0; q < 8; ++q) {
          const float4 v = tp[q];
          acc[4 * q + 0] += v.x * t; acc[4 * q + 1] += v.y * t; acc[4 * q + 2] += v.z * t; acc[4 * q + 3] += v.w * t;
        }
      }
      uint4* dst = (uint4*)((bfr*)(ws + OFF_WIN1) + (size_t)(1536 + cs * 512 + g * 128 + j) * 1024 + kb * 64 + kg * 32);
#pragma unroll
      for (int q = 0; q < 4; ++q)
        dst[q] = make_uint4(pk2(acc[8 * q], acc[8 * q + 1]), pk2(acc[8 * q + 2], acc[8 * q + 3]), pk2(acc[8 * q + 4], acc[8 * q + 5]), pk2(acc[8 * q + 6], acc[8 * q + 7]));
    } else if (it < B_ACTX) {
      const int t = it - B_ALAT;
      bfr* dst = (bfr*)(ws + OFF_ALAT) + (size_t)t * 4096;
      const float nrm = 0.02209708691207961f;
#pragma unroll
      for (int half = 0; half < 2; ++half) {
        const int k0 = half * 2048 + tid * 8;
        unsigned o[4];
#pragma unroll
        for (int j = 0; j < 4; ++j) {
          float v[2];
#pragma unroll
          for (int e = 0; e < 2; ++e) {
            const int k = k0 + 2 * j + e;
            const int m = (t * (k & 2047)) & 2047;
            const float a = (float)m * (2.f / 2048.f);
            v[e] = (k < 2048 ? cospif(a) : -sinpif(a)) * nrm;
          }
          o[j] = pk2(v[0], v[1]);
        }
        *(uint4*)(dst + k0) = make_uint4(o[0], o[1], o[2], o[3]);
      }
    } else if (it < B_CACHE) {
      const int t = it - B_ACTX;
      bfr* dst = (bfr*)(ws + OFF_ACTX) + (size_t)t * 512;
      const float nrm = 0.0625f;
      float v[2];
#pragma unroll
      for (int e = 0; e < 2; ++e) {
        const int k = tid * 2 + e;
        const int m = (t * (k & 255)) & 255;
        const float a = (float)m * (2.f / 256.f);
        v[e] = (k < 256 ? cospif(a) : -sinpif(a)) * nrm;
      }
      *(unsigned*)(dst + tid * 2) = pk2(v[0], v[1]);
    } else if (it < B_SSM) {
      const int r = it - B_CACHE;
#pragma unroll
      for (int i = 0; i < 8; ++i) {
        const int e = r * 2048 + tid + 256 * i;
        const int d = e & 63, kvh = (e >> 6) & 1, key = (e >> 7) & 511, b = e >> 16;
        ((bfr*)(ws + OFF_KL))[((size_t)(b * 2 + kvh) * 2560 + key) * 64 + d] = f2bf(p.in[2][e]);
        ((bfr*)(ws + OFF_VL))[((size_t)(b * 2 + kvh) * 64 + d) * 2560 + key] = f2bf(p.in[3][e]);
      }
    } else if (it < B_ZERO) {
      const int dg = it - B_SSM;
      const int pp = tid & 63, part = tid >> 6;
      const double lr = (double)p.in[14][dg * 64 + pp], li = (double)p.in[15][dg * 64 + pp];
      const double dt = (double)__expf(p.in[16][dg]) ;
      const float dtf = expf(p.in[16][dg]);
      const double dtd = (double)dtf;
      (void)dt;
      const double PI = 3.14159265358979323846;
      double ap = li * dtd / PI;
      double ar = ap - 2.0 * rint(ap * 0.5);
      const float er = expf((float)(lr * dtd));
      const double lbr = (double)er * (double)cospif((float)ar), lbi = (double)er * (double)sinpif((float)ar);
      double ap2 = ap * 256.0;
      double ar2 = ap2 - 2.0 * rint(ap2 * 0.5);
      const float er2 = expf((float)(lr * dtd * 256.0));
      if (part == 0) {
        ((float2*)(ws + OFF_LAMB))[dg * 64 + pp] = make_float2((float)lbr, (float)lbi);
        ((float2*)(ws + OFF_LAMP))[dg * 64 + pp] = make_float2(er2 * cospif((float)ar2), er2 * sinpif((float)ar2));
      }
      const double den = lr * lr + li * li;
      const double fr = ((lbr - 1.0) * lr + lbi * li) / den, fi = (lbi * lr - (lbr - 1.0) * li) / den;
      float* bb = (float*)(ws + OFF_BB) + (size_t)(dg * 64 + pp) * 32;
#pragma unroll
      for (int q = 0; q < 4; ++q) {
        const int c = part * 4 + q;
        const double br = (double)p.in[17][(size_t)(dg * 64 + pp) * 16 + c], bi = (double)p.in[18][(size_t)(dg * 64 + pp) * 16 + c];
        bb[c] = (float)(fr * br - fi * bi);
        bb[16 + c] = (float)(fr * bi + fi * br);
      }
      bfr* cm = (bfr*)(ws + OFF_CMB) + (size_t)dg * 2048;
#pragma unroll
      for (int q = 0; q < 8; ++q) {
        const int e = tid * 8 + q, c = e >> 7, k = e & 127;
        const float v = k < 64 ? p.in[19][(size_t)(dg * 16 + c) * 64 + k] : -p.in[20][(size_t)(dg * 16 + c) * 64 + (k - 64)];
        cm[e] = f2bf(v);
      }
    } else if (it < B_ROPE) {
      const int r = it - B_ZERO;
      ((float*)(ws + OFF_ROWSS))[r * 256 + tid] = 0.f;
    } else {
      const int e = (it - B_ROPE) * 256 + tid;
      const int n = e >> 4, pr = e & 15;
      const double q4[4] = {1.0, 0.5623413251903491, 0.31622776601683794, 0.1778279410038923};
      double inv = q4[0];
      if ((pr & 3) == 1) inv = q4[1]; else if ((pr & 3) == 2) inv = q4[2]; else if ((pr & 3) == 3) inv = q4[3];
      const int dec = pr >> 2;
      if (dec == 1) inv *= 0.1; else if (dec == 2) inv *= 0.01; else if (dec == 3) inv *= 0.001;
      const double ap = (double)n * inv / 3.14159265358979323846;
      const double ar = ap - 2.0 * rint(ap * 0.5);
      ((float2*)(ws + OFF_ROPE))[e] = make_float2(cospif((float)ar), sinpif((float)ar));
    }
  }
}

template <int MODE>
DI void phase_rows(const Params& p) {
  unsigned char* ws = p.ws;
  const int lane = threadIdx.x & 63, wave = threadIdx.x >> 6;
  const float* mod = (const float*)(ws + OFF_MOD);
  for (int it = blockIdx.x; it < NTOK / 4; it += gridDim.x) {
    const int T = it * 4 + wave;
    const int ci = cond_of(T);
    float4 xv[4];
    if (MODE == 2) {
      const bfr* xr = (const bfr*)(ws + OFF_X1) + (size_t)T * 1024 + lane * 4;
#pragma unroll
      for (int j = 0; j < 4; ++j) {
        const uint2 raw = *(const uint2*)(xr + 256 * j);
        xv[j].x = bf2f(raw.x & 0xffff); xv[j].y = bf2f(raw.x >> 16); xv[j].z = bf2f(raw.y & 0xffff); xv[j].w = bf2f(raw.y >> 16);
      }
    } else {
      const float4* xr = (const float4*)xrow(p, T) + lane;
#pragma unroll
      for (int j = 0; j < 4; ++j) xv[j] = xr[64 * j];
    }
    if (MODE >= 1) {
      const int l = MODE - 1;
      const bfr* orow = (const bfr*)(ws + OFF_O) + (size_t)T * 1024;
      float4 ov[4]; float ss = 0.f;
#pragma unroll
      for (int j = 0; j < 4; ++j) {
        const uint2 raw = *(const uint2*)(orow + lane * 4 + 256 * j);
        ov[j].x = bf2f(raw.x & 0xffff); ov[j].y = bf2f(raw.x >> 16); ov[j].z = bf2f(raw.y & 0xffff); ov[j].w = bf2f(raw.y >> 16);
        ss += ov[j].x * ov[j].x + ov[j].y * ov[j].y + ov[j].z * ov[j].z + ov[j].w * ov[j].w;
      }
      const float rinv = rsqrtf(wave_sum(ss) * (1.f / 1024.f) + EPS);
      const float* gate = mod + (l * 3 + ci) * 3072 + 2048;
      const float* gp = p.in[10] + l * 1024;
#pragma unroll
      for (int j = 0; j < 4; ++j) {
        const int k = lane * 4 + 256 * j;
        const float4 g4 = *(const float4*)(gate + k), n4 = *(const float4*)(gp + k);
        xv[j].x += g4.x * (ov[j].x * rinv * n4.x); xv[j].y += g4.y * (ov[j].y * rinv * n4.y);
        xv[j].z += g4.z * (ov[j].z * rinv * n4.z); xv[j].w += g4.w * (ov[j].w * rinv * n4.w);
      }
      if (MODE == 2) {
        float4* yr = (float4*)(p.out + OUT_Y + (size_t)T * 1024) + lane;
#pragma unroll
        for (int j = 0; j < 4; ++j) yr[64 * j] = xv[j];
      } else {
        bfr* x1r = (bfr*)(ws + OFF_X1) + (size_t)T * 1024 + lane * 4;
#pragma unroll
        for (int j = 0; j < 4; ++j) *(uint2*)(x1r + 256 * j) = make_uint2(pk2(xv[j].x, xv[j].y), pk2(xv[j].z, xv[j].w));
      }
    }
    if (MODE <= 1) {
      const int l = MODE;
      float ss = 0.f;
#pragma unroll
      for (int j = 0; j < 4; ++j) ss += xv[j].x * xv[j].x + xv[j].y * xv[j].y + xv[j].z * xv[j].z + xv[j].w * xv[j].w;
      const float rinv = rsqrtf(wave_sum(ss) * (1.f / 1024.f) + EPS);
      const float* shift = mod + (l * 3 + ci) * 3072;
      const float* scale = shift + 1024;
      const float* gp = p.in[9] + l * 1024;
      bfr* hr = (bfr*)(ws + OFF_HN) + (size_t)T * 1024;
#pragma unroll
      for (int j = 0; j < 4; ++j) {
        const int k = lane * 4 + 256 * j;
        const float4 s4 = *(const float4*)(shift + k), c4 = *(const float4*)(scale + k), n4 = *(const float4*)(gp + k);
        const float a = xv[j].x * rinv * n4.x * (1.f + c4.x) + s4.x;
        const float b = xv[j].y * rinv * n4.y * (1.f + c4.y) + s4.y;
        const float c = xv[j].z * rinv * n4.z * (1.f + c4.z) + s4.z;
        const float d = xv[j].w * rinv * n4.w * (1.f + c4.w) + s4.w;
        *(uint2*)(hr + k) = make_uint2(pk2(a, b), pk2(c, d));
      }
    }
  }
}

DI void phase_win0(const Params& p, unsigned char* smem) {
  unsigned char* ws = p.ws;
  const int lane = threadIdx.x & 63, wave = threadIdx.x >> 6, l32 = lane & 31, h = lane >> 5, wm = wave >> 1, wn = wave & 1;
  const bfr* A = (const bfr*)(ws + OFF_HN);
  const bfr* Bt = (const bfr*)(ws + OFF_WIN0);
  int tm, tn;
  if (!xcd_tile(0, 18, tm, tn)) return;
  LdBf al{A + (size_t)tm * 128 * 1024, 1024}, bl{Bt + (size_t)tn * 128 * 1024, 1024};
  for (int step = 0;; ++step) {
    const int m0 = tm * 128, n0 = tn * 128;
    int tm2 = 0, tn2 = 0;
    auto next_tile = [&]() {
      if (!xcd_tile(step + 1, 18, tm2, tn2)) return false;
      al.base = A + (size_t)tm2 * 128 * 1024; bl.base = Bt + (size_t)tn2 * 128 * 1024;
      return true;
    };
    auto ep = [&](f32x16 (&acc)[2][2]) {
      const int colbase = n0 + wn * 64, rbase = m0 + wm * 64;
      const bool lat = m0 >= NCTX;
      if (tn == 5) {
        const int hd = (colbase - 640) >> 6;
#pragma unroll
        for (int mi = 0; mi < 2; ++mi)
#pragma unroll
          for (int ni = 0; ni < 2; ++ni) {
            const int d = ni * 32 + l32;
#pragma unroll
            for (int i4 = 0; i4 < 4; ++i4) {
              const int r0 = rbase + mi * 32 + 8 * i4 + 4 * h;
              const float a = acc[mi][ni][4 * i4], b2 = acc[mi][ni][4 * i4 + 1], c = acc[mi][ni][4 * i4 + 2], e = acc[mi][ni][4 * i4 + 3];
              const uint2 pk = make_uint2(pk2(a, b2), pk2(c, e));
              if (!lat) {
                p.out[OUT_V + (size_t)(r0 + 0) * 128 + hd * 64 + d] = a;
                p.out[OUT_V + (size_t)(r0 + 1) * 128 + hd * 64 + d] = b2;
                p.out[OUT_V + (size_t)(r0 + 2) * 128 + hd * 64 + d] = c;
                p.out[OUT_V + (size_t)(r0 + 3) * 128 + hd * 64 + d] = e;
                const int b = r0 >> 8, l = r0 & 255;
                *(uint2*)((bfr*)(ws + OFF_VC) + ((size_t)(b * 2 + hd) * 64 + d) * 256 + l) = pk;
              } else {
                const int b = (r0 - NCTX) >> 11, l = (r0 - NCTX) & 2047;
                *(uint2*)((bfr*)(ws + OFF_VL) + ((size_t)(b * 2 + hd) * 64 + d) * 2560 + 512 + l) = pk;
              }
            }
          }
      } else if (colbase < 640) {
        const bool isq = colbase < 512;
        const float* gain = isq ? p.in[12] : p.in[13];
        const int hd = isq ? (colbase >> 6) : ((colbase - 512) >> 6);
        float4 gv[2][4];
#pragma unroll
        for (int mi = 0; mi < 2; ++mi)
#pragma unroll
          for (int i4 = 0; i4 < 4; ++i4) gv[mi][i4] = *(const float4*)(gain + mi * 32 + 8 * i4 + 4 * h);
#pragma unroll
        for (int ni = 0; ni < 2; ++ni) {
          const int T = rbase + ni * 32 + l32;
          float ss = 0.f;
#pragma unroll
          for (int mi = 0; mi < 2; ++mi)
#pragma unroll
            for (int i = 0; i < 16; ++i) ss += acc[mi][ni][i] * acc[mi][ni][i];
          ss += __shfl_xor(ss, 32);
          const float rinv = rsqrtf(ss * (1.f / 64.f) + EPS);
          float v[2][16];
#pragma unroll
          for (int mi = 0; mi < 2; ++mi)
#pragma unroll
            for (int i4 = 0; i4 < 4; ++i4) {
              v[mi][4 * i4 + 0] = acc[mi][ni][4 * i4 + 0] * rinv * gv[mi][i4].x;
              v[mi][4 * i4 + 1] = acc[mi][ni][4 * i4 + 1] * rinv * gv[mi][i4].y;
              v[mi][4 * i4 + 2] = acc[mi][ni][4 * i4 + 2] * rinv * gv[mi][i4].z;
              v[mi][4 * i4 + 3] = acc[mi][ni][4 * i4 + 3] * rinv * gv[mi][i4].w;
            }
          if (!lat && !isq) {
#pragma unroll
            for (int mi = 0; mi < 2; ++mi)
#pragma unroll
              for (int i4 = 0; i4 < 4; ++i4)
                *(float4*)(p.out + OUT_K + (size_t)T * 128 + hd * 64 + mi * 32 + 8 * i4 + 4 * h) = make_float4(v[mi][4 * i4], v[mi][4 * i4 + 1], v[mi][4 * i4 + 2], v[mi][4 * i4 + 3]);
          }
          if (lat) {
            const int pos = (T - NCTX) & 2047;
            const float* rope = (const float*)(ws + OFF_ROPE);
#pragma unroll
            for (int mi = 0; mi < 2; ++mi) {
              const float* rb = rope + ((mi == 0 ? (pos >> 6) : (pos & 63)) * 16 + 4 * h) * 2;
#pragma unroll
              for (int i4 = 0; i4 < 2; ++i4) {
                const float4 cs0 = *(const float4*)(rb + 16 * i4), cs1 = *(const float4*)(rb + 16 * i4 + 4);
                const float cc[4] = {cs0.x, cs0.z, cs1.x, cs1.z}, sn[4] = {cs0.y, cs0.w, cs1.y, cs1.w};
#pragma unroll
                for (int e = 0; e < 4; ++e) {
                  const float x1 = v[mi][4 * i4 + e], x2 = v[mi][4 * i4 + e + 8];
                  v[mi][4 * i4 + e] = x1 * cc[e] - x2 * sn[e];
                  v[mi][4 * i4 + e + 8] = x1 * sn[e] + x2 * cc[e];
                }
              }
            }
          }
          bfr* dst;
          float sc = 1.f;
          if (isq) { dst = (bfr*)(ws + OFF_QB) + (size_t)T * 512 + hd * 64; sc = 0.125f; }
          else if (!lat) { dst = (bfr*)(ws + OFF_KC) + ((size_t)((T >> 8) * 2 + hd) * 256 + (T & 255)) * 64; }
          else { dst = (bfr*)(ws + OFF_KL) + ((size_t)(((T - NCTX) >> 11) * 2 + hd) * 2560 + 512 + ((T - NCTX) & 2047)) * 64; }
#pragma unroll
          for (int mi = 0; mi < 2; ++mi)
#pragma unroll
            for (int i4 = 0; i4 < 4; ++i4)
              *(uint2*)(dst + mi * 32 + 8 * i4 + 4 * h) = make_uint2(pk2(v[mi][4 * i4] * sc, v[mi][4 * i4 + 1] * sc), pk2(v[mi][4 * i4 + 2] * sc, v[mi][4 * i4 + 3] * sc));
        }
      } else {
        const int sec = colbase < 1280 ? 0 : (colbase < 1792 ? 1 : 2);
        const int cb = colbase - (sec == 0 ? 768 : (sec == 1 ? 1280 : 1792));
        if (sec == 1) {
#pragma unroll
          for (int ni = 0; ni < 2; ++ni) {
            const int T = rbase + ni * 32 + l32;
#pragma unroll
            for (int mi = 0; mi < 2; ++mi)
#pragma unroll
              for (int i4 = 0; i4 < 4; ++i4)
                *(float4*)((float*)(ws + OFF_U) + (size_t)T * 512 + cb + mi * 32 + 8 * i4 + 4 * h) =
                    make_float4(acc[mi][ni][4 * i4], acc[mi][ni][4 * i4 + 1], acc[mi][ni][4 * i4 + 2], acc[mi][ni][4 * i4 + 3]);
          }
        } else {
          unsigned short* stg = (unsigned short*)smem;
#pragma unroll
          for (int ni = 0; ni < 2; ++ni) {
            const int row = wm * 64 + ni * 32 + l32;
#pragma unroll
            for (int mi = 0; mi < 2; ++mi)
#pragma unroll
              for (int i4 = 0; i4 < 4; ++i4) {
                const float a = acc[mi][ni][4 * i4], b2 = acc[mi][ni][4 * i4 + 1], c2 = acc[mi][ni][4 * i4 + 2], e = acc[mi][ni][4 * i4 + 3];
                *(uint2*)(stg + row * 136 + wn * 64 + mi * 32 + 8 * i4 + 4 * h) = make_uint2(pk2(silu_f(a), silu_f(b2)), pk2(silu_f(c2), silu_f(e)));
              }
          }
          __syncthreads();
          bfr* dbase = (bfr*)(ws + (sec == 0 ? OFF_GA : OFF_GB)) + (size_t)m0 * 512 + (n0 - (sec == 0 ? 768 : 1792));
#pragma unroll
          for (int i = 0; i < 8; ++i) {
            const int id = threadIdx.x + 256 * i, r = id >> 4, c16 = id & 15;
            *(uint4*)(dbase + (size_t)r * 512 + c16 * 8) = *(const uint4*)(stg + r * 136 + c16 * 8);
          }
        }
      }
    };
    al.base = A + (size_t)m0 * 1024; bl.base = Bt + (size_t)n0 * 1024;
    gemm_tile<128>(16, tn != 5, al, bl, ep, smem);
    if (!next_tile()) break;
    tm = tm2; tn = tn2;
  }
}

DI void attn_item(const Params& p, unsigned char* smem, int it) {
  unsigned char* ws = p.ws;
  const int tid = threadIdx.x, lane = tid & 63, wave = tid >> 6, l32 = lane & 31, h = lane >> 5;
  int T0, nkeys, ldv; const bfr *Kp, *Vp; int kvh;
  if (it < 256) {
    const int b = it >> 7, qt = it & 63; kvh = (it >> 6) & 1;
    T0 = NCTX + b * 2048 + qt * 32; nkeys = 2560; ldv = 2560;
    Kp = (const bfr*)(ws + OFF_KL) + (size_t)(b * 2 + kvh) * 2560 * 64;
    Vp = (const bfr*)(ws + OFF_VL) + (size_t)(b * 2 + kvh) * 64 * 2560;
  } else {
    const int i2 = it - 256; const int b = i2 >> 4, qt = i2 & 7; kvh = (i2 >> 3) & 1;
    T0 = b * 256 + qt * 32; nkeys = 256; ldv = 256;
    Kp = (const bfr*)(ws + OFF_KC) + (size_t)(b * 2 + kvh) * 256 * 64;
    Vp = (const bfr*)(ws + OFF_VC) + (size_t)(b * 2 + kvh) * 64 * 256;
  }
  const int head = kvh * 4 + wave;
  unsigned short* Ks = (unsigned short*)smem;
  unsigned short* Vs = Ks + 64 * 72;
  bf16x8 qf[4];
  {
    const bfr* q = (const bfr*)(ws + OFF_QB) + (size_t)(T0 + l32) * 512 + head * 64 + 8 * h;
#pragma unroll
    for (int ks = 0; ks < 4; ++ks) qf[ks] = *(const bf16x8*)(q + 16 * ks);
  }
  float m = -1e30f, lsum = 0.f;
  f32x16 O[2];
#pragma unroll
  for (int i = 0; i < 16; ++i) { O[0][i] = 0.f; O[1][i] = 0.f; }
  const int rr0 = tid >> 3, cc0 = (tid & 7) * 8;
  const bfr* kp0 = Kp + (size_t)rr0 * 64 + cc0;
  const bfr* vp0 = Vp + (size_t)rr0 * ldv + cc0;
  uint4 kreg0 = *(const uint4*)kp0, kreg1 = *(const uint4*)(kp0 + 32 * 64);
  uint4 vreg0 = *(const uint4*)vp0, vreg1 = *(const uint4*)(vp0 + (size_t)32 * ldv);
  for (int k0 = 0; k0 < nkeys; k0 += 64) {
    __syncthreads();
    *(uint4*)(Ks + rr0 * 72 + cc0) = kreg0; *(uint4*)(Ks + (rr0 + 32) * 72 + cc0) = kreg1;
    *(uint4*)(Vs + rr0 * 72 + cc0) = vreg0; *(uint4*)(Vs + (rr0 + 32) * 72 + cc0) = vreg1;
    __syncthreads();
    if (k0 + 64 < nkeys) {
      kreg0 = *(const uint4*)(kp0 + (size_t)(k0 + 64) * 64); kreg1 = *(const uint4*)(kp0 + (size_t)(k0 + 96) * 64);
      vreg0 = *(const uint4*)(vp0 + k0 + 64); vreg1 = *(const uint4*)(vp0 + (size_t)32 * ldv + k0 + 64);
    }
    f32x16 st[2];
#pragma unroll
    for (int kt = 0; kt < 2; ++kt) {
#pragma unroll
      for (int i = 0; i < 16; ++i) st[kt][i] = 0.f;
#pragma unroll
      for (int ks = 0; ks < 4; ++ks) {
        const bf16x8 a = *(const bf16x8*)(Ks + (32 * kt + l32) * 72 + 16 * ks + 8 * h);
        st[kt] = MFMA32(a, qf[ks], st[kt]);
      }
    }
    float mx = st[0][0];
#pragma unroll
    for (int i = 0; i < 16; ++i) { mx = fmaxf(mx, st[0][i]); mx = fmaxf(mx, st[1][i]); }
    mx = fmaxf(mx, __shfl_xor(mx, 32));
    const float mn = fmaxf(m, mx);
    const float alpha = __expf(m - mn);
    m = mn;
    float ps = 0.f;
#pragma unroll
    for (int kt = 0; kt < 2; ++kt)
#pragma unroll
      for (int i = 0; i < 16; ++i) { const float e = __expf(st[kt][i] - mn); st[kt][i] = e; ps += e; }
    lsum = lsum * alpha + ps;
#pragma unroll
    for (int i = 0; i < 16; ++i) { O[0][i] *= alpha; O[1][i] *= alpha; }
#pragma unroll
    for (int kt = 0; kt < 2; ++kt)
#pragma unroll
      for (int s = 0; s < 2; ++s) {
        const uint4 pu = make_uint4(pk2(st[kt][8 * s], st[kt][8 * s + 1]), pk2(st[kt][8 * s + 2], st[kt][8 * s + 3]),
                                    pk2(st[kt][8 * s + 4], st[kt][8 * s + 5]), pk2(st[kt][8 * s + 6], st[kt][8 * s + 7]));
        const bf16x8 pf = __builtin_bit_cast(bf16x8, pu);
#pragma unroll
        for (int dt = 0; dt < 2; ++dt) {
          const unsigned short* vr = Vs + (32 * dt + l32) * 72 + 32 * kt + 16 * s + 4 * h;
          const s16x4 lo = *(const s16x4*)vr, hi = *(const s16x4*)(vr + 8);
          const bf16x8 va = __builtin_shufflevector(lo, hi, 0, 1, 2, 3, 4, 5, 6, 7);
          O[dt] = MFMA32(va, pf, O[dt]);
        }
      }
  }
  const float ltot = lsum + __shfl_xor(lsum, 32);
  const float inv = 1.f / ltot;
  const int T = T0 + l32;
#pragma unroll
  for (int dt = 0; dt < 2; ++dt)
#pragma unroll
    for (int i4 = 0; i4 < 4; ++i4) {
      const int d = 32 * dt + 8 * i4 + 4 * h;
      const uint2 g = *(const uint2*)((const bfr*)(ws + OFF_GA) + (size_t)T * 512 + head * 64 + d);
      const float a = O[dt][4 * i4] * inv * bf2f(g.x & 0xffff), b = O[dt][4 * i4 + 1] * inv * bf2f(g.x >> 16);
      const float c = O[dt][4 * i4 + 2] * inv * bf2f(g.y & 0xffff), e = O[dt][4 * i4 + 3] * inv * bf2f(g.y >> 16);
      *(uint2*)((bfr*)(ws + OFF_MIX) + (size_t)T * 1024 + head * 64 + d) = make_uint2(pk2(a, b), pk2(c, e));
    }
}

DI void attn_lat_item(const Params& p, unsigned char* smem, int it) {
  unsigned char* ws = p.ws;
  const int tid = threadIdx.x, lane = tid & 63, wave = tid >> 6, l32 = lane & 31, h = lane >> 5;
  const int b = it >> 8, kvh = (it >> 7) & 1, qt = (it >> 1) & 63, hp = it & 1;
  const int hw = wave & 1, kh = wave >> 1;
  const int T0 = NCTX + b * 2048 + qt * 32;
  const int head = kvh * 4 + hp * 2 + hw;
  const bfr* Kp = (const bfr*)(ws + OFF_KL) + ((size_t)(b * 2 + kvh) * 2560 + kh * 1280) * 64;
  const bfr* Vp = (const bfr*)(ws + OFF_VL) + (size_t)(b * 2 + kvh) * 64 * 2560 + kh * 1280;
  unsigned short* Ks = (unsigned short*)smem + kh * (2 * 64 * 72);
  unsigned short* Vs = Ks + 64 * 72;
  bf16x8 qf[4];
  {
    const bfr* q = (const bfr*)(ws + OFF_QB) + (size_t)(T0 + l32) * 512 + head * 64 + 8 * h;
#pragma unroll
    for (int ks = 0; ks < 4; ++ks) qf[ks] = *(const bf16x8*)(q + 16 * ks);
  }
  float m = -1e30f, lsum = 0.f;
  f32x16 O[2];
#pragma unroll
  for (int i = 0; i < 16; ++i) { O[0][i] = 0.f; O[1][i] = 0.f; }
  const int t2 = tid & 127, rr0 = t2 >> 3, cc0 = (t2 & 7) * 8;
  const bfr* kp0 = Kp + (size_t)rr0 * 64 + cc0;
  const bfr* vp0 = Vp + (size_t)rr0 * 2560 + cc0;
  uint4 kr0 = *(const uint4*)kp0, kr1 = *(const uint4*)(kp0 + 16 * 64), kr2 = *(const uint4*)(kp0 + 32 * 64), kr3 = *(const uint4*)(kp0 + 48 * 64);
  uint4 vr0 = *(const uint4*)vp0, vr1 = *(const uint4*)(vp0 + (size_t)16 * 2560), vr2 = *(const uint4*)(vp0 + (size_t)32 * 2560), vr3 = *(const uint4*)(vp0 + (size_t)48 * 2560);
  for (int k0 = 0; k0 < 1280; k0 += 64) {
    __syncthreads();
    *(uint4*)(Ks + rr0 * 72 + cc0) = kr0; *(uint4*)(Ks + (rr0 + 16) * 72 + cc0) = kr1; *(uint4*)(Ks + (rr0 + 32) * 72 + cc0) = kr2; *(uint4*)(Ks + (rr0 + 48) * 72 + cc0) = kr3;
    *(uint4*)(Vs + rr0 * 72 + cc0) = vr0; *(uint4*)(Vs + (rr0 + 16) * 72 + cc0) = vr1; *(uint4*)(Vs + (rr0 + 32) * 72 + cc0) = vr2; *(uint4*)(Vs + (rr0 + 48) * 72 + cc0) = vr3;
    __syncthreads();
    if (k0 + 64 < 1280) {
      const bfr* kq = kp0 + (size_t)(k0 + 64) * 64; const bfr* vq = vp0 + k0 + 64;
      kr0 = *(const uint4*)kq; kr1 = *(const uint4*)(kq + 16 * 64); kr2 = *(const uint4*)(kq + 32 * 64); kr3 = *(const uint4*)(kq + 48 * 64);
      vr0 = *(const uint4*)vq; vr1 = *(const uint4*)(vq + (size_t)16 * 2560); vr2 = *(const uint4*)(vq + (size_t)32 * 2560); vr3 = *(const uint4*)(vq + (size_t)48 * 2560);
    }
    f32x16 st[2];
#pragma unroll
    for (int kt = 0; kt < 2; ++kt) {
#pragma unroll
      for (int i = 0; i < 16; ++i) st[kt][i] = 0.f;
#pragma unroll
      for (int ks = 0; ks < 4; ++ks) {
        const bf16x8 a = *(const bf16x8*)(Ks + (32 * kt + l32) * 72 + 16 * ks + 8 * h);
        st[kt] = MFMA32(a, qf[ks], st[kt]);
      }
    }
    float mx = st[0][0];
#pragma unroll
    for (int i = 0; i < 16; ++i) { mx = fmaxf(mx, st[0][i]); mx = fmaxf(mx, st[1][i]); }
    mx = fmaxf(mx, __shfl_xor(mx, 32));
    const float mn = fmaxf(m, mx);
    const float alpha = __expf(m - mn);
    m = mn;
    float ps = 0.f;
#pragma unroll
    for (int kt = 0; kt < 2; ++kt)
#pragma unroll
      for (int i = 0; i < 16; ++i) { const float e = __expf(st[kt][i] - mn); st[kt][i] = e; ps += e; }
    lsum = lsum * alpha + ps;
#pragma unroll
    for (int i = 0; i < 16; ++i) { O[0][i] *= alpha; O[1][i] *= alpha; }
#pragma unroll
    for (int kt = 0; kt < 2; ++kt)
#pragma unroll
      for (int s = 0; s < 2; ++s) {
        const uint4 pu = make_uint4(pk2(st[kt][8 * s], st[kt][8 * s + 1]), pk2(st[kt][8 * s + 2], st[kt][8 * s + 3]),
                                    pk2(st[kt][8 * s + 4], st[kt][8 * s + 5]), pk2(st[kt][8 * s + 6], st[kt][8 * s + 7]));
        const bf16x8 pf = __builtin_bit_cast(bf16x8, pu);
#pragma unroll
        for (int dt = 0; dt < 2; ++dt) {
          const unsigned short* vr = Vs + (32 * dt + l32) * 72 + 32 * kt + 16 * s + 4 * h;
          const s16x4 lo = *(const s16x4*)vr, hi = *(const s16x4*)(vr + 8);
          const bf16x8 va = __builtin_shufflevector(lo, hi, 0, 1, 2, 3, 4, 5, 6, 7);
          O[dt] = MFMA32(va, pf, O[dt]);
        }
      }
  }
  float ltot = lsum + __shfl_xor(lsum, 32);
  float* xb = (float*)smem + (hw * 64 + lane) * 36;
  __syncthreads();
  if (kh == 1) {
#pragma unroll
    for (int i = 0; i < 16; ++i) { xb[i] = O[0][i]; xb[16 + i] = O[1][i]; }
    xb[32] = m; xb[33] = ltot;
  }
  __syncthreads();
  if (kh == 0) {
    const float m2 = xb[32], l2 = xb[33];
    const float mm = fmaxf(m, m2), a1 = __expf(m - mm), a2 = __expf(m2 - mm);
    ltot = ltot * a1 + l2 * a2;
    const float inv = 1.f / ltot;
#pragma unroll
    for (int i = 0; i < 16; ++i) { O[0][i] = (O[0][i] * a1 + xb[i] * a2) * inv; O[1][i] = (O[1][i] * a1 + xb[16 + i] * a2) * inv; }
    const int T = T0 + l32;
#pragma unroll
    for (int dt = 0; dt < 2; ++dt)
#pragma unroll
      for (int i4 = 0; i4 < 4; ++i4) {
        const int d = 32 * dt + 8 * i4 + 4 * h;
        const uint2 g = *(const uint2*)((const bfr*)(ws + OFF_GA) + (size_t)T * 512 + head * 64 + d);
        const float a = O[dt][4 * i4] * bf2f(g.x & 0xffff), bq = O[dt][4 * i4 + 1] * bf2f(g.x >> 16);
        const float c = O[dt][4 * i4 + 2] * bf2f(g.y & 0xffff), e = O[dt][4 * i4 + 3] * bf2f(g.y >> 16);
        *(uint2*)((bfr*)(ws + OFF_MIX) + (size_t)T * 1024 + head * 64 + d) = make_uint2(pk2(a, bq), pk2(c, e));
      }
  }
}

DI int seg_T0(int seg) { return seg < 32 ? seg * 256 : NCTX + ((seg - 32) >> 3) * 2048 + ((seg - 32) & 7) * 256; }

DI void split_bf16(const float4& v0, const float4& v1, bf16x8& hi, bf16x8& lo) {
  const unsigned h0 = pk2(v0.x, v0.y), h1 = pk2(v0.z, v0.w), h2 = pk2(v1.x, v1.y), h3 = pk2(v1.z, v1.w);
  hi = __builtin_bit_cast(bf16x8, make_uint4(h0, h1, h2, h3));
  const unsigned l0 = pk2(v0.x - bf2f(h0 & 0xffff), v0.y - bf2f(h0 >> 16)), l1 = pk2(v0.z - bf2f(h1 & 0xffff), v0.w - bf2f(h1 >> 16));
  const unsigned l2 = pk2(v1.x - bf2f(h2 & 0xffff), v1.y - bf2f(h2 >> 16)), l3 = pk2(v1.z - bf2f(h3 & 0xffff), v1.w - bf2f(h3 >> 16));
  lo = __builtin_bit_cast(bf16x8, make_uint4(l0, l1, l2, l3));
}

DI void s5_wave(const Params& p, float* BU  , int it) {
  unsigned char* ws = p.ws;
  const int lane = threadIdx.x & 63, l32 = lane & 31, h = lane >> 5;
  const int di = it & 1, g = (it >> 1) & 31, seg = it >> 6;
  const int T0 = seg_T0(seg);
  const int dg = di * 32 + g;
  bf16x8 bhi[4], blo[4];
#pragma unroll
  for (int nt = 0; nt < 4; ++nt) {
    const float* bb = (const float*)(ws + OFF_BB) + (size_t)(dg * 64 + (nt & 1) * 32 + l32) * 32 + (nt >> 1) * 16 + 8 * h;
    split_bf16(*(const float4*)bb, *(const float4*)(bb + 4), bhi[nt], blo[nt]);
  }
  const float2 lam = ((const float2*)(ws + OFF_LAMB))[dg * 64 + lane];
  bf16x8 cmf[4];
  {
    const bfr* cm = (const bfr*)(ws + OFF_CMB) + (size_t)dg * 2048 + (lane & 15) * 128 + 8 * (lane >> 4);
#pragma unroll
    for (int ks = 0; ks < 4; ++ks) cmf[ks] = *(const bf16x8*)(cm + 32 * ks);
  }
  float hr = 0.f, hi = 0.f;
  bfr* yout = (bfr*)(ws + (di == 0 ? OFF_YF : OFF_YB));
  const float* ubase = (const float*)(ws + OFF_U) + g * 16 + 8 * h;
  float4 u0, u1;
  { const int T = di == 0 ? T0 + l32 : T0 + 255 - l32; const float* up = ubase + (size_t)T * 512; u0 = *(const float4*)up; u1 = *(const float4*)(up + 4); }
  for (int c = 0; c < 8; ++c) {
    bf16x8 ahi, alo;
    split_bf16(u0, u1, ahi, alo);
    if (c < 7) { const int sg = 32 * (c + 1) + l32; const int T = di == 0 ? T0 + sg : T0 + 255 - sg; const float* up = ubase + (size_t)T * 512; u0 = *(const float4*)up; u1 = *(const float4*)(up + 4); }
#pragma unroll
    for (int nt = 0; nt < 4; ++nt) {
      f32x16 acc;
#pragma unroll
      for (int i = 0; i < 16; ++i) acc[i] = 0.f;
      acc = MFMA32(ahi, bhi[nt], acc);
      acc = MFMA32(alo, bhi[nt], acc);
      acc = MFMA32(ahi, blo[nt], acc);
#pragma unroll
      for (int i = 0; i < 16; ++i) BU[crow(i, h) * 132 + 32 * nt + l32] = acc[i];
    }
    __builtin_amdgcn_wave_barrier();
#pragma unroll 8
    for (int sl = 0; sl < 32; ++sl) {
      const float br = BU[sl * 132 + lane], bi = BU[sl * 132 + 64 + lane];
      const float nr = lam.x * hr - lam.y * hi + br;
      const float ni = lam.x * hi + lam.y * hr + bi;
      hr = nr; hi = ni;
      BU[sl * 132 + lane] = hr; BU[sl * 132 + 64 + lane] = hi;
    }
    __builtin_amdgcn_wave_barrier();
#pragma unroll
    for (int tt = 0; tt < 2; ++tt) {
      f32x4 acc = {0.f, 0.f, 0.f, 0.f};
      const float* hrow = BU + (16 * tt + (lane & 15)) * 132 + 8 * (lane >> 4);
#pragma unroll
      for (int ks = 0; ks < 4; ++ks) {
        const float4 v0 = *(const float4*)(hrow + 32 * ks), v1 = *(const float4*)(hrow + 32 * ks + 4);
        const bf16x8 a = __builtin_bit_cast(bf16x8, make_uint4(pk2(v0.x, v0.y), pk2(v0.z, v0.w), pk2(v1.x, v1.y), pk2(v1.z, v1.w)));
        acc = MFMA16(a, cmf[ks], acc);
      }
#pragma unroll
      for (int i = 0; i < 4; ++i) {
        const int sg = 32 * c + 16 * tt + 4 * (lane >> 4) + i;
        const int T = di == 0 ? T0 + sg : T0 + 255 - sg;
        yout[(size_t)T * 512 + g * 16 + (lane & 15)] = f2bf(acc[i]);
      }
    }
    __builtin_amdgcn_wave_barrier();
  }
  ((float2*)(ws + OFF_E))[((size_t)(seg * 2 + di) * 32 + g) * 64 + lane] = make_float2(hr, hi);
  if (seg < 32) {
    float* so = p.out + OUT_S + (size_t)((seg * 2 + di) * 2) * 2048 + g * 64 + lane;
    so[0] = hr; so[2048] = hi;
  }
}

DI void phase_mix0(const Params& p, unsigned char* smem) {
  constexpr int N_S5 = 3072;
  const int b = blockIdx.x, G = gridDim.x, wave = threadIdx.x >> 6;
  float* BUw = (float*)smem + wave * (32 * 132);
  if (G == 512) {
    attn_lat_item(p, smem, b);
    __syncthreads();
    if (b < 256) { for (int r = 0; r < 2; ++r) s5_wave(p, BUw, b * 8 + r * 4 + wave); }
    else s5_wave(p, BUw, 2048 + (b - 256) * 4 + wave);
    __syncthreads();
    attn_item(p, smem, 256 + b);
  } else {
    for (int it = b * 4 + wave; it < N_S5; it += G * 4) s5_wave(p, BUw, it);
    for (int it = b; it < 512; it += G) { __syncthreads(); attn_lat_item(p, smem, it); }
    for (int it = b; it < 512; it += G) { __syncthreads(); attn_item(p, smem, 256 + it); }
  }
}

DI void phase_s5fix(const Params& p, unsigned char* smem) {
  unsigned char* ws = p.ws;
  const int tid = threadIdx.x, lane = tid & 63, wave = tid >> 6;
  float* ycorr = (float*)smem;
  float* HC = (float*)smem + 4096 + wave * (16 * 132);
  for (int it = blockIdx.x; it < 48 * 32; it += gridDim.x) {
    const int g = it & 31, seg = it >> 5;
    const int T0 = seg_T0(seg);
    __syncthreads();
    if (seg >= 32) {
      for (int e = tid; e < 4096; e += 256) ycorr[e] = 0.f;
      __syncthreads();
      const int b = (seg - 32) >> 3, j = (seg - 32) & 7;
      const int di = wave & 1, half = wave >> 1;
      const int dg = di * 32 + g;
      const float2 lam = ((const float2*)(ws + OFF_LAMB))[dg * 64 + lane];
      const float2 lp = ((const float2*)(ws + OFF_LAMP))[dg * 64 + lane];
      const float* st = p.in[4] + (size_t)((b * 2 + di) * 2) * 2048 + g * 64 + lane;
      float hr = st[0], hi = st[2048];
      const int nprev = di == 0 ? j : 7 - j;
      float2 ev[7];
#pragma unroll
      for (int q = 0; q < 7; ++q) {
        const int jj = di == 0 ? q : 7 - q;
        ev[q] = ((const float2*)(ws + OFF_E))[((size_t)((32 + b * 8 + jj) * 2 + di) * 32 + g) * 64 + lane];
      }
#pragma unroll
      for (int q = 0; q < 7; ++q) {
        if (q < nprev) {
          const float nr = lp.x * hr - lp.y * hi + ev[q].x, ni = lp.x * hi + lp.y * hr + ev[q].y;
          hr = nr; hi = ni;
        }
      }
      float cr = lam.x, cim = lam.y;
      if (half) {
        float sr = lam.x, si = lam.y;
#pragma unroll
        for (int q = 0; q < 7; ++q) { const float t = sr * sr - si * si; si = 2.f * sr * si; sr = t; }
        cr = sr * lam.x - si * lam.y; cim = sr * lam.y + si * lam.x;
      }
      bf16x8 cmf[4];
      {
        const bfr* cm = (const bfr*)(ws + OFF_CMB) + (size_t)dg * 2048 + (lane & 15) * 128 + 8 * (lane >> 4);
#pragma unroll
        for (int ks = 0; ks < 4; ++ks) cmf[ks] = *(const bf16x8*)(cm + 32 * ks);
      }
      for (int c = 0; c < 8; ++c) {
#pragma unroll 8
        for (int sl = 0; sl < 16; ++sl) {
          HC[sl * 132 + lane] = cr * hr - cim * hi;
          HC[sl * 132 + 64 + lane] = cr * hi + cim * hr;
          const float nr = cr * lam.x - cim * lam.y, ni = cr * lam.y + cim * lam.x;
          cr = nr; cim = ni;
        }
        __builtin_amdgcn_wave_barrier();
        f32x4 acc = {0.f, 0.f, 0.f, 0.f};
        const float* hrow = HC + (lane & 15) * 132 + 8 * (lane >> 4);
#pragma unroll
        for (int ks = 0; ks < 4; ++ks) {
          const float4 v0 = *(const float4*)(hrow + 32 * ks), v1 = *(const float4*)(hrow + 32 * ks + 4);
          const bf16x8 a = __builtin_bit_cast(bf16x8, make_uint4(pk2(v0.x, v0.y), pk2(v0.z, v0.w), pk2(v1.x, v1.y), pk2(v1.z, v1.w)));
          acc = MFMA16(a, cmf[ks], acc);
        }
#pragma unroll
        for (int i = 0; i < 4; ++i) {
          const int sg = 128 * half + 16 * c + 4 * (lane >> 4) + i;
          const int tl = di == 0 ? sg : 255 - sg;
          atomicAdd(&ycorr[tl * 16 + (lane & 15)], acc[i]);
        }
        __builtin_amdgcn_wave_barrier();
      }
      __syncthreads();
    }
    {
      const int T = T0 + tid;
      const float* up = (const float*)(ws + OFF_U) + (size_t)T * 512 + g * 16;
      const bfr* yf = (const bfr*)(ws + OFF_YF) + (size_t)T * 512 + g * 16;
      const bfr* yb = (const bfr*)(ws + OFF_YB) + (size_t)T * 512 + g * 16;
      const float* dsk = p.in[21] + g * 16;
      unsigned o[8];
#pragma unroll
      for (int q = 0; q < 2; ++q) {
        const uint4 f = *(const uint4*)(yf + 8 * q), bk = *(const uint4*)(yb + 8 * q);
        const float4 u0 = *(const float4*)(up + 8 * q), u1 = *(const float4*)(up + 8 * q + 4);
        const float4 d0 = *(const float4*)(dsk + 8 * q), d1 = *(const float4*)(dsk + 8 * q + 4);
        const float* yc = ycorr + tid * 16 + 8 * q;
        const float uu[8] = {u0.x, u0.y, u0.z, u0.w, u1.x, u1.y, u1.z, u1.w};
        const float dd[8] = {d0.x, d0.y, d0.z, d0.w, d1.x, d1.y, d1.z, d1.w};
        const unsigned ff[4] = {f.x, f.y, f.z, f.w}, bb[4] = {bk.x, bk.y, bk.z, bk.w};
        float y[8];
#pragma unroll
        for (int e = 0; e < 8; ++e) {
          const float a = (e & 1) ? bf2f(ff[e >> 1] >> 16) : bf2f(ff[e >> 1] & 0xffff);
          const float c2 = (e & 1) ? bf2f(bb[e >> 1] >> 16) : bf2f(bb[e >> 1] & 0xffff);
          y[e] = gelu_f(uu[e] * dd[e] + a + c2 + (seg >= 32 ? yc[e] : 0.f));
        }
#pragma unroll
        for (int e = 0; e < 4; ++e) o[4 * q + e] = pk2(y[2 * e], y[2 * e + 1]);
      }
      uint4* dst = (uint4*)((bfr*)(ws + OFF_YG) + (size_t)T * 512 + g * 16);
      dst[0] = make_uint4(o[0], o[1], o[2], o[3]);
      dst[1] = make_uint4(o[4], o[5], o[6], o[7]);
    }
  }
}

template <int MODE>
DI void phase_tokgemm(const Params& p, unsigned char* smem, int layer) {
  unsigned char* ws = p.ws;
  const int lane = threadIdx.x & 63, wave = threadIdx.x >> 6, l32 = lane & 31, h = lane >> 5, wm = wave >> 1, wn = wave & 1;
  constexpr int K = MODE == 1 ? 1024 : 512, N = MODE == 1 ? 1024 : 512;
  const bfr* A = (const bfr*)(ws + (MODE == 0 ? OFF_YG : (MODE == 1 ? OFF_MIX : OFF_FZ)));
  const bfr* Bt = (const bfr*)(ws + (MODE == 0 ? OFF_GLU : (MODE == 1 ? (layer == 0 ? OFF_WOUT0 : OFF_WOUT1) : OFF_FNET)));
  constexpr int TN = N / 128;
  int tm, tn;
  if (!xcd_tile(0, TN, tm, tn)) return;
  LdBf alp{A + (size_t)tm * 128 * K, (size_t)K}, bl{Bt + (size_t)tn * 128 * K, (size_t)K};
  GStage<128> gst;
  bool first = true;
  for (int step = 0;; ++step) {
    const int m0 = tm * 128, n0 = tn * 128;
    int tm2 = 0, tn2 = 0;
    auto next_tile = [&]() {
      if (!xcd_tile(step + 1, TN, tm2, tn2)) return false;
      alp.base = A + (size_t)tm2 * 128 * K; bl.base = Bt + (size_t)tn2 * 128 * K;
      return true;
    };
    auto ep_direct = [&](f32x16 (&acc)[2][2]) {
#pragma unroll
      for (int ni = 0; ni < 2; ++ni) {
        const int T = m0 + wm * 64 + ni * 32 + l32;
#pragma unroll
        for (int mi = 0; mi < 2; ++mi)
#pragma unroll
          for (int i4 = 0; i4 < 4; ++i4) {
            const int n = n0 + wn * 64 + mi * 32 + 8 * i4 + 4 * h;
            float a = acc[mi][ni][4 * i4], b2 = acc[mi][ni][4 * i4 + 1], c2 = acc[mi][ni][4 * i4 + 2], e = acc[mi][ni][4 * i4 + 3];
            if (MODE == 0) {
              const uint2 y = *(const uint2*)((const bfr*)(ws + OFF_YG) + (size_t)T * 512 + n);
              const uint2 gb = *(const uint2*)((const bfr*)(ws + OFF_GB) + (size_t)T * 512 + n);
              const float4 bs = *(const float4*)(p.in[23] + n);
              a = bf2f(y.x & 0xffff) * sigmoid_f(a + bs.x) * bf2f(gb.x & 0xffff);
              b2 = bf2f(y.x >> 16) * sigmoid_f(b2 + bs.y) * bf2f(gb.x >> 16);
              c2 = bf2f(y.y & 0xffff) * sigmoid_f(c2 + bs.z) * bf2f(gb.y & 0xffff);
              e = bf2f(y.y >> 16) * sigmoid_f(e + bs.w) * bf2f(gb.y >> 16);
              *(uint2*)((bfr*)(ws + OFF_MIX) + (size_t)T * 1024 + 512 + n) = make_uint2(pk2(a, b2), pk2(c2, e));
            } else if (MODE == 1) {
              *(uint2*)((bfr*)(ws + OFF_O) + (size_t)T * 1024 + n) = make_uint2(pk2(a, b2), pk2(c2, e));
            } else {
              const uint2 gd = *(const uint2*)((const bfr*)(ws + OFF_GDS) + (size_t)T * 512 + n);
              a *= bf2f(gd.x & 0xffff); b2 *= bf2f(gd.x >> 16); c2 *= bf2f(gd.y & 0xffff); e *= bf2f(gd.y >> 16);
              *(uint2*)((bfr*)(ws + OFF_MIX) + (size_t)T * 1024 + 512 + n) = make_uint2(pk2(a, b2), pk2(c2, e));
            }
          }
      }
    };
    auto ep_staged = [&](f32x16 (&acc)[2][2]) {
      unsigned short* stg = (unsigned short*)smem;
#pragma unroll
      for (int ni = 0; ni < 2; ++ni) {
        const int row = wm * 64 + ni * 32 + l32;
        const int T = m0 + row;
#pragma unroll
        for (int mi = 0; mi < 2; ++mi)
#pragma unroll
          for (int i4 = 0; i4 < 4; ++i4) {
            const int cl = wn * 64 + mi * 32 + 8 * i4 + 4 * h;
            const int n = n0 + cl;
            float a = acc[mi][ni][4 * i4], b2 = acc[mi][ni][4 * i4 + 1], c2 = acc[mi][ni][4 * i4 + 2], e = acc[mi][ni][4 * i4 + 3];
            if (MODE == 0) {
              const uint2 y = *(const uint2*)((const bfr*)(ws + OFF_YG) + (size_t)T * 512 + n);
              const uint2 gb = *(const uint2*)((const bfr*)(ws + OFF_GB) + (size_t)T * 512 + n);
              const float4 bs = *(const float4*)(p.in[23] + n);
              a = bf2f(y.x & 0xffff) * sigmoid_f(a + bs.x) * bf2f(gb.x & 0xffff);
              b2 = bf2f(y.x >> 16) * sigmoid_f(b2 + bs.y) * bf2f(gb.x >> 16);
              c2 = bf2f(y.y & 0xffff) * sigmoid_f(c2 + bs.z) * bf2f(gb.y & 0xffff);
              e = bf2f(y.y >> 16) * sigmoid_f(e + bs.w) * bf2f(gb.y >> 16);
            } else if (MODE == 2) {
              const uint2 gd = *(const uint2*)((const bfr*)(ws + OFF_GDS) + (size_t)T * 512 + n);
              a *= bf2f(gd.x & 0xffff); b2 *= bf2f(gd.x >> 16); c2 *= bf2f(gd.y & 0xffff); e *= bf2f(gd.y >> 16);
            }
            *(uint2*)(stg + row * 136 + cl) = make_uint2(pk2(a, b2), pk2(c2, e));
          }
      }
      __syncthreads();
      bfr* dbase = MODE == 1 ? (bfr*)(ws + OFF_O) + (size_t)m0 * 1024 + n0 : (bfr*)(ws + OFF_MIX) + (size_t)m0 * 1024 + 512 + n0;
#pragma unroll
      for (int i = 0; i < 8; ++i) {
        const int id = threadIdx.x + 256 * i, r = id >> 4, c16 = id & 15;
        *(uint4*)(dbase + (size_t)r * 1024 + c16 * 8) = *(const uint4*)(stg + r * 136 + c16 * 8);
      }
    };
    auto ep = [&](f32x16 (&acc)[2][2]) { if constexpr (MODE == 1) ep_staged(acc); else ep_direct(acc); };
    if constexpr (MODE == 2) {
      bl.base = Bt + (size_t)n0 * K;
      if (m0 < NCTX) {
        LdBf al{A + (size_t)m0 * K, (size_t)K};
        gemm_tile<128>(K / 64, true, al, bl, ep, smem);
      } else {
        LdFz al{(const bfr*)(ws + OFF_HN) + (size_t)(m0 - NCTX) * 512};
        gemm_tile<128, false>(K / 64, true, al, bl, ep, smem);
      }
      if (!next_tile()) break;
    } else {
      const bool more = gemm_tile_pf<128>(K / 64, true, first, alp, bl, gst, ep, next_tile, smem);
      first = false;
      if (!more) break;
    }
    tm = tm2; tn = tn2;
  }
}

DI void phase_win1(const Params& p, unsigned char* smem) {
  unsigned char* ws = p.ws;
  const int lane = threadIdx.x & 63, wave = threadIdx.x >> 6, l32 = lane & 31, h = lane >> 5, wm = wave >> 1, wn = wave & 1;
  const bfr* A = (const bfr*)(ws + OFF_HN);
  const bfr* Bt = (const bfr*)(ws + OFF_WIN1);
  int tm, tn;
  if (!xcd_tile(0, 24, tm, tn)) return;
  LdBf al{A + (size_t)tm * 128 * 1024, 1024}, bl{Bt + (size_t)tn * 128 * 1024, 1024};
  for (int step = 0;; ++step) {
    const int m0 = tm * 128, n0 = tn * 128;
    int tm2 = 0, tn2 = 0;
    auto next_tile = [&]() {
      if (!xcd_tile(step + 1, 24, tm2, tn2)) return false;
      al.base = A + (size_t)tm2 * 128 * 1024; bl.base = Bt + (size_t)tn2 * 128 * 1024;
      return true;
    };
    auto ep = [&](f32x16 (&acc)[2][2]) {
      const int colbase = n0 + wn * 64, rbase = m0 + wm * 64;
      const int sec = colbase >> 9;
      const int cbt = n0 & 511;
      const bool lat = m0 >= NCTX;
      unsigned short* stg = (unsigned short*)smem;
      if (sec == 0 || sec == 2 || sec == 5) {
#pragma unroll
        for (int ni = 0; ni < 2; ++ni) {
          const int row = wm * 64 + ni * 32 + l32;
#pragma unroll
          for (int mi = 0; mi < 2; ++mi)
#pragma unroll
            for (int i4 = 0; i4 < 4; ++i4) {
              const float a = acc[mi][ni][4 * i4], b2 = acc[mi][ni][4 * i4 + 1], c2 = acc[mi][ni][4 * i4 + 2], e = acc[mi][ni][4 * i4 + 3];
              const uint2 o = sec == 0 ? make_uint2(pk2(gelu_f(a), gelu_f(b2)), pk2(gelu_f(c2), gelu_f(e))) : make_uint2(pk2(silu_f(a), silu_f(b2)), pk2(silu_f(c2), silu_f(e)));
              *(uint2*)(stg + row * 136 + wn * 64 + mi * 32 + 8 * i4 + 4 * h) = o;
            }
        }
      } else {
        if (sec == 1) {
          float* rowss = (float*)(ws + OFF_ROWSS);
#pragma unroll
          for (int mi = 0; mi < 2; ++mi)
#pragma unroll
            for (int i = 0; i < 16; ++i) {
              const float g0 = gelu_f(acc[mi][0][i]), g1 = gelu_f(acc[mi][1][i]);
              acc[mi][0][i] = g0; acc[mi][1][i] = g1;
              const float ss = half_sum32(g0 * g0 + g1 * g1);
              if (l32 == 0) atomicAdd(rowss + rbase + mi * 32 + crow(i, h), ss);
            }
        }
#pragma unroll
        for (int mi = 0; mi < 2; ++mi)
#pragma unroll
          for (int ni = 0; ni < 2; ++ni)
#pragma unroll
            for (int i4 = 0; i4 < 4; ++i4)
              *(uint2*)(stg + (wn * 64 + ni * 32 + l32) * 136 + wm * 64 + mi * 32 + 8 * i4 + 4 * h) =
                  make_uint2(pk2(acc[mi][ni][4 * i4], acc[mi][ni][4 * i4 + 1]), pk2(acc[mi][ni][4 * i4 + 2], acc[mi][ni][4 * i4 + 3]));
      }
      __syncthreads();
      bfr* dbase; size_t dld;
      if (sec == 0 || sec == 2 || sec == 5) { dbase = (bfr*)(ws + (sec == 0 ? OFF_CUG : (sec == 2 ? OFF_GCS : OFF_GDS))) + (size_t)m0 * 512 + cbt; dld = 512; }
      else if (sec == 1) { dbase = (bfr*)(ws + OFF_CVT) + (size_t)cbt * NTOK + m0; dld = NTOK; }
      else if (!lat) { dbase = (bfr*)(ws + OFF_ZTC) + ((size_t)((m0 >> 8) * 512 + cbt)) * 512 + (sec - 3) * 256 + (m0 & 255); dld = 512; }
      else { dbase = (bfr*)(ws + OFF_ZTL) + ((size_t)(((m0 - NCTX) >> 11) * 512 + cbt)) * 4096 + (sec - 3) * 2048 + ((m0 - NCTX) & 2047); dld = 4096; }
#pragma unroll
      for (int i = 0; i < 8; ++i) {
        const int id = threadIdx.x + 256 * i, r = id >> 4, c16 = id & 15;
        *(uint4*)(dbase + (size_t)r * dld + c16 * 8) = *(const uint4*)(stg + r * 136 + c16 * 8);
      }
    };
    const int sec0 = n0 >> 9;
    al.base = A + (size_t)m0 * 1024; bl.base = Bt + (size_t)n0 * 1024;
    gemm_tile<128>(16, sec0 == 0 || sec0 == 2 || sec0 == 5, al, bl, ep, smem);
    if (!next_tile()) break;
    tm = tm2; tn = tn2;
  }
}

struct LdWs {
  const float* w; const float* rowss;
  const float* p[4]; const float* rp;
  DI void init(int lrow, int lcol) {
#pragma unroll
    for (int i = 0; i < 4; ++i) p[i] = w + (lrow + 32 * i) * 128 + lcol;
    rp = rowss + lcol;
  }
  DI void advance(int adv) {
#pragma unroll
    for (int i = 0; i < 4; ++i) p[i] += 64 * adv;
    rp += 64 * adv;
  }
  DI uint4 load(int i) const {
    const float* wp = p[i];
    const float4 a = *(const float4*)wp, b = *(const float4*)(wp + 4);
    const float4 s0 = *(const float4*)rp, s1 = *(const float4*)(rp + 4);
    const float r0 = rsqrtf(s0.x * (1.f / 512.f) + EPS), r1 = rsqrtf(s0.y * (1.f / 512.f) + EPS), r2 = rsqrtf(s0.z * (1.f / 512.f) + EPS), r3 = rsqrtf(s0.w * (1.f / 512.f) + EPS);
    const float r4 = rsqrtf(s1.x * (1.f / 512.f) + EPS), r5 = rsqrtf(s1.y * (1.f / 512.f) + EPS), r6 = rsqrtf(s1.z * (1.f / 512.f) + EPS), r7 = rsqrtf(s1.w * (1.f / 512.f) + EPS);
    return make_uint4(pk2(a.x * r0, a.y * r1), pk2(a.z * r2, a.w * r3), pk2(b.x * r4, b.y * r5), pk2(b.z * r6, b.w * r7));
  }
};

DI void phase_mix1(const Params& p, unsigned char* smem) {
  unsigned char* ws = p.ws;
  const int lane = threadIdx.x & 63, wave = threadIdx.x >> 6, l32 = lane & 31, h = lane >> 5, wm = wave >> 1, wn = wave & 1;
  constexpr int N_FL = 512, N_FC = 256, N_G = 768;
  for (int it = blockIdx.x; it < N_FL + N_FC + N_G; it += gridDim.x) {
    if (it < N_FL + N_FC) {
      const bfr *A, *Bt; int K, Tbase, tm, tn;
      int kq = 0; bool isl = it < N_FL;
      if (isl) {
        const int b = it >> 8; kq = it & 3; tn = (it >> 2) & 3; tm = (it >> 4) & 15; K = 4096;
        A = (const bfr*)(ws + OFF_ALAT) + kq * 1024; Bt = (const bfr*)(ws + OFF_ZTL) + (size_t)b * 512 * 4096 + kq * 1024; Tbase = NCTX + b * 2048;
      } else {
        const int i2 = it - N_FL; const int b = i2 >> 3; tm = (i2 >> 2) & 1; tn = i2 & 3; K = 512;
        A = (const bfr*)(ws + OFF_ACTX); Bt = (const bfr*)(ws + OFF_ZTC) + (size_t)b * 512 * 512; Tbase = b * 256;
      }
      LdBf al{A + (size_t)tm * 128 * K, (size_t)K}, bl{Bt + (size_t)tn * 128 * K, (size_t)K};
      auto ep = [&](f32x16 (&acc)[2][2]) {
#pragma unroll
        for (int mi = 0; mi < 2; ++mi)
#pragma unroll
          for (int ni = 0; ni < 2; ++ni)
#pragma unroll
            for (int i = 0; i < 16; ++i) {
              const int T = Tbase + tm * 128 + wm * 64 + mi * 32 + crow(i, h);
              const int n = tn * 128 + wn * 64 + ni * 32 + l32;
              if (!isl) ((bfr*)(ws + OFF_FZ))[(size_t)T * 512 + n] = f2bf(acc[mi][ni][i]);
              else ((bfr*)(ws + OFF_HN))[((size_t)kq * 4096 + (T - NCTX)) * 512 + n] = f2bf(acc[mi][ni][i]);
            }
      };
      gemm_tile<128>(isl ? 16 : K / 64, false, al, bl, ep, smem);
    } else {
      const int i2 = it - N_FL - N_FC; const int hg = i2 & 7, chunk = i2 >> 3;
      LdWs al{p.in[27] + (size_t)hg * 128 * 128, (const float*)(ws + OFF_ROWSS) + chunk * 128};
      LdBf bl{(const bfr*)(ws + OFF_CVT) + (size_t)(hg * 64) * NTOK + chunk * 128, (size_t)NTOK};
      auto ep = [&](f32x16 (&acc)[2][1]) {
        const int c = hg * 64 + wn * 32 + l32;
        const float vg = p.in[26][c];
#pragma unroll
        for (int mi = 0; mi < 2; ++mi)
#pragma unroll
          for (int i = 0; i < 16; ++i) {
            const int t = wm * 64 + mi * 32 + crow(i, h);
            const int T = chunk * 128 + t;
            const float sp = acc[mi][0][i] * vg + p.in[28][hg * 128 + t];
            const float cu = bf2f(((const bfr*)(ws + OFF_CUG))[(size_t)T * 512 + c]);
            const float gc = bf2f(((const bfr*)(ws + OFF_GCS))[(size_t)T * 512 + c]);
            ((bfr*)(ws + OFF_MIX))[(size_t)T * 1024 + c] = f2bf(cu * sp * gc);
          }
      };
      gemm_tile<64>(2, false, al, bl, ep, smem);
    }
  }
}

constexpr int NPHASE = 13;
#ifndef DOUBLE_MASK
#define DOUBLE_MASK 0
#endif
template <int PH>
DI void run_phase(const Params& p, unsigned char* smem) {
  if constexpr (PH == 0) phase0(p, smem);
  else if constexpr (PH == 1) phase_rows<0>(p);
  else if constexpr (PH == 2) phase_win0(p, smem);
  else if constexpr (PH == 3) phase_mix0(p, smem);
  else if constexpr (PH == 4) phase_s5fix(p, smem);
  else if constexpr (PH == 5) phase_tokgemm<0>(p, smem, 0);
  else if constexpr (PH == 6) phase_tokgemm<1>(p, smem, 0);
  else if constexpr (PH == 7) phase_rows<1>(p);
  else if constexpr (PH == 8) phase_win1(p, smem);
  else if constexpr (PH == 9) phase_mix1(p, smem);
  else if constexpr (PH == 10) phase_tokgemm<2>(p, smem, 1);
  else if constexpr (PH == 11) phase_tokgemm<1>(p, smem, 1);
  else if constexpr (PH == 12) phase_rows<2>(p);
}
template <int LO, int HI>
DI void run_range(const Params& p, unsigned char* smem, const XcdBarrier& xb) {
  if constexpr (LO < HI) {
    run_phase<LO>(p, smem);
    if constexpr (((DOUBLE_MASK) >> LO) & 1) { xcd_barrier(xb); run_phase<LO>(p, smem); }
    if constexpr (LO + 1 < HI) { xcd_barrier(xb); run_range<LO + 1, HI>(p, smem, xb); }
  }
}
template <int LO, int HI>
__global__ void __launch_bounds__(256, 2) mega(Params p) {
  __shared__ __attribute__((aligned(16))) unsigned char smem[73728];
  __shared__ uint4 xb_words;
  if (threadIdx.x == 0) xb_words = make_uint4(0u, 0u, 0u, 0u);
  __syncthreads();
  XcdBarrier xb = xcd_barrier_post((unsigned*)(p.ws + OFF_BAR), (volatile LAS unsigned*)&xb_words);
  run_range<LO, HI>(p, smem, xb);
  if (p.ph_lo != 0) cg::this_grid().sync();
}

#ifndef ONE_LAUNCH
#define ONE_LAUNCH 1
#endif
#if !ONE_LAUNCH
template <int PH>
static void launch_phases(Params& p, int grid, hipStream_t stream) {
  if constexpr (PH < NPHASE) {
    hipLaunchKernelGGL((mega<PH, PH + 1>), dim3(grid), dim3(256), 0, stream, p);
    launch_phases<PH + 1>(p, grid, stream);
  }
}
#endif

#ifndef ONE_LAUNCH
#define ONE_LAUNCH 1
#endif

extern "C" void kernel_launch(void* const* d_in, const int* in_sizes, int n_in, void* d_out, int out_size, void* d_ws, size_t ws_size, hipStream_t stream) {
  static int grid_blocks = 0;
  if (!grid_blocks) {
    int dev = 0, cus = 0, per_cu = 0;
    (void)hipGetDevice(&dev);
    (void)hipDeviceGetAttribute(&cus, hipDeviceAttributeMultiprocessorCount, dev);
    (void)hipOccupancyMaxActiveBlocksPerMultiprocessor(&per_cu, mega<0, NPHASE>, 256, 0);
    if (per_cu > 2) per_cu = 2;
    if (per_cu < 1) per_cu = 1;
    grid_blocks = cus * per_cu;
    if (n_in != 31 || ws_size < WS_TOTAL) fprintf(stderr, "kernel_launch: unexpected n_in %d or ws_size %zu (need %zu)\n", n_in, ws_size, (size_t)WS_TOTAL);
  }
  Params p{};
  for (int i = 0; i < 31; ++i) p.in[i] = (const float*)d_in[i];
  p.out = (float*)d_out; p.ws = (unsigned char*)d_ws;
  (void)hipMemsetAsync((unsigned char*)d_ws + OFF_BAR, 0, 16384, stream);
#if ONE_LAUNCH
  p.ph_lo = 0; p.ph_hi = NPHASE;
  void* args[] = {&p};
  hipError_t e = hipLaunchCooperativeKernel((void*)mega<0, NPHASE>, dim3(grid_blocks), dim3(256), args, 0, stream);
  if (e != hipSuccess) fprintf(stderr, "cooperative launch failed: %s (grid %d)\n", hipGetErrorString(e), grid_blocks);
#else
  launch_phases<0>(p, grid_blocks, stream);
#endif
}
```

```cpp
#include <hip/hip_runtime.h>
#include <hip/hip_cooperative_groups.h>
#include <cstdio>
#include <cstdint>
namespace cg = cooperative_groups;

#define DI __device__ __forceinline__
typedef unsigned short bfr;
using bf16x8 = __attribute__((ext_vector_type(8))) short;
using s16x4  = __attribute__((ext_vector_type(4))) short;
using f32x16 = __attribute__((ext_vector_type(16))) float;
using f32x4  = __attribute__((ext_vector_type(4))) float;

#define MFMA32(a, b, c) __builtin_amdgcn_mfma_f32_32x32x16_bf16((a), (b), (c), 0, 0, 0)
#define MFMA16(a, b, c) __builtin_amdgcn_mfma_f32_16x16x32_bf16((a), (b), (c), 0, 0, 0)

constexpr int NTOK = 12288, NCTX = 8192;
constexpr float EPS = 1e-6f;

constexpr size_t OFF_MOD   = 0;
constexpr size_t OFF_ROWSS = OFF_MOD + 73728;
constexpr size_t OFF_ROPE  = OFF_ROWSS + 49152;
constexpr size_t OFF_LAMB  = OFF_ROPE + 8192;
constexpr size_t OFF_LAMP  = OFF_LAMB + 32768;
constexpr size_t OFF_BB    = OFF_LAMP + 32768;
constexpr size_t OFF_CMB   = OFF_BB + 524288;
constexpr size_t OFF_E     = OFF_CMB + 262144;
constexpr size_t OFF_WIN0  = OFF_E + 1572864;
constexpr size_t OFF_GLU   = OFF_WIN0 + 4718592;
constexpr size_t OFF_WOUT0 = OFF_GLU + 524288;
constexpr size_t OFF_WIN1  = OFF_WOUT0 + 2097152;
constexpr size_t OFF_FNET  = OFF_WIN1 + 6291456;
constexpr size_t OFF_WOUT1 = OFF_FNET + 524288;
constexpr size_t OFF_ACTX  = OFF_WOUT1 + 2097152;
constexpr size_t OFF_ALAT  = OFF_ACTX + 262144;
constexpr size_t OFF_X1    = OFF_ALAT + 16777216;
constexpr size_t OFF_HN    = OFF_X1 + 50331648;
constexpr size_t OFF_MIX   = OFF_HN + 25165824;
constexpr size_t OFF_O     = OFF_MIX + 25165824;
constexpr size_t OFF_U     = OFF_O;
constexpr size_t OFF_R     = OFF_O + 25165824;
constexpr size_t OFF_QB = OFF_R;
constexpr size_t OFF_KC = OFF_QB + 12582912;
constexpr size_t OFF_KL = OFF_KC + 2097152;
constexpr size_t OFF_VC = OFF_KL + 1310720;
constexpr size_t OFF_VL = OFF_VC + 2097152;
constexpr size_t OFF_GA = OFF_VL + 1310720;
constexpr size_t OFF_GB = OFF_GA + 12582912;
constexpr size_t OFF_YF = OFF_GB + 12582912;
constexpr size_t OFF_YB = OFF_YF + 12582912;
constexpr size_t OFF_YG = OFF_YB + 12582912;
constexpr size_t END_L0 = OFF_YG + 12582912;
constexpr size_t OFF_CUG = OFF_R;
constexpr size_t OFF_GCS = OFF_CUG + 12582912;
constexpr size_t OFF_GDS = OFF_GCS + 12582912;
constexpr size_t OFF_CVT = OFF_GDS + 12582912;
constexpr size_t OFF_FZ  = OFF_CVT + 12582912;
constexpr size_t OFF_ZTC = OFF_FZ + 12582912;
constexpr size_t OFF_ZTL = OFF_ZTC + 16777216;
constexpr size_t END_L1 = OFF_ZTL + 8388608;
constexpr size_t WS_NEED = (END_L0 > END_L1 ? END_L0 : END_L1);
constexpr size_t OFF_BAR = WS_NEED;
constexpr size_t WS_TOTAL = OFF_BAR + 16384;
static_assert(WS_TOTAL <= (size_t)256 * 1024 * 1024, "workspace too large");

constexpr size_t OUT_Y = 0, OUT_K = 12582912, OUT_V = 13631488, OUT_S = 14680064;

struct Params {
  const float* in[31];
  float* out;
  unsigned char* ws;
  int ph_lo, ph_hi;
};

typedef __bf16 hbf2 __attribute__((ext_vector_type(2)));
typedef float hfl2 __attribute__((ext_vector_type(2)));
DI unsigned pk2(float lo, float hi) { hfl2 v = {lo, hi}; hbf2 r = __builtin_convertvector(v, hbf2); return __builtin_bit_cast(unsigned, r); }
DI unsigned short f2bf(float x) { return (unsigned short)(pk2(x, 0.f) & 0xffffu); }
DI float bf2f(unsigned short b) { return __uint_as_float(((unsigned)b) << 16); }
DI float wave_sum(float v) {
#pragma unroll
  for (int o = 1; o < 64; o <<= 1) v += __shfl_xor(v, o);
  return v;
}
DI float half_sum32(float v) {
#pragma unroll
  for (int o = 1; o < 32; o <<= 1) v += __shfl_xor(v, o);
  return v;
}
DI float silu_f(float x) { return x / (1.f + __expf(-x)); }
DI float sigmoid_f(float x) { return 1.f / (1.f + __expf(-x)); }
DI float gelu_f(float x) { float z = 0.7978845608028654f * (x + 0.044715f * x * x * x); return x / (1.f + __expf(-2.f * z)); }
DI int crow(int i, int h) { return (i & 3) + 8 * (i >> 2) + 4 * h; }
DI const float* xrow(const Params& p, int T) { return T < NCTX ? p.in[0] + (size_t)T * 1024 : p.in[1] + (size_t)(T - NCTX) * 1024; }
DI int cond_of(int T) { return T < NCTX ? 0 : 1 + ((T - NCTX) >> 11); }

template <int BN, bool D2 = false, class AL, class BL, class EP>
DI void gemm_tile(int nk, bool swp, AL al, BL bl, EP ep, unsigned char* smem) {
  constexpr int NI = BN / 64;
  constexpr int NB = BN / 32;
  constexpr int STG = (128 + BN) * 72;
  unsigned short* S0 = (unsigned short*)smem;
  const int tid = threadIdx.x, lane = tid & 63, wave = tid >> 6, l32 = lane & 31, h = lane >> 5;
  const int wm = wave >> 1, wn = wave & 1;
  const int xoff = (swp ? 128 * 72 + (wn * 64 + l32) * 72 : (wm * 64 + l32) * 72) + h * 8;
  const int yoff = (swp ? (wm * 64 + l32) * 72 : 128 * 72 + (wn * (BN / 2) + l32) * 72) + h * 8;
  f32x16 acc[2][NI];
#pragma unroll
  for (int mi = 0; mi < 2; ++mi)
#pragma unroll
    for (int ni = 0; ni < NI; ++ni)
#pragma unroll
      for (int i = 0; i < 16; ++i) acc[mi][ni][i] = 0.f;
  uint4 ra[2][4], rb[2][NB];
  const int lrow = tid >> 3, lcol = (tid & 7) * 8;
  al.init(lrow, lcol); bl.init(lrow, lcol);
  int nxt = 0;
  auto gload = [&](uint4 (&a4)[4], uint4 (&b4)[NB]) {
#pragma unroll
    for (int i = 0; i < 4; ++i) a4[i] = al.load(i);
#pragma unroll
    for (int i = 0; i < NB; ++i) b4[i] = bl.load(i);
    const int adv = (nxt + 1 < nk) ? 1 : 0;
    al.advance(adv); bl.advance(adv); nxt += adv;
  };
  auto lstore = [&](const uint4 (&a4)[4], const uint4 (&b4)[NB], unsigned short* st) {
#pragma unroll
    for (int i = 0; i < 4; ++i) *(uint4*)(st + (lrow + 32 * i) * 72 + lcol) = a4[i];
#pragma unroll
    for (int i = 0; i < NB; ++i) *(uint4*)(st + 128 * 72 + (lrow + 32 * i) * 72 + lcol) = b4[i];
  };
  auto compute = [&](const unsigned short* st) {
#pragma unroll
    for (int ks = 0; ks < 4; ++ks) {
      bf16x8 x[2], y[NI];
#pragma unroll
      for (int mi = 0; mi < 2; ++mi) x[mi] = *(const bf16x8*)(st + xoff + mi * 32 * 72 + ks * 16);
#pragma unroll
      for (int ni = 0; ni < NI; ++ni) y[ni] = *(const bf16x8*)(st + yoff + ni * 32 * 72 + ks * 16);
#pragma unroll
      for (int mi = 0; mi < 2; ++mi)
#pragma unroll
        for (int ni = 0; ni < NI; ++ni) acc[mi][ni] = MFMA32(x[mi], y[ni], acc[mi][ni]);
    }
  };
  if constexpr (D2) {
    gload(ra[0], rb[0]);
    gload(ra[1], rb[1]);
    __syncthreads();
    lstore(ra[0], rb[0], S0);
    gload(ra[0], rb[0]);
    __syncthreads();
    for (int kt = 0; kt < nk; kt += 2) {
      compute(S0);
      lstore(ra[1], rb[1], S0 + STG);
      gload(ra[1], rb[1]);
      __syncthreads();
      compute(S0 + STG);
      if (kt + 2 < nk) lstore(ra[0], rb[0], S0);
      gload(ra[0], rb[0]);
      __syncthreads();
    }
  } else {
    gload(ra[0], rb[0]);
    __syncthreads();
    lstore(ra[0], rb[0], S0);
    gload(ra[0], rb[0]);
    __syncthreads();
    for (int kt = 0; kt < nk; kt += 2) {
      compute(S0);
      lstore(ra[0], rb[0], S0 + STG);
      gload(ra[0], rb[0]);
      __syncthreads();
      compute(S0 + STG);
      if (kt + 2 < nk) lstore(ra[0], rb[0], S0);
      gload(ra[0], rb[0]);
      __syncthreads();
    }
  }
  ep(acc);
}

template <int BN> struct GStage { uint4 ra[2][4]; uint4 rb[2][BN / 32]; int nxt; };
template <int BN, class AL, class BL, class EP, class NX>
DI bool gemm_tile_pf(int nk, bool swp, bool first, AL& al, BL& bl, GStage<BN>& st, EP ep, NX next_tile, unsigned char* smem) {
  constexpr int NI = BN / 64;
  constexpr int NB = BN / 32;
  constexpr int STG = (128 + BN) * 72;
  unsigned short* S0 = (unsigned short*)smem;
  const int tid = threadIdx.x, lane = tid & 63, wave = tid >> 6, l32 = lane & 31, h = lane >> 5;
  const int wm = wave >> 1, wn = wave & 1;
  const int xoff = (swp ? 128 * 72 + (wn * 64 + l32) * 72 : (wm * 64 + l32) * 72) + h * 8;
  const int yoff = (swp ? (wm * 64 + l32) * 72 : 128 * 72 + (wn * (BN / 2) + l32) * 72) + h * 8;
  f32x16 acc[2][NI];
#pragma unroll
  for (int mi = 0; mi < 2; ++mi)
#pragma unroll
    for (int ni = 0; ni < NI; ++ni)
#pragma unroll
      for (int i = 0; i < 16; ++i) acc[mi][ni][i] = 0.f;
  const int lrow = tid >> 3, lcol = (tid & 7) * 8;
  auto gload = [&](uint4 (&a4)[4], uint4 (&b4)[NB]) {
#pragma unroll
    for (int i = 0; i < 4; ++i) a4[i] = al.load(i);
#pragma unroll
    for (int i = 0; i < NB; ++i) b4[i] = bl.load(i);
    const int adv = (st.nxt + 1 < nk) ? 1 : 0;
    al.advance(adv); bl.advance(adv); st.nxt += adv;
  };
  auto lstore = [&](const uint4 (&a4)[4], const uint4 (&b4)[NB], unsigned short* sp) {
#pragma unroll
    for (int i = 0; i < 4; ++i) *(uint4*)(sp + (lrow + 32 * i) * 72 + lcol) = a4[i];
#pragma unroll
    for (int i = 0; i < NB; ++i) *(uint4*)(sp + 128 * 72 + (lrow + 32 * i) * 72 + lcol) = b4[i];
  };
  auto compute = [&](const unsigned short* sp) {
#pragma unroll
    for (int ks = 0; ks < 4; ++ks) {
      bf16x8 x[2], y[NI];
#pragma unroll
      for (int mi = 0; mi < 2; ++mi) x[mi] = *(const bf16x8*)(sp + xoff + mi * 32 * 72 + ks * 16);
#pragma unroll
      for (int ni = 0; ni < NI; ++ni) y[ni] = *(const bf16x8*)(sp + yoff + ni * 32 * 72 + ks * 16);
#pragma unroll
      for (int mi = 0; mi < 2; ++mi)
#pragma unroll
        for (int ni = 0; ni < NI; ++ni) acc[mi][ni] = MFMA32(x[mi], y[ni], acc[mi][ni]);
    }
  };
  if (first) {
    al.init(lrow, lcol); bl.init(lrow, lcol); st.nxt = 0;
    gload(st.ra[0], st.rb[0]);
    gload(st.ra[1], st.rb[1]);
  }
  __syncthreads();
  lstore(st.ra[0], st.rb[0], S0);
  gload(st.ra[0], st.rb[0]);
  __syncthreads();
  for (int kt = 0; kt < nk; kt += 2) {
    compute(S0);
    lstore(st.ra[1], st.rb[1], S0 + STG);
    gload(st.ra[1], st.rb[1]);
    __syncthreads();
    compute(S0 + STG);
    if (kt + 2 < nk) lstore(st.ra[0], st.rb[0], S0);
    gload(st.ra[0], st.rb[0]);
    __syncthreads();
  }
  const bool more = next_tile();
  if (more) {
    al.init(lrow, lcol); bl.init(lrow, lcol); st.nxt = 0;
    gload(st.ra[0], st.rb[0]);
    gload(st.ra[1], st.rb[1]);
  }
  ep(acc);
  return more;
}

DI bool xcd_tile(int step, int ntn, int& tm, int& tn) {
  const int G = gridDim.x;
  if ((G & 7) == 0) {
    const int x = blockIdx.x & 7, loc = blockIdx.x >> 3, per = G >> 3;
    const int j = loc + step * per;
    if (j >= 12 * ntn) return false;
    tn = j / 12; tm = 12 * x + j % 12;
    return true;
  }
  const int it = blockIdx.x + step * G;
  if (it >= 96 * ntn) return false;
  tm = it / ntn; tn = it % ntn;
  return true;
}

#define GAS __attribute__((address_space(1)))
typedef unsigned u32x4 __attribute__((ext_vector_type(4)));
DI uint4 gld16(const GAS char* q) { const u32x4 v = *(const GAS u32x4*)q; return make_uint4(v.x, v.y, v.z, v.w); }
struct LdBf {
  const bfr* base; size_t ld;
  const GAS char* p[4];
  DI void init(int lrow, int lcol) {
#pragma unroll
    for (int i = 0; i < 4; ++i) { p[i] = (const GAS char*)(base + (size_t)(lrow + 32 * i) * ld + lcol); asm volatile("" : "+v"(p[i])); }
  }
  DI uint4 load(int i) const { return gld16(p[i]); }
  DI void advance(int adv) {
#pragma unroll
    for (int i = 0; i < 4; ++i) p[i] += 128 * adv;
  }
};
#define XB_TMO      128
#define XB_XCNT(j)  (256  + 64 * (j))
#define XB_XSUB(j)  (1280 + 64 * (j))
#define XB_XGEN(j)  (2304 + 64 * (j))
#define XB_TOP      3328
#define XB_TOPGEN   3392
#define XCD_BAR_WORDS 3456
#define XB_SPIN_CAP (1u << 20)
#define LAS __attribute__((address_space(3)))
DI unsigned xb_ld(unsigned* p)              { return __hip_atomic_load(p, __ATOMIC_RELAXED, __HIP_MEMORY_SCOPE_AGENT); }
DI unsigned xb_add(unsigned* p, unsigned v) { return __hip_atomic_fetch_add(p, v, __ATOMIC_RELAXED, __HIP_MEMORY_SCOPE_AGENT); }
DI unsigned xb_xcc_id() { return (unsigned)__builtin_amdgcn_s_getreg((3 << 11) | 20) & 0xFu; }
#define XB_SPIN(cond, bar) do { unsigned _sp = 0; while (cond) { __builtin_amdgcn_s_sleep(1); \
    if ((++_sp & 255u) == 0u) { if (xb_ld(&(bar)[XB_TMO])) break; if (_sp > XB_SPIN_CAP) { atomicAdd(&(bar)[XB_TMO], 1u); break; } } } } while (0)
struct XcdBarrier { unsigned* bar; unsigned x; volatile LAS unsigned* st; };
DI XcdBarrier xcd_barrier_post(unsigned* bar, volatile LAS unsigned* st) {
  XcdBarrier b; b.bar = bar; b.x = xb_xcc_id(); b.st = st;
  if (threadIdx.x == 0) (void)xb_add(&bar[XB_XCNT(b.x)], 1u);
  return b;
}
DI void xcd_barrier_complete(unsigned* bar, unsigned x, unsigned& nloc, unsigned& nx) {
  const unsigned G = gridDim.x * gridDim.y * gridDim.z;
  unsigned sum, cnt, mine, sp = 0u;
  for (;;) {
    sum = 0u; cnt = 0u; mine = 0u;
#pragma unroll
    for (unsigned j = 0; j < 16; ++j) { const unsigned c = xb_ld(&bar[XB_XCNT(j)]); sum += c; cnt += (c > 0u) ? 1u : 0u; mine = (j == x) ? c : mine; }
    if (sum == G) break;
    __builtin_amdgcn_s_sleep(1);
    if ((++sp & 255u) == 0u) { if (xb_ld(&bar[XB_TMO])) break; if (sp > XB_SPIN_CAP) { atomicAdd(&bar[XB_TMO], 1u); break; } }
  }
  nloc = mine > 0u ? mine : 1u; nx = cnt > 0u ? cnt : 1u;
}
DI void xcd_barrier(const XcdBarrier& b) {
  asm volatile("s_waitcnt vmcnt(0)" ::: "memory");
  __syncthreads();
  if (threadIdx.x == 0) {
    unsigned* bar = b.bar;
    __builtin_amdgcn_s_waitcnt(0);
    unsigned nloc = b.st[0], nx = b.st[1];
    if (nloc == 0u) { xcd_barrier_complete(bar, b.x, nloc, nx); b.st[0] = nloc; b.st[1] = nx; }
    const unsigned old = xb_add(&bar[XB_XSUB(b.x)], 1u);
    const unsigned gen = old / nloc;
    if (old + 1u == (gen + 1u) * nloc) {
      __builtin_amdgcn_fence(__ATOMIC_RELEASE, "agent");
      asm volatile("s_waitcnt vmcnt(0)" ::: "memory");
      const unsigned og = xb_add(&bar[XB_TOP], 1u);
      const unsigned tg = og / nx;
      if (og + 1u == (tg + 1u) * nx) xb_add(&bar[XB_TOPGEN], 1u);
      else XB_SPIN(xb_ld(&bar[XB_TOPGEN]) == tg, bar);
      __builtin_amdgcn_fence(__ATOMIC_ACQUIRE, "agent");
      xb_add(&bar[XB_XGEN(b.x)], 1u);
      asm volatile("s_waitcnt vmcnt(0)" ::: "memory");
    } else {
      XB_SPIN(xb_ld(&bar[XB_XGEN(b.x)]) == gen, bar);
      __builtin_amdgcn_fence(__ATOMIC_ACQUIRE, "agent");
      asm volatile("s_waitcnt vmcnt(0)" ::: "memory");
    }
  }
  __syncthreads();
}

struct LdFz {
  const bfr* pz;
  const GAS char* p[4];
  DI void init(int lrow, int lcol) {
#pragma unroll
    for (int i = 0; i < 4; ++i) { p[i] = (const GAS char*)(pz + (size_t)(lrow + 32 * i) * 512 + lcol); asm volatile("" : "+v"(p[i])); }
  }
  DI void advance(int adv) {
#pragma unroll
    for (int i = 0; i < 4; ++i) p[i] += 128 * adv;
  }
  DI uint4 load(int i) const {
    const GAS char* q = p[i];
    const uint4 a = gld16(q), b = gld16(q + (size_t)4096 * 512 * 2), c = gld16(q + (size_t)2 * 4096 * 512 * 2), d = gld16(q + (size_t)3 * 4096 * 512 * 2);
#define SUM4(f) pk2(bf2f(a.f & 0xffff) + bf2f(b.f & 0xffff) + bf2f(c.f & 0xffff) + bf2f(d.f & 0xffff), bf2f(a.f >> 16) + bf2f(b.f >> 16) + bf2f(c.f >> 16) + bf2f(d.f >> 16))
    return make_uint4(SUM4(x), SUM4(y), SUM4(z), SUM4(w));
#undef SUM4
  }
};

DI void transpose_tile(const float* W, int ldw, int kbase, int nbase, bfr* WT, int ldt, int trow, float* sm) {
  const int tid = threadIdx.x;
#pragma unroll
  for (int i = 0; i < 4; ++i) {
    const int r = (tid >> 4) + 16 * i, c = (tid & 15) * 4;
    const float4 v = *(const float4*)(W + (size_t)(kbase + r) * ldw + nbase + c);
    sm[r * 65 + c] = v.x; sm[r * 65 + c + 1] = v.y; sm[r * 65 + c + 2] = v.z; sm[r * 65 + c + 3] = v.w;
  }
  __syncthreads();
  const int n = tid >> 2, kc = (tid & 3) * 16;
  unsigned o[8];
#pragma unroll
  for (int j = 0; j < 8; ++j) o[j] = pk2(sm[(kc + 2 * j) * 65 + n], sm[(kc + 2 * j + 1) * 65 + n]);
  uint4* dst = (uint4*)(WT + (size_t)(trow + n) * ldt + kbase + kc);
  dst[0] = make_uint4(o[0], o[1], o[2], o[3]);
  dst[1] = make_uint4(o[4], o[5], o[6], o[7]);
}

DI void phase0(const Params& p, unsigned char* smem) {
  const int tid = threadIdx.x;
  float* smf = (float*)smem;
  unsigned char* ws = p.ws;
  constexpr int N_ADA = 192;
  constexpr int N_T0 = 16 * 36, N_TG = 64, N_TO0 = 256, N_T1A = 16 * 24, N_T1B = 16 * 8, N_TF = 64, N_TO1 = 256;
  constexpr int N_FOLD = 128, N_ALAT = 2048, N_ACTX = 256, N_CACHE = 64, N_SSM = 64, N_ZERO = 48, N_ROPE = 4;
  constexpr int B_T0 = N_ADA, B_TG = B_T0 + N_T0, B_TO0 = B_TG + N_TG, B_T1A = B_TO0 + N_TO0, B_T1B = B_T1A + N_T1A,
                B_TF = B_T1B + N_T1B, B_TO1 = B_TF + N_TF, B_FOLD = B_TO1 + N_TO1, B_ALAT = B_FOLD + N_FOLD,
                B_ACTX = B_ALAT + N_ALAT, B_CACHE = B_ACTX + N_ACTX, B_SSM = B_CACHE + N_CACHE, B_ZERO = B_SSM + N_SSM,
                B_ROPE = B_ZERO + N_ZERO, N_ALL = B_ROPE + N_ROPE;
  for (int it = blockIdx.x; it < N_ALL; it += gridDim.x) {
    __syncthreads();
    if (it < B_T0) {
      const int l = it / 96, cgp = it % 96;
      float* sc = smf;
      float* red = smf + 3072;
      for (int e = tid; e < 3072; e += 256) {
        const int ci = e >> 10, k = e & 1023;
        const float cv = ci == 0 ? p.in[6][k] : p.in[5][(ci - 1) * 1024 + k];
        sc[e] = silu_f(cv);
      }
      __syncthreads();
      const int cq = tid & 7, rg = tid >> 3;
      const float* w = p.in[7] + (size_t)l * 1024 * 3072 + cgp * 32 + cq * 4;
      float4 a0 = make_float4(0.f, 0.f, 0.f, 0.f), a1 = a0, a2 = a0;
#pragma unroll 16
      for (int k = rg; k < 1024; k += 32) {
        const float4 wv = *(const float4*)(w + (size_t)k * 3072);
        const float s0 = sc[k], s1 = sc[1024 + k], s2 = sc[2048 + k];
        a0.x += s0 * wv.x; a0.y += s0 * wv.y; a0.z += s0 * wv.z; a0.w += s0 * wv.w;
        a1.x += s1 * wv.x; a1.y += s1 * wv.y; a1.z += s1 * wv.z; a1.w += s1 * wv.w;
        a2.x += s2 * wv.x; a2.y += s2 * wv.y; a2.z += s2 * wv.z; a2.w += s2 * wv.w;
      }
      *(float4*)(red + (0 * 32 + rg) * 32 + cq * 4) = a0;
      *(float4*)(red + (1 * 32 + rg) * 32 + cq * 4) = a1;
      *(float4*)(red + (2 * 32 + rg) * 32 + cq * 4) = a2;
      __syncthreads();
      if (tid < 96) {
        const int c2 = tid & 31, ci = tid >> 5;
        float s = 0.f;
#pragma unroll
        for (int q = 0; q < 32; ++q) s += red[(ci * 32 + q) * 32 + c2];
        const int n2 = cgp * 32 + c2;
        ((float*)(ws + OFF_MOD))[(l * 3 + ci) * 3072 + n2] = s + p.in[8][l * 3072 + n2];
      }
    } else if (it < B_FOLD) {
      const float* W; int ldw, nbase_off = 0, trow_off = 0, ntn, ldt; bfr* WT; int r;
      if (it < B_TG)        { r = it - B_T0;  W = p.in[11]; ldw = 2304; ntn = 36; WT = (bfr*)(ws + OFF_WIN0); ldt = 1024; }
      else if (it < B_TO0)  { r = it - B_TG;  W = p.in[22]; ldw = 512;  ntn = 8;  WT = (bfr*)(ws + OFF_GLU); ldt = 512; }
      else if (it < B_T1A)  { r = it - B_TO0; W = p.in[24]; ldw = 1024; ntn = 16; WT = (bfr*)(ws + OFF_WOUT0); ldt = 1024; }
      else if (it < B_T1B)  { r = it - B_T1A; W = p.in[25]; ldw = 2560; ntn = 24; WT = (bfr*)(ws + OFF_WIN1); ldt = 1024; }
      else if (it < B_TF)   { r = it - B_T1B; W = p.in[25]; ldw = 2560; ntn = 8;  WT = (bfr*)(ws + OFF_WIN1); ldt = 1024; nbase_off = 2048; trow_off = 2560; }
      else if (it < B_TO1)  { r = it - B_TF;  W = p.in[29]; ldw = 512;  ntn = 8;  WT = (bfr*)(ws + OFF_FNET); ldt = 512; }
      else                  { r = it - B_TO1; W = p.in[30]; ldw = 1024; ntn = 16; WT = (bfr*)(ws + OFF_WOUT1); ldt = 1024; }
      const int kb = r / ntn, nb = r % ntn;
      transpose_tile(W, ldw, kb * 64, nbase_off + nb * 64, WT, ldt, trow_off + nb * 64, smf);
    } else if (it < B_ALAT) {
      const int r = it - B_FOLD, cs = r & 1, kb = (r >> 1) & 15, g = r >> 5;
      float* tile = smf;
      float* tw = smf + 128 * 68;
      const float* W = p.in[25];
      {
        const int c4 = (tid & 31) * 4, kr = tid >> 5;
#pragma unroll
        for (int i = 0; i < 8; ++i) {
          const int k = kr + 8 * i;
          const float4 v = *(const float4*)(W + (size_t)(kb * 64 + k) * 2560 + 1536 + g * 128 + c4);
          tile[(c4 + 0) * 68 + k] = v.x; tile[(c4 + 1) * 68 + k] = v.y; tile[(c4 + 2) * 68 + k] = v.z; tile[(c4 + 3) * 68 + k] = v.w;
        }
        if (tid < 128) {
          const float a = 2.f * (float)tid / 128.f;
          tw[tid] = (cs == 0 ? cospif(a) : sinpif(a)) * 0.08838834764831845f;
        }
      }
      __syncthreads();
      const int j = tid & 127, kg = tid >> 7;
      float acc[32];
#pragma unroll
      for (int i = 0; i < 32; ++i) acc[i] = 0.f;
      for (int c = 0; c < 128; ++c) {
        const float t = tw[(j * c) & 127];
        const float4* tp = (const float4*)(tile + c * 68 + kg * 32);
#pragma unroll
        for (int q = 0; q < 8; ++q) {
          const float4 v = tp[q];
          acc[4 * q + 0] += v.x * t; acc[4 * q + 1] += v.y * t; acc[4 * q + 2] += v.z * t; acc[4 * q + 3] += v.w * t;
        }
      }
      uint4* dst = (uint4*)((bfr*)(ws + OFF_WIN1) + (size_t)(1536 + cs * 512 + g * 128 + j) * 1024 + kb * 64 + kg * 32);
#pragma unroll
      for (int q = 0; q < 4; ++q)
        dst[q] = make_uint4(pk2(acc[8 * q], acc[8 * q + 1]), pk2(acc[8 * q + 2], acc[8 * q + 3]), pk2(acc[8 * q + 4], acc[8 * q + 5]), pk2(acc[8 * q + 6], acc[8 * q + 7]));
    } else if (it < B_ACTX) {
      const int t = it - B_ALAT;
      bfr* dst = (bfr*)(ws + OFF_ALAT) + (size_t)t * 4096;
      const float nrm = 0.02209708691207961f;
#pragma unroll
      for (int half = 0; half < 2; ++half) {
        const int k0 = half * 2048 + tid * 8;
        unsigned o[4];
#pragma unroll
        for (int j = 0; j < 4; ++j) {
          float v[2];
#pragma unroll
          for (int e = 0; e < 2; ++e) {
            const int k = k0 + 2 * j + e;
            const int m = (t * (k & 2047)) & 2047;
            const float a = (float)m * (2.f / 2048.f);
            v[e] = (k < 2048 ? cospif(a) : -sinpif(a)) * nrm;
          }
          o[j] = pk2(v[0], v[1]);
        }
        *(uint4*)(dst + k0) = make_uint4(o[0], o[1], o[2], o[3]);
      }
    } else if (it < B_CACHE) {
      const int t = it - B_ACTX;
      bfr* dst = (bfr*)(ws + OFF_ACTX) + (size_t)t * 512;
      const float nrm = 0.0625f;
      float v[2];
#pragma unroll
      for (int e = 0; e < 2; ++e) {
        const int k = tid * 2 + e;
        const int m = (t * (k & 255)) & 255;
        const float a = (float)m * (2.f / 256.f);
        v[e] = (k < 256 ? cospif(a) : -sinpif(a)) * nrm;
      }
      *(unsigned*)(dst + tid * 2) = pk2(v[0], v[1]);
    } else if (it < B_SSM) {
      const int r = it - B_CACHE;
#pragma unroll
      for (int i = 0; i < 8; ++i) {
        const int e = r * 2048 + tid + 256 * i;
        const int d = e & 63, kvh = (e >> 6) & 1, key = (e >> 7) & 511, b = e >> 16;
        ((bfr*)(ws + OFF_KL))[((size_t)(b * 2 + kvh) * 2560 + key) * 64 + d] = f2bf(p.in[2][e]);
        ((bfr*)(ws + OFF_VL))[((size_t)(b * 2 + kvh) * 64 + d) * 2560 + key] = f2bf(p.in[3][e]);
      }
    } else if (it < B_ZERO) {
      const int dg = it - B_SSM;
      const int pp = tid & 63, part = tid >> 6;
      const double lr = (double)p.in[14][dg * 64 + pp], li = (double)p.in[15][dg * 64 + pp];
      const double dt = (double)__expf(p.in[16][dg]) ;
      const float dtf = expf(p.in[16][dg]);
      const double dtd = (double)dtf;
      (void)dt;
      const double PI = 3.14159265358979323846;
      double ap = li * dtd / PI;
      double ar = ap - 2.0 * rint(ap * 0.5);
      const float er = expf((float)(lr * dtd));
      const double lbr = (double)er * (double)cospif((float)ar), lbi = (double)er * (double)sinpif((float)ar);
      double ap2 = ap * 256.0;
      double ar2 = ap2 - 2.0 * rint(ap2 * 0.5);
      const float er2 = expf((float)(lr * dtd * 256.0));
      if (part == 0) {
        ((float2*)(ws + OFF_LAMB))[dg * 64 + pp] = make_float2((float)lbr, (float)lbi);
        ((float2*)(ws + OFF_LAMP))[dg * 64 + pp] = make_float2(er2 * cospif((float)ar2), er2 * sinpif((float)ar2));
      }
      const double den = lr * lr + li * li;
      const double fr = ((lbr - 1.0) * lr + lbi * li) / den, fi = (lbi * lr - (lbr - 1.0) * li) / den;
      float* bb = (float*)(ws + OFF_BB) + (size_t)(dg * 64 + pp) * 32;
#pragma unroll
      for (int q = 0; q < 4; ++q) {
        const int c = part * 4 + q;
        const double br = (double)p.in[17][(size_t)(dg * 64 + pp) * 16 + c], bi = (double)p.in[18][(size_t)(dg * 64 + pp) * 16 + c];
        bb[c] = (float)(fr * br - fi * bi);
        bb[16 + c] = (float)(fr * bi + fi * br);
      }
      bfr* cm = (bfr*)(ws + OFF_CMB) + (size_t)dg * 2048;
#pragma unroll
      for (int q = 0; q < 8; ++q) {
        const int e = tid * 8 + q, c = e >> 7, k = e & 127;
        const float v = k < 64 ? p.in[19][(size_t)(dg * 16 + c) * 64 + k] : -p.in[20][(size_t)(dg * 16 + c) * 64 + (k - 64)];
        cm[e] = f2bf(v);
      }
    } else if (it < B_ROPE) {
      const int r = it - B_ZERO;
      ((float*)(ws + OFF_ROWSS))[r * 256 + tid] = 0.f;
    } else {
      const int e = (it - B_ROPE) * 256 + tid;
      const int n = e >> 4, pr = e & 15;
      const double q4[4] = {1.0, 0.5623413251903491, 0.31622776601683794, 0.1778279410038923};
      double inv = q4[0];
      if ((pr & 3) == 1) inv = q4[1]; else if ((pr & 3) == 2) inv = q4[2]; else if ((pr & 3) == 3) inv = q4[3];
      const int dec = pr >> 2;
      if (dec == 1) inv *= 0.1; else if (dec == 2) inv *= 0.01; else if (dec == 3) inv *= 0.001;
      const double ap = (double)n * inv / 3.14159265358979323846;
      const double ar = ap - 2.0 * rint(ap * 0.5);
      ((float2*)(ws + OFF_ROPE))[e] = make_float2(cospif((float)ar), sinpif((float)ar));
    }
  }
}

template <int MODE>
DI void phase_rows(const Params& p) {
  unsigned char* ws = p.ws;
  const int lane = threadIdx.x & 63, wave = threadIdx.x >> 6;
  const float* mod = (const float*)(ws + OFF_MOD);
  for (int it = blockIdx.x; it < NTOK / 4; it += gridDim.x) {
    const int T = it * 4 + wave;
    const int ci = cond_of(T);
    float4 xv[4];
    if (MODE == 2) {
      const bfr* xr = (const bfr*)(ws + OFF_X1) + (size_t)T * 1024 + lane * 4;
#pragma unroll
      for (int j = 0; j < 4; ++j) {
        const uint2 raw = *(const uint2*)(xr + 256 * j);
        xv[j].x = bf2f(raw.x & 0xffff); xv[j].y = bf2f(raw.x >> 16); xv[j].z = bf2f(raw.y & 0xffff); xv[j].w = bf2f(raw.y >> 16);
      }
    } else {
      const float4* xr = (const float4*)xrow(p, T) + lane;
#pragma unroll
      for (int j = 0; j < 4; ++j) xv[j] = xr[64 * j];
    }
    if (MODE >= 1) {
      const int l = MODE - 1;
      const bfr* orow = (const bfr*)(ws + OFF_O) + (size_t)T * 1024;
      float4 ov[4]; float ss = 0.f;
#pragma unroll
      for (int j = 0; j < 4; ++j) {
        const uint2 raw = *(const uint2*)(orow + lane * 4 + 256 * j);
        ov[j].x = bf2f(raw.x & 0xffff); ov[j].y = bf2f(raw.x >> 16); ov[j].z = bf2f(raw.y & 0xffff); ov[j].w = bf2f(raw.y >> 16);
        ss += ov[j].x * ov[j].x + ov[j].y * ov[j].y + ov[j].z * ov[j].z + ov[j].w * ov[j].w;
      }
      const float rinv = rsqrtf(wave_sum(ss) * (1.f / 1024.f) + EPS);
      const float* gate = mod + (l * 3 + ci) * 3072 + 2048;
      const float* gp = p.in[10] + l * 1024;
#pragma unroll
      for (int j = 0; j < 4; ++j) {
        const int k = lane * 4 + 256 * j;
        const float4 g4 = *(const float4*)(gate + k), n4 = *(const float4*)(gp + k);
        xv[j].x += g4.x * (ov[j].x * rinv * n4.x); xv[j].y += g4.y * (ov[j].y * rinv * n4.y);
        xv[j].z += g4.z * (ov[j].z * rinv * n4.z); xv[j].w += g4.w * (ov[j].w * rinv * n4.w);
      }
      if (MODE == 2) {
        float4* yr = (float4*)(p.out + OUT_Y + (size_t)T * 1024) + lane;
#pragma unroll
        for (int j = 0; j < 4; ++j) yr[64 * j] = xv[j];
      } else {
        bfr* x1r = (bfr*)(ws + OFF_X1) + (size_t)T * 1024 + lane * 4;
#pragma unroll
        for (int j = 0; j < 4; ++j) *(uint2*)(x1r + 256 * j) = make_uint2(pk2(xv[j].x, xv[j].y), pk2(xv[j].z, xv[j].w));
      }
    }
    if (MODE <= 1) {
      const int l = MODE;
      float ss = 0.f;
#pragma unroll
      for (int j = 0; j < 4; ++j) ss += xv[j].x * xv[j].x + xv[j].y * xv[j].y + xv[j].z * xv[j].z + xv[j].w * xv[j].w;
      const float rinv = rsqrtf(wave_sum(ss) * (1.f / 1024.f) + EPS);
      const float* shift = mod + (l * 3 + ci) * 3072;
      const float* scale = shift + 1024;
      const float* gp = p.in[9] + l * 1024;
      bfr* hr = (bfr*)(ws + OFF_HN) + (size_t)T * 1024;
#pragma unroll
      for (int j = 0; j < 4; ++j) {
        const int k = lane * 4 + 256 * j;
        const float4 s4 = *(const float4*)(shift + k), c4 = *(const float4*)(scale + k), n4 = *(const float4*)(gp + k);
        const float a = xv[j].x * rinv * n4.x * (1.f + c4.x) + s4.x;
        const float b = xv[j].y * rinv * n4.y * (1.f + c4.y) + s4.y;
        const float c = xv[j].z * rinv * n4.z * (1.f + c4.z) + s4.z;
        const float d = xv[j].w * rinv * n4.w * (1.f + c4.w) + s4.w;
        *(uint2*)(hr + k) = make_uint2(pk2(a, b), pk2(c, d));
      }
    }
  }
}

DI void phase_win0(const Params& p, unsigned char* smem) {
  unsigned char* ws = p.ws;
  const int lane = threadIdx.x & 63, wave = threadIdx.x >> 6, l32 = lane & 31, h = lane >> 5, wm = wave >> 1, wn = wave & 1;
  const bfr* A = (const bfr*)(ws + OFF_HN);
  const bfr* Bt = (const bfr*)(ws + OFF_WIN0);
  int tm, tn;
  if (!xcd_tile(0, 18, tm, tn)) return;
  LdBf al{A + (size_t)tm * 128 * 1024, 1024}, bl{Bt + (size_t)tn * 128 * 1024, 1024};
  for (int step = 0;; ++step) {
    const int m0 = tm * 128, n0 = tn * 128;
    int tm2 = 0, tn2 = 0;
    auto next_tile = [&]() {
      if (!xcd_tile(step + 1, 18, tm2, tn2)) return false;
      al.base = A + (size_t)tm2 * 128 * 1024; bl.base = Bt + (size_t)tn2 * 128 * 1024;
      return true;
    };
    auto ep = [&](f32x16 (&acc)[2][2]) {
      const int colbase = n0 + wn * 64, rbase = m0 + wm * 64;
      const bool lat = m0 >= NCTX;
      if (tn == 5) {
        const int hd = (colbase - 640) >> 6;
#pragma unroll
        for (int mi = 0; mi < 2; ++mi)
#pragma unroll
          for (int ni = 0; ni < 2; ++ni) {
            const int d = ni * 32 + l32;
#pragma unroll
            for (int i4 = 0; i4 < 4; ++i4) {
              const int r0 = rbase + mi * 32 + 8 * i4 + 4 * h;
              const float a = acc[mi][ni][4 * i4], b2 = acc[mi][ni][4 * i4 + 1], c = acc[mi][ni][4 * i4 + 2], e = acc[mi][ni][4 * i4 + 3];
              const uint2 pk = make_uint2(pk2(a, b2), pk2(c, e));
              if (!lat) {
                p.out[OUT_V + (size_t)(r0 + 0) * 128 + hd * 64 + d] = a;
                p.out[OUT_V + (size_t)(r0 + 1) * 128 + hd * 64 + d] = b2;
                p.out[OUT_V + (size_t)(r0 + 2) * 128 + hd * 64 + d] = c;
                p.out[OUT_V + (size_t)(r0 + 3) * 128 + hd * 64 + d] = e;
                const int b = r0 >> 8, l = r0 & 255;
                *(uint2*)((bfr*)(ws + OFF_VC) + ((size_t)(b * 2 + hd) * 64 + d) * 256 + l) = pk;
              } else {
                const int b = (r0 - NCTX) >> 11, l = (r0 - NCTX) & 2047;
                *(uint2*)((bfr*)(ws + OFF_VL) + ((size_t)(b * 2 + hd) * 64 + d) * 2560 + 512 + l) = pk;
              }
            }
          }
      } else if (colbase < 640) {
        const bool isq = colbase < 512;
        const float* gain = isq ? p.in[12] : p.in[13];
        const int hd = isq ? (colbase >> 6) : ((colbase - 512) >> 6);
        float4 gv[2][4];
#pragma unroll
        for (int mi = 0; mi < 2; ++mi)
#pragma unroll
          for (int i4 = 0; i4 < 4; ++i4) gv[mi][i4] = *(const float4*)(gain + mi * 32 + 8 * i4 + 4 * h);
#pragma unroll
        for (int ni = 0; ni < 2; ++ni) {
          const int T = rbase + ni * 32 + l32;
          float ss = 0.f;
#pragma unroll
          for (int mi = 0; mi < 2; ++mi)
#pragma unroll
            for (int i = 0; i < 16; ++i) ss += acc[mi][ni][i] * acc[mi][ni][i];
          ss += __shfl_xor(ss, 32);
          const float rinv = rsqrtf(ss * (1.f / 64.f) + EPS);
          float v[2][16];
#pragma unroll
          for (int mi = 0; mi < 2; ++mi)
#pragma unroll
            for (int i4 = 0; i4 < 4; ++i4) {
              v[mi][4 * i4 + 0] = acc[mi][ni][4 * i4 + 0] * rinv * gv[mi][i4].x;
              v[mi][4 * i4 + 1] = acc[mi][ni][4 * i4 + 1] * rinv * gv[mi][i4].y;
              v[mi][4 * i4 + 2] = acc[mi][ni][4 * i4 + 2] * rinv * gv[mi][i4].z;
              v[mi][4 * i4 + 3] = acc[mi][ni][4 * i4 + 3] * rinv * gv[mi][i4].w;
            }
          if (!lat && !isq) {
#pragma unroll
            for (int mi = 0; mi < 2; ++mi)
#pragma unroll
              for (int i4 = 0; i4 < 4; ++i4)
                *(float4*)(p.out + OUT_K + (size_t)T * 128 + hd * 64 + mi * 32 + 8 * i4 + 4 * h) = make_float4(v[mi][4 * i4], v[mi][4 * i4 + 1], v[mi][4 * i4 + 2], v[mi][4 * i4 + 3]);
          }
          if (lat) {
            const int pos = (T - NCTX) & 2047;
            const float* rope = (const float*)(ws + OFF_ROPE);
#pragma unroll
            for (int mi = 0; mi < 2; ++mi) {
              const float* rb = rope + ((mi == 0 ? (pos >> 6) : (pos & 63)) * 16 + 4 * h) * 2;
#pragma unroll
              for (int i4 = 0; i4 < 2; ++i4) {
                const float4 cs0 = *(const float4*)(rb + 16 * i4), cs1 = *(const float4*)(rb + 16 * i4 + 4);
                const float cc[4] = {cs0.x, cs0.z, cs1.x, cs1.z}, sn[4] = {cs0.y, cs0.w, cs1.y, cs1.w};
#pragma unroll
                for (int e = 0; e < 4; ++e) {
                  const float x1 = v[mi][4 * i4 + e], x2 = v[mi][4 * i4 + e + 8];
                  v[mi][4 * i4 + e] = x1 * cc[e] - x2 * sn[e];
                  v[mi][4 * i4 + e + 8] = x1 * sn[e] + x2 * cc[e];
                }
              }
            }
          }
          bfr* dst;
          float sc = 1.f;
          if (isq) { dst = (bfr*)(ws + OFF_QB) + (size_t)T * 512 + hd * 64; sc = 0.125f; }
          else if (!lat) { dst = (bfr*)(ws + OFF_KC) + ((size_t)((T >> 8) * 2 + hd) * 256 + (T & 255)) * 64; }
          else { dst = (bfr*)(ws + OFF_KL) + ((size_t)(((T - NCTX) >> 11) * 2 + hd) * 2560 + 512 + ((T - NCTX) & 2047)) * 64; }
#pragma unroll
          for (int mi = 0; mi < 2; ++mi)
#pragma unroll
            for (int i4 = 0; i4 < 4; ++i4)
              *(uint2*)(dst + mi * 32 + 8 * i4 + 4 * h) = make_uint2(pk2(v[mi][4 * i4] * sc, v[mi][4 * i4 + 1] * sc), pk2(v[mi][4 * i4 + 2] * sc, v[mi][4 * i4 + 3] * sc));
        }
      } else {
        const int sec = colbase < 1280 ? 0 : (colbase < 1792 ? 1 : 2);
        const int cb = colbase - (sec == 0 ? 768 : (sec == 1 ? 1280 : 1792));
        if (sec == 1) {
          float* stf = (float*)smem;
#pragma unroll
          for (int ni = 0; ni < 2; ++ni) {
            const int row = wm * 64 + ni * 32 + l32;
#pragma unroll
            for (int mi = 0; mi < 2; ++mi)
#pragma unroll
              for (int i4 = 0; i4 < 4; ++i4)
                *(float4*)(stf + row * 132 + wn * 64 + mi * 32 + 8 * i4 + 4 * h) =
                    make_float4(acc[mi][ni][4 * i4], acc[mi][ni][4 * i4 + 1], acc[mi][ni][4 * i4 + 2], acc[mi][ni][4 * i4 + 3]);
          }
          __syncthreads();
          float* dbase = (float*)(ws + OFF_U) + (size_t)m0 * 512 + (n0 - 1280);
#pragma unroll 4
          for (int i = 0; i < 16; ++i) {
            const int id = threadIdx.x + 256 * i, r = id >> 5, c4 = id & 31;
            *(float4*)(dbase + (size_t)r * 512 + c4 * 4) = *(const float4*)(stf + r * 132 + c4 * 4);
          }
        } else {
          unsigned short* stg = (unsigned short*)smem;
#pragma unroll
          for (int ni = 0; ni < 2; ++ni) {
            const int row = wm * 64 + ni * 32 + l32;
#pragma unroll
            for (int mi = 0; mi < 2; ++mi)
#pragma unroll
              for (int i4 = 0; i4 < 4; ++i4) {
                const float a = acc[mi][ni][4 * i4], b2 = acc[mi][ni][4 * i4 + 1], c2 = acc[mi][ni][4 * i4 + 2], e = acc[mi][ni][4 * i4 + 3];
                *(uint2*)(stg + row * 136 + wn * 64 + mi * 32 + 8 * i4 + 4 * h) = make_uint2(pk2(silu_f(a), silu_f(b2)), pk2(silu_f(c2), silu_f(e)));
              }
          }
          __syncthreads();
          bfr* dbase = (bfr*)(ws + (sec == 0 ? OFF_GA : OFF_GB)) + (size_t)m0 * 512 + (n0 - (sec == 0 ? 768 : 1792));
#pragma unroll
          for (int i = 0; i < 8; ++i) {
            const int id = threadIdx.x + 256 * i, r = id >> 4, c16 = id & 15;
            *(uint4*)(dbase + (size_t)r * 512 + c16 * 8) = *(const uint4*)(stg + r * 136 + c16 * 8);
          }
        }
      }
    };
    al.base = A + (size_t)m0 * 1024; bl.base = Bt + (size_t)n0 * 1024;
    gemm_tile<128>(16, tn != 5, al, bl, ep, smem);
    if (!next_tile()) break;
    tm = tm2; tn = tn2;
  }
}

DI void attn_item(const Params& p, unsigned char* smem, int it) {
  unsigned char* ws = p.ws;
  const int tid = threadIdx.x, lane = tid & 63, wave = tid >> 6, l32 = lane & 31, h = lane >> 5;
  int T0, nkeys, ldv; const bfr *Kp, *Vp; int kvh;
  if (it < 256) {
    const int b = it >> 7, qt = it & 63; kvh = (it >> 6) & 1;
    T0 = NCTX + b * 2048 + qt * 32; nkeys = 2560; ldv = 2560;
    Kp = (const bfr*)(ws + OFF_KL) + (size_t)(b * 2 + kvh) * 2560 * 64;
    Vp = (const bfr*)(ws + OFF_VL) + (size_t)(b * 2 + kvh) * 64 * 2560;
  } else {
    const int i2 = it - 256; const int b = i2 >> 4, qt = i2 & 7; kvh = (i2 >> 3) & 1;
    T0 = b * 256 + qt * 32; nkeys = 256; ldv = 256;
    Kp = (const bfr*)(ws + OFF_KC) + (size_t)(b * 2 + kvh) * 256 * 64;
    Vp = (const bfr*)(ws + OFF_VC) + (size_t)(b * 2 + kvh) * 64 * 256;
  }
  const int head = kvh * 4 + wave;
  unsigned short* Ks = (unsigned short*)smem;
  unsigned short* Vs = Ks + 64 * 72;
  bf16x8 qf[4];
  {
    const bfr* q = (const bfr*)(ws + OFF_QB) + (size_t)(T0 + l32) * 512 + head * 64 + 8 * h;
#pragma unroll
    for (int ks = 0; ks < 4; ++ks) qf[ks] = *(const bf16x8*)(q + 16 * ks);
  }
  float m = -1e30f, lsum = 0.f;
  f32x16 O[2];
#pragma unroll
  for (int i = 0; i < 16; ++i) { O[0][i] = 0.f; O[1][i] = 0.f; }
  const int rr0 = tid >> 3, cc0 = (tid & 7) * 8;
  const bfr* kp0 = Kp + (size_t)rr0 * 64 + cc0;
  const bfr* vp0 = Vp + (size_t)rr0 * ldv + cc0;
  uint4 kreg0 = *(const uint4*)kp0, kreg1 = *(const uint4*)(kp0 + 32 * 64);
  uint4 vreg0 = *(const uint4*)vp0, vreg1 = *(const uint4*)(vp0 + (size_t)32 * ldv);
  for (int k0 = 0; k0 < nkeys; k0 += 64) {
    __syncthreads();
    *(uint4*)(Ks + rr0 * 72 + cc0) = kreg0; *(uint4*)(Ks + (rr0 + 32) * 72 + cc0) = kreg1;
    *(uint4*)(Vs + rr0 * 72 + cc0) = vreg0; *(uint4*)(Vs + (rr0 + 32) * 72 + cc0) = vreg1;
    __syncthreads();
    if (k0 + 64 < nkeys) {
      kreg0 = *(const uint4*)(kp0 + (size_t)(k0 + 64) * 64); kreg1 = *(const uint4*)(kp0 + (size_t)(k0 + 96) * 64);
      vreg0 = *(const uint4*)(vp0 + k0 + 64); vreg1 = *(const uint4*)(vp0 + (size_t)32 * ldv + k0 + 64);
    }
    f32x16 st[2];
#pragma unroll
    for (int kt = 0; kt < 2; ++kt) {
#pragma unroll
      for (int i = 0; i < 16; ++i) st[kt][i] = 0.f;
#pragma unroll
      for (int ks = 0; ks < 4; ++ks) {
        const bf16x8 a = *(const bf16x8*)(Ks + (32 * kt + l32) * 72 + 16 * ks + 8 * h);
        st[kt] = MFMA32(a, qf[ks], st[kt]);
      }
    }
    float mx = st[0][0];
#pragma unroll
    for (int i = 0; i < 16; ++i) { mx = fmaxf(mx, st[0][i]); mx = fmaxf(mx, st[1][i]); }
    mx = fmaxf(mx, __shfl_xor(mx, 32));
    const float mn = fmaxf(m, mx);
    const float alpha = __expf(m - mn);
    m = mn;
    float ps = 0.f;
#pragma unroll
    for (int kt = 0; kt < 2; ++kt)
#pragma unroll
      for (int i = 0; i < 16; ++i) { const float e = __expf(st[kt][i] - mn); st[kt][i] = e; ps += e; }
    lsum = lsum * alpha + ps;
#pragma unroll
    for (int i = 0; i < 16; ++i) { O[0][i] *= alpha; O[1][i] *= alpha; }
#pragma unroll
    for (int kt = 0; kt < 2; ++kt)
#pragma unroll
      for (int s = 0; s < 2; ++s) {
        const uint4 pu = make_uint4(pk2(st[kt][8 * s], st[kt][8 * s + 1]), pk2(st[kt][8 * s + 2], st[kt][8 * s + 3]),
                                    pk2(st[kt][8 * s + 4], st[kt][8 * s + 5]), pk2(st[kt][8 * s + 6], st[kt][8 * s + 7]));
        const bf16x8 pf = __builtin_bit_cast(bf16x8, pu);
#pragma unroll
        for (int dt = 0; dt < 2; ++dt) {
          const unsigned short* vr = Vs + (32 * dt + l32) * 72 + 32 * kt + 16 * s + 4 * h;
          const s16x4 lo = *(const s16x4*)vr, hi = *(const s16x4*)(vr + 8);
          const bf16x8 va = __builtin_shufflevector(lo, hi, 0, 1, 2, 3, 4, 5, 6, 7);
          O[dt] = MFMA32(va, pf, O[dt]);
        }
      }
  }
  const float ltot = lsum + __shfl_xor(lsum, 32);
  const float inv = 1.f / ltot;
  const int T = T0 + l32;
#pragma unroll
  for (int dt = 0; dt < 2; ++dt)
#pragma unroll
    for (int i4 = 0; i4 < 4; ++i4) {
      const int d = 32 * dt + 8 * i4 + 4 * h;
      const uint2 g = *(const uint2*)((const bfr*)(ws + OFF_GA) + (size_t)T * 512 + head * 64 + d);
      const float a = O[dt][4 * i4] * inv * bf2f(g.x & 0xffff), b = O[dt][4 * i4 + 1] * inv * bf2f(g.x >> 16);
      const float c = O[dt][4 * i4 + 2] * inv * bf2f(g.y & 0xffff), e = O[dt][4 * i4 + 3] * inv * bf2f(g.y >> 16);
      *(uint2*)((bfr*)(ws + OFF_MIX) + (size_t)T * 1024 + head * 64 + d) = make_uint2(pk2(a, b), pk2(c, e));
    }
}

DI void attn_lat_item(const Params& p, unsigned char* smem, int it) {
  unsigned char* ws = p.ws;
  const int tid = threadIdx.x, lane = tid & 63, wave = tid >> 6, l32 = lane & 31, h = lane >> 5;
  const int b = it >> 8, kvh = (it >> 7) & 1, qt = (it >> 1) & 63, hp = it & 1;
  const int hw = wave & 1, kh = wave >> 1;
  const int T0 = NCTX + b * 2048 + qt * 32;
  const int head = kvh * 4 + hp * 2 + hw;
  const bfr* Kp = (const bfr*)(ws + OFF_KL) + ((size_t)(b * 2 + kvh) * 2560 + kh * 1280) * 64;
  const bfr* Vp = (const bfr*)(ws + OFF_VL) + (size_t)(b * 2 + kvh) * 64 * 2560 + kh * 1280;
  unsigned short* Ks = (unsigned short*)smem + kh * (2 * 64 * 72);
  unsigned short* Vs = Ks + 64 * 72;
  bf16x8 qf[4];
  {
    const bfr* q = (const bfr*)(ws + OFF_QB) + (size_t)(T0 + l32) * 512 + head * 64 + 8 * h;
#pragma unroll
    for (int ks = 0; ks < 4; ++ks) qf[ks] = *(const bf16x8*)(q + 16 * ks);
  }
  float m = -1e30f, lsum = 0.f;
  f32x16 O[2];
#pragma unroll
  for (int i = 0; i < 16; ++i) { O[0][i] = 0.f; O[1][i] = 0.f; }
  const int t2 = tid & 127, rr0 = t2 >> 3, cc0 = (t2 & 7) * 8;
  const bfr* kp0 = Kp + (size_t)rr0 * 64 + cc0;
  const bfr* vp0 = Vp + (size_t)rr0 * 2560 + cc0;
  uint4 kr0 = *(const uint4*)kp0, kr1 = *(const uint4*)(kp0 + 16 * 64), kr2 = *(const uint4*)(kp0 + 32 * 64), kr3 = *(const uint4*)(kp0 + 48 * 64);
  uint4 vr0 = *(const uint4*)vp0, vr1 = *(const uint4*)(vp0 + (size_t)16 * 2560), vr2 = *(const uint4*)(vp0 + (size_t)32 * 2560), vr3 = *(const uint4*)(vp0 + (size_t)48 * 2560);
  for (int k0 = 0; k0 < 1280; k0 += 64) {
    __syncthreads();
    *(uint4*)(Ks + rr0 * 72 + cc0) = kr0; *(uint4*)(Ks + (rr0 + 16) * 72 + cc0) = kr1; *(uint4*)(Ks + (rr0 + 32) * 72 + cc0) = kr2; *(uint4*)(Ks + (rr0 + 48) * 72 + cc0) = kr3;
    *(uint4*)(Vs + rr0 * 72 + cc0) = vr0; *(uint4*)(Vs + (rr0 + 16) * 72 + cc0) = vr1; *(uint4*)(Vs + (rr0 + 32) * 72 + cc0) = vr2; *(uint4*)(Vs + (rr0 + 48) * 72 + cc0) = vr3;
    __syncthreads();
    if (k0 + 64 < 1280) {
      const bfr* kq = kp0 + (size_t)(k0 + 64) * 64; const bfr* vq = vp0 + k0 + 64;
      kr0 = *(const uint4*)kq; kr1 = *(const uint4*)(kq + 16 * 64); kr2 = *(const uint4*)(kq + 32 * 64); kr3 = *(const uint4*)(kq + 48 * 64);
      vr0 = *(const uint4*)vq; vr1 = *(const uint4*)(vq + (size_t)16 * 2560); vr2 = *(const uint4*)(vq + (size_t)32 * 2560); vr3 = *(const uint4*)(vq + (size_t)48 * 2560);
    }
    f32x16 st[2];
#pragma unroll
    for (int kt = 0; kt < 2; ++kt) {
#pragma unroll
      for (int i = 0; i < 16; ++i) st[kt][i] = 0.f;
#pragma unroll
      for (int ks = 0; ks < 4; ++ks) {
        const bf16x8 a = *(const bf16x8*)(Ks + (32 * kt + l32) * 72 + 16 * ks + 8 * h);
        st[kt] = MFMA32(a, qf[ks], st[kt]);
      }
    }
    float mx = st[0][0];
#pragma unroll
    for (int i = 0; i < 16; ++i) { mx = fmaxf(mx, st[0][i]); mx = fmaxf(mx, st[1][i]); }
    mx = fmaxf(mx, __shfl_xor(mx, 32));
    const float mn = fmaxf(m, mx);
    const float alpha = __expf(m - mn);
    m = mn;
    float ps = 0.f;
#pragma unroll
    for (int kt = 0; kt < 2; ++kt)
#pragma unroll
      for (int i = 0; i < 16; ++i) { const float e = __expf(st[kt][i] - mn); st[kt][i] = e; ps += e; }
    lsum = lsum * alpha + ps;
#pragma unroll
    for (int i = 0; i < 16; ++i) { O[0][i] *= alpha; O[1][i] *= alpha; }
#pragma unroll
    for (int kt = 0; kt < 2; ++kt)
#pragma unroll
      for (int s = 0; s < 2; ++s) {
        const uint4 pu = make_uint4(pk2(st[kt][8 * s], st[kt][8 * s + 1]), pk2(st[kt][8 * s + 2], st[kt][8 * s + 3]),
                                    pk2(st[kt][8 * s + 4], st[kt][8 * s + 5]), pk2(st[kt][8 * s + 6], st[kt][8 * s + 7]));
        const bf16x8 pf = __builtin_bit_cast(bf16x8, pu);
#pragma unroll
        for (int dt = 0; dt < 2; ++dt) {
          const unsigned short* vr = Vs + (32 * dt + l32) * 72 + 32 * kt + 16 * s + 4 * h;
          const s16x4 lo = *(const s16x4*)vr, hi = *(const s16x4*)(vr + 8);
          const bf16x8 va = __builtin_shufflevector(lo, hi, 0, 1, 2, 3, 4, 5, 6, 7);
          O[dt] = MFMA32(va, pf, O[dt]);
        }
      }
  }
  float ltot = lsum + __shfl_xor(lsum, 32);
  float* xb = (float*)smem + (hw * 64 + lane) * 36;
  __syncthreads();
  if (kh == 1) {
#pragma unroll
    for (int i = 0; i < 16; ++i) { xb[i] = O[0][i]; xb[16 + i] = O[1][i]; }
    xb[32] = m; xb[33] = ltot;
  }
  __syncthreads();
  if (kh == 0) {
    const float m2 = xb[32], l2 = xb[33];
    const float mm = fmaxf(m, m2), a1 = __expf(m - mm), a2 = __expf(m2 - mm);
    ltot = ltot * a1 + l2 * a2;
    const float inv = 1.f / ltot;
#pragma unroll
    for (int i = 0; i < 16; ++i) { O[0][i] = (O[0][i] * a1 + xb[i] * a2) * inv; O[1][i] = (O[1][i] * a1 + xb[16 + i] * a2) * inv; }
    const int T = T0 + l32;
#pragma unroll
    for (int dt = 0; dt < 2; ++dt)
#pragma unroll
      for (int i4 = 0; i4 < 4; ++i4) {
        const int d = 32 * dt + 8 * i4 + 4 * h;
        const uint2 g = *(const uint2*)((const bfr*)(ws + OFF_GA) + (size_t)T * 512 + head * 64 + d);
        const float a = O[dt][4 * i4] * bf2f(g.x & 0xffff), bq = O[dt][4 * i4 + 1] * bf2f(g.x >> 16);
        const float c = O[dt][4 * i4 + 2] * bf2f(g.y & 0xffff), e = O[dt][4 * i4 + 3] * bf2f(g.y >> 16);
        *(uint2*)((bfr*)(ws + OFF_MIX) + (size_t)T * 1024 + head * 64 + d) = make_uint2(pk2(a, bq), pk2(c, e));
      }
  }
}

DI int seg_T0(int seg) { return seg < 32 ? seg * 256 : NCTX + ((seg - 32) >> 3) * 2048 + ((seg - 32) & 7) * 256; }

DI void split_bf16(const float4& v0, const float4& v1, bf16x8& hi, bf16x8& lo) {
  const unsigned h0 = pk2(v0.x, v0.y), h1 = pk2(v0.z, v0.w), h2 = pk2(v1.x, v1.y), h3 = pk2(v1.z, v1.w);
  hi = __builtin_bit_cast(bf16x8, make_uint4(h0, h1, h2, h3));
  const unsigned l0 = pk2(v0.x - bf2f(h0 & 0xffff), v0.y - bf2f(h0 >> 16)), l1 = pk2(v0.z - bf2f(h1 & 0xffff), v0.w - bf2f(h1 >> 16));
  const unsigned l2 = pk2(v1.x - bf2f(h2 & 0xffff), v1.y - bf2f(h2 >> 16)), l3 = pk2(v1.z - bf2f(h3 & 0xffff), v1.w - bf2f(h3 >> 16));
  lo = __builtin_bit_cast(bf16x8, make_uint4(l0, l1, l2, l3));
}

DI void s5_wave(const Params& p, float* BU  , int it) {
  unsigned char* ws = p.ws;
  const int lane = threadIdx.x & 63, l32 = lane & 31, h = lane >> 5;
  const int di = it & 1, g = (it >> 1) & 31, seg = it >> 6;
  const int T0 = seg_T0(seg);
  const int dg = di * 32 + g;
  bf16x8 bhi[4], blo[4];
#pragma unroll
  for (int nt = 0; nt < 4; ++nt) {
    const float* bb = (const float*)(ws + OFF_BB) + (size_t)(dg * 64 + (nt & 1) * 32 + l32) * 32 + (nt >> 1) * 16 + 8 * h;
    split_bf16(*(const float4*)bb, *(const float4*)(bb + 4), bhi[nt], blo[nt]);
  }
  const float2 lam = ((const float2*)(ws + OFF_LAMB))[dg * 64 + lane];
  bf16x8 cmf[4];
  {
    const bfr* cm = (const bfr*)(ws + OFF_CMB) + (size_t)dg * 2048 + (lane & 15) * 128 + 8 * (lane >> 4);
#pragma unroll
    for (int ks = 0; ks < 4; ++ks) cmf[ks] = *(const bf16x8*)(cm + 32 * ks);
  }
  float hr = 0.f, hi = 0.f;
  bfr* yout = (bfr*)(ws + (di == 0 ? OFF_YF : OFF_YB));
  const float* ubase = (const float*)(ws + OFF_U) + g * 16 + 8 * h;
  float4 u0, u1;
  { const int T = di == 0 ? T0 + l32 : T0 + 255 - l32; const float* up = ubase + (size_t)T * 512; u0 = *(const float4*)up; u1 = *(const float4*)(up + 4); }
  for (int c = 0; c < 8; ++c) {
    bf16x8 ahi, alo;
    split_bf16(u0, u1, ahi, alo);
    if (c < 7) { const int sg = 32 * (c + 1) + l32; const int T = di == 0 ? T0 + sg : T0 + 255 - sg; const float* up = ubase + (size_t)T * 512; u0 = *(const float4*)up; u1 = *(const float4*)(up + 4); }
#pragma unroll
    for (int nt = 0; nt < 4; ++nt) {
      f32x16 acc;
#pragma unroll
      for (int i = 0; i < 16; ++i) acc[i] = 0.f;
      acc = MFMA32(ahi, bhi[nt], acc);
      acc = MFMA32(alo, bhi[nt], acc);
      acc = MFMA32(ahi, blo[nt], acc);
#pragma unroll
      for (int i = 0; i < 16; ++i) BU[crow(i, h) * 132 + 32 * nt + l32] = acc[i];
    }
    __builtin_amdgcn_wave_barrier();
#pragma unroll 8
    for (int sl = 0; sl < 32; ++sl) {
      const float br = BU[sl * 132 + lane], bi = BU[sl * 132 + 64 + lane];
      const float nr = lam.x * hr - lam.y * hi + br;
      const float ni = lam.x * hi + lam.y * hr + bi;
      hr = nr; hi = ni;
      BU[sl * 132 + lane] = hr; BU[sl * 132 + 64 + lane] = hi;
    }
    __builtin_amdgcn_wave_barrier();
#pragma unroll
    for (int tt = 0; tt < 2; ++tt) {
      f32x4 acc = {0.f, 0.f, 0.f, 0.f};
      const float* hrow = BU + (16 * tt + (lane & 15)) * 132 + 8 * (lane >> 4);
#pragma unroll
      for (int ks = 0; ks < 4; ++ks) {
        const float4 v0 = *(const float4*)(hrow + 32 * ks), v1 = *(const float4*)(hrow + 32 * ks + 4);
        const bf16x8 a = __builtin_bit_cast(bf16x8, make_uint4(pk2(v0.x, v0.y), pk2(v0.z, v0.w), pk2(v1.x, v1.y), pk2(v1.z, v1.w)));
        acc = MFMA16(a, cmf[ks], acc);
      }
#pragma unroll
      for (int i = 0; i < 4; ++i) {
        const int sg = 32 * c + 16 * tt + 4 * (lane >> 4) + i;
        const int T = di == 0 ? T0 + sg : T0 + 255 - sg;
        yout[(size_t)T * 512 + g * 16 + (lane & 15)] = f2bf(acc[i]);
      }
    }
    __builtin_amdgcn_wave_barrier();
  }
  ((float2*)(ws + OFF_E))[((size_t)(seg * 2 + di) * 32 + g) * 64 + lane] = make_float2(hr, hi);
  if (seg < 32) {
    float* so = p.out + OUT_S + (size_t)((seg * 2 + di) * 2) * 2048 + g * 64 + lane;
    so[0] = hr; so[2048] = hi;
  }
}

DI void phase_mix0(const Params& p, unsigned char* smem) {
  constexpr int N_S5 = 3072;
  const int b = blockIdx.x, G = gridDim.x, wave = threadIdx.x >> 6;
  float* BUw = (float*)smem + wave * (32 * 132);
  if (G == 512) {
    attn_lat_item(p, smem, b);
    __syncthreads();
    if (b < 256) { for (int r = 0; r < 2; ++r) s5_wave(p, BUw, b * 8 + r * 4 + wave); }
    else s5_wave(p, BUw, 2048 + (b - 256) * 4 + wave);
    __syncthreads();
    attn_item(p, smem, 256 + b);
  } else {
    for (int it = b * 4 + wave; it < N_S5; it += G * 4) s5_wave(p, BUw, it);
    for (int it = b; it < 512; it += G) { __syncthreads(); attn_lat_item(p, smem, it); }
    for (int it = b; it < 512; it += G) { __syncthreads(); attn_item(p, smem, 256 + it); }
  }
}

DI void phase_s5fix(const Params& p, unsigned char* smem) {
  unsigned char* ws = p.ws;
  const int tid = threadIdx.x, lane = tid & 63, wave = tid >> 6;
  float* ycorr = (float*)smem;
  float* HC = (float*)smem + 4096 + wave * (16 * 132);
  for (int it = blockIdx.x; it < 48 * 32; it += gridDim.x) {
    const int g = it & 31, seg = it >> 5;
    const int T0 = seg_T0(seg);
    __syncthreads();
    if (seg >= 32) {
      for (int e = tid; e < 4096; e += 256) ycorr[e] = 0.f;
      __syncthreads();
      const int b = (seg - 32) >> 3, j = (seg - 32) & 7;
      const int di = wave & 1, half = wave >> 1;
      const int dg = di * 32 + g;
      const float2 lam = ((const float2*)(ws + OFF_LAMB))[dg * 64 + lane];
      const float2 lp = ((const float2*)(ws + OFF_LAMP))[dg * 64 + lane];
      const float* st = p.in[4] + (size_t)((b * 2 + di) * 2) * 2048 + g * 64 + lane;
      float hr = st[0], hi = st[2048];
      const int nprev = di == 0 ? j : 7 - j;
      float2 ev[7];
#pragma unroll
      for (int q = 0; q < 7; ++q) {
        const int jj = di == 0 ? q : 7 - q;
        ev[q] = ((const float2*)(ws + OFF_E))[((size_t)((32 + b * 8 + jj) * 2 + di) * 32 + g) * 64 + lane];
      }
#pragma unroll
      for (int q = 0; q < 7; ++q) {
        if (q < nprev) {
          const float nr = lp.x * hr - lp.y * hi + ev[q].x, ni = lp.x * hi + lp.y * hr + ev[q].y;
          hr = nr; hi = ni;
        }
      }
      float cr = lam.x, cim = lam.y;
      if (half) {
        float sr = lam.x, si = lam.y;
#pragma unroll
        for (int q = 0; q < 7; ++q) { const float t = sr * sr - si * si; si = 2.f * sr * si; sr = t; }
        cr = sr * lam.x - si * lam.y; cim = sr * lam.y + si * lam.x;
      }
      bf16x8 cmf[4];
      {
        const bfr* cm = (const bfr*)(ws + OFF_CMB) + (size_t)dg * 2048 + (lane & 15) * 128 + 8 * (lane >> 4);
#pragma unroll
        for (int ks = 0; ks < 4; ++ks) cmf[ks] = *(const bf16x8*)(cm + 32 * ks);
      }
      for (int c = 0; c < 8; ++c) {
#pragma unroll 8
        for (int sl = 0; sl < 16; ++sl) {
          HC[sl * 132 + lane] = cr * hr - cim * hi;
          HC[sl * 132 + 64 + lane] = cr * hi + cim * hr;
          const float nr = cr * lam.x - cim * lam.y, ni = cr * lam.y + cim * lam.x;
          cr = nr; cim = ni;
        }
        __builtin_amdgcn_wave_barrier();
        f32x4 acc = {0.f, 0.f, 0.f, 0.f};
        const float* hrow = HC + (lane & 15) * 132 + 8 * (lane >> 4);
#pragma unroll
        for (int ks = 0; ks < 4; ++ks) {
          const float4 v0 = *(const float4*)(hrow + 32 * ks), v1 = *(const float4*)(hrow + 32 * ks + 4);
          const bf16x8 a = __builtin_bit_cast(bf16x8, make_uint4(pk2(v0.x, v0.y), pk2(v0.z, v0.w), pk2(v1.x, v1.y), pk2(v1.z, v1.w)));
          acc = MFMA16(a, cmf[ks], acc);
        }
#pragma unroll
        for (int i = 0; i < 4; ++i) {
          const int sg = 128 * half + 16 * c + 4 * (lane >> 4) + i;
          const int tl = di == 0 ? sg : 255 - sg;
          atomicAdd(&ycorr[tl * 16 + (lane & 15)], acc[i]);
        }
        __builtin_amdgcn_wave_barrier();
      }
      __syncthreads();
    }
    {
      const int T = T0 + tid;
      const float* up = (const float*)(ws + OFF_U) + (size_t)T * 512 + g * 16;
      const bfr* yf = (const bfr*)(ws + OFF_YF) + (size_t)T * 512 + g * 16;
      const bfr* yb = (const bfr*)(ws + OFF_YB) + (size_t)T * 512 + g * 16;
      const float* dsk = p.in[21] + g * 16;
      unsigned o[8];
#pragma unroll
      for (int q = 0; q < 2; ++q) {
        const uint4 f = *(const uint4*)(yf + 8 * q), bk = *(const uint4*)(yb + 8 * q);
        const float4 u0 = *(const float4*)(up + 8 * q), u1 = *(const float4*)(up + 8 * q + 4);
        const float4 d0 = *(const float4*)(dsk + 8 * q), d1 = *(const float4*)(dsk + 8 * q + 4);
        const float* yc = ycorr + tid * 16 + 8 * q;
        const float uu[8] = {u0.x, u0.y, u0.z, u0.w, u1.x, u1.y, u1.z, u1.w};
        const float dd[8] = {d0.x, d0.y, d0.z, d0.w, d1.x, d1.y, d1.z, d1.w};
        const unsigned ff[4] = {f.x, f.y, f.z, f.w}, bb[4] = {bk.x, bk.y, bk.z, bk.w};
        float y[8];
#pragma unroll
        for (int e = 0; e < 8; ++e) {
          const float a = (e & 1) ? bf2f(ff[e >> 1] >> 16) : bf2f(ff[e >> 1] & 0xffff);
          const float c2 = (e & 1) ? bf2f(bb[e >> 1] >> 16) : bf2f(bb[e >> 1] & 0xffff);
          y[e] = gelu_f(uu[e] * dd[e] + a + c2 + (seg >= 32 ? yc[e] : 0.f));
        }
#pragma unroll
        for (int e = 0; e < 4; ++e) o[4 * q + e] = pk2(y[2 * e], y[2 * e + 1]);
      }
      uint4* dst = (uint4*)((bfr*)(ws + OFF_YG) + (size_t)T * 512 + g * 16);
      dst[0] = make_uint4(o[0], o[1], o[2], o[3]);
      dst[1] = make_uint4(o[4], o[5], o[6], o[7]);
    }
  }
}

template <int MODE>
DI void phase_tokgemm(const Params& p, unsigned char* smem, int layer) {
  unsigned char* ws = p.ws;
  const int lane = threadIdx.x & 63, wave = threadIdx.x >> 6, l32 = lane & 31, h = lane >> 5, wm = wave >> 1, wn = wave & 1;
  constexpr int K = MODE == 1 ? 1024 : 512, N = MODE == 1 ? 1024 : 512;
  const bfr* A = (const bfr*)(ws + (MODE == 0 ? OFF_YG : (MODE == 1 ? OFF_MIX : OFF_FZ)));
  const bfr* Bt = (const bfr*)(ws + (MODE == 0 ? OFF_GLU : (MODE == 1 ? (layer == 0 ? OFF_WOUT0 : OFF_WOUT1) : OFF_FNET)));
  constexpr int TN = N / 128;
  int tm, tn;
  if (!xcd_tile(0, TN, tm, tn)) return;
  LdBf alp{A + (size_t)tm * 128 * K, (size_t)K}, bl{Bt + (size_t)tn * 128 * K, (size_t)K};
  for (int step = 0;; ++step) {
    const int m0 = tm * 128, n0 = tn * 128;
    int tm2 = 0, tn2 = 0;
    auto next_tile = [&]() {
      if (!xcd_tile(step + 1, TN, tm2, tn2)) return false;
      alp.base = A + (size_t)tm2 * 128 * K; bl.base = Bt + (size_t)tn2 * 128 * K;
      return true;
    };
    auto ep_direct = [&](f32x16 (&acc)[2][2]) {
#pragma unroll
      for (int ni = 0; ni < 2; ++ni) {
        const int T = m0 + wm * 64 + ni * 32 + l32;
#pragma unroll
        for (int mi = 0; mi < 2; ++mi)
#pragma unroll
          for (int i4 = 0; i4 < 4; ++i4) {
            const int n = n0 + wn * 64 + mi * 32 + 8 * i4 + 4 * h;
            float a = acc[mi][ni][4 * i4], b2 = acc[mi][ni][4 * i4 + 1], c2 = acc[mi][ni][4 * i4 + 2], e = acc[mi][ni][4 * i4 + 3];
            if (MODE == 0) {
              const uint2 y = *(const uint2*)((const bfr*)(ws + OFF_YG) + (size_t)T * 512 + n);
              const uint2 gb = *(const uint2*)((const bfr*)(ws + OFF_GB) + (size_t)T * 512 + n);
              const float4 bs = *(const float4*)(p.in[23] + n);
              a = bf2f(y.x & 0xffff) * sigmoid_f(a + bs.x) * bf2f(gb.x & 0xffff);
              b2 = bf2f(y.x >> 16) * sigmoid_f(b2 + bs.y) * bf2f(gb.x >> 16);
              c2 = bf2f(y.y & 0xffff) * sigmoid_f(c2 + bs.z) * bf2f(gb.y & 0xffff);
              e = bf2f(y.y >> 16) * sigmoid_f(e + bs.w) * bf2f(gb.y >> 16);
              *(uint2*)((bfr*)(ws + OFF_MIX) + (size_t)T * 1024 + 512 + n) = make_uint2(pk2(a, b2), pk2(c2, e));
            } else if (MODE == 1) {
              *(uint2*)((bfr*)(ws + OFF_O) + (size_t)T * 1024 + n) = make_uint2(pk2(a, b2), pk2(c2, e));
            } else {
              const uint2 gd = *(const uint2*)((const bfr*)(ws + OFF_GDS) + (size_t)T * 512 + n);
              a *= bf2f(gd.x & 0xffff); b2 *= bf2f(gd.x >> 16); c2 *= bf2f(gd.y & 0xffff); e *= bf2f(gd.y >> 16);
              *(uint2*)((bfr*)(ws + OFF_MIX) + (size_t)T * 1024 + 512 + n) = make_uint2(pk2(a, b2), pk2(c2, e));
            }
          }
      }
    };
    auto ep_staged = [&](f32x16 (&acc)[2][2]) {
      unsigned short* stg = (unsigned short*)smem;
#pragma unroll
      for (int ni = 0; ni < 2; ++ni) {
        const int row = wm * 64 + ni * 32 + l32;
        const int T = m0 + row;
#pragma unroll
        for (int mi = 0; mi < 2; ++mi)
#pragma unroll
          for (int i4 = 0; i4 < 4; ++i4) {
            const int cl = wn * 64 + mi * 32 + 8 * i4 + 4 * h;
            const int n = n0 + cl;
            float a = acc[mi][ni][4 * i4], b2 = acc[mi][ni][4 * i4 + 1], c2 = acc[mi][ni][4 * i4 + 2], e = acc[mi][ni][4 * i4 + 3];
            if (MODE == 0) {
              const uint2 y = *(const uint2*)((const bfr*)(ws + OFF_YG) + (size_t)T * 512 + n);
              const uint2 gb = *(const uint2*)((const bfr*)(ws + OFF_GB) + (size_t)T * 512 + n);
              const float4 bs = *(const float4*)(p.in[23] + n);
              a = bf2f(y.x & 0xffff) * sigmoid_f(a + bs.x) * bf2f(gb.x & 0xffff);
              b2 = bf2f(y.x >> 16) * sigmoid_f(b2 + bs.y) * bf2f(gb.x >> 16);
              c2 = bf2f(y.y & 0xffff) * sigmoid_f(c2 + bs.z) * bf2f(gb.y & 0xffff);
              e = bf2f(y.y >> 16) * sigmoid_f(e + bs.w) * bf2f(gb.y >> 16);
            } else if (MODE == 2) {
              const uint2 gd = *(const uint2*)((const bfr*)(ws + OFF_GDS) + (size_t)T * 512 + n);
              a *= bf2f(gd.x & 0xffff); b2 *= bf2f(gd.x >> 16); c2 *= bf2f(gd.y & 0xffff); e *= bf2f(gd.y >> 16);
            }
            *(uint2*)(stg + row * 136 + cl) = make_uint2(pk2(a, b2), pk2(c2, e));
          }
      }
      __syncthreads();
      bfr* dbase = MODE == 1 ? (bfr*)(ws + OFF_O) + (size_t)m0 * 1024 + n0 : (bfr*)(ws + OFF_MIX) + (size_t)m0 * 1024 + 512 + n0;
#pragma unroll
      for (int i = 0; i < 8; ++i) {
        const int id = threadIdx.x + 256 * i, r = id >> 4, c16 = id & 15;
        *(uint4*)(dbase + (size_t)r * 1024 + c16 * 8) = *(const uint4*)(stg + r * 136 + c16 * 8);
      }
    };
    auto ep = [&](f32x16 (&acc)[2][2]) { if constexpr (MODE == 1) ep_staged(acc); else ep_direct(acc); };
    if constexpr (MODE == 2) {
      bl.base = Bt + (size_t)n0 * K;
      if (m0 < NCTX) {
        LdBf al{A + (size_t)m0 * K, (size_t)K};
        gemm_tile<128>(K / 64, true, al, bl, ep, smem);
      } else {
        LdFz al{(const bfr*)(ws + OFF_HN) + (size_t)(m0 - NCTX) * 512};
        gemm_tile<128, false>(K / 64, true, al, bl, ep, smem);
      }
      if (!next_tile()) break;
    } else {
      alp.base = A + (size_t)m0 * K; bl.base = Bt + (size_t)n0 * K;
      gemm_tile<128>(K / 64, true, alp, bl, ep, smem);
      if (!next_tile()) break;
    }
    tm = tm2; tn = tn2;
  }
}

DI void phase_win1(const Params& p, unsigned char* smem) {
  unsigned char* ws = p.ws;
  const int lane = threadIdx.x & 63, wave = threadIdx.x >> 6, l32 = lane & 31, h = lane >> 5, wm = wave >> 1, wn = wave & 1;
  const bfr* A = (const bfr*)(ws + OFF_HN);
  const bfr* Bt = (const bfr*)(ws + OFF_WIN1);
  int tm, tn;
  if (!xcd_tile(0, 24, tm, tn)) return;
  LdBf al{A + (size_t)tm * 128 * 1024, 1024}, bl{Bt + (size_t)tn * 128 * 1024, 1024};
  for (int step = 0;; ++step) {
    const int m0 = tm * 128, n0 = tn * 128;
    int tm2 = 0, tn2 = 0;
    auto next_tile = [&]() {
      if (!xcd_tile(step + 1, 24, tm2, tn2)) return false;
      al.base = A + (size_t)tm2 * 128 * 1024; bl.base = Bt + (size_t)tn2 * 128 * 1024;
      return true;
    };
    auto ep = [&](f32x16 (&acc)[2][2]) {
      const int colbase = n0 + wn * 64, rbase = m0 + wm * 64;
      const int sec = colbase >> 9;
      const int cbt = n0 & 511;
      const bool lat = m0 >= NCTX;
      unsigned short* stg = (unsigned short*)smem;
      if (sec == 0 || sec == 2 || sec == 5) {
#pragma unroll
        for (int ni = 0; ni < 2; ++ni) {
          const int row = wm * 64 + ni * 32 + l32;
#pragma unroll
          for (int mi = 0; mi < 2; ++mi)
#pragma unroll
            for (int i4 = 0; i4 < 4; ++i4) {
              const float a = acc[mi][ni][4 * i4], b2 = acc[mi][ni][4 * i4 + 1], c2 = acc[mi][ni][4 * i4 + 2], e = acc[mi][ni][4 * i4 + 3];
              const uint2 o = sec == 0 ? make_uint2(pk2(gelu_f(a), gelu_f(b2)), pk2(gelu_f(c2), gelu_f(e))) : make_uint2(pk2(silu_f(a), silu_f(b2)), pk2(silu_f(c2), silu_f(e)));
              *(uint2*)(stg + row * 136 + wn * 64 + mi * 32 + 8 * i4 + 4 * h) = o;
            }
        }
      } else {
        if (sec == 1) {
          float* rowss = (float*)(ws + OFF_ROWSS);
#pragma unroll
          for (int mi = 0; mi < 2; ++mi)
#pragma unroll
            for (int i = 0; i < 16; ++i) {
              const float g0 = gelu_f(acc[mi][0][i]), g1 = gelu_f(acc[mi][1][i]);
              acc[mi][0][i] = g0; acc[mi][1][i] = g1;
              const float ss = half_sum32(g0 * g0 + g1 * g1);
              if (l32 == 0) atomicAdd(rowss + rbase + mi * 32 + crow(i, h), ss);
            }
        }
#pragma unroll
        for (int mi = 0; mi < 2; ++mi)
#pragma unroll
          for (int ni = 0; ni < 2; ++ni)
#pragma unroll
            for (int i4 = 0; i4 < 4; ++i4)
              *(uint2*)(stg + (wn * 64 + ni * 32 + l32) * 136 + wm * 64 + mi * 32 + 8 * i4 + 4 * h) =
                  make_uint2(pk2(acc[mi][ni][4 * i4], acc[mi][ni][4 * i4 + 1]), pk2(acc[mi][ni][4 * i4 + 2], acc[mi][ni][4 * i4 + 3]));
      }
      __syncthreads();
      bfr* dbase; size_t dld;
      if (sec == 0 || sec == 2 || sec == 5) { dbase = (bfr*)(ws + (sec == 0 ? OFF_CUG : (sec == 2 ? OFF_GCS : OFF_GDS))) + (size_t)m0 * 512 + cbt; dld = 512; }
      else if (sec == 1) { dbase = (bfr*)(ws + OFF_CVT) + (size_t)cbt * NTOK + m0; dld = NTOK; }
      else if (!lat) { dbase = (bfr*)(ws + OFF_ZTC) + ((size_t)((m0 >> 8) * 512 + cbt)) * 512 + (sec - 3) * 256 + (m0 & 255); dld = 512; }
      else { dbase = (bfr*)(ws + OFF_ZTL) + ((size_t)(((m0 - NCTX) >> 11) * 512 + cbt)) * 4096 + (sec - 3) * 2048 + ((m0 - NCTX) & 2047); dld = 4096; }
#pragma unroll
      for (int i = 0; i < 8; ++i) {
        const int id = threadIdx.x + 256 * i, r = id >> 4, c16 = id & 15;
        *(uint4*)(dbase + (size_t)r * dld + c16 * 8) = *(const uint4*)(stg + r * 136 + c16 * 8);
      }
    };
    const int sec0 = n0 >> 9;
    al.base = A + (size_t)m0 * 1024; bl.base = Bt + (size_t)n0 * 1024;
    gemm_tile<128>(16, sec0 == 0 || sec0 == 2 || sec0 == 5, al, bl, ep, smem);
    if (!next_tile()) break;
    tm = tm2; tn = tn2;
  }
}

struct LdWs {
  const float* w; const float* rowss;
  const float* p[4]; const float* rp;
  DI void init(int lrow, int lcol) {
#pragma unroll
    for (int i = 0; i < 4; ++i) p[i] = w + (lrow + 32 * i) * 128 + lcol;
    rp = rowss + lcol;
  }
  DI void advance(int adv) {
#pragma unroll
    for (int i = 0; i < 4; ++i) p[i] += 64 * adv;
    rp += 64 * adv;
  }
  DI uint4 load(int i) const {
    const float* wp = p[i];
    const float4 a = *(const float4*)wp, b = *(const float4*)(wp + 4);
    const float4 s0 = *(const float4*)rp, s1 = *(const float4*)(rp + 4);
    const float r0 = rsqrtf(s0.x * (1.f / 512.f) + EPS), r1 = rsqrtf(s0.y * (1.f / 512.f) + EPS), r2 = rsqrtf(s0.z * (1.f / 512.f) + EPS), r3 = rsqrtf(s0.w * (1.f / 512.f) + EPS);
    const float r4 = rsqrtf(s1.x * (1.f / 512.f) + EPS), r5 = rsqrtf(s1.y * (1.f / 512.f) + EPS), r6 = rsqrtf(s1.z * (1.f / 512.f) + EPS), r7 = rsqrtf(s1.w * (1.f / 512.f) + EPS);
    return make_uint4(pk2(a.x * r0, a.y * r1), pk2(a.z * r2, a.w * r3), pk2(b.x * r4, b.y * r5), pk2(b.z * r6, b.w * r7));
  }
};

DI void phase_mix1(const Params& p, unsigned char* smem) {
  unsigned char* ws = p.ws;
  const int lane = threadIdx.x & 63, wave = threadIdx.x >> 6, l32 = lane & 31, h = lane >> 5, wm = wave >> 1, wn = wave & 1;
  constexpr int N_FL = 512, N_FC = 256, N_G = 768;
  for (int it = blockIdx.x; it < N_FL + N_FC + N_G; it += gridDim.x) {
    if (it < N_FL + N_FC) {
      const bfr *A, *Bt; int K, Tbase, tm, tn;
      int kq = 0; bool isl = it < N_FL;
      if (isl) {
        const int b = it >> 8; kq = it & 3; tn = (it >> 2) & 3; tm = (it >> 4) & 15; K = 4096;
        A = (const bfr*)(ws + OFF_ALAT) + kq * 1024; Bt = (const bfr*)(ws + OFF_ZTL) + (size_t)b * 512 * 4096 + kq * 1024; Tbase = NCTX + b * 2048;
      } else {
        const int i2 = it - N_FL; const int b = i2 >> 3; tm = (i2 >> 2) & 1; tn = i2 & 3; K = 512;
        A = (const bfr*)(ws + OFF_ACTX); Bt = (const bfr*)(ws + OFF_ZTC) + (size_t)b * 512 * 512; Tbase = b * 256;
      }
      LdBf al{A + (size_t)tm * 128 * K, (size_t)K}, bl{Bt + (size_t)tn * 128 * K, (size_t)K};
      auto ep = [&](f32x16 (&acc)[2][2]) {
#pragma unroll
        for (int mi = 0; mi < 2; ++mi)
#pragma unroll
          for (int ni = 0; ni < 2; ++ni)
#pragma unroll
            for (int i = 0; i < 16; ++i) {
              const int T = Tbase + tm * 128 + wm * 64 + mi * 32 + crow(i, h);
              const int n = tn * 128 + wn * 64 + ni * 32 + l32;
              if (!isl) ((bfr*)(ws + OFF_FZ))[(size_t)T * 512 + n] = f2bf(acc[mi][ni][i]);
              else ((bfr*)(ws + OFF_HN))[((size_t)kq * 4096 + (T - NCTX)) * 512 + n] = f2bf(acc[mi][ni][i]);
            }
      };
      gemm_tile<128>(isl ? 16 : K / 64, false, al, bl, ep, smem);
    } else {
      const int i2 = it - N_FL - N_FC; const int hg = i2 & 7, chunk = i2 >> 3;
      LdWs al{p.in[27] + (size_t)hg * 128 * 128, (const float*)(ws + OFF_ROWSS) + chunk * 128};
      LdBf bl{(const bfr*)(ws + OFF_CVT) + (size_t)(hg * 64) * NTOK + chunk * 128, (size_t)NTOK};
      auto ep = [&](f32x16 (&acc)[2][1]) {
        const int c = hg * 64 + wn * 32 + l32;
        const float vg = p.in[26][c];
#pragma unroll
        for (int mi = 0; mi < 2; ++mi)
#pragma unroll
          for (int i = 0; i < 16; ++i) {
            const int t = wm * 64 + mi * 32 + crow(i, h);
            const int T = chunk * 128 + t;
            const float sp = acc[mi][0][i] * vg + p.in[28][hg * 128 + t];
            const float cu = bf2f(((const bfr*)(ws + OFF_CUG))[(size_t)T * 512 + c]);
            const float gc = bf2f(((const bfr*)(ws + OFF_GCS))[(size_t)T * 512 + c]);
            ((bfr*)(ws + OFF_MIX))[(size_t)T * 1024 + c] = f2bf(cu * sp * gc);
          }
      };
      gemm_tile<64>(2, false, al, bl, ep, smem);
    }
  }
}

constexpr int NPHASE = 13;
#ifndef DOUBLE_MASK
#define DOUBLE_MASK 0
#endif
template <int PH>
DI void run_phase(const Params& p, unsigned char* smem) {
  if constexpr (PH == 0) phase0(p, smem);
  else if constexpr (PH == 1) phase_rows<0>(p);
  else if constexpr (PH == 2) phase_win0(p, smem);
  else if constexpr (PH == 3) phase_mix0(p, smem);
  else if constexpr (PH == 4) phase_s5fix(p, smem);
  else if constexpr (PH == 5) phase_tokgemm<0>(p, smem, 0);
  else if constexpr (PH == 6) phase_tokgemm<1>(p, smem, 0);
  else if constexpr (PH == 7) phase_rows<1>(p);
  else if constexpr (PH == 8) phase_win1(p, smem);
  else if constexpr (PH == 9) phase_mix1(p, smem);
  else if constexpr (PH == 10) phase_tokgemm<2>(p, smem, 1);
  else if constexpr (PH == 11) phase_tokgemm<1>(p, smem, 1);
  else if constexpr (PH == 12) phase_rows<2>(p);
}
template <int LO, int HI>
DI void run_range(const Params& p, unsigned char* smem, const XcdBarrier& xb) {
  if constexpr (LO < HI) {
    run_phase<LO>(p, smem);
    if constexpr (((DOUBLE_MASK) >> LO) & 1) { xcd_barrier(xb); run_phase<LO>(p, smem); }
    if constexpr (LO + 1 < HI) { xcd_barrier(xb); run_range<LO + 1, HI>(p, smem, xb); }
  }
}
template <int LO, int HI>
__global__ void __launch_bounds__(256, 2) mega(Params p) {
  __shared__ __attribute__((aligned(16))) unsigned char smem[73728];
  __shared__ uint4 xb_words;
  if (threadIdx.x == 0) xb_words = make_uint4(0u, 0u, 0u, 0u);
  __syncthreads();
  XcdBarrier xb = xcd_barrier_post((unsigned*)(p.ws + OFF_BAR), (volatile LAS unsigned*)&xb_words);
  run_range<LO, HI>(p, smem, xb);
  if (p.ph_lo != 0) cg::this_grid().sync();
}

#ifndef ONE_LAUNCH
#define ONE_LAUNCH 1
#endif
#if !ONE_LAUNCH
template <int PH>
static void launch_phases(Params& p, int grid, hipStream_t stream) {
  if constexpr (PH < NPHASE) {
    hipLaunchKernelGGL((mega<PH, PH + 1>), dim3(grid), dim3(256), 0, stream, p);
    launch_phases<PH + 1>(p, grid, stream);
  }
}
#endif

#ifndef ONE_LAUNCH
#define ONE_LAUNCH 1
#endif

extern "C" void kernel_launch(void* const* d_in, const int* in_sizes, int n_in, void* d_out, int out_size, void* d_ws, size_t ws_size, hipStream_t stream) {
  static int grid_blocks = 0;
  if (!grid_blocks) {
    int dev = 0, cus = 0, per_cu = 0;
    (void)hipGetDevice(&dev);
    (void)hipDeviceGetAttribute(&cus, hipDeviceAttributeMultiprocessorCount, dev);
    (void)hipOccupancyMaxActiveBlocksPerMultiprocessor(&per_cu, mega<0, NPHASE>, 256, 0);
    if (per_cu > 2) per_cu = 2;
    if (per_cu < 1) per_cu = 1;
    grid_blocks = cus * per_cu;
    if (n_in != 31 || ws_size < WS_TOTAL) fprintf(stderr, "kernel_launch: unexpected n_in %d or ws_size %zu (need %zu)\n", n_in, ws_size, (size_t)WS_TOTAL);
  }
  Params p{};
  for (int i = 0; i < 31; ++i) p.in[i] = (const float*)d_in[i];
  p.out = (float*)d_out; p.ws = (unsigned char*)d_ws;
  (void)hipMemsetAsync((unsigned char*)d_ws + OFF_BAR, 0, 16384, stream);
#if ONE_LAUNCH
  p.ph_lo = 0; p.ph_hi = NPHASE;
  void* args[] = {&p};
  hipError_t e = hipLaunchCooperativeKernel((void*)mega<0, NPHASE>, dim3(grid_blocks), dim3(256), args, 0, stream);
  if (e != hipSuccess) fprintf(stderr, "cooperative launch failed: %s (grid %d)\n", hipGetErrorString(e), grid_blocks);
#else
  launch_phases<0>(p, grid_blocks, stream);
#endif
}
```

```cpp
#include <hip/hip_runtime.h>
#include <hip/hip_cooperative_groups.h>
#include <cstdio>
#include <cstdint>
namespace cg = cooperative_groups;

#define DI __device__ __forceinline__
typedef unsigned short bfr;
using bf16x8 = __attribute__((ext_vector_type(8))) short;
using s16x4  = __attribute__((ext_vector_type(4))) short;
using f32x16 = __attribute__((ext_vector_type(16))) float;
using f32x4  = __attribute__((ext_vector_type(4))) float;

#define MFMA32(a, b, c) __builtin_amdgcn_mfma_f32_32x32x16_bf16((a), (b), (c), 0, 0, 0)
#define MFMA16(a, b, c) __builtin_amdgcn_mfma_f32_16x16x32_bf16((a), (b), (c), 0, 0, 0)

constexpr int NTOK = 12288, NCTX = 8192;
constexpr float EPS = 1e-6f;

constexpr size_t OFF_MOD   = 0;
constexpr size_t OFF_ROWSS = OFF_MOD + 73728;
constexpr size_t OFF_ROPE  = OFF_ROWSS + 49152;
constexpr size_t OFF_LAMB  = OFF_ROPE + 8192;
constexpr size_t OFF_LAMP  = OFF_LAMB + 32768;
constexpr size_t OFF_BB    = OFF_LAMP + 32768;
constexpr size_t OFF_CMB   = OFF_BB + 524288;
constexpr size_t OFF_E     = OFF_CMB + 262144;
constexpr size_t OFF_WIN0  = OFF_E + 1572864;
constexpr size_t OFF_GLU   = OFF_WIN0 + 4718592;
constexpr size_t OFF_WOUT0 = OFF_GLU + 524288;
constexpr size_t OFF_WIN1  = OFF_WOUT0 + 2097152;
constexpr size_t OFF_FNET  = OFF_WIN1 + 6291456;
constexpr size_t OFF_WOUT1 = OFF_FNET + 524288;
constexpr size_t OFF_ACTX  = OFF_WOUT1 + 2097152;
constexpr size_t OFF_ALAT  = OFF_ACTX + 262144;
constexpr size_t OFF_X1    = OFF_ALAT + 16777216;
constexpr size_t OFF_HN    = OFF_X1 + 50331648;
constexpr size_t OFF_MIX   = OFF_HN + 25165824;
constexpr size_t OFF_O     = OFF_MIX + 25165824;
constexpr size_t OFF_U     = OFF_O;
constexpr size_t OFF_R     = OFF_O + 25165824;
constexpr size_t OFF_QB = OFF_R;
constexpr size_t OFF_KC = OFF_QB + 12582912;
constexpr size_t OFF_KL = OFF_KC + 2097152;
constexpr size_t OFF_VC = OFF_KL + 1310720;
constexpr size_t OFF_VL = OFF_VC + 2097152;
constexpr size_t OFF_GA = OFF_VL + 1310720;
constexpr size_t OFF_GB = OFF_GA + 12582912;
constexpr size_t OFF_YF = OFF_GB + 12582912;
constexpr size_t OFF_YB = OFF_YF + 12582912;
constexpr size_t OFF_YG = OFF_YB + 12582912;
constexpr size_t END_L0 = OFF_YG + 12582912;
constexpr size_t OFF_CUG = OFF_R;
constexpr size_t OFF_GCS = OFF_CUG + 12582912;
constexpr size_t OFF_GDS = OFF_GCS + 12582912;
constexpr size_t OFF_CVT = OFF_GDS + 12582912;
constexpr size_t OFF_FZ  = OFF_CVT + 12582912;
constexpr size_t OFF_ZTC = OFF_FZ + 12582912;
constexpr size_t OFF_ZTL = OFF_ZTC + 16777216;
constexpr size_t END_L1 = OFF_ZTL + 8388608;
constexpr size_t WS_NEED = (END_L0 > END_L1 ? END_L0 : END_L1);
constexpr size_t OFF_BAR = WS_NEED;
constexpr size_t WS_TOTAL = OFF_BAR + 16384;
static_assert(WS_TOTAL <= (size_t)256 * 1024 * 1024, "workspace too large");

constexpr size_t OUT_Y = 0, OUT_K = 12582912, OUT_V = 13631488, OUT_S = 14680064;

struct Params {
  const float* in[31];
  float* out;
  unsigned char* ws;
  int ph_lo, ph_hi;
};

typedef __bf16 hbf2 __attribute__((ext_vector_type(2)));
typedef float hfl2 __attribute__((ext_vector_type(2)));
DI unsigned pk2(float lo, float hi) { hfl2 v = {lo, hi}; hbf2 r = __builtin_convertvector(v, hbf2); return __builtin_bit_cast(unsigned, r); }
DI unsigned short f2bf(float x) { return (unsigned short)(pk2(x, 0.f) & 0xffffu); }
DI float bf2f(unsigned short b) { return __uint_as_float(((unsigned)b) << 16); }
DI float wave_sum(float v) {
#pragma unroll
  for (int o = 1; o < 64; o <<= 1) v += __shfl_xor(v, o);
  return v;
}
DI float half_sum32(float v) {
#pragma unroll
  for (int o = 1; o < 32; o <<= 1) v += __shfl_xor(v, o);
  return v;
}
DI float silu_f(float x) { return x / (1.f + __expf(-x)); }
DI float sigmoid_f(float x) { return 1.f / (1.f + __expf(-x)); }
DI float gelu_f(float x) { float z = 0.7978845608028654f * (x + 0.044715f * x * x * x); return x / (1.f + __expf(-2.f * z)); }
DI int crow(int i, int h) { return (i & 3) + 8 * (i >> 2) + 4 * h; }
DI const float* xrow(const Params& p, int T) { return T < NCTX ? p.in[0] + (size_t)T * 1024 : p.in[1] + (size_t)(T - NCTX) * 1024; }
DI int cond_of(int T) { return T < NCTX ? 0 : 1 + ((T - NCTX) >> 11); }

template <int BN, bool D2 = false, class AL, class BL, class EP>
DI void gemm_tile(int nk, bool swp, AL al, BL bl, EP ep, unsigned char* smem) {
  constexpr int NI = BN / 64;
  constexpr int NB = BN / 32;
  constexpr int STG = (128 + BN) * 72;
  unsigned short* S0 = (unsigned short*)smem;
  const int tid = threadIdx.x, lane = tid & 63, wave = tid >> 6, l32 = lane & 31, h = lane >> 5;
  const int wm = wave >> 1, wn = wave & 1;
  const int xoff = (swp ? 128 * 72 + (wn * 64 + l32) * 72 : (wm * 64 + l32) * 72) + h * 8;
  const int yoff = (swp ? (wm * 64 + l32) * 72 : 128 * 72 + (wn * (BN / 2) + l32) * 72) + h * 8;
  f32x16 acc[2][NI];
#pragma unroll
  for (int mi = 0; mi < 2; ++mi)
#pragma unroll
    for (int ni = 0; ni < NI; ++ni)
#pragma unroll
      for (int i = 0; i < 16; ++i) acc[mi][ni][i] = 0.f;
  uint4 ra[2][4], rb[2][NB];
  const int lrow = tid >> 3, lcol = (tid & 7) * 8;
  al.init(lrow, lcol); bl.init(lrow, lcol);
  int nxt = 0;
  auto gload = [&](uint4 (&a4)[4], uint4 (&b4)[NB]) {
#pragma unroll
    for (int i = 0; i < 4; ++i) a4[i] = al.load(i);
#pragma unroll
    for (int i = 0; i < NB; ++i) b4[i] = bl.load(i);
    const int adv = (nxt + 1 < nk) ? 1 : 0;
    al.advance(adv); bl.advance(adv); nxt += adv;
  };
  auto lstore = [&](const uint4 (&a4)[4], const uint4 (&b4)[NB], unsigned short* st) {
#pragma unroll
    for (int i = 0; i < 4; ++i) *(uint4*)(st + (lrow + 32 * i) * 72 + lcol) = a4[i];
#pragma unroll
    for (int i = 0; i < NB; ++i) *(uint4*)(st + 128 * 72 + (lrow + 32 * i) * 72 + lcol) = b4[i];
  };
  auto compute = [&](const unsigned short* st) {
#pragma unroll
    for (int ks = 0; ks < 4; ++ks) {
      bf16x8 x[2], y[NI];
#pragma unroll
      for (int mi = 0; mi < 2; ++mi) x[mi] = *(const bf16x8*)(st + xoff + mi * 32 * 72 + ks * 16);
#pragma unroll
      for (int ni = 0; ni < NI; ++ni) y[ni] = *(const bf16x8*)(st + yoff + ni * 32 * 72 + ks * 16);
#pragma unroll
      for (int mi = 0; mi < 2; ++mi)
#pragma unroll
        for (int ni = 0; ni < NI; ++ni) acc[mi][ni] = MFMA32(x[mi], y[ni], acc[mi][ni]);
    }
  };
  if constexpr (D2) {
    gload(ra[0], rb[0]);
    gload(ra[1], rb[1]);
    __syncthreads();
    lstore(ra[0], rb[0], S0);
    gload(ra[0], rb[0]);
    __syncthreads();
    for (int kt = 0; kt < nk; kt += 2) {
      compute(S0);
      lstore(ra[1], rb[1], S0 + STG);
      gload(ra[1], rb[1]);
      __syncthreads();
      compute(S0 + STG);
      if (kt + 2 < nk) lstore(ra[0], rb[0], S0);
      gload(ra[0], rb[0]);
      __syncthreads();
    }
  } else {
    gload(ra[0], rb[0]);
    __syncthreads();
    lstore(ra[0], rb[0], S0);
    gload(ra[0], rb[0]);
    __syncthreads();
    for (int kt = 0; kt < nk; kt += 2) {
      compute(S0);
      lstore(ra[0], rb[0], S0 + STG);
      gload(ra[0], rb[0]);
      __syncthreads();
      compute(S0 + STG);
      if (kt + 2 < nk) lstore(ra[0], rb[0], S0);
      gload(ra[0], rb[0]);
      __syncthreads();
    }
  }
  ep(acc);
}

template <int BN> struct GStage { uint4 ra[2][4]; uint4 rb[2][BN / 32]; int nxt; };
template <int BN, class AL, class BL, class EP, class NX>
DI bool gemm_tile_pf(int nk, bool swp, bool first, AL& al, BL& bl, GStage<BN>& st, EP ep, NX next_tile, unsigned char* smem) {
  constexpr int NI = BN / 64;
  constexpr int NB = BN / 32;
  constexpr int STG = (128 + BN) * 72;
  unsigned short* S0 = (unsigned short*)smem;
  const int tid = threadIdx.x, lane = tid & 63, wave = tid >> 6, l32 = lane & 31, h = lane >> 5;
  const int wm = wave >> 1, wn = wave & 1;
  const int xoff = (swp ? 128 * 72 + (wn * 64 + l32) * 72 : (wm * 64 + l32) * 72) + h * 8;
  const int yoff = (swp ? (wm * 64 + l32) * 72 : 128 * 72 + (wn * (BN / 2) + l32) * 72) + h * 8;
  f32x16 acc[2][NI];
#pragma unroll
  for (int mi = 0; mi < 2; ++mi)
#pragma unroll
    for (int ni = 0; ni < NI; ++ni)
#pragma unroll
      for (int i = 0; i < 16; ++i) acc[mi][ni][i] = 0.f;
  const int lrow = tid >> 3, lcol = (tid & 7) * 8;
  auto gload = [&](uint4 (&a4)[4], uint4 (&b4)[NB]) {
#pragma unroll
    for (int i = 0; i < 4; ++i) a4[i] = al.load(i);
#pragma unroll
    for (int i = 0; i < NB; ++i) b4[i] = bl.load(i);
    const int adv = (st.nxt + 1 < nk) ? 1 : 0;
    al.advance(adv); bl.advance(adv); st.nxt += adv;
  };
  auto lstore = [&](const uint4 (&a4)[4], const uint4 (&b4)[NB], unsigned short* sp) {
#pragma unroll
    for (int i = 0; i < 4; ++i) *(uint4*)(sp + (lrow + 32 * i) * 72 + lcol) = a4[i];
#pragma unroll
    for (int i = 0; i < NB; ++i) *(uint4*)(sp + 128 * 72 + (lrow + 32 * i) * 72 + lcol) = b4[i];
  };
  auto compute = [&](const unsigned short* sp) {
#pragma unroll
    for (int ks = 0; ks < 4; ++ks) {
      bf16x8 x[2], y[NI];
#pragma unroll
      for (int mi = 0; mi < 2; ++mi) x[mi] = *(const bf16x8*)(sp + xoff + mi * 32 * 72 + ks * 16);
#pragma unroll
      for (int ni = 0; ni < NI; ++ni) y[ni] = *(const bf16x8*)(sp + yoff + ni * 32 * 72 + ks * 16);
#pragma unroll
      for (int mi = 0; mi < 2; ++mi)
#pragma unroll
        for (int ni = 0; ni < NI; ++ni) acc[mi][ni] = MFMA32(x[mi], y[ni], acc[mi][ni]);
    }
  };
  if (first) {
    al.init(lrow, lcol); bl.init(lrow, lcol); st.nxt = 0;
    gload(st.ra[0], st.rb[0]);
    gload(st.ra[1], st.rb[1]);
  }
  __syncthreads();
  lstore(st.ra[0], st.rb[0], S0);
  gload(st.ra[0], st.rb[0]);
  __syncthreads();
  for (int kt = 0; kt < nk; kt += 2) {
    compute(S0);
    lstore(st.ra[1], st.rb[1], S0 + STG);
    gload(st.ra[1], st.rb[1]);
    __syncthreads();
    compute(S0 + STG);
    if (kt + 2 < nk) lstore(st.ra[0], st.rb[0], S0);
    gload(st.ra[0], st.rb[0]);
    __syncthreads();
  }
  const bool more = next_tile();
  if (more) {
    al.init(lrow, lcol); bl.init(lrow, lcol); st.nxt = 0;
    gload(st.ra[0], st.rb[0]);
    gload(st.ra[1], st.rb[1]);
  }
  ep(acc);
  return more;
}

DI bool xcd_tile(int step, int ntn, int& tm, int& tn) {
  const int G = gridDim.x;
  if ((G & 7) == 0) {
    const int x = blockIdx.x & 7, loc = blockIdx.x >> 3, per = G >> 3;
    const int j = loc + step * per;
    if (j >= 12 * ntn) return false;
    tn = j / 12; tm = 12 * x + j % 12;
    return true;
  }
  const int it = blockIdx.x + step * G;
  if (it >= 96 * ntn) return false;
  tm = it / ntn; tn = it % ntn;
  return true;
}

#define GAS __attribute__((address_space(1)))
typedef unsigned u32x4 __attribute__((ext_vector_type(4)));
DI uint4 gld16(const GAS char* q) { const u32x4 v = *(const GAS u32x4*)q; return make_uint4(v.x, v.y, v.z, v.w); }
struct LdBf {
  const bfr* base; size_t ld;
  const GAS char* p[4];
  DI void init(int lrow, int lcol) {
#pragma unroll
    for (int i = 0; i < 4; ++i) { p[i] = (const GAS char*)(base + (size_t)(lrow + 32 * i) * ld + lcol); asm volatile("" : "+v"(p[i])); }
  }
  DI uint4 load(int i) const { return gld16(p[i]); }
  DI void advance(int adv) {
#pragma unroll
    for (int i = 0; i < 4; ++i) p[i] += 128 * adv;
  }
};
#define XB_TMO      128
#define XB_XCNT(j)  (256  + 64 * (j))
#define XB_XSUB(j)  (1280 + 64 * (j))
#define XB_XGEN(j)  (2304 + 64 * (j))
#define XB_TOP      3328
#define XB_TOPGEN   3392
#define XCD_BAR_WORDS 3456
#define XB_SPIN_CAP (1u << 20)
#define LAS __attribute__((address_space(3)))
DI unsigned xb_ld(unsigned* p)              { return __hip_atomic_load(p, __ATOMIC_RELAXED, __HIP_MEMORY_SCOPE_AGENT); }
DI unsigned xb_add(unsigned* p, unsigned v) { return __hip_atomic_fetch_add(p, v, __ATOMIC_RELAXED, __HIP_MEMORY_SCOPE_AGENT); }
DI unsigned xb_xcc_id() { return (unsigned)__builtin_amdgcn_s_getreg((3 << 11) | 20) & 0xFu; }
#define XB_SPIN(cond, bar) do { unsigned _sp = 0; while (cond) { __builtin_amdgcn_s_sleep(1); \
    if ((++_sp & 255u) == 0u) { if (xb_ld(&(bar)[XB_TMO])) break; if (_sp > XB_SPIN_CAP) { atomicAdd(&(bar)[XB_TMO], 1u); break; } } } } while (0)
struct XcdBarrier { unsigned* bar; unsigned x; volatile LAS unsigned* st; };
DI XcdBarrier xcd_barrier_post(unsigned* bar, volatile LAS unsigned* st) {
  XcdBarrier b; b.bar = bar; b.x = xb_xcc_id(); b.st = st;
  if (threadIdx.x == 0) (void)xb_add(&bar[XB_XCNT(b.x)], 1u);
  return b;
}
DI void xcd_barrier_complete(unsigned* bar, unsigned x, unsigned& nloc, unsigned& nx) {
  const unsigned G = gridDim.x * gridDim.y * gridDim.z;
  unsigned sum, cnt, mine, sp = 0u;
  for (;;) {
    sum = 0u; cnt = 0u; mine = 0u;
#pragma unroll
    for (unsigned j = 0; j < 16; ++j) { const unsigned c = xb_ld(&bar[XB_XCNT(j)]); sum += c; cnt += (c > 0u) ? 1u : 0u; mine = (j == x) ? c : mine; }
    if (sum == G) break;
    __builtin_amdgcn_s_sleep(1);
    if ((++sp & 255u) == 0u) { if (xb_ld(&bar[XB_TMO])) break; if (sp > XB_SPIN_CAP) { atomicAdd(&bar[XB_TMO], 1u); break; } }
  }
  nloc = mine > 0u ? mine : 1u; nx = cnt > 0u ? cnt : 1u;
}
DI void xcd_barrier(const XcdBarrier& b) {
  asm volatile("s_waitcnt vmcnt(0)" ::: "memory");
  __syncthreads();
  if (threadIdx.x == 0) {
    unsigned* bar = b.bar;
    __builtin_amdgcn_s_waitcnt(0);
    unsigned nloc = b.st[0], nx = b.st[1];
    if (nloc == 0u) { xcd_barrier_complete(bar, b.x, nloc, nx); b.st[0] = nloc; b.st[1] = nx; }
    const unsigned old = xb_add(&bar[XB_XSUB(b.x)], 1u);
    const unsigned gen = old / nloc;
    if (old + 1u == (gen + 1u) * nloc) {
      __builtin_amdgcn_fence(__ATOMIC_RELEASE, "agent");
      asm volatile("s_waitcnt vmcnt(0)" ::: "memory");
      const unsigned og = xb_add(&bar[XB_TOP], 1u);
      const unsigned tg = og / nx;
      if (og + 1u == (tg + 1u) * nx) xb_add(&bar[XB_TOPGEN], 1u);
      else XB_SPIN(xb_ld(&bar[XB_TOPGEN]) == tg, bar);
      __builtin_amdgcn_fence(__ATOMIC_ACQUIRE, "agent");
      xb_add(&bar[XB_XGEN(b.x)], 1u);
      asm volatile("s_waitcnt vmcnt(0)" ::: "memory");
    } else {
      XB_SPIN(xb_ld(&bar[XB_XGEN(b.x)]) == gen, bar);
      __builtin_amdgcn_fence(__ATOMIC_ACQUIRE, "agent");
      asm volatile("s_waitcnt vmcnt(0)" ::: "memory");
    }
  }
  __syncthreads();
}

struct LdFz {
  const bfr* pz;
  const GAS char* p[4];
  DI void init(int lrow, int lcol) {
#pragma unroll
    for (int i = 0; i < 4; ++i) { p[i] = (const GAS char*)(pz + (size_t)(lrow + 32 * i) * 512 + lcol); asm volatile("" : "+v"(p[i])); }
  }
  DI void advance(int adv) {
#pragma unroll
    for (int i = 0; i < 4; ++i) p[i] += 128 * adv;
  }
  DI uint4 load(int i) const {
    const GAS char* q = p[i];
    const uint4 a = gld16(q), b = gld16(q + (size_t)4096 * 512 * 2), c = gld16(q + (size_t)2 * 4096 * 512 * 2), d = gld16(q + (size_t)3 * 4096 * 512 * 2);
#define SUM4(f) pk2(bf2f(a.f & 0xffff) + bf2f(b.f & 0xffff) + bf2f(c.f & 0xffff) + bf2f(d.f & 0xffff), bf2f(a.f >> 16) + bf2f(b.f >> 16) + bf2f(c.f >> 16) + bf2f(d.f >> 16))
    return make_uint4(SUM4(x), SUM4(y), SUM4(z), SUM4(w));
#undef SUM4
  }
};

DI void transpose_tile(const float* W, int ldw, int kbase, int nbase, bfr* WT, int ldt, int trow, float* sm) {
  const int tid = threadIdx.x;
#pragma unroll
  for (int i = 0; i < 4; ++i) {
    const int r = (tid >> 4) + 16 * i, c = (tid & 15) * 4;
    const float4 v = *(const float4*)(W + (size_t)(kbase + r) * ldw + nbase + c);
    sm[r * 65 + c] = v.x; sm[r * 65 + c + 1] = v.y; sm[r * 65 + c + 2] = v.z; sm[r * 65 + c + 3] = v.w;
  }
  __syncthreads();
  const int n = tid >> 2, kc = (tid & 3) * 16;
  unsigned o[8];
#pragma unroll
  for (int j = 0; j < 8; ++j) o[j] = pk2(sm[(kc + 2 * j) * 65 + n], sm[(kc + 2 * j + 1) * 65 + n]);
  uint4* dst = (uint4*)(WT + (size_t)(trow + n) * ldt + kbase + kc);
  dst[0] = make_uint4(o[0], o[1], o[2], o[3]);
  dst[1] = make_uint4(o[4], o[5], o[6], o[7]);
}

DI void phase0(const Params& p, unsigned char* smem) {
  const int tid = threadIdx.x;
  float* smf = (float*)smem;
  unsigned char* ws = p.ws;
  constexpr int N_ADA = 192;
  constexpr int N_T0 = 16 * 36, N_TG = 64, N_TO0 = 256, N_T1A = 16 * 24, N_T1B = 16 * 8, N_TF = 64, N_TO1 = 256;
  constexpr int N_FOLD = 128, N_ALAT = 2048, N_ACTX = 256, N_CACHE = 64, N_SSM = 64, N_ZERO = 48, N_ROPE = 4;
  constexpr int B_T0 = N_ADA, B_TG = B_T0 + N_T0, B_TO0 = B_TG + N_TG, B_T1A = B_TO0 + N_TO0, B_T1B = B_T1A + N_T1A,
                B_TF = B_T1B + N_T1B, B_TO1 = B_TF + N_TF, B_FOLD = B_TO1 + N_TO1, B_ALAT = B_FOLD + N_FOLD,
                B_ACTX = B_ALAT + N_ALAT, B_CACHE = B_ACTX + N_ACTX, B_SSM = B_CACHE + N_CACHE, B_ZERO = B_SSM + N_SSM,
                B_ROPE = B_ZERO + N_ZERO, N_ALL = B_ROPE + N_ROPE;
  for (int it = blockIdx.x; it < N_ALL; it += gridDim.x) {
    __syncthreads();
    if (it < B_T0) {
      const int l = it / 96, cgp = it % 96;
      float* sc = smf;
      float* red = smf + 3072;
      for (int e = tid; e < 3072; e += 256) {
        const int ci = e >> 10, k = e & 1023;
        const float cv = ci == 0 ? p.in[6][k] : p.in[5][(ci - 1) * 1024 + k];
        sc[e] = silu_f(cv);
      }
      __syncthreads();
      const int cq = tid & 7, rg = tid >> 3;
      const float* w = p.in[7] + (size_t)l * 1024 * 3072 + cgp * 32 + cq * 4;
      float4 a0 = make_float4(0.f, 0.f, 0.f, 0.f), a1 = a0, a2 = a0;
#pragma unroll 16
      for (int k = rg; k < 1024; k += 32) {
        const float4 wv = *(const float4*)(w + (size_t)k * 3072);
        const float s0 = sc[k], s1 = sc[1024 + k], s2 = sc[2048 + k];
        a0.x += s0 * wv.x; a0.y += s0 * wv.y; a0.z += s0 * wv.z; a0.w += s0 * wv.w;
        a1.x += s1 * wv.x; a1.y += s1 * wv.y; a1.z += s1 * wv.z; a1.w += s1 * wv.w;
        a2.x += s2 * wv.x; a2.y += s2 * wv.y; a2.z += s2 * wv.z; a2.w += s2 * wv.w;
      }
      *(float4*)(red + (0 * 32 + rg) * 32 + cq * 4) = a0;
      *(float4*)(red + (1 * 32 + rg) * 32 + cq * 4) = a1;
      *(float4*)(red + (2 * 32 + rg) * 32 + cq * 4) = a2;
      __syncthreads();
      if (tid < 96) {
        const int c2 = tid & 31, ci = tid >> 5;
        float s = 0.f;
#pragma unroll
        for (int q = 0; q < 32; ++q) s += red[(ci * 32 + q) * 32 + c2];
        const int n2 = cgp * 32 + c2;
        ((float*)(ws + OFF_MOD))[(l * 3 + ci) * 3072 + n2] = s + p.in[8][l * 3072 + n2];
      }
    } else if (it < B_FOLD) {
      const float* W; int ldw, nbase_off = 0, trow_off = 0, ntn, ldt; bfr* WT; int r;
      if (it < B_TG)        { r = it - B_T0;  W = p.in[11]; ldw = 2304; ntn = 36; WT = (bfr*)(ws + OFF_WIN0); ldt = 1024; }
      else if (it < B_TO0)  { r = it - B_TG;  W = p.in[22]; ldw = 512;  ntn = 8;  WT = (bfr*)(ws + OFF_GLU); ldt = 512; }
      else if (it < B_T1A)  { r = it - B_TO0; W = p.in[24]; ldw = 1024; ntn = 16; WT = (bfr*)(ws + OFF_WOUT0); ldt = 1024; }
      else if (it < B_T1B)  { r = it - B_T1A; W = p.in[25]; ldw = 2560; ntn = 24; WT = (bfr*)(ws + OFF_WIN1); ldt = 1024; }
      else if (it < B_TF)   { r = it - B_T1B; W = p.in[25]; ldw = 2560; ntn = 8;  WT = (bfr*)(ws + OFF_WIN1); ldt = 1024; nbase_off = 2048; trow_off = 2560; }
      else if (it < B_TO1)  { r = it - B_TF;  W = p.in[29]; ldw = 512;  ntn = 8;  WT = (bfr*)(ws + OFF_FNET); ldt = 512; }
      else                  { r = it - B_TO1; W = p.in[30]; ldw = 1024; ntn = 16; WT = (bfr*)(ws + OFF_WOUT1); ldt = 1024; }
      const int kb = r / ntn, nb = r % ntn;
      transpose_tile(W, ldw, kb * 64, nbase_off + nb * 64, WT, ldt, trow_off + nb * 64, smf);
    } else if (it < B_ALAT) {
      const int r = it - B_FOLD, cs = r & 1, kb = (r >> 1) & 15, g = r >> 5;
      float* tile = smf;
      float* tw = smf + 128 * 68;
      const float* W = p.in[25];
      {
        const int c4 = (tid & 31) * 4, kr = tid >> 5;
#pragma unroll
        for (int i = 0; i < 8; ++i) {
          const int k = kr + 8 * i;
          const float4 v = *(const float4*)(W + (size_t)(kb * 64 + k) * 2560 + 1536 + g * 128 + c4);
          tile[(c4 + 0) * 68 + k] = v.x; tile[(c4 + 1) * 68 + k] = v.y; tile[(c4 + 2) * 68 + k] = v.z; tile[(c4 + 3) * 68 + k] = v.w;
        }
        if (tid < 128) {
          const float a = 2.f * (float)tid / 128.f;
          tw[tid] = (cs == 0 ? cospif(a) : sinpif(a)) * 0.08838834764831845f;
        }
      }
      __syncthreads();
      const int j = tid & 127, kg = tid >> 7;
      float acc[32];
#pragma unroll
      for (int i = 0; i < 32; ++i) acc[i] = 0.f;
      for (int c = 0; c < 128; ++c) {
        const float t = tw[(j * c) & 127];
        const float4* tp = (const float4*)(tile + c * 68 + kg * 32);
#pragma unroll
        for (int q = 0; q < 8; ++q) {
          const float4 v = tp[q];
          acc[4 * q + 0] += v.x * t; acc[4 * q + 1] += v.y * t; acc[4 * q + 2] += v.z * t; acc[4 * q + 3] += v.w * t;
        }
      }
      uint4* dst = (uint4*)((bfr*)(ws + OFF_WIN1) + (size_t)(1536 + cs * 512 + g * 128 + j) * 1024 + kb * 64 + kg * 32);
#pragma unroll
      for (int q = 0; q < 4; ++q)
        dst[q] = make_uint4(pk2(acc[8 * q], acc[8 * q + 1]), pk2(acc[8 * q + 2], acc[8 * q + 3]), pk2(acc[8 * q + 4], acc[8 * q + 5]), pk2(acc[8 * q + 6], acc[8 * q + 7]));
    } else if (it < B_ACTX) {
      const int t = it - B_ALAT;
      bfr* dst = (bfr*)(ws + OFF_ALAT) + (size_t)t * 4096;
      const float nrm = 0.02209708691207961f;
#pragma unroll
      for (int half = 0; half < 2; ++half) {
        const int k0 = half * 2048 + tid * 8;
        unsigned o[4];
#pragma unroll
        for (int j = 0; j < 4; ++j) {
          float v[2];
#pragma unroll
          for (int e = 0; e < 2; ++e) {
            const int k = k0 + 2 * j + e;
            const int m = (t * (k & 2047)) & 2047;
            const float a = (float)m * (2.f / 2048.f);
            v[e] = (k < 2048 ? cospif(a) : -sinpif(a)) * nrm;
          }
          o[j] = pk2(v[0], v[1]);
        }
        *(uint4*)(dst + k0) = make_uint4(o[0], o[1], o[2], o[3]);
      }
    } else if (it < B_CACHE) {
      const int t = it - B_ACTX;
      bfr* dst = (bfr*)(ws + OFF_ACTX) + (size_t)t * 512;
      const float nrm = 0.0625f;
      float v[2];
#pragma unroll
      for (int e = 0; e < 2; ++e) {
        const int k = tid * 2 + e;
        const int m = (t * (k & 255)) & 255;
        const float a = (float)m * (2.f / 256.f);
        v[e] = (k < 256 ? cospif(a) : -sinpif(a)) * nrm;
      }
      *(unsigned*)(dst + tid * 2) = pk2(v[0], v[1]);
    } else if (it < B_SSM) {
      const int r = it - B_CACHE;
#pragma unroll
      for (int i = 0; i < 8; ++i) {
        const int e = r * 2048 + tid + 256 * i;
        const int d = e & 63, kvh = (e >> 6) & 1, key = (e >> 7) & 511, b = e >> 16;
        ((bfr*)(ws + OFF_KL))[((size_t)(b * 2 + kvh) * 2560 + key) * 64 + d] = f2bf(p.in[2][e]);
        ((bfr*)(ws + OFF_VL))[((size_t)(b * 2 + kvh) * 64 + d) * 2560 + key] = f2bf(p.in[3][e]);
      }
    } else if (it < B_ZERO) {
      const int dg = it - B_SSM;
      const int pp = tid & 63, part = tid >> 6;
      const double lr = (double)p.in[14][dg * 64 + pp], li = (double)p.in[15][dg * 64 + pp];
      const double dt = (double)__expf(p.in[16][dg]) ;
      const float dtf = expf(p.in[16][dg]);
      const double dtd = (double)dtf;
      (void)dt;
      const double PI = 3.14159265358979323846;
      double ap = li * dtd / PI;
      double ar = ap - 2.0 * rint(ap * 0.5);
      const float er = expf((float)(lr * dtd));
      const double lbr = (double)er * (double)cospif((float)ar), lbi = (double)er * (double)sinpif((float)ar);
      double ap2 = ap * 256.0;
      double ar2 = ap2 - 2.0 * rint(ap2 * 0.5);
      const float er2 = expf((float)(lr * dtd * 256.0));
      if (part == 0) {
        ((float2*)(ws + OFF_LAMB))[dg * 64 + pp] = make_float2((float)lbr, (float)lbi);
        ((float2*)(ws + OFF_LAMP))[dg * 64 + pp] = make_float2(er2 * cospif((float)ar2), er2 * sinpif((float)ar2));
      }
      const double den = lr * lr + li * li;
      const double fr = ((lbr - 1.0) * lr + lbi * li) / den, fi = (lbi * lr - (lbr - 1.0) * li) / den;
      float* bb = (float*)(ws + OFF_BB) + (size_t)(dg * 64 + pp) * 32;
#pragma unroll
      for (int q = 0; q < 4; ++q) {
        const int c = part * 4 + q;
        const double br = (double)p.in[17][(size_t)(dg * 64 + pp) * 16 + c], bi = (double)p.in[18][(size_t)(dg * 64 + pp) * 16 + c];
        bb[c] = (float)(fr * br - fi * bi);
        bb[16 + c] = (float)(fr * bi + fi * br);
      }
      bfr* cm = (bfr*)(ws + OFF_CMB) + (size_t)dg * 2048;
#pragma unroll
      for (int q = 0; q < 8; ++q) {
        const int e = tid * 8 + q, c = e >> 7, k = e & 127;
        const float v = k < 64 ? p.in[19][(size_t)(dg * 16 + c) * 64 + k] : -p.in[20][(size_t)(dg * 16 + c) * 64 + (k - 64)];
        cm[e] = f2bf(v);
      }
    } else if (it < B_ROPE) {
      const int r = it - B_ZERO;
      ((float*)(ws + OFF_ROWSS))[r * 256 + tid] = 0.f;
    } else {
      const int e = (it - B_ROPE) * 256 + tid;
      const int n = e >> 4, pr = e & 15;
      const double q4[4] = {1.0, 0.5623413251903491, 0.31622776601683794, 0.1778279410038923};
      double inv = q4[0];
      if ((pr & 3) == 1) inv = q4[1]; else if ((pr & 3) == 2) inv = q4[2]; else if ((pr & 3) == 3) inv = q4[3];
      const int dec = pr >> 2;
      if (dec == 1) inv *= 0.1; else if (dec == 2) inv *= 0.01; else if (dec == 3) inv *= 0.001;
      const double ap = (double)n * inv / 3.14159265358979323846;
      const double ar = ap - 2.0 * rint(ap * 0.5);
      ((float2*)(ws + OFF_ROPE))[e] = make_float2(cospif((float)ar), sinpif((float)ar));
    }
  }
}

template <int MODE>
DI void phase_rows(const Params& p) {
  unsigned char* ws = p.ws;
  const int lane = threadIdx.x & 63, wave = threadIdx.x >> 6;
  const float* mod = (const float*)(ws + OFF_MOD);
  for (int it = blockIdx.x; it < NTOK / 4; it += gridDim.x) {
    const int T = it * 4 + wave;
    const int ci = cond_of(T);
    float4 xv[4];
    if (MODE == 2) {
      const bfr* xr = (const bfr*)(ws + OFF_X1) + (size_t)T * 1024 + lane * 4;
#pragma unroll
      for (int j = 0; j < 4; ++j) {
        const uint2 raw = *(const uint2*)(xr + 256 * j);
        xv[j].x = bf2f(raw.x & 0xffff); xv[j].y = bf2f(raw.x >> 16); xv[j].z = bf2f(raw.y & 0xffff); xv[j].w = bf2f(raw.y >> 16);
      }
    } else {
      const float4* xr = (const float4*)xrow(p, T) + lane;
#pragma unroll
      for (int j = 0; j < 4; ++j) xv[j] = xr[64 * j];
    }
    if (MODE >= 1) {
      const int l = MODE - 1;
      const bfr* orow = (const bfr*)(ws + OFF_O) + (size_t)T * 1024;
      float4 ov[4]; float ss = 0.f;
#pragma unroll
      for (int j = 0; j < 4; ++j) {
        const uint2 raw = *(const uint2*)(orow + lane * 4 + 256 * j);
        ov[j].x = bf2f(raw.x & 0xffff); ov[j].y = bf2f(raw.x >> 16); ov[j].z = bf2f(raw.y & 0xffff); ov[j].w = bf2f(raw.y >> 16);
        ss += ov[j].x * ov[j].x + ov[j].y * ov[j].y + ov[j].z * ov[j].z + ov[j].w * ov[j].w;
      }
      const float rinv = rsqrtf(wave_sum(ss) * (1.f / 1024.f) + EPS);
      const float* gate = mod + (l * 3 + ci) * 3072 + 2048;
      const float* gp = p.in[10] + l * 1024;
#pragma unroll
      for (int j = 0; j < 4; ++j) {
        const int k = lane * 4 + 256 * j;
        const float4 g4 = *(const float4*)(gate + k), n4 = *(const float4*)(gp + k);
        xv[j].x += g4.x * (ov[j].x * rinv * n4.x); xv[j].y += g4.y * (ov[j].y * rinv * n4.y);
        xv[j].z += g4.z * (ov[j].z * rinv * n4.z); xv[j].w += g4.w * (ov[j].w * rinv * n4.w);
      }
      if (MODE == 2) {
        float4* yr = (float4*)(p.out + OUT_Y + (size_t)T * 1024) + lane;
#pragma unroll
        for (int j = 0; j < 4; ++j) yr[64 * j] = xv[j];
      } else {
        bfr* x1r = (bfr*)(ws + OFF_X1) + (size_t)T * 1024 + lane * 4;
#pragma unroll
        for (int j = 0; j < 4; ++j) *(uint2*)(x1r + 256 * j) = make_uint2(pk2(xv[j].x, xv[j].y), pk2(xv[j].z, xv[j].w));
      }
    }
    if (MODE <= 1) {
      const int l = MODE;
      float ss = 0.f;
#pragma unroll
      for (int j = 0; j < 4; ++j) ss += xv[j].x * xv[j].x + xv[j].y * xv[j].y + xv[j].z * xv[j].z + xv[j].w * xv[j].w;
      const float rinv = rsqrtf(wave_sum(ss) * (1.f / 1024.f) + EPS);
      const float* shift = mod + (l * 3 + ci) * 3072;
      const float* scale = shift + 1024;
      const float* gp = p.in[9] + l * 1024;
      bfr* hr = (bfr*)(ws + OFF_HN) + (size_t)T * 1024;
#pragma unroll
      for (int j = 0; j < 4; ++j) {
        const int k = lane * 4 + 256 * j;
        const float4 s4 = *(const float4*)(shift + k), c4 = *(const float4*)(scale + k), n4 = *(const float4*)(gp + k);
        const float a = xv[j].x * rinv * n4.x * (1.f + c4.x) + s4.x;
        const float b = xv[j].y * rinv * n4.y * (1.f + c4.y) + s4.y;
        const float c = xv[j].z * rinv * n4.z * (1.f + c4.z) + s4.z;
        const float d = xv[j].w * rinv * n4.w * (1.f + c4.w) + s4.w;
        *(uint2*)(hr + k) = make_uint2(pk2(a, b), pk2(c, d));
      }
    }
  }
}

DI void phase_win0(const Params& p, unsigned char* smem) {
  unsigned char* ws = p.ws;
  const int lane = threadIdx.x & 63, wave = threadIdx.x >> 6, l32 = lane & 31, h = lane >> 5, wm = wave >> 1, wn = wave & 1;
  const bfr* A = (const bfr*)(ws + OFF_HN);
  const bfr* Bt = (const bfr*)(ws + OFF_WIN0);
  int tm, tn;
  if (!xcd_tile(0, 18, tm, tn)) return;
  LdBf al{A + (size_t)tm * 128 * 1024, 1024}, bl{Bt + (size_t)tn * 128 * 1024, 1024};
  for (int step = 0;; ++step) {
    const int m0 = tm * 128, n0 = tn * 128;
    int tm2 = 0, tn2 = 0;
    auto next_tile = [&]() {
      if (!xcd_tile(step + 1, 18, tm2, tn2)) return false;
      al.base = A + (size_t)tm2 * 128 * 1024; bl.base = Bt + (size_t)tn2 * 128 * 1024;
      return true;
    };
    auto ep = [&](f32x16 (&acc)[2][2]) {
      const int colbase = n0 + wn * 64, rbase = m0 + wm * 64;
      const bool lat = m0 >= NCTX;
      if (tn == 5) {
        const int hd = (colbase - 640) >> 6;
#pragma unroll
        for (int mi = 0; mi < 2; ++mi)
#pragma unroll
          for (int ni = 0; ni < 2; ++ni) {
            const int d = ni * 32 + l32;
#pragma unroll
            for (int i4 = 0; i4 < 4; ++i4) {
              const int r0 = rbase + mi * 32 + 8 * i4 + 4 * h;
              const float a = acc[mi][ni][4 * i4], b2 = acc[mi][ni][4 * i4 + 1], c = acc[mi][ni][4 * i4 + 2], e = acc[mi][ni][4 * i4 + 3];
              const uint2 pk = make_uint2(pk2(a, b2), pk2(c, e));
              if (!lat) {
                p.out[OUT_V + (size_t)(r0 + 0) * 128 + hd * 64 + d] = a;
                p.out[OUT_V + (size_t)(r0 + 1) * 128 + hd * 64 + d] = b2;
                p.out[OUT_V + (size_t)(r0 + 2) * 128 + hd * 64 + d] = c;
                p.out[OUT_V + (size_t)(r0 + 3) * 128 + hd * 64 + d] = e;
                const int b = r0 >> 8, l = r0 & 255;
                *(uint2*)((bfr*)(ws + OFF_VC) + ((size_t)(b * 2 + hd) * 64 + d) * 256 + l) = pk;
              } else {
                const int b = (r0 - NCTX) >> 11, l = (r0 - NCTX) & 2047;
                *(uint2*)((bfr*)(ws + OFF_VL) + ((size_t)(b * 2 + hd) * 64 + d) * 2560 + 512 + l) = pk;
              }
            }
          }
      } else if (colbase < 640) {
        const bool isq = colbase < 512;
        const float* gain = isq ? p.in[12] : p.in[13];
        const int hd = isq ? (colbase >> 6) : ((colbase - 512) >> 6);
        float4 gv[2][4];
#pragma unroll
        for (int mi = 0; mi < 2; ++mi)
#pragma unroll
          for (int i4 = 0; i4 < 4; ++i4) gv[mi][i4] = *(const float4*)(gain + mi * 32 + 8 * i4 + 4 * h);
#pragma unroll
        for (int ni = 0; ni < 2; ++ni) {
          const int T = rbase + ni * 32 + l32;
          float ss = 0.f;
#pragma unroll
          for (int mi = 0; mi < 2; ++mi)
#pragma unroll
            for (int i = 0; i < 16; ++i) ss += acc[mi][ni][i] * acc[mi][ni][i];
          ss += __shfl_xor(ss, 32);
          const float rinv = rsqrtf(ss * (1.f / 64.f) + EPS);
          float v[2][16];
#pragma unroll
          for (int mi = 0; mi < 2; ++mi)
#pragma unroll
            for (int i4 = 0; i4 < 4; ++i4) {
              v[mi][4 * i4 + 0] = acc[mi][ni][4 * i4 + 0] * rinv * gv[mi][i4].x;
              v[mi][4 * i4 + 1] = acc[mi][ni][4 * i4 + 1] * rinv * gv[mi][i4].y;
              v[mi][4 * i4 + 2] = acc[mi][ni][4 * i4 + 2] * rinv * gv[mi][i4].z;
              v[mi][4 * i4 + 3] = acc[mi][ni][4 * i4 + 3] * rinv * gv[mi][i4].w;
            }
          if (!lat && !isq) {
#pragma unroll
            for (int mi = 0; mi < 2; ++mi)
#pragma unroll
              for (int i4 = 0; i4 < 4; ++i4)
                *(float4*)(p.out + OUT_K + (size_t)T * 128 + hd * 64 + mi * 32 + 8 * i4 + 4 * h) = make_float4(v[mi][4 * i4], v[mi][4 * i4 + 1], v[mi][4 * i4 + 2], v[mi][4 * i4 + 3]);
          }
          if (lat) {
            const int pos = (T - NCTX) & 2047;
            const float* rope = (const float*)(ws + OFF_ROPE);
#pragma unroll
            for (int mi = 0; mi < 2; ++mi) {
              const float* rb = rope + ((mi == 0 ? (pos >> 6) : (pos & 63)) * 16 + 4 * h) * 2;
#pragma unroll
              for (int i4 = 0; i4 < 2; ++i4) {
                const float4 cs0 = *(const float4*)(rb + 16 * i4), cs1 = *(const float4*)(rb + 16 * i4 + 4);
                const float cc[4] = {cs0.x, cs0.z, cs1.x, cs1.z}, sn[4] = {cs0.y, cs0.w, cs1.y, cs1.w};
#pragma unroll
                for (int e = 0; e < 4; ++e) {
                  const float x1 = v[mi][4 * i4 + e], x2 = v[mi][4 * i4 + e + 8];
                  v[mi][4 * i4 + e] = x1 * cc[e] - x2 * sn[e];
                  v[mi][4 * i4 + e + 8] = x1 * sn[e] + x2 * cc[e];
                }
              }
            }
          }
          bfr* dst;
          float sc = 1.f;
          if (isq) { dst = (bfr*)(ws + OFF_QB) + (size_t)T * 512 + hd * 64; sc = 0.125f; }
          else if (!lat) { dst = (bfr*)(ws + OFF_KC) + ((size_t)((T >> 8) * 2 + hd) * 256 + (T & 255)) * 64; }
          else { dst = (bfr*)(ws + OFF_KL) + ((size_t)(((T - NCTX) >> 11) * 2 + hd) * 2560 + 512 + ((T - NCTX) & 2047)) * 64; }
#pragma unroll
          for (int mi = 0; mi < 2; ++mi)
#pragma unroll
            for (int i4 = 0; i4 < 4; ++i4)
              *(uint2*)(dst + mi * 32 + 8 * i4 + 4 * h) = make_uint2(pk2(v[mi][4 * i4] * sc, v[mi][4 * i4 + 1] * sc), pk2(v[mi][4 * i4 + 2] * sc, v[mi][4 * i4 + 3] * sc));
        }
      } else {
        const int sec = colbase < 1280 ? 0 : (colbase < 1792 ? 1 : 2);
        const int cb = colbase - (sec == 0 ? 768 : (sec == 1 ? 1280 : 1792));
        if (sec == 1) {
          float* stf = (float*)smem;
#pragma unroll
          for (int ni = 0; ni < 2; ++ni) {
            const int row = wm * 64 + ni * 32 + l32;
#pragma unroll
            for (int mi = 0; mi < 2; ++mi)
#pragma unroll
              for (int i4 = 0; i4 < 4; ++i4)
                *(float4*)(stf + row * 132 + wn * 64 + mi * 32 + 8 * i4 + 4 * h) =
                    make_float4(acc[mi][ni][4 * i4], acc[mi][ni][4 * i4 + 1], acc[mi][ni][4 * i4 + 2], acc[mi][ni][4 * i4 + 3]);
          }
          __syncthreads();
          float* dbase = (float*)(ws + OFF_U) + (size_t)m0 * 512 + (n0 - 1280);
#pragma unroll 4
          for (int i = 0; i < 16; ++i) {
            const int id = threadIdx.x + 256 * i, r = id >> 5, c4 = id & 31;
            *(float4*)(dbase + (size_t)r * 512 + c4 * 4) = *(const float4*)(stf + r * 132 + c4 * 4);
          }
        } else {
          unsigned short* stg = (unsigned short*)smem;
#pragma unroll
          for (int ni = 0; ni < 2; ++ni) {
            const int row = wm * 64 + ni * 32 + l32;
#pragma unroll
            for (int mi = 0; mi < 2; ++mi)
#pragma unroll
              for (int i4 = 0; i4 < 4; ++i4) {
                const float a = acc[mi][ni][4 * i4], b2 = acc[mi][ni][4 * i4 + 1], c2 = acc[mi][ni][4 * i4 + 2], e = acc[mi][ni][4 * i4 + 3];
                *(uint2*)(stg + row * 136 + wn * 64 + mi * 32 + 8 * i4 + 4 * h) = make_uint2(pk2(silu_f(a), silu_f(b2)), pk2(silu_f(c2), silu_f(e)));
              }
          }
          __syncthreads();
          bfr* dbase = (bfr*)(ws + (sec == 0 ? OFF_GA : OFF_GB)) + (size_t)m0 * 512 + (n0 - (sec == 0 ? 768 : 1792));
#pragma unroll
          for (int i = 0; i < 8; ++i) {
            const int id = threadIdx.x + 256 * i, r = id >> 4, c16 = id & 15;
            *(uint4*)(dbase + (size_t)r * 512 + c16 * 8) = *(const uint4*)(stg + r * 136 + c16 * 8);
          }
        }
      }
    };
    al.base = A + (size_t)m0 * 1024; bl.base = Bt + (size_t)n0 * 1024;
    gemm_tile<128>(16, tn != 5, al, bl, ep, smem);
    if (!next_tile()) break;
    tm = tm2; tn = tn2;
  }
}

DI void attn_item(const Params& p, unsigned char* smem, int it) {
  unsigned char* ws = p.ws;
  const int tid = threadIdx.x, lane = tid & 63, wave = tid >> 6, l32 = lane & 31, h = lane >> 5;
  int T0, nkeys, ldv; const bfr *Kp, *Vp; int kvh;
  if (it < 256) {
    const int b = it >> 7, qt = it & 63; kvh = (it >> 6) & 1;
    T0 = NCTX + b * 2048 + qt * 32; nkeys = 2560; ldv = 2560;
    Kp = (const bfr*)(ws + OFF_KL) + (size_t)(b * 2 + kvh) * 2560 * 64;
    Vp = (const bfr*)(ws + OFF_VL) + (size_t)(b * 2 + kvh) * 64 * 2560;
  } else {
    const int i2 = it - 256; const int b = i2 >> 4, qt = i2 & 7; kvh = (i2 >> 3) & 1;
    T0 = b * 256 + qt * 32; nkeys = 256; ldv = 256;
    Kp = (const bfr*)(ws + OFF_KC) + (size_t)(b * 2 + kvh) * 256 * 64;
    Vp = (const bfr*)(ws + OFF_VC) + (size_t)(b * 2 + kvh) * 64 * 256;
  }
  const int head = kvh * 4 + wave;
  unsigned short* Ks = (unsigned short*)smem;
  unsigned short* Vs = Ks + 64 * 72;
  bf16x8 qf[4];
  {
    const bfr* q = (const bfr*)(ws + OFF_QB) + (size_t)(T0 + l32) * 512 + head * 64 + 8 * h;
#pragma unroll
    for (int ks = 0; ks < 4; ++ks) qf[ks] = *(const bf16x8*)(q + 16 * ks);
  }
  float m = -1e30f, lsum = 0.f;
  f32x16 O[2];
#pragma unroll
  for (int i = 0; i < 16; ++i) { O[0][i] = 0.f; O[1][i] = 0.f; }
  const int rr0 = tid >> 3, cc0 = (tid & 7) * 8;
  const bfr* kp0 = Kp + (size_t)rr0 * 64 + cc0;
  const bfr* vp0 = Vp + (size_t)rr0 * ldv + cc0;
  uint4 kreg0 = *(const uint4*)kp0, kreg1 = *(const uint4*)(kp0 + 32 * 64);
  uint4 vreg0 = *(const uint4*)vp0, vreg1 = *(const uint4*)(vp0 + (size_t)32 * ldv);
  for (int k0 = 0; k0 < nkeys; k0 += 64) {
    __syncthreads();
    *(uint4*)(Ks + rr0 * 72 + cc0) = kreg0; *(uint4*)(Ks + (rr0 + 32) * 72 + cc0) = kreg1;
    *(uint4*)(Vs + rr0 * 72 + cc0) = vreg0; *(uint4*)(Vs + (rr0 + 32) * 72 + cc0) = vreg1;
    __syncthreads();
    if (k0 + 64 < nkeys) {
      kreg0 = *(const uint4*)(kp0 + (size_t)(k0 + 64) * 64); kreg1 = *(const uint4*)(kp0 + (size_t)(k0 + 96) * 64);
      vreg0 = *(const uint4*)(vp0 + k0 + 64); vreg1 = *(const uint4*)(vp0 + (size_t)32 * ldv + k0 + 64);
    }
    f32x16 st[2];
#pragma unroll
    for (int kt = 0; kt < 2; ++kt) {
#pragma unroll
      for (int i = 0; i < 16; ++i) st[kt][i] = 0.f;
#pragma unroll
      for (int ks = 0; ks < 4; ++ks) {
        const bf16x8 a = *(const bf16x8*)(Ks + (32 * kt + l32) * 72 + 16 * ks + 8 * h);
        st[kt] = MFMA32(a, qf[ks], st[kt]);
      }
    }
    float mx = st[0][0];
#pragma unroll
    for (int i = 0; i < 16; ++i) { mx = fmaxf(mx, st[0][i]); mx = fmaxf(mx, st[1][i]); }
    mx = fmaxf(mx, __shfl_xor(mx, 32));
    const float mn = fmaxf(m, mx);
    const float alpha = __expf(m - mn);
    m = mn;
    float ps = 0.f;
#pragma unroll
    for (int kt = 0; kt < 2; ++kt)
#pragma unroll
      for (int i = 0; i < 16; ++i) { const float e = __expf(st[kt][i] - mn); st[kt][i] = e; ps += e; }
    lsum = lsum * alpha + ps;
#pragma unroll
    for (int i = 0; i < 16; ++i) { O[0][i] *= alpha; O[1][i] *= alpha; }
#pragma unroll
    for (int kt = 0; kt < 2; ++kt)
#pragma unroll
      for (int s = 0; s < 2; ++s) {
        const uint4 pu = make_uint4(pk2(st[kt][8 * s], st[kt][8 * s + 1]), pk2(st[kt][8 * s + 2], st[kt][8 * s + 3]),
                                    pk2(st[kt][8 * s + 4], st[kt][8 * s + 5]), pk2(st[kt][8 * s + 6], st[kt][8 * s + 7]));
        const bf16x8 pf = __builtin_bit_cast(bf16x8, pu);
#pragma unroll
        for (int dt = 0; dt < 2; ++dt) {
          const unsigned short* vr = Vs + (32 * dt + l32) * 72 + 32 * kt + 16 * s + 4 * h;
          const s16x4 lo = *(const s16x4*)vr, hi = *(const s16x4*)(vr + 8);
          const bf16x8 va = __builtin_shufflevector(lo, hi, 0, 1, 2, 3, 4, 5, 6, 7);
          O[dt] = MFMA32(va, pf, O[dt]);
        }
      }
  }
  const float ltot = lsum + __shfl_xor(lsum, 32);
  const float inv = 1.f / ltot;
  const int T = T0 + l32;
#pragma unroll
  for (int dt = 0; dt < 2; ++dt)
#pragma unroll
    for (int i4 = 0; i4 < 4; ++i4) {
      const int d = 32 * dt + 8 * i4 + 4 * h;
      const uint2 g = *(const uint2*)((const bfr*)(ws + OFF_GA) + (size_t)T * 512 + head * 64 + d);
      const float a = O[dt][4 * i4] * inv * bf2f(g.x & 0xffff), b = O[dt][4 * i4 + 1] * inv * bf2f(g.x >> 16);
      const float c = O[dt][4 * i4 + 2] * inv * bf2f(g.y & 0xffff), e = O[dt][4 * i4 + 3] * inv * bf2f(g.y >> 16);
      *(uint2*)((bfr*)(ws + OFF_MIX) + (size_t)T * 1024 + head * 64 + d) = make_uint2(pk2(a, b), pk2(c, e));
    }
}

DI void attn_lat_item(const Params& p, unsigned char* smem, int it) {
  unsigned char* ws = p.ws;
  const int tid = threadIdx.x, lane = tid & 63, wave = tid >> 6, l32 = lane & 31, h = lane >> 5;
  const int b = it >> 8, kvh = (it >> 7) & 1, qt = (it >> 1) & 63, hp = it & 1;
  const int hw = wave & 1, kh = wave >> 1;
  const int T0 = NCTX + b * 2048 + qt * 32;
  const int head = kvh * 4 + hp * 2 + hw;
  const bfr* Kp = (const bfr*)(ws + OFF_KL) + ((size_t)(b * 2 + kvh) * 2560 + kh * 1280) * 64;
  const bfr* Vp = (const bfr*)(ws + OFF_VL) + (size_t)(b * 2 + kvh) * 64 * 2560 + kh * 1280;
  unsigned short* Ks = (unsigned short*)smem + kh * (2 * 64 * 72);
  unsigned short* Vs = Ks + 64 * 72;
  bf16x8 qf[4];
  {
    const bfr* q = (const bfr*)(ws + OFF_QB) + (size_t)(T0 + l32) * 512 + head * 64 + 8 * h;
#pragma unroll
    for (int ks = 0; ks < 4; ++ks) qf[ks] = *(const bf16x8*)(q + 16 * ks);
  }
  float m = -1e30f, lsum = 0.f;
  f32x16 O[2];
#pragma unroll
  for (int i = 0; i < 16; ++i) { O[0][i] = 0.f; O[1][i] = 0.f; }
  const int t2 = tid & 127, rr0 = t2 >> 3, cc0 = (t2 & 7) * 8;
  const bfr* kp0 = Kp + (size_t)rr0 * 64 + cc0;
  const bfr* vp0 = Vp + (size_t)rr0 * 2560 + cc0;
  uint4 kr0 = *(const uint4*)kp0, kr1 = *(const uint4*)(kp0 + 16 * 64), kr2 = *(const uint4*)(kp0 + 32 * 64), kr3 = *(const uint4*)(kp0 + 48 * 64);
  uint4 vr0 = *(const uint4*)vp0, vr1 = *(const uint4*)(vp0 + (size_t)16 * 2560), vr2 = *(const uint4*)(vp0 + (size_t)32 * 2560), vr3 = *(const uint4*)(vp0 + (size_t)48 * 2560);
  for (int k0 = 0; k0 < 1280; k0 += 64) {
    __syncthreads();
    *(uint4*)(Ks + rr0 * 72 + cc0) = kr0; *(uint4*)(Ks + (rr0 + 16) * 72 + cc0) = kr1; *(uint4*)(Ks + (rr0 + 32) * 72 + cc0) = kr2; *(uint4*)(Ks + (rr0 + 48) * 72 + cc0) = kr3;
    *(uint4*)(Vs + rr0 * 72 + cc0) = vr0; *(uint4*)(Vs + (rr0 + 16) * 72 + cc0) = vr1; *(uint4*)(Vs + (rr0 + 32) * 72 + cc0) = vr2; *(uint4*)(Vs + (rr0 + 48) * 72 + cc0) = vr3;
    __syncthreads();
    if (k0 + 64 < 1280) {
      const bfr* kq = kp0 + (size_t)(k0 + 64) * 64; const bfr* vq = vp0 + k0 + 64;
      kr0 = *(const uint4*)kq; kr1 = *(const uint4*)(kq + 16 * 64); kr2 = *(const uint4*)(kq + 32 * 64); kr3 = *(const uint4*)(kq + 48 * 64);
      vr0 = *(const uint4*)vq; vr1 = *(const uint4*)(vq + (size_t)16 * 2560); vr2 = *(const uint4*)(vq + (size_t)32 * 2560); vr3 = *(const uint4*)(vq + (size_t)48 * 2560);
    }
    f32x16 st[2];
#pragma unroll
    for (int kt = 0; kt < 2; ++kt) {
#pragma unroll
      for (int i = 0; i < 16; ++i) st[kt][i] = 0.f;
#pragma unroll
      for (int ks = 0; ks < 4; ++ks) {
        const bf16x8 a = *(const bf16x8*)(Ks + (32 * kt + l32) * 72 + 16 * ks + 8 * h);
        st[kt] = MFMA32(a, qf[ks], st[kt]);
      }
    }
    float mx = st[0][0];
#pragma unroll
    for (int i = 0; i < 16; ++i) { mx = fmaxf(mx, st[0][i]); mx = fmaxf(mx, st[1][i]); }
    mx = fmaxf(mx, __shfl_xor(mx, 32));
    const float mn = fmaxf(m, mx);
    const float alpha = __expf(m - mn);
    m = mn;
    float ps = 0.f;
#pragma unroll
    for (int kt = 0; kt < 2; ++kt)
#pragma unroll
      for (int i = 0; i < 16; ++i) { const float e = __expf(st[kt][i] - mn); st[kt][i] = e; ps += e; }
    lsum = lsum * alpha + ps;
#pragma unroll
    for (int i = 0; i < 16; ++i) { O[0][i] *= alpha; O[1][i] *= alpha; }
#pragma unroll
    for (int kt = 0; kt < 2; ++kt)
#pragma unroll
      for (int s = 0; s < 2; ++s) {
        const uint4 pu = make_uint4(pk2(st[kt][8 * s], st[kt][8 * s + 1]), pk2(st[kt][8 * s + 2], st[kt][8 * s + 3]),
                                    pk2(st[kt][8 * s + 4], st[kt][8 * s + 5]), pk2(st[kt][8 * s + 6], st[kt][8 * s + 7]));
        const bf16x8 pf = __builtin_bit_cast(bf16x8, pu);
#pragma unroll
        for (int dt = 0; dt < 2; ++dt) {
          const unsigned short* vr = Vs + (32 * dt + l32) * 72 + 32 * kt + 16 * s + 4 * h;
          const s16x4 lo = *(const s16x4*)vr, hi = *(const s16x4*)(vr + 8);
          const bf16x8 va = __builtin_shufflevector(lo, hi, 0, 1, 2, 3, 4, 5, 6, 7);
          O[dt] = MFMA32(va, pf, O[dt]);
        }
      }
  }
  float ltot = lsum + __shfl_xor(lsum, 32);
  float* xb = (float*)smem + (hw * 64 + lane) * 36;
  __syncthreads();
  if (kh == 1) {
#pragma unroll
    for (int i = 0; i < 16; ++i) { xb[i] = O[0][i]; xb[16 + i] = O[1][i]; }
    xb[32] = m; xb[33] = ltot;
  }
  __syncthreads();
  if (kh == 0) {
    const float m2 = xb[32], l2 = xb[33];
    const float mm = fmaxf(m, m2), a1 = __expf(m - mm), a2 = __expf(m2 - mm);
    ltot = ltot * a1 + l2 * a2;
    const float inv = 1.f / ltot;
#pragma unroll
    for (int i = 0; i < 16; ++i) { O[0][i] = (O[0][i] * a1 + xb[i] * a2) * inv; O[1][i] = (O[1][i] * a1 + xb[16 + i] * a2) * inv; }
    const int T = T0 + l32;
#pragma unroll
    for (int dt = 0; dt < 2; ++dt)
#pragma unroll
      for (int i4 = 0; i4 < 4; ++i4) {
        const int d = 32 * dt + 8 * i4 + 4 * h;
        const uint2 g = *(const uint2*)((const bfr*)(ws + OFF_GA) + (size_t)T * 512 + head * 64 + d);
        const float a = O[dt][4 * i4] * bf2f(g.x & 0xffff), bq = O[dt][4 * i4 + 1] * bf2f(g.x >> 16);
        const float c = O[dt][4 * i4 + 2] * bf2f(g.y & 0xffff), e = O[dt][4 * i4 + 3] * bf2f(g.y >> 16);
        *(uint2*)((bfr*)(ws + OFF_MIX) + (size_t)T * 1024 + head * 64 + d) = make_uint2(pk2(a, bq), pk2(c, e));
      }
  }
}

DI int seg_T0(int seg) { return seg < 32 ? seg * 256 : NCTX + ((seg - 32) >> 3) * 2048 + ((seg - 32) & 7) * 256; }

DI void split_bf16(const float4& v0, const float4& v1, bf16x8& hi, bf16x8& lo) {
  const unsigned h0 = pk2(v0.x, v0.y), h1 = pk2(v0.z, v0.w), h2 = pk2(v1.x, v1.y), h3 = pk2(v1.z, v1.w);
  hi = __builtin_bit_cast(bf16x8, make_uint4(h0, h1, h2, h3));
  const unsigned l0 = pk2(v0.x - bf2f(h0 & 0xffff), v0.y - bf2f(h0 >> 16)), l1 = pk2(v0.z - bf2f(h1 & 0xffff), v0.w - bf2f(h1 >> 16));
  const unsigned l2 = pk2(v1.x - bf2f(h2 & 0xffff), v1.y - bf2f(h2 >> 16)), l3 = pk2(v1.z - bf2f(h3 & 0xffff), v1.w - bf2f(h3 >> 16));
  lo = __builtin_bit_cast(bf16x8, make_uint4(l0, l1, l2, l3));
}

DI void s5_wave(const Params& p, float* BU  , int it) {
  unsigned char* ws = p.ws;
  const int lane = threadIdx.x & 63, l32 = lane & 31, h = lane >> 5;
  const int di = it & 1, g = (it >> 1) & 31, seg = it >> 6;
  const int T0 = seg_T0(seg);
  const int dg = di * 32 + g;
  bf16x8 bhi[4], blo[4];
#pragma unroll
  for (int nt = 0; nt < 4; ++nt) {
    const float* bb = (const float*)(ws + OFF_BB) + (size_t)(dg * 64 + (nt & 1) * 32 + l32) * 32 + (nt >> 1) * 16 + 8 * h;
    split_bf16(*(const float4*)bb, *(const float4*)(bb + 4), bhi[nt], blo[nt]);
  }
  const float2 lam = ((const float2*)(ws + OFF_LAMB))[dg * 64 + lane];
  bf16x8 cmf[4];
  {
    const bfr* cm = (const bfr*)(ws + OFF_CMB) + (size_t)dg * 2048 + (lane & 15) * 128 + 8 * (lane >> 4);
#pragma unroll
    for (int ks = 0; ks < 4; ++ks) cmf[ks] = *(const bf16x8*)(cm + 32 * ks);
  }
  float hr = 0.f, hi = 0.f;
  bfr* yout = (bfr*)(ws + (di == 0 ? OFF_YF : OFF_YB));
  const float* ubase = (const float*)(ws + OFF_U) + g * 16 + 8 * h;
  float4 u0, u1;
  { const int T = di == 0 ? T0 + l32 : T0 + 255 - l32; const float* up = ubase + (size_t)T * 512; u0 = *(const float4*)up; u1 = *(const float4*)(up + 4); }
  for (int c = 0; c < 8; ++c) {
    bf16x8 ahi, alo;
    split_bf16(u0, u1, ahi, alo);
    if (c < 7) { const int sg = 32 * (c + 1) + l32; const int T = di == 0 ? T0 + sg : T0 + 255 - sg; const float* up = ubase + (size_t)T * 512; u0 = *(const float4*)up; u1 = *(const float4*)(up + 4); }
#pragma unroll
    for (int nt = 0; nt < 4; ++nt) {
      f32x16 acc;
#pragma unroll
      for (int i = 0; i < 16; ++i) acc[i] = 0.f;
      acc = MFMA32(ahi, bhi[nt], acc);
      acc = MFMA32(alo, bhi[nt], acc);
      acc = MFMA32(ahi, blo[nt], acc);
#pragma unroll
      for (int i = 0; i < 16; ++i) BU[crow(i, h) * 132 + 32 * nt + l32] = acc[i];
    }
    __builtin_amdgcn_wave_barrier();
#pragma unroll 8
    for (int sl = 0; sl < 32; ++sl) {
      const float br = BU[sl * 132 + lane], bi = BU[sl * 132 + 64 + lane];
      const float nr = lam.x * hr - lam.y * hi + br;
      const float ni = lam.x * hi + lam.y * hr + bi;
      hr = nr; hi = ni;
      BU[sl * 132 + lane] = hr; BU[sl * 132 + 64 + lane] = hi;
    }
    __builtin_amdgcn_wave_barrier();
#pragma unroll
    for (int tt = 0; tt < 2; ++tt) {
      f32x4 acc = {0.f, 0.f, 0.f, 0.f};
      const float* hrow = BU + (16 * tt + (lane & 15)) * 132 + 8 * (lane >> 4);
#pragma unroll
      for (int ks = 0; ks < 4; ++ks) {
        const float4 v0 = *(const float4*)(hrow + 32 * ks), v1 = *(const float4*)(hrow + 32 * ks + 4);
        const bf16x8 a = __builtin_bit_cast(bf16x8, make_uint4(pk2(v0.x, v0.y), pk2(v0.z, v0.w), pk2(v1.x, v1.y), pk2(v1.z, v1.w)));
        acc = MFMA16(a, cmf[ks], acc);
      }
#pragma unroll
      for (int i = 0; i < 4; ++i) {
        const int sg = 32 * c + 16 * tt + 4 * (lane >> 4) + i;
        const int T = di == 0 ? T0 + sg : T0 + 255 - sg;
        yout[(size_t)T * 512 + g * 16 + (lane & 15)] = f2bf(acc[i]);
      }
    }
    __builtin_amdgcn_wave_barrier();
  }
  ((float2*)(ws + OFF_E))[((size_t)(seg * 2 + di) * 32 + g) * 64 + lane] = make_float2(hr, hi);
  if (seg < 32) {
    float* so = p.out + OUT_S + (size_t)((seg * 2 + di) * 2) * 2048 + g * 64 + lane;
    so[0] = hr; so[2048] = hi;
  }
}

DI void phase_mix0(const Params& p, unsigned char* smem) {
  constexpr int N_S5 = 3072;
  const int b = blockIdx.x, G = gridDim.x, wave = threadIdx.x >> 6;
  float* BUw = (float*)smem + wave * (32 * 132);
  if (G == 512) {
    attn_lat_item(p, smem, b);
    __syncthreads();
    if (b < 256) { for (int r = 0; r < 2; ++r) s5_wave(p, BUw, b * 8 + r * 4 + wave); }
    else s5_wave(p, BUw, 2048 + (b - 256) * 4 + wave);
    __syncthreads();
    attn_item(p, smem, 256 + b);
  } else {
    for (int it = b * 4 + wave; it < N_S5; it += G * 4) s5_wave(p, BUw, it);
    for (int it = b; it < 512; it += G) { __syncthreads(); attn_lat_item(p, smem, it); }
    for (int it = b; it < 512; it += G) { __syncthreads(); attn_item(p, smem, 256 + it); }
  }
}

DI void phase_s5fix(const Params& p, unsigned char* smem) {
  unsigned char* ws = p.ws;
  const int tid = threadIdx.x, lane = tid & 63, wave = tid >> 6;
  float* ycorr = (float*)smem;
  float* HC = (float*)smem + 4096 + wave * (16 * 132);
  for (int it = blockIdx.x; it < 48 * 32; it += gridDim.x) {
    const int g = it & 31, seg = it >> 5;
    const int T0 = seg_T0(seg);
    __syncthreads();
    if (seg >= 32) {
      for (int e = tid; e < 4096; e += 256) ycorr[e] = 0.f;
      __syncthreads();
      const int b = (seg - 32) >> 3, j = (seg - 32) & 7;
      const int di = wave & 1, half = wave >> 1;
      const int dg = di * 32 + g;
      const float2 lam = ((const float2*)(ws + OFF_LAMB))[dg * 64 + lane];
      const float2 lp = ((const float2*)(ws + OFF_LAMP))[dg * 64 + lane];
      const float* st = p.in[4] + (size_t)((b * 2 + di) * 2) * 2048 + g * 64 + lane;
      float hr = st[0], hi = st[2048];
      const int nprev = di == 0 ? j : 7 - j;
      float2 ev[7];
#pragma unroll
      for (int q = 0; q < 7; ++q) {
        const int jj = di == 0 ? q : 7 - q;
        ev[q] = ((const float2*)(ws + OFF_E))[((size_t)((32 + b * 8 + jj) * 2 + di) * 32 + g) * 64 + lane];
      }
#pragma unroll
      for (int q = 0; q < 7; ++q) {
        if (q < nprev) {
          const float nr = lp.x * hr - lp.y * hi + ev[q].x, ni = lp.x * hi + lp.y * hr + ev[q].y;
          hr = nr; hi = ni;
        }
      }
      float cr = lam.x, cim = lam.y;
      if (half) {
        float sr = lam.x, si = lam.y;
#pragma unroll
        for (int q = 0; q < 7; ++q) { const float t = sr * sr - si * si; si = 2.f * sr * si; sr = t; }
        cr = sr * lam.x - si * lam.y; cim = sr * lam.y + si * lam.x;
      }
      bf16x8 cmf[4];
      {
        const bfr* cm = (const bfr*)(ws + OFF_CMB) + (size_t)dg * 2048 + (lane & 15) * 128 + 8 * (lane >> 4);
#pragma unroll
        for (int ks = 0; ks < 4; ++ks) cmf[ks] = *(const bf16x8*)(cm + 32 * ks);
      }
      for (int c = 0; c < 8; ++c) {
#pragma unroll 8
        for (int sl = 0; sl < 16; ++sl) {
          HC[sl * 132 + lane] = cr * hr - cim * hi;
          HC[sl * 132 + 64 + lane] = cr * hi + cim * hr;
          const float nr = cr * lam.x - cim * lam.y, ni = cr * lam.y + cim * lam.x;
          cr = nr; cim = ni;
        }
        __builtin_amdgcn_wave_barrier();
        f32x4 acc = {0.f, 0.f, 0.f, 0.f};
        const float* hrow = HC + (lane & 15) * 132 + 8 * (lane >> 4);
#pragma unroll
        for (int ks = 0; ks < 4; ++ks) {
          const float4 v0 = *(const float4*)(hrow + 32 * ks), v1 = *(const float4*)(hrow + 32 * ks + 4);
          const bf16x8 a = __builtin_bit_cast(bf16x8, make_uint4(pk2(v0.x, v0.y), pk2(v0.z, v0.w), pk2(v1.x, v1.y), pk2(v1.z, v1.w)));
          acc = MFMA16(a, cmf[ks], acc);
        }
#pragma unroll
        for (int i = 0; i < 4; ++i) {
          const int sg = 128 * half + 16 * c + 4 * (lane >> 4) + i;
          const int tl = di == 0 ? sg : 255 - sg;
          atomicAdd(&ycorr[tl * 16 + (lane & 15)], acc[i]);
        }
        __builtin_amdgcn_wave_barrier();
      }
      __syncthreads();
    }
    {
      const int c4 = (tid & 3) * 4;
      const float4 d4 = *(const float4*)(p.in[21] + g * 16 + c4);
      float4 uv[4]; uint2 fv[4], bv[4];
#pragma unroll
      for (int ps = 0; ps < 4; ++ps) {
        const int T = T0 + ps * 64 + (tid >> 2);
        uv[ps] = *(const float4*)((const float*)(ws + OFF_U) + (size_t)T * 512 + g * 16 + c4);
        fv[ps] = *(const uint2*)((const bfr*)(ws + OFF_YF) + (size_t)T * 512 + g * 16 + c4);
        bv[ps] = *(const uint2*)((const bfr*)(ws + OFF_YB) + (size_t)T * 512 + g * 16 + c4);
      }
#pragma unroll
      for (int ps = 0; ps < 4; ++ps) {
        const int tl = ps * 64 + (tid >> 2);
        float4 yc = make_float4(0.f, 0.f, 0.f, 0.f);
        if (seg >= 32) yc = *(const float4*)(ycorr + tl * 16 + c4);
        const float y0 = gelu_f(uv[ps].x * d4.x + bf2f(fv[ps].x & 0xffff) + bf2f(bv[ps].x & 0xffff) + yc.x);
        const float y1 = gelu_f(uv[ps].y * d4.y + bf2f(fv[ps].x >> 16) + bf2f(bv[ps].x >> 16) + yc.y);
        const float y2 = gelu_f(uv[ps].z * d4.z + bf2f(fv[ps].y & 0xffff) + bf2f(bv[ps].y & 0xffff) + yc.z);
        const float y3 = gelu_f(uv[ps].w * d4.w + bf2f(fv[ps].y >> 16) + bf2f(bv[ps].y >> 16) + yc.w);
        *(uint2*)((bfr*)(ws + OFF_YG) + (size_t)(T0 + tl) * 512 + g * 16 + c4) = make_uint2(pk2(y0, y1), pk2(y2, y3));
      }
    }
  }
}

template <int MODE>
DI void phase_tokgemm(const Params& p, unsigned char* smem, int layer) {
  unsigned char* ws = p.ws;
  const int lane = threadIdx.x & 63, wave = threadIdx.x >> 6, l32 = lane & 31, h = lane >> 5, wm = wave >> 1, wn = wave & 1;
  constexpr int K = MODE == 1 ? 1024 : 512, N = MODE == 1 ? 1024 : 512;
  const bfr* A = (const bfr*)(ws + (MODE == 0 ? OFF_YG : (MODE == 1 ? OFF_MIX : OFF_FZ)));
  const bfr* Bt = (const bfr*)(ws + (MODE == 0 ? OFF_GLU : (MODE == 1 ? (layer == 0 ? OFF_WOUT0 : OFF_WOUT1) : OFF_FNET)));
  constexpr int TN = N / 128;
  int tm, tn;
  if (!xcd_tile(0, TN, tm, tn)) return;
  LdBf alp{A + (size_t)tm * 128 * K, (size_t)K}, bl{Bt + (size_t)tn * 128 * K, (size_t)K};
  for (int step = 0;; ++step) {
    const int m0 = tm * 128, n0 = tn * 128;
    int tm2 = 0, tn2 = 0;
    auto next_tile = [&]() {
      if (!xcd_tile(step + 1, TN, tm2, tn2)) return false;
      alp.base = A + (size_t)tm2 * 128 * K; bl.base = Bt + (size_t)tn2 * 128 * K;
      return true;
    };
    auto ep_direct = [&](f32x16 (&acc)[2][2]) {
#pragma unroll
      for (int ni = 0; ni < 2; ++ni) {
        const int T = m0 + wm * 64 + ni * 32 + l32;
#pragma unroll
        for (int mi = 0; mi < 2; ++mi)
#pragma unroll
          for (int i4 = 0; i4 < 4; ++i4) {
            const int n = n0 + wn * 64 + mi * 32 + 8 * i4 + 4 * h;
            float a = acc[mi][ni][4 * i4], b2 = acc[mi][ni][4 * i4 + 1], c2 = acc[mi][ni][4 * i4 + 2], e = acc[mi][ni][4 * i4 + 3];
            if (MODE == 0) {
              const uint2 y = *(const uint2*)((const bfr*)(ws + OFF_YG) + (size_t)T * 512 + n);
              const uint2 gb = *(const uint2*)((const bfr*)(ws + OFF_GB) + (size_t)T * 512 + n);
              const float4 bs = *(const float4*)(p.in[23] + n);
              a = bf2f(y.x & 0xffff) * sigmoid_f(a + bs.x) * bf2f(gb.x & 0xffff);
              b2 = bf2f(y.x >> 16) * sigmoid_f(b2 + bs.y) * bf2f(gb.x >> 16);
              c2 = bf2f(y.y & 0xffff) * sigmoid_f(c2 + bs.z) * bf2f(gb.y & 0xffff);
              e = bf2f(y.y >> 16) * sigmoid_f(e + bs.w) * bf2f(gb.y >> 16);
              *(uint2*)((bfr*)(ws + OFF_MIX) + (size_t)T * 1024 + 512 + n) = make_uint2(pk2(a, b2), pk2(c2, e));
            } else if (MODE == 1) {
              *(uint2*)((bfr*)(ws + OFF_O) + (size_t)T * 1024 + n) = make_uint2(pk2(a, b2), pk2(c2, e));
            } else {
              const uint2 gd = *(const uint2*)((const bfr*)(ws + OFF_GDS) + (size_t)T * 512 + n);
              a *= bf2f(gd.x & 0xffff); b2 *= bf2f(gd.x >> 16); c2 *= bf2f(gd.y & 0xffff); e *= bf2f(gd.y >> 16);
              *(uint2*)((bfr*)(ws + OFF_MIX) + (size_t)T * 1024 + 512 + n) = make_uint2(pk2(a, b2), pk2(c2, e));
            }
          }
      }
    };
    auto ep_staged = [&](f32x16 (&acc)[2][2]) {
      unsigned short* stg = (unsigned short*)smem;
#pragma unroll
      for (int ni = 0; ni < 2; ++ni) {
        const int row = wm * 64 + ni * 32 + l32;
        const int T = m0 + row;
#pragma unroll
        for (int mi = 0; mi < 2; ++mi)
#pragma unroll
          for (int i4 = 0; i4 < 4; ++i4) {
            const int cl = wn * 64 + mi * 32 + 8 * i4 + 4 * h;
            const int n = n0 + cl;
            float a = acc[mi][ni][4 * i4], b2 = acc[mi][ni][4 * i4 + 1], c2 = acc[mi][ni][4 * i4 + 2], e = acc[mi][ni][4 * i4 + 3];
            if (MODE == 0) {
              const uint2 y = *(const uint2*)((const bfr*)(ws + OFF_YG) + (size_t)T * 512 + n);
              const uint2 gb = *(const uint2*)((const bfr*)(ws + OFF_GB) + (size_t)T * 512 + n);
              const float4 bs = *(const float4*)(p.in[23] + n);
              a = bf2f(y.x & 0xffff) * sigmoid_f(a + bs.x) * bf2f(gb.x & 0xffff);
              b2 = bf2f(y.x >> 16) * sigmoid_f(b2 + bs.y) * bf2f(gb.x >> 16);
              c2 = bf2f(y.y & 0xffff) * sigmoid_f(c2 + bs.z) * bf2f(gb.y & 0xffff);
              e = bf2f(y.y >> 16) * sigmoid_f(e + bs.w) * bf2f(gb.y >> 16);
            } else if (MODE == 2) {
              const uint2 gd = *(const uint2*)((const bfr*)(ws + OFF_GDS) + (size_t)T * 512 + n);
              a *= bf2f(gd.x & 0xffff); b2 *= bf2f(gd.x >> 16); c2 *= bf2f(gd.y & 0xffff); e *= bf2f(gd.y >> 16);
            }
            *(uint2*)(stg + row * 136 + cl) = make_uint2(pk2(a, b2), pk2(c2, e));
          }
      }
      __syncthreads();
      bfr* dbase = MODE == 1 ? (bfr*)(ws + OFF_O) + (size_t)m0 * 1024 + n0 : (bfr*)(ws + OFF_MIX) + (size_t)m0 * 1024 + 512 + n0;
#pragma unroll
      for (int i = 0; i < 8; ++i) {
        const int id = threadIdx.x + 256 * i, r = id >> 4, c16 = id & 15;
        *(uint4*)(dbase + (size_t)r * 1024 + c16 * 8) = *(const uint4*)(stg + r * 136 + c16 * 8);
      }
    };
    auto ep = [&](f32x16 (&acc)[2][2]) { if constexpr (MODE == 1) ep_staged(acc); else ep_direct(acc); };
    if constexpr (MODE == 2) {
      bl.base = Bt + (size_t)n0 * K;
      if (m0 < NCTX) {
        LdBf al{A + (size_t)m0 * K, (size_t)K};
        gemm_tile<128>(K / 64, true, al, bl, ep, smem);
      } else {
        LdFz al{(const bfr*)(ws + OFF_HN) + (size_t)(m0 - NCTX) * 512};
        gemm_tile<128, false>(K / 64, true, al, bl, ep, smem);
      }
      if (!next_tile()) break;
    } else {
      alp.base = A + (size_t)m0 * K; bl.base = Bt + (size_t)n0 * K;
      gemm_tile<128>(K / 64, true, alp, bl, ep, smem);
      if (!next_tile()) break;
    }
    tm = tm2; tn = tn2;
  }
}

DI void phase_win1(const Params& p, unsigned char* smem) {
  unsigned char* ws = p.ws;
  const int lane = threadIdx.x & 63, wave = threadIdx.x >> 6, l32 = lane & 31, h = lane >> 5, wm = wave >> 1, wn = wave & 1;
  const bfr* A = (const bfr*)(ws + OFF_HN);
  const bfr* Bt = (const bfr*)(ws + OFF_WIN1);
  int tm, tn;
  if (!xcd_tile(0, 24, tm, tn)) return;
  LdBf al{A + (size_t)tm * 128 * 1024, 1024}, bl{Bt + (size_t)tn * 128 * 1024, 1024};
  for (int step = 0;; ++step) {
    const int m0 = tm * 128, n0 = tn * 128;
    int tm2 = 0, tn2 = 0;
    auto next_tile = [&]() {
      if (!xcd_tile(step + 1, 24, tm2, tn2)) return false;
      al.base = A + (size_t)tm2 * 128 * 1024; bl.base = Bt + (size_t)tn2 * 128 * 1024;
      return true;
    };
    auto ep = [&](f32x16 (&acc)[2][2]) {
      const int colbase = n0 + wn * 64, rbase = m0 + wm * 64;
      const int sec = colbase >> 9;
      const int cbt = n0 & 511;
      const bool lat = m0 >= NCTX;
      unsigned short* stg = (unsigned short*)smem;
      if (sec == 0 || sec == 2 || sec == 5) {
#pragma unroll
        for (int ni = 0; ni < 2; ++ni) {
          const int row = wm * 64 + ni * 32 + l32;
#pragma unroll
          for (int mi = 0; mi < 2; ++mi)
#pragma unroll
            for (int i4 = 0; i4 < 4; ++i4) {
              const float a = acc[mi][ni][4 * i4], b2 = acc[mi][ni][4 * i4 + 1], c2 = acc[mi][ni][4 * i4 + 2], e = acc[mi][ni][4 * i4 + 3];
              const uint2 o = sec == 0 ? make_uint2(pk2(gelu_f(a), gelu_f(b2)), pk2(gelu_f(c2), gelu_f(e))) : make_uint2(pk2(silu_f(a), silu_f(b2)), pk2(silu_f(c2), silu_f(e)));
              *(uint2*)(stg + row * 136 + wn * 64 + mi * 32 + 8 * i4 + 4 * h) = o;
            }
        }
      } else {
        if (sec == 1) {
          float* rowss = (float*)(ws + OFF_ROWSS);
#pragma unroll
          for (int mi = 0; mi < 2; ++mi)
#pragma unroll
            for (int i = 0; i < 16; ++i) {
              const float g0 = gelu_f(acc[mi][0][i]), g1 = gelu_f(acc[mi][1][i]);
              acc[mi][0][i] = g0; acc[mi][1][i] = g1;
              const float ss = half_sum32(g0 * g0 + g1 * g1);
              if (l32 == 0) atomicAdd(rowss + rbase + mi * 32 + crow(i, h), ss);
            }
        }
#pragma unroll
        for (int mi = 0; mi < 2; ++mi)
#pragma unroll
          for (int ni = 0; ni < 2; ++ni)
#pragma unroll
            for (int i4 = 0; i4 < 4; ++i4)
              *(uint2*)(stg + (wn * 64 + ni * 32 + l32) * 136 + wm * 64 + mi * 32 + 8 * i4 + 4 * h) =
                  make_uint2(pk2(acc[mi][ni][4 * i4], acc[mi][ni][4 * i4 + 1]), pk2(acc[mi][ni][4 * i4 + 2], acc[mi][ni][4 * i4 + 3]));
      }
      __syncthreads();
      bfr* dbase; size_t dld;
      if (sec == 0 || sec == 2 || sec == 5) { dbase = (bfr*)(ws + (sec == 0 ? OFF_CUG : (sec == 2 ? OFF_GCS : OFF_GDS))) + (size_t)m0 * 512 + cbt; dld = 512; }
      else if (sec == 1) { dbase = (bfr*)(ws + OFF_CVT) + (size_t)cbt * NTOK + m0; dld = NTOK; }
      else if (!lat) { dbase = (bfr*)(ws + OFF_ZTC) + ((size_t)((m0 >> 8) * 512 + cbt)) * 512 + (sec - 3) * 256 + (m0 & 255); dld = 512; }
      else { dbase = (bfr*)(ws + OFF_ZTL) + ((size_t)(((m0 - NCTX) >> 11) * 512 + cbt)) * 4096 + (sec - 3) * 2048 + ((m0 - NCTX) & 2047); dld = 4096; }
#pragma unroll
      for (int i = 0; i < 8; ++i) {
        const int id = threadIdx.x + 256 * i, r = id >> 4, c16 = id & 15;
        *(uint4*)(dbase + (size_t)r * dld + c16 * 8) = *(const uint4*)(stg + r * 136 + c16 * 8);
      }
    };
    const int sec0 = n0 >> 9;
    al.base = A + (size_t)m0 * 1024; bl.base = Bt + (size_t)n0 * 1024;
    gemm_tile<128>(16, sec0 == 0 || sec0 == 2 || sec0 == 5, al, bl, ep, smem);
    if (!next_tile()) break;
    tm = tm2; tn = tn2;
  }
}

struct LdWs {
  const float* w; const float* rowss;
  const float* p[4]; const float* rp;
  DI void init(int lrow, int lcol) {
#pragma unroll
    for (int i = 0; i < 4; ++i) p[i] = w + (lrow + 32 * i) * 128 + lcol;
    rp = rowss + lcol;
  }
  DI void advance(int adv) {
#pragma unroll
    for (int i = 0; i < 4; ++i) p[i] += 64 * adv;
    rp += 64 * adv;
  }
  DI uint4 load(int i) const {
    const float* wp = p[i];
    const float4 a = *(const float4*)wp, b = *(const float4*)(wp + 4);
    const float4 s0 = *(const float4*)rp, s1 = *(const float4*)(rp + 4);
    const float r0 = rsqrtf(s0.x * (1.f / 512.f) + EPS), r1 = rsqrtf(s0.y * (1.f / 512.f) + EPS), r2 = rsqrtf(s0.z * (1.f / 512.f) + EPS), r3 = rsqrtf(s0.w * (1.f / 512.f) + EPS);
    const float r4 = rsqrtf(s1.x * (1.f / 512.f) + EPS), r5 = rsqrtf(s1.y * (1.f / 512.f) + EPS), r6 = rsqrtf(s1.z * (1.f / 512.f) + EPS), r7 = rsqrtf(s1.w * (1.f / 512.f) + EPS);
    return make_uint4(pk2(a.x * r0, a.y * r1), pk2(a.z * r2, a.w * r3), pk2(b.x * r4, b.y * r5), pk2(b.z * r6, b.w * r7));
  }
};

DI void phase_mix1(const Params& p, unsigned char* smem) {
  unsigned char* ws = p.ws;
  const int lane = threadIdx.x & 63, wave = threadIdx.x >> 6, l32 = lane & 31, h = lane >> 5, wm = wave >> 1, wn = wave & 1;
  constexpr int N_FL = 512, N_FC = 256, N_G = 768;
  for (int it = blockIdx.x; it < N_FL + N_FC + N_G; it += gridDim.x) {
    if (it < N_FL + N_FC) {
      const bfr *A, *Bt; int K, Tbase, tm, tn;
      int kq = 0; bool isl = it < N_FL;
      if (isl) {
        const int b = it >> 8; kq = it & 3; tn = (it >> 2) & 3; tm = (it >> 4) & 15; K = 4096;
        A = (const bfr*)(ws + OFF_ALAT) + kq * 1024; Bt = (const bfr*)(ws + OFF_ZTL) + (size_t)b * 512 * 4096 + kq * 1024; Tbase = NCTX + b * 2048;
      } else {
        const int i2 = it - N_FL; const int b = i2 >> 3; tm = (i2 >> 2) & 1; tn = i2 & 3; K = 512;
        A = (const bfr*)(ws + OFF_ACTX); Bt = (const bfr*)(ws + OFF_ZTC) + (size_t)b * 512 * 512; Tbase = b * 256;
      }
      LdBf al{A + (size_t)tm * 128 * K, (size_t)K}, bl{Bt + (size_t)tn * 128 * K, (size_t)K};
      auto ep = [&](f32x16 (&acc)[2][2]) {
#pragma unroll
        for (int mi = 0; mi < 2; ++mi)
#pragma unroll
          for (int ni = 0; ni < 2; ++ni)
#pragma unroll
            for (int i = 0; i < 16; ++i) {
              const int T = Tbase + tm * 128 + wm * 64 + mi * 32 + crow(i, h);
              const int n = tn * 128 + wn * 64 + ni * 32 + l32;
              if (!isl) ((bfr*)(ws + OFF_FZ))[(size_t)T * 512 + n] = f2bf(acc[mi][ni][i]);
              else ((bfr*)(ws + OFF_HN))[((size_t)kq * 4096 + (T - NCTX)) * 512 + n] = f2bf(acc[mi][ni][i]);
            }
      };
      gemm_tile<128>(isl ? 16 : K / 64, false, al, bl, ep, smem);
    } else {
      const int i2 = it - N_FL - N_FC; const int hg = i2 & 7, chunk = i2 >> 3;
      LdWs al{p.in[27] + (size_t)hg * 128 * 128, (const float*)(ws + OFF_ROWSS) + chunk * 128};
      LdBf bl{(const bfr*)(ws + OFF_CVT) + (size_t)(hg * 64) * NTOK + chunk * 128, (size_t)NTOK};
      auto ep = [&](f32x16 (&acc)[2][1]) {
        const int c = hg * 64 + wn * 32 + l32;
        const float vg = p.in[26][c];
#pragma unroll
        for (int mi = 0; mi < 2; ++mi)
#pragma unroll
          for (int i = 0; i < 16; ++i) {
            const int t = wm * 64 + mi * 32 + crow(i, h);
            const int T = chunk * 128 + t;
            const float sp = acc[mi][0][i] * vg + p.in[28][hg * 128 + t];
            const float cu = bf2f(((const bfr*)(ws + OFF_CUG))[(size_t)T * 512 + c]);
            const float gc = bf2f(((const bfr*)(ws + OFF_GCS))[(size_t)T * 512 + c]);
            ((bfr*)(ws + OFF_MIX))[(size_t)T * 1024 + c] = f2bf(cu * sp * gc);
          }
      };
      gemm_tile<64>(2, false, al, bl, ep, smem);
    }
  }
}

constexpr int NPHASE = 13;
#ifndef DOUBLE_MASK
#define DOUBLE_MASK 0
#endif
template <int PH>
DI void run_phase(const Params& p, unsigned char* smem) {
  if constexpr (PH == 0) phase0(p, smem);
  else if constexpr (PH == 1) phase_rows<0>(p);
  else if constexpr (PH == 2) phase_win0(p, smem);
  else if constexpr (PH == 3) phase_mix0(p, smem);
  else if constexpr (PH == 4) phase_s5fix(p, smem);
  else if constexpr (PH == 5) phase_tokgemm<0>(p, smem, 0);
  else if constexpr (PH == 6) phase_tokgemm<1>(p, smem, 0);
  else if constexpr (PH == 7) phase_rows<1>(p);
  else if constexpr (PH == 8) phase_win1(p, smem);
  else if constexpr (PH == 9) phase_mix1(p, smem);
  else if constexpr (PH == 10) phase_tokgemm<2>(p, smem, 1);
  else if constexpr (PH == 11) phase_tokgemm<1>(p, smem, 1);
  else if constexpr (PH == 12) phase_rows<2>(p);
}
template <int LO, int HI>
DI void run_range(const Params& p, unsigned char* smem, const XcdBarrier& xb) {
  if constexpr (LO < HI) {
    run_phase<LO>(p, smem);
    if constexpr (((DOUBLE_MASK) >> LO) & 1) { xcd_barrier(xb); run_phase<LO>(p, smem); }
    if constexpr (LO + 1 < HI) { xcd_barrier(xb); run_range<LO + 1, HI>(p, smem, xb); }
  }
}
template <int LO, int HI>
__global__ void __launch_bounds__(256, 2) mega(Params p) {
  __shared__ __attribute__((aligned(16))) unsigned char smem[73728];
  __shared__ uint4 xb_words;
  if (threadIdx.x == 0) xb_words = make_uint4(0u, 0u, 0u, 0u);
  __syncthreads();
  XcdBarrier xb = xcd_barrier_post((unsigned*)(p.ws + OFF_BAR), (volatile LAS unsigned*)&xb_words);
  run_range<LO, HI>(p, smem, xb);
  if (p.ph_lo != 0) cg::this_grid().sync();
}

#ifndef ONE_LAUNCH
#define ONE_LAUNCH 1
#endif
#if !ONE_LAUNCH
template <int PH>
static void launch_phases(Params& p, int grid, hipStream_t stream) {
  if constexpr (PH < NPHASE) {
    hipLaunchKernelGGL((mega<PH, PH + 1>), dim3(grid), dim3(256), 0, stream, p);
    launch_phases<PH + 1>(p, grid, stream);
  }
}
#endif

#ifndef ONE_LAUNCH
#define ONE_LAUNCH 1
#endif

extern "C" void kernel_launch(void* const* d_in, const int* in_sizes, int n_in, void* d_out, int out_size, void* d_ws, size_t ws_size, hipStream_t stream) {
  static int grid_blocks = 0;
  if (!grid_blocks) {
    int dev = 0, cus = 0, per_cu = 0;
    (void)hipGetDevice(&dev);
    (void)hipDeviceGetAttribute(&cus, hipDeviceAttributeMultiprocessorCount, dev);
    (void)hipOccupancyMaxActiveBlocksPerMultiprocessor(&per_cu, mega<0, NPHASE>, 256, 0);
    if (per_cu > 2) per_cu = 2;
    if (per_cu < 1) per_cu = 1;
    grid_blocks = cus * per_cu;
    if (n_in != 31 || ws_size < WS_TOTAL) fprintf(stderr, "kernel_launch: unexpected n_in %d or ws_size %zu (need %zu)\n", n_in, ws_size, (size_t)WS_TOTAL);
  }
  Params p{};
  for (int i = 0; i < 31; ++i) p.in[i] = (const float*)d_in[i];
  p.out = (float*)d_out; p.ws = (unsigned char*)d_ws;
  (void)hipMemsetAsync((unsigned char*)d_ws + OFF_BAR, 0, 16384, stream);
#if ONE_LAUNCH
  p.ph_lo = 0; p.ph_hi = NPHASE;
  void* args[] = {&p};
  hipError_t e = hipLaunchCooperativeKernel((void*)mega<0, NPHASE>, dim3(grid_blocks), dim3(256), args, 0, stream);
  if (e != hipSuccess) fprintf(stderr, "cooperative launch failed: %s (grid %d)\n", hipGetErrorString(e), grid_blocks);
#else
  launch_phases<0>(p, grid_blocks, stream);
#endif
}
```

```cpp
#include <hip/hip_runtime.h>
#include <hip/hip_cooperative_groups.h>
#include <cstdio>
#include <cstdint>
namespace cg = cooperative_groups;

#define DI __device__ __forceinline__
typedef unsigned short bfr;
using bf16x8 = __attribute__((ext_vector_type(8))) short;
using s16x4  = __attribute__((ext_vector_type(4))) short;
using f32x16 = __attribute__((ext_vector_type(16))) float;
using f32x4  = __attribute__((ext_vector_type(4))) float;

#define MFMA32(a, b, c) __builtin_amdgcn_mfma_f32_32x32x16_bf16((a), (b), (c), 0, 0, 0)
#define MFMA16(a, b, c) __builtin_amdgcn_mfma_f32_16x16x32_bf16((a), (b), (c), 0, 0, 0)

constexpr int NTOK = 12288, NCTX = 8192;
constexpr float EPS = 1e-6f;

constexpr size_t OFF_MOD   = 0;
constexpr size_t OFF_ROWSS = OFF_MOD + 73728;
constexpr size_t OFF_ROPE  = OFF_ROWSS + 49152;
constexpr size_t OFF_LAMB  = OFF_ROPE + 8192;
constexpr size_t OFF_LAMP  = OFF_LAMB + 32768;
constexpr size_t OFF_BB    = OFF_LAMP + 32768;
constexpr size_t OFF_CMB   = OFF_BB + 524288;
constexpr size_t OFF_E     = OFF_CMB + 262144;
constexpr size_t OFF_WIN0  = OFF_E + 1572864;
constexpr size_t OFF_GLU   = OFF_WIN0 + 4718592;
constexpr size_t OFF_WOUT0 = OFF_GLU + 524288;
constexpr size_t OFF_WIN1  = OFF_WOUT0 + 2097152;
constexpr size_t OFF_FNET  = OFF_WIN1 + 6291456;
constexpr size_t OFF_WOUT1 = OFF_FNET + 524288;
constexpr size_t OFF_ACTX  = OFF_WOUT1 + 2097152;
constexpr size_t OFF_ALAT  = OFF_ACTX + 262144;
constexpr size_t OFF_X1    = OFF_ALAT + 16777216;
constexpr size_t OFF_HN    = OFF_X1 + 50331648;
constexpr size_t OFF_MIX   = OFF_HN + 25165824;
constexpr size_t OFF_O     = OFF_MIX + 25165824;
constexpr size_t OFF_U     = OFF_O;
constexpr size_t OFF_R     = OFF_O + 25165824;
constexpr size_t OFF_QB = OFF_R;
constexpr size_t OFF_KC = OFF_QB + 12582912;
constexpr size_t OFF_KL = OFF_KC + 2097152;
constexpr size_t OFF_VC = OFF_KL + 1310720;
constexpr size_t OFF_VL = OFF_VC + 2097152;
constexpr size_t OFF_GA = OFF_VL + 1310720;
constexpr size_t OFF_GB = OFF_GA + 12582912;
constexpr size_t OFF_YF = OFF_GB + 12582912;
constexpr size_t OFF_YB = OFF_YF + 12582912;
constexpr size_t OFF_YG = OFF_YB + 12582912;
constexpr size_t END_L0 = OFF_YG + 12582912;
constexpr size_t OFF_CUG = OFF_R;
constexpr size_t OFF_GCS = OFF_CUG + 12582912;
constexpr size_t OFF_GDS = OFF_GCS + 12582912;
constexpr size_t OFF_CVT = OFF_GDS + 12582912;
constexpr size_t OFF_FZ  = OFF_CVT + 12582912;
constexpr size_t OFF_ZTC = OFF_FZ + 12582912;
constexpr size_t OFF_ZTL = OFF_ZTC + 16777216;
constexpr size_t END_L1 = OFF_ZTL + 8388608;
constexpr size_t WS_NEED = (END_L0 > END_L1 ? END_L0 : END_L1);
constexpr size_t OFF_BAR = WS_NEED;
constexpr size_t WS_TOTAL = OFF_BAR + 16384;
static_assert(WS_TOTAL <= (size_t)256 * 1024 * 1024, "workspace too large");

constexpr size_t OUT_Y = 0, OUT_K = 12582912, OUT_V = 13631488, OUT_S = 14680064;

struct Params {
  const float* in[31];
  float* out;
  unsigned char* ws;
  int ph_lo, ph_hi;
};

typedef __bf16 hbf2 __attribute__((ext_vector_type(2)));
typedef float hfl2 __attribute__((ext_vector_type(2)));
DI unsigned pk2(float lo, float hi) { hfl2 v = {lo, hi}; hbf2 r = __builtin_convertvector(v, hbf2); return __builtin_bit_cast(unsigned, r); }
DI unsigned short f2bf(float x) { return (unsigned short)(pk2(x, 0.f) & 0xffffu); }
DI float bf2f(unsigned short b) { return __uint_as_float(((unsigned)b) << 16); }
#define WAVE_SYNC() do { asm volatile("s_waitcnt lgkmcnt(0)" ::: "memory"); __builtin_amdgcn_wave_barrier(); } while (0)
DI float wave_sum(float v) {
#pragma unroll
  for (int o = 1; o < 64; o <<= 1) v += __shfl_xor(v, o);
  return v;
}
DI float half_sum32(float v) {
#pragma unroll
  for (int o = 1; o < 32; o <<= 1) v += __shfl_xor(v, o);
  return v;
}
DI float silu_f(float x) { return x / (1.f + __expf(-x)); }
DI float sigmoid_f(float x) { return 1.f / (1.f + __expf(-x)); }
DI float gelu_f(float x) { float z = 0.7978845608028654f * (x + 0.044715f * x * x * x); return x / (1.f + __expf(-2.f * z)); }
DI int crow(int i, int h) { return (i & 3) + 8 * (i >> 2) + 4 * h; }
DI const float* xrow(const Params& p, int T) { return T < NCTX ? p.in[0] + (size_t)T * 1024 : p.in[1] + (size_t)(T - NCTX) * 1024; }
DI int cond_of(int T) { return T < NCTX ? 0 : 1 + ((T - NCTX) >> 11); }

template <int BN, bool D2 = false, class AL, class BL, class EP>
DI void gemm_tile(int nk, bool swp, AL al, BL bl, EP ep, unsigned char* smem) {
  constexpr int NI = BN / 64;
  constexpr int NB = BN / 32;
  constexpr int STG = (128 + BN) * 72;
  unsigned short* S0 = (unsigned short*)smem;
  const int tid = threadIdx.x, lane = tid & 63, wave = tid >> 6, l32 = lane & 31, h = lane >> 5;
  const int wm = wave >> 1, wn = wave & 1;
  const int xoff = (swp ? 128 * 72 + (wn * 64 + l32) * 72 : (wm * 64 + l32) * 72) + h * 8;
  const int yoff = (swp ? (wm * 64 + l32) * 72 : 128 * 72 + (wn * (BN / 2) + l32) * 72) + h * 8;
  f32x16 acc[2][NI];
#pragma unroll
  for (int mi = 0; mi < 2; ++mi)
#pragma unroll
    for (int ni = 0; ni < NI; ++ni)
#pragma unroll
      for (int i = 0; i < 16; ++i) acc[mi][ni][i] = 0.f;
  uint4 ra[2][4], rb[2][NB];
  const int lrow = tid >> 3, lcol = (tid & 7) * 8;
  al.init(lrow, lcol); bl.init(lrow, lcol);
  int nxt = 0;
  auto gload = [&](uint4 (&a4)[4], uint4 (&b4)[NB]) {
#pragma unroll
    for (int i = 0; i < 4; ++i) a4[i] = al.load(i);
#pragma unroll
    for (int i = 0; i < NB; ++i) b4[i] = bl.load(i);
    const int adv = (nxt + 1 < nk) ? 1 : 0;
    al.advance(adv); bl.advance(adv); nxt += adv;
  };
  auto lstore = [&](const uint4 (&a4)[4], const uint4 (&b4)[NB], unsigned short* st) {
#pragma unroll
    for (int i = 0; i < 4; ++i) *(uint4*)(st + (lrow + 32 * i) * 72 + lcol) = a4[i];
#pragma unroll
    for (int i = 0; i < NB; ++i) *(uint4*)(st + 128 * 72 + (lrow + 32 * i) * 72 + lcol) = b4[i];
  };
  auto compute = [&](const unsigned short* st) {
#pragma unroll
    for (int ks = 0; ks < 4; ++ks) {
      bf16x8 x[2], y[NI];
#pragma unroll
      for (int mi = 0; mi < 2; ++mi) x[mi] = *(const bf16x8*)(st + xoff + mi * 32 * 72 + ks * 16);
#pragma unroll
      for (int ni = 0; ni < NI; ++ni) y[ni] = *(const bf16x8*)(st + yoff + ni * 32 * 72 + ks * 16);
#pragma unroll
      for (int mi = 0; mi < 2; ++mi)
#pragma unroll
        for (int ni = 0; ni < NI; ++ni) acc[mi][ni] = MFMA32(x[mi], y[ni], acc[mi][ni]);
    }
  };
  if constexpr (D2) {
    gload(ra[0], rb[0]);
    gload(ra[1], rb[1]);
    __syncthreads();
    lstore(ra[0], rb[0], S0);
    gload(ra[0], rb[0]);
    __syncthreads();
    for (int kt = 0; kt < nk; kt += 2) {
      compute(S0);
      lstore(ra[1], rb[1], S0 + STG);
      gload(ra[1], rb[1]);
      __syncthreads();
      compute(S0 + STG);
      if (kt + 2 < nk) lstore(ra[0], rb[0], S0);
      gload(ra[0], rb[0]);
      __syncthreads();
    }
  } else {
    gload(ra[0], rb[0]);
    __syncthreads();
    lstore(ra[0], rb[0], S0);
    gload(ra[0], rb[0]);
    __syncthreads();
    for (int kt = 0; kt < nk; kt += 2) {
      compute(S0);
      lstore(ra[0], rb[0], S0 + STG);
      gload(ra[0], rb[0]);
      __syncthreads();
      compute(S0 + STG);
      if (kt + 2 < nk) lstore(ra[0], rb[0], S0);
      gload(ra[0], rb[0]);
      __syncthreads();
    }
  }
  ep(acc);
}

template <int BN> struct GStage { uint4 ra[2][4]; uint4 rb[2][BN / 32]; int nxt; };
template <int BN, class AL, class BL, class EP, class NX>
DI bool gemm_tile_pf(int nk, bool swp, bool first, AL& al, BL& bl, GStage<BN>& st, EP ep, NX next_tile, unsigned char* smem) {
  constexpr int NI = BN / 64;
  constexpr int NB = BN / 32;
  constexpr int STG = (128 + BN) * 72;
  unsigned short* S0 = (unsigned short*)smem;
  const int tid = threadIdx.x, lane = tid & 63, wave = tid >> 6, l32 = lane & 31, h = lane >> 5;
  const int wm = wave >> 1, wn = wave & 1;
  const int xoff = (swp ? 128 * 72 + (wn * 64 + l32) * 72 : (wm * 64 + l32) * 72) + h * 8;
  const int yoff = (swp ? (wm * 64 + l32) * 72 : 128 * 72 + (wn * (BN / 2) + l32) * 72) + h * 8;
  f32x16 acc[2][NI];
#pragma unroll
  for (int mi = 0; mi < 2; ++mi)
#pragma unroll
    for (int ni = 0; ni < NI; ++ni)
#pragma unroll
      for (int i = 0; i < 16; ++i) acc[mi][ni][i] = 0.f;
  const int lrow = tid >> 3, lcol = (tid & 7) * 8;
  auto gload = [&](uint4 (&a4)[4], uint4 (&b4)[NB]) {
#pragma unroll
    for (int i = 0; i < 4; ++i) a4[i] = al.load(i);
#pragma unroll
    for (int i = 0; i < NB; ++i) b4[i] = bl.load(i);
    const int adv = (st.nxt + 1 < nk) ? 1 : 0;
    al.advance(adv); bl.advance(adv); st.nxt += adv;
  };
  auto lstore = [&](const uint4 (&a4)[4], const uint4 (&b4)[NB], unsigned short* sp) {
#pragma unroll
    for (int i = 0; i < 4; ++i) *(uint4*)(sp + (lrow + 32 * i) * 72 + lcol) = a4[i];
#pragma unroll
    for (int i = 0; i < NB; ++i) *(uint4*)(sp + 128 * 72 + (lrow + 32 * i) * 72 + lcol) = b4[i];
  };
  auto compute = [&](const unsigned short* sp) {
#pragma unroll
    for (int ks = 0; ks < 4; ++ks) {
      bf16x8 x[2], y[NI];
#pragma unroll
      for (int mi = 0; mi < 2; ++mi) x[mi] = *(const bf16x8*)(sp + xoff + mi * 32 * 72 + ks * 16);
#pragma unroll
      for (int ni = 0; ni < NI; ++ni) y[ni] = *(const bf16x8*)(sp + yoff + ni * 32 * 72 + ks * 16);
#pragma unroll
      for (int mi = 0; mi < 2; ++mi)
#pragma unroll
        for (int ni = 0; ni < NI; ++ni) acc[mi][ni] = MFMA32(x[mi], y[ni], acc[mi][ni]);
    }
  };
  if (first) {
    al.init(lrow, lcol); bl.init(lrow, lcol); st.nxt = 0;
    gload(st.ra[0], st.rb[0]);
    gload(st.ra[1], st.rb[1]);
  }
  __syncthreads();
  lstore(st.ra[0], st.rb[0], S0);
  gload(st.ra[0], st.rb[0]);
  __syncthreads();
  for (int kt = 0; kt < nk; kt += 2) {
    compute(S0);
    lstore(st.ra[1], st.rb[1], S0 + STG);
    gload(st.ra[1], st.rb[1]);
    __syncthreads();
    compute(S0 + STG);
    if (kt + 2 < nk) lstore(st.ra[0], st.rb[0], S0);
    gload(st.ra[0], st.rb[0]);
    __syncthreads();
  }
  const bool more = next_tile();
  if (more) {
    al.init(lrow, lcol); bl.init(lrow, lcol); st.nxt = 0;
    gload(st.ra[0], st.rb[0]);
    gload(st.ra[1], st.rb[1]);
  }
  ep(acc);
  return more;
}

DI bool xcd_tile(int step, int ntn, int& tm, int& tn) {
  const int G = gridDim.x;
  if ((G & 7) == 0) {
    const int x = blockIdx.x & 7, loc = blockIdx.x >> 3, per = G >> 3;
    const int j = loc + step * per;
    if (j >= 12 * ntn) return false;
    tn = j / 12; tm = 12 * x + j % 12;
    return true;
  }
  const int it = blockIdx.x + step * G;
  if (it >= 96 * ntn) return false;
  tm = it / ntn; tn = it % ntn;
  return true;
}

#define GAS __attribute__((address_space(1)))
typedef unsigned u32x4 __attribute__((ext_vector_type(4)));
DI uint4 gld16(const GAS char* q) { const u32x4 v = *(const GAS u32x4*)q; return make_uint4(v.x, v.y, v.z, v.w); }
struct LdBf {
  const bfr* base; size_t ld;
  const GAS char* p[4];
  DI void init(int lrow, int lcol) {
#pragma unroll
    for (int i = 0; i < 4; ++i) { p[i] = (const GAS char*)(base + (size_t)(lrow + 32 * i) * ld + lcol); asm volatile("" : "+v"(p[i])); }
  }
  DI uint4 load(int i) const { return gld16(p[i]); }
  DI void advance(int adv) {
#pragma unroll
    for (int i = 0; i < 4; ++i) p[i] += 128 * adv;
  }
};
#define XB_TMO      128
#define XB_XCNT(j)  (256  + 64 * (j))
#define XB_XSUB(j)  (1280 + 64 * (j))
#define XB_XGEN(j)  (2304 + 64 * (j))
#define XB_TOP      3328
#define XB_TOPGEN   3392
#define XCD_BAR_WORDS 3456
#define XB_SPIN_CAP (1u << 20)
#define LAS __attribute__((address_space(3)))
DI unsigned xb_ld(unsigned* p)              { return __hip_atomic_load(p, __ATOMIC_RELAXED, __HIP_MEMORY_SCOPE_AGENT); }
DI unsigned xb_add(unsigned* p, unsigned v) { return __hip_atomic_fetch_add(p, v, __ATOMIC_RELAXED, __HIP_MEMORY_SCOPE_AGENT); }
DI unsigned xb_xcc_id() { return (unsigned)__builtin_amdgcn_s_getreg((3 << 11) | 20) & 0xFu; }
#define XB_SPIN(cond, bar) do { unsigned _sp = 0; while (cond) { __builtin_amdgcn_s_sleep(1); \
    if ((++_sp & 255u) == 0u) { if (xb_ld(&(bar)[XB_TMO])) break; if (_sp > XB_SPIN_CAP) { atomicAdd(&(bar)[XB_TMO], 1u); break; } } } } while (0)
struct XcdBarrier { unsigned* bar; unsigned x; volatile LAS unsigned* st; };
DI XcdBarrier xcd_barrier_post(unsigned* bar, volatile LAS unsigned* st) {
  XcdBarrier b; b.bar = bar; b.x = xb_xcc_id(); b.st = st;
  if (threadIdx.x == 0) (void)xb_add(&bar[XB_XCNT(b.x)], 1u);
  return b;
}
DI void xcd_barrier_complete(unsigned* bar, unsigned x, unsigned& nloc, unsigned& nx) {
  const unsigned G = gridDim.x * gridDim.y * gridDim.z;
  unsigned sum, cnt, mine, sp = 0u;
  for (;;) {
    sum = 0u; cnt = 0u; mine = 0u;
#pragma unroll
    for (unsigned j = 0; j < 16; ++j) { const unsigned c = xb_ld(&bar[XB_XCNT(j)]); sum += c; cnt += (c > 0u) ? 1u : 0u; mine = (j == x) ? c : mine; }
    if (sum == G) break;
    __builtin_amdgcn_s_sleep(1);
    if ((++sp & 255u) == 0u) { if (xb_ld(&bar[XB_TMO])) break; if (sp > XB_SPIN_CAP) { atomicAdd(&bar[XB_TMO], 1u); break; } }
  }
  nloc = mine > 0u ? mine : 1u; nx = cnt > 0u ? cnt : 1u;
}
DI void xcd_barrier(const XcdBarrier& b) {
  asm volatile("s_waitcnt vmcnt(0)" ::: "memory");
  __syncthreads();
  if (threadIdx.x == 0) {
    unsigned* bar = b.bar;
    __builtin_amdgcn_s_waitcnt(0);
    unsigned nloc = b.st[0], nx = b.st[1];
    if (nloc == 0u) { xcd_barrier_complete(bar, b.x, nloc, nx); b.st[0] = nloc; b.st[1] = nx; }
    const unsigned old = xb_add(&bar[XB_XSUB(b.x)], 1u);
    const unsigned gen = old / nloc;
    if (old + 1u == (gen + 1u) * nloc) {
      __builtin_amdgcn_fence(__ATOMIC_RELEASE, "agent");
      asm volatile("s_waitcnt vmcnt(0)" ::: "memory");
      const unsigned og = xb_add(&bar[XB_TOP], 1u);
      const unsigned tg = og / nx;
      if (og + 1u == (tg + 1u) * nx) xb_add(&bar[XB_TOPGEN], 1u);
      else XB_SPIN(xb_ld(&bar[XB_TOPGEN]) == tg, bar);
      __builtin_amdgcn_fence(__ATOMIC_ACQUIRE, "agent");
      xb_add(&bar[XB_XGEN(b.x)], 1u);
      asm volatile("s_waitcnt vmcnt(0)" ::: "memory");
    } else {
      XB_SPIN(xb_ld(&bar[XB_XGEN(b.x)]) == gen, bar);
      __builtin_amdgcn_fence(__ATOMIC_ACQUIRE, "agent");
      asm volatile("s_waitcnt vmcnt(0)" ::: "memory");
    }
  }
  __syncthreads();
}

struct LdFz {
  const bfr* pz;
  const GAS char* p[4];
  DI void init(int lrow, int lcol) {
#pragma unroll
    for (int i = 0; i < 4; ++i) { p[i] = (const GAS char*)(pz + (size_t)(lrow + 32 * i) * 512 + lcol); asm volatile("" : "+v"(p[i])); }
  }
  DI void advance(int adv) {
#pragma unroll
    for (int i = 0; i < 4; ++i) p[i] += 128 * adv;
  }
  DI uint4 load(int i) const {
    const GAS char* q = p[i];
    const uint4 a = gld16(q), b = gld16(q + (size_t)4096 * 512 * 2), c = gld16(q + (size_t)2 * 4096 * 512 * 2), d = gld16(q + (size_t)3 * 4096 * 512 * 2);
#define SUM4(f) pk2(bf2f(a.f & 0xffff) + bf2f(b.f & 0xffff) + bf2f(c.f & 0xffff) + bf2f(d.f & 0xffff), bf2f(a.f >> 16) + bf2f(b.f >> 16) + bf2f(c.f >> 16) + bf2f(d.f >> 16))
    return make_uint4(SUM4(x), SUM4(y), SUM4(z), SUM4(w));
#undef SUM4
  }
};

DI void transpose_tile(const float* W, int ldw, int kbase, int nbase, bfr* WT, int ldt, int trow, float* sm) {
  const int tid = threadIdx.x;
#pragma unroll
  for (int i = 0; i < 4; ++i) {
    const int r = (tid >> 4) + 16 * i, c = (tid & 15) * 4;
    const float4 v = *(const float4*)(W + (size_t)(kbase + r) * ldw + nbase + c);
    sm[r * 65 + c] = v.x; sm[r * 65 + c + 1] = v.y; sm[r * 65 + c + 2] = v.z; sm[r * 65 + c + 3] = v.w;
  }
  __syncthreads();
  const int n = tid >> 2, kc = (tid & 3) * 16;
  unsigned o[8];
#pragma unroll
  for (int j = 0; j < 8; ++j) o[j] = pk2(sm[(kc + 2 * j) * 65 + n], sm[(kc + 2 * j + 1) * 65 + n]);
  uint4* dst = (uint4*)(WT + (size_t)(trow + n) * ldt + kbase + kc);
  dst[0] = make_uint4(o[0], o[1], o[2], o[3]);
  dst[1] = make_uint4(o[4], o[5], o[6], o[7]);
}

DI void phase0(const Params& p, unsigned char* smem) {
  const int tid = threadIdx.x;
  float* smf = (float*)smem;
  unsigned char* ws = p.ws;
  constexpr int N_ADA = 192;
  constexpr int N_T0 = 16 * 36, N_TG = 64, N_TO0 = 256, N_T1A = 16 * 24, N_T1B = 16 * 8, N_TF = 64, N_TO1 = 256;
  constexpr int N_FOLD = 128, N_ALAT = 2048, N_ACTX = 256, N_CACHE = 64, N_SSM = 64, N_ZERO = 48, N_ROPE = 4;
  constexpr int B_T0 = N_ADA, B_TG = B_T0 + N_T0, B_TO0 = B_TG + N_TG, B_T1A = B_TO0 + N_TO0, B_T1B = B_T1A + N_T1A,
                B_TF = B_T1B + N_T1B, B_TO1 = B_TF + N_TF, B_FOLD = B_TO1 + N_TO1, B_ALAT = B_FOLD + N_FOLD,
                B_ACTX = B_ALAT + N_ALAT, B_CACHE = B_ACTX + N_ACTX, B_SSM = B_CACHE + N_CACHE, B_ZERO = B_SSM + N_SSM,
                B_ROPE = B_ZERO + N_ZERO, N_ALL = B_ROPE + N_ROPE;
  for (int it = blockIdx.x; it < N_ALL; it += gridDim.x) {
    __syncthreads();
    if (it < B_T0) {
      const int l = it / 96, cgp = it % 96;
      float* sc = smf;
      float* red = smf + 3072;
      for (int e = tid; e < 3072; e += 256) {
        const int ci = e >> 10, k = e & 1023;
        const float cv = ci == 0 ? p.in[6][k] : p.in[5][(ci - 1) * 1024 + k];
        sc[e] = silu_f(cv);
      }
      __syncthreads();
      const int cq = tid & 7, rg = tid >> 3;
      const float* w = p.in[7] + (size_t)l * 1024 * 3072 + cgp * 32 + cq * 4;
      float4 a0 = make_float4(0.f, 0.f, 0.f, 0.f), a1 = a0, a2 = a0;
#pragma unroll 16
      for (int k = rg; k < 1024; k += 32) {
        const float4 wv = *(const float4*)(w + (size_t)k * 3072);
        const float s0 = sc[k], s1 = sc[1024 + k], s2 = sc[2048 + k];
        a0.x += s0 * wv.x; a0.y += s0 * wv.y; a0.z += s0 * wv.z; a0.w += s0 * wv.w;
        a1.x += s1 * wv.x; a1.y += s1 * wv.y; a1.z += s1 * wv.z; a1.w += s1 * wv.w;
        a2.x += s2 * wv.x; a2.y += s2 * wv.y; a2.z += s2 * wv.z; a2.w += s2 * wv.w;
      }
      *(float4*)(red + (0 * 32 + rg) * 32 + cq * 4) = a0;
      *(float4*)(red + (1 * 32 + rg) * 32 + cq * 4) = a1;
      *(float4*)(red + (2 * 32 + rg) * 32 + cq * 4) = a2;
      __syncthreads();
      if (tid < 96) {
        const int c2 = tid & 31, ci = tid >> 5;
        float s = 0.f;
#pragma unroll
        for (int q = 0; q < 32; ++q) s += red[(ci * 32 + q) * 32 + c2];
        const int n2 = cgp * 32 + c2;
        ((float*)(ws + OFF_MOD))[(l * 3 + ci) * 3072 + n2] = s + p.in[8][l * 3072 + n2];
      }
    } else if (it < B_FOLD) {
      const float* W; int ldw, nbase_off = 0, trow_off = 0, ntn, ldt; bfr* WT; int r;
      if (it < B_TG)        { r = it - B_T0;  W = p.in[11]; ldw = 2304; ntn = 36; WT = (bfr*)(ws + OFF_WIN0); ldt = 1024; }
      else if (it < B_TO0)  { r = it - B_TG;  W = p.in[22]; ldw = 512;  ntn = 8;  WT = (bfr*)(ws + OFF_GLU); ldt = 512; }
      else if (it < B_T1A)  { r = it - B_TO0; W = p.in[24]; ldw = 1024; ntn = 16; WT = (bfr*)(ws + OFF_WOUT0); ldt = 1024; }
      else if (it < B_T1B)  { r = it - B_T1A; W = p.in[25]; ldw = 2560; ntn = 24; WT = (bfr*)(ws + OFF_WIN1); ldt = 1024; }
      else if (it < B_TF)   { r = it - B_T1B; W = p.in[25]; ldw = 2560; ntn = 8;  WT = (bfr*)(ws + OFF_WIN1); ldt = 1024; nbase_off = 2048; trow_off = 2560; }
      else if (it < B_TO1)  { r = it - B_TF;  W = p.in[29]; ldw = 512;  ntn = 8;  WT = (bfr*)(ws + OFF_FNET); ldt = 512; }
      else                  { r = it - B_TO1; W = p.in[30]; ldw = 1024; ntn = 16; WT = (bfr*)(ws + OFF_WOUT1); ldt = 1024; }
      const int kb = r / ntn, nb = r % ntn;
      transpose_tile(W, ldw, kb * 64, nbase_off + nb * 64, WT, ldt, trow_off + nb * 64, smf);
    } else if (it < B_ALAT) {
      const int r = it - B_FOLD, cs = r & 1, kb = (r >> 1) & 15, g = r >> 5;
      float* tile = smf;
      float* tw = smf + 128 * 68;
      const float* W = p.in[25];
      {
        const int c4 = (tid & 31) * 4, kr = tid >> 5;
#pragma unroll
        for (int i = 0; i < 8; ++i) {
          const int k = kr + 8 * i;
          const float4 v = *(const float4*)(W + (size_t)(kb * 64 + k) * 2560 + 1536 + g * 128 + c4);
          tile[(c4 + 0) * 68 + k] = v.x; tile[(c4 + 1) * 68 + k] = v.y; tile[(c4 + 2) * 68 + k] = v.z; tile[(c4 + 3) * 68 + k] = v.w;
        }
        if (tid < 128) {
          const float a = 2.f * (float)tid / 128.f;
          tw[tid] = (cs == 0 ? cospif(a) : sinpif(a)) * 0.08838834764831845f;
        }
      }
      __syncthreads();
      const int j = tid & 127, kg = tid >> 7;
      float acc[32];
#pragma unroll
      for (int i = 0; i < 32; ++i) acc[i] = 0.f;
      for (int c = 0; c < 128; ++c) {
        const float t = tw[(j * c) & 127];
        const float4* tp = (const float4*)(tile + c * 68 + kg * 32);
#pragma unroll
        for (int q = 0; q < 8; ++q) {
          const float4 v = tp[q];
          acc[4 * q + 0] += v.x * t; acc[4 * q + 1] += v.y * t; acc[4 * q + 2] += v.z * t; acc[4 * q + 3] += v.w * t;
        }
      }
      uint4* dst = (uint4*)((bfr*)(ws + OFF_WIN1) + (size_t)(1536 + cs * 512 + g * 128 + j) * 1024 + kb * 64 + kg * 32);
#pragma unroll
      for (int q = 0; q < 4; ++q)
        dst[q] = make_uint4(pk2(acc[8 * q], acc[8 * q + 1]), pk2(acc[8 * q + 2], acc[8 * q + 3]), pk2(acc[8 * q + 4], acc[8 * q + 5]), pk2(acc[8 * q + 6], acc[8 * q + 7]));
    } else if (it < B_ACTX) {
      const int t = it - B_ALAT;
      bfr* dst = (bfr*)(ws + OFF_ALAT) + (size_t)t * 4096;
      const float nrm = 0.02209708691207961f;
#pragma unroll
      for (int half = 0; half < 2; ++half) {
        const int k0 = half * 2048 + tid * 8;
        unsigned o[4];
#pragma unroll
        for (int j = 0; j < 4; ++j) {
          float v[2];
#pragma unroll
          for (int e = 0; e < 2; ++e) {
            const int k = k0 + 2 * j + e;
            const int m = (t * (k & 2047)) & 2047;
            const float a = (float)m * (2.f / 2048.f);
            v[e] = (k < 2048 ? cospif(a) : -sinpif(a)) * nrm;
          }
          o[j] = pk2(v[0], v[1]);
        }
        *(uint4*)(dst + k0) = make_uint4(o[0], o[1], o[2], o[3]);
      }
    } else if (it < B_CACHE) {
      const int t = it - B_ACTX;
      bfr* dst = (bfr*)(ws + OFF_ACTX) + (size_t)t * 512;
      const float nrm = 0.0625f;
      float v[2];
#pragma unroll
      for (int e = 0; e < 2; ++e) {
        const int k = tid * 2 + e;
        const int m = (t * (k & 255)) & 255;
        const float a = (float)m * (2.f / 256.f);
        v[e] = (k < 256 ? cospif(a) : -sinpif(a)) * nrm;
      }
      *(unsigned*)(dst + tid * 2) = pk2(v[0], v[1]);
    } else if (it < B_SSM) {
      const int r = it - B_CACHE;
#pragma unroll
      for (int i = 0; i < 8; ++i) {
        const int e = r * 2048 + tid + 256 * i;
        const int d = e & 63, kvh = (e >> 6) & 1, key = (e >> 7) & 511, b = e >> 16;
        ((bfr*)(ws + OFF_KL))[((size_t)(b * 2 + kvh) * 2560 + key) * 64 + d] = f2bf(p.in[2][e]);
        ((bfr*)(ws + OFF_VL))[((size_t)(b * 2 + kvh) * 64 + d) * 2560 + key] = f2bf(p.in[3][e]);
      }
    } else if (it < B_ZERO) {
      const int dg = it - B_SSM;
      const int pp = tid & 63, part = tid >> 6;
      const double lr = (double)p.in[14][dg * 64 + pp], li = (double)p.in[15][dg * 64 + pp];
      const double dt = (double)__expf(p.in[16][dg]) ;
      const float dtf = expf(p.in[16][dg]);
      const double dtd = (double)dtf;
      (void)dt;
      const double PI = 3.14159265358979323846;
      double ap = li * dtd / PI;
      double ar = ap - 2.0 * rint(ap * 0.5);
      const float er = expf((float)(lr * dtd));
      const double lbr = (double)er * (double)cospif((float)ar), lbi = (double)er * (double)sinpif((float)ar);
      double ap2 = ap * 256.0;
      double ar2 = ap2 - 2.0 * rint(ap2 * 0.5);
      const float er2 = expf((float)(lr * dtd * 256.0));
      if (part == 0) {
        ((float2*)(ws + OFF_LAMB))[dg * 64 + pp] = make_float2((float)lbr, (float)lbi);
        ((float2*)(ws + OFF_LAMP))[dg * 64 + pp] = make_float2(er2 * cospif((float)ar2), er2 * sinpif((float)ar2));
      }
      const double den = lr * lr + li * li;
      const double fr = ((lbr - 1.0) * lr + lbi * li) / den, fi = (lbi * lr - (lbr - 1.0) * li) / den;
      float* bb = (float*)(ws + OFF_BB) + (size_t)(dg * 64 + pp) * 32;
#pragma unroll
      for (int q = 0; q < 4; ++q) {
        const int c = part * 4 + q;
        const double br = (double)p.in[17][(size_t)(dg * 64 + pp) * 16 + c], bi = (double)p.in[18][(size_t)(dg * 64 + pp) * 16 + c];
        bb[c] = (float)(fr * br - fi * bi);
        bb[16 + c] = (float)(fr * bi + fi * br);
      }
      bfr* cm = (bfr*)(ws + OFF_CMB) + (size_t)dg * 2048;
#pragma unroll
      for (int q = 0; q < 8; ++q) {
        const int e = tid * 8 + q, c = e >> 7, k = e & 127;
        const float v = k < 64 ? p.in[19][(size_t)(dg * 16 + c) * 64 + k] : -p.in[20][(size_t)(dg * 16 + c) * 64 + (k - 64)];
        cm[e] = f2bf(v);
      }
    } else if (it < B_ROPE) {
      const int r = it - B_ZERO;
      ((float*)(ws + OFF_ROWSS))[r * 256 + tid] = 0.f;
    } else {
      const int e = (it - B_ROPE) * 256 + tid;
      const int n = e >> 4, pr = e & 15;
      const double q4[4] = {1.0, 0.5623413251903491, 0.31622776601683794, 0.1778279410038923};
      double inv = q4[0];
      if ((pr & 3) == 1) inv = q4[1]; else if ((pr & 3) == 2) inv = q4[2]; else if ((pr & 3) == 3) inv = q4[3];
      const int dec = pr >> 2;
      if (dec == 1) inv *= 0.1; else if (dec == 2) inv *= 0.01; else if (dec == 3) inv *= 0.001;
      const double ap = (double)n * inv / 3.14159265358979323846;
      const double ar = ap - 2.0 * rint(ap * 0.5);
      ((float2*)(ws + OFF_ROPE))[e] = make_float2(cospif((float)ar), sinpif((float)ar));
    }
  }
}

template <int MODE>
DI void phase_rows(const Params& p) {
  unsigned char* ws = p.ws;
  const int lane = threadIdx.x & 63, wave = threadIdx.x >> 6;
  const float* mod = (const float*)(ws + OFF_MOD);
  for (int it = blockIdx.x; it < NTOK / 4; it += gridDim.x) {
    const int T = it * 4 + wave;
    const int ci = cond_of(T);
    float4 xv[4];
    if (MODE == 2) {
      const bfr* xr = (const bfr*)(ws + OFF_X1) + (size_t)T * 1024 + lane * 4;
#pragma unroll
      for (int j = 0; j < 4; ++j) {
        const uint2 raw = *(const uint2*)(xr + 256 * j);
        xv[j].x = bf2f(raw.x & 0xffff); xv[j].y = bf2f(raw.x >> 16); xv[j].z = bf2f(raw.y & 0xffff); xv[j].w = bf2f(raw.y >> 16);
      }
    } else {
      const float4* xr = (const float4*)xrow(p, T) + lane;
#pragma unroll
      for (int j = 0; j < 4; ++j) xv[j] = xr[64 * j];
    }
    if (MODE >= 1) {
      const int l = MODE - 1;
      const bfr* orow = (const bfr*)(ws + OFF_O) + (size_t)T * 1024;
      float4 ov[4]; float ss = 0.f;
#pragma unroll
      for (int j = 0; j < 4; ++j) {
        const uint2 raw = *(const uint2*)(orow + lane * 4 + 256 * j);
        ov[j].x = bf2f(raw.x & 0xffff); ov[j].y = bf2f(raw.x >> 16); ov[j].z = bf2f(raw.y & 0xffff); ov[j].w = bf2f(raw.y >> 16);
        ss += ov[j].x * ov[j].x + ov[j].y * ov[j].y + ov[j].z * ov[j].z + ov[j].w * ov[j].w;
      }
      const float rinv = rsqrtf(wave_sum(ss) * (1.f / 1024.f) + EPS);
      const float* gate = mod + (l * 3 + ci) * 3072 + 2048;
      const float* gp = p.in[10] + l * 1024;
#pragma unroll
      for (int j = 0; j < 4; ++j) {
        const int k = lane * 4 + 256 * j;
        const float4 g4 = *(const float4*)(gate + k), n4 = *(const float4*)(gp + k);
        xv[j].x += g4.x * (ov[j].x * rinv * n4.x); xv[j].y += g4.y * (ov[j].y * rinv * n4.y);
        xv[j].z += g4.z * (ov[j].z * rinv * n4.z); xv[j].w += g4.w * (ov[j].w * rinv * n4.w);
      }
      if (MODE == 2) {
        float4* yr = (float4*)(p.out + OUT_Y + (size_t)T * 1024) + lane;
#pragma unroll
        for (int j = 0; j < 4; ++j) yr[64 * j] = xv[j];
      } else {
        bfr* x1r = (bfr*)(ws + OFF_X1) + (size_t)T * 1024 + lane * 4;
#pragma unroll
        for (int j = 0; j < 4; ++j) *(uint2*)(x1r + 256 * j) = make_uint2(pk2(xv[j].x, xv[j].y), pk2(xv[j].z, xv[j].w));
      }
    }
    if (MODE <= 1) {
      const int l = MODE;
      float ss = 0.f;
#pragma unroll
      for (int j = 0; j < 4; ++j) ss += xv[j].x * xv[j].x + xv[j].y * xv[j].y + xv[j].z * xv[j].z + xv[j].w * xv[j].w;
      const float rinv = rsqrtf(wave_sum(ss) * (1.f / 1024.f) + EPS);
      const float* shift = mod + (l * 3 + ci) * 3072;
      const float* scale = shift + 1024;
      const float* gp = p.in[9] + l * 1024;
      bfr* hr = (bfr*)(ws + OFF_HN) + (size_t)T * 1024;
#pragma unroll
      for (int j = 0; j < 4; ++j) {
        const int k = lane * 4 + 256 * j;
        const float4 s4 = *(const float4*)(shift + k), c4 = *(const float4*)(scale + k), n4 = *(const float4*)(gp + k);
        const float a = xv[j].x * rinv * n4.x * (1.f + c4.x) + s4.x;
        const float b = xv[j].y * rinv * n4.y * (1.f + c4.y) + s4.y;
        const float c = xv[j].z * rinv * n4.z * (1.f + c4.z) + s4.z;
        const float d = xv[j].w * rinv * n4.w * (1.f + c4.w) + s4.w;
        *(uint2*)(hr + k) = make_uint2(pk2(a, b), pk2(c, d));
      }
    }
  }
}

DI void phase_win0(const Params& p, unsigned char* smem) {
  unsigned char* ws = p.ws;
  const int lane = threadIdx.x & 63, wave = threadIdx.x >> 6, l32 = lane & 31, h = lane >> 5, wm = wave >> 1, wn = wave & 1;
  const bfr* A = (const bfr*)(ws + OFF_HN);
  const bfr* Bt = (const bfr*)(ws + OFF_WIN0);
  int tm, tn;
  if (!xcd_tile(0, 18, tm, tn)) return;
  LdBf al{A + (size_t)tm * 128 * 1024, 1024}, bl{Bt + (size_t)tn * 128 * 1024, 1024};
  for (int step = 0;; ++step) {
    const int m0 = tm * 128, n0 = tn * 128;
    int tm2 = 0, tn2 = 0;
    auto next_tile = [&]() {
      if (!xcd_tile(step + 1, 18, tm2, tn2)) return false;
      al.base = A + (size_t)tm2 * 128 * 1024; bl.base = Bt + (size_t)tn2 * 128 * 1024;
      return true;
    };
    auto ep = [&](f32x16 (&acc)[2][2]) {
      const int colbase = n0 + wn * 64, rbase = m0 + wm * 64;
      const bool lat = m0 >= NCTX;
      if (tn == 5) {
        const int hd = (colbase - 640) >> 6;
#pragma unroll
        for (int mi = 0; mi < 2; ++mi)
#pragma unroll
          for (int ni = 0; ni < 2; ++ni) {
            const int d = ni * 32 + l32;
#pragma unroll
            for (int i4 = 0; i4 < 4; ++i4) {
              const int r0 = rbase + mi * 32 + 8 * i4 + 4 * h;
              const float a = acc[mi][ni][4 * i4], b2 = acc[mi][ni][4 * i4 + 1], c = acc[mi][ni][4 * i4 + 2], e = acc[mi][ni][4 * i4 + 3];
              const uint2 pk = make_uint2(pk2(a, b2), pk2(c, e));
              if (!lat) {
                p.out[OUT_V + (size_t)(r0 + 0) * 128 + hd * 64 + d] = a;
                p.out[OUT_V + (size_t)(r0 + 1) * 128 + hd * 64 + d] = b2;
                p.out[OUT_V + (size_t)(r0 + 2) * 128 + hd * 64 + d] = c;
                p.out[OUT_V + (size_t)(r0 + 3) * 128 + hd * 64 + d] = e;
                const int b = r0 >> 8, l = r0 & 255;
                *(uint2*)((bfr*)(ws + OFF_VC) + ((size_t)(b * 2 + hd) * 64 + d) * 256 + l) = pk;
              } else {
                const int b = (r0 - NCTX) >> 11, l = (r0 - NCTX) & 2047;
                *(uint2*)((bfr*)(ws + OFF_VL) + ((size_t)(b * 2 + hd) * 64 + d) * 2560 + 512 + l) = pk;
              }
            }
          }
      } else if (colbase < 640) {
        const bool isq = colbase < 512;
        const float* gain = isq ? p.in[12] : p.in[13];
        const int hd = isq ? (colbase >> 6) : ((colbase - 512) >> 6);
        float4 gv[2][4];
#pragma unroll
        for (int mi = 0; mi < 2; ++mi)
#pragma unroll
          for (int i4 = 0; i4 < 4; ++i4) gv[mi][i4] = *(const float4*)(gain + mi * 32 + 8 * i4 + 4 * h);
#pragma unroll
        for (int ni = 0; ni < 2; ++ni) {
          const int T = rbase + ni * 32 + l32;
          float ss = 0.f;
#pragma unroll
          for (int mi = 0; mi < 2; ++mi)
#pragma unroll
            for (int i = 0; i < 16; ++i) ss += acc[mi][ni][i] * acc[mi][ni][i];
          ss += __shfl_xor(ss, 32);
          const float rinv = rsqrtf(ss * (1.f / 64.f) + EPS);
          float v[2][16];
#pragma unroll
          for (int mi = 0; mi < 2; ++mi)
#pragma unroll
            for (int i4 = 0; i4 < 4; ++i4) {
              v[mi][4 * i4 + 0] = acc[mi][ni][4 * i4 + 0] * rinv * gv[mi][i4].x;
              v[mi][4 * i4 + 1] = acc[mi][ni][4 * i4 + 1] * rinv * gv[mi][i4].y;
              v[mi][4 * i4 + 2] = acc[mi][ni][4 * i4 + 2] * rinv * gv[mi][i4].z;
              v[mi][4 * i4 + 3] = acc[mi][ni][4 * i4 + 3] * rinv * gv[mi][i4].w;
            }
          if (!lat && !isq) {
#pragma unroll
            for (int mi = 0; mi < 2; ++mi)
#pragma unroll
              for (int i4 = 0; i4 < 4; ++i4)
                *(float4*)(p.out + OUT_K + (size_t)T * 128 + hd * 64 + mi * 32 + 8 * i4 + 4 * h) = make_float4(v[mi][4 * i4], v[mi][4 * i4 + 1], v[mi][4 * i4 + 2], v[mi][4 * i4 + 3]);
          }
          if (lat) {
            const int pos = (T - NCTX) & 2047;
            const float* rope = (const float*)(ws + OFF_ROPE);
#pragma unroll
            for (int mi = 0; mi < 2; ++mi) {
              const float* rb = rope + ((mi == 0 ? (pos >> 6) : (pos & 63)) * 16 + 4 * h) * 2;
#pragma unroll
              for (int i4 = 0; i4 < 2; ++i4) {
                const float4 cs0 = *(const float4*)(rb + 16 * i4), cs1 = *(const float4*)(rb + 16 * i4 + 4);
                const float cc[4] = {cs0.x, cs0.z, cs1.x, cs1.z}, sn[4] = {cs0.y, cs0.w, cs1.y, cs1.w};
#pragma unroll
                for (int e = 0; e < 4; ++e) {
                  const float x1 = v[mi][4 * i4 + e], x2 = v[mi][4 * i4 + e + 8];
                  v[mi][4 * i4 + e] = x1 * cc[e] - x2 * sn[e];
                  v[mi][4 * i4 + e + 8] = x1 * sn[e] + x2 * cc[e];
                }
              }
            }
          }
          bfr* dst;
          float sc = 1.f;
          if (isq) { dst = (bfr*)(ws + OFF_QB) + (size_t)T * 512 + hd * 64; sc = 0.125f; }
          else if (!lat) { dst = (bfr*)(ws + OFF_KC) + ((size_t)((T >> 8) * 2 + hd) * 256 + (T & 255)) * 64; }
          else { dst = (bfr*)(ws + OFF_KL) + ((size_t)(((T - NCTX) >> 11) * 2 + hd) * 2560 + 512 + ((T - NCTX) & 2047)) * 64; }
#pragma unroll
          for (int mi = 0; mi < 2; ++mi)
#pragma unroll
            for (int i4 = 0; i4 < 4; ++i4)
              *(uint2*)(dst + mi * 32 + 8 * i4 + 4 * h) = make_uint2(pk2(v[mi][4 * i4] * sc, v[mi][4 * i4 + 1] * sc), pk2(v[mi][4 * i4 + 2] * sc, v[mi][4 * i4 + 3] * sc));
        }
      } else {
        const int sec = colbase < 1280 ? 0 : (colbase < 1792 ? 1 : 2);
        const int cb = colbase - (sec == 0 ? 768 : (sec == 1 ? 1280 : 1792));
        if (sec == 1) {
          float* stf = (float*)smem;
#pragma unroll
          for (int ni = 0; ni < 2; ++ni) {
            const int row = wm * 64 + ni * 32 + l32;
#pragma unroll
            for (int mi = 0; mi < 2; ++mi)
#pragma unroll
              for (int i4 = 0; i4 < 4; ++i4)
                *(float4*)(stf + row * 132 + wn * 64 + mi * 32 + 8 * i4 + 4 * h) =
                    make_float4(acc[mi][ni][4 * i4], acc[mi][ni][4 * i4 + 1], acc[mi][ni][4 * i4 + 2], acc[mi][ni][4 * i4 + 3]);
          }
          __syncthreads();
          float* dbase = (float*)(ws + OFF_U) + (size_t)m0 * 512 + (n0 - 1280);
#pragma unroll 4
          for (int i = 0; i < 16; ++i) {
            const int id = threadIdx.x + 256 * i, r = id >> 5, c4 = id & 31;
            *(float4*)(dbase + (size_t)r * 512 + c4 * 4) = *(const float4*)(stf + r * 132 + c4 * 4);
          }
        } else {
          unsigned short* stg = (unsigned short*)smem;
#pragma unroll
          for (int ni = 0; ni < 2; ++ni) {
            const int row = wm * 64 + ni * 32 + l32;
#pragma unroll
            for (int mi = 0; mi < 2; ++mi)
#pragma unroll
              for (int i4 = 0; i4 < 4; ++i4) {
                const float a = acc[mi][ni][4 * i4], b2 = acc[mi][ni][4 * i4 + 1], c2 = acc[mi][ni][4 * i4 + 2], e = acc[mi][ni][4 * i4 + 3];
                *(uint2*)(stg + row * 136 + wn * 64 + mi * 32 + 8 * i4 + 4 * h) = make_uint2(pk2(silu_f(a), silu_f(b2)), pk2(silu_f(c2), silu_f(e)));
              }
          }
          __syncthreads();
          bfr* dbase = (bfr*)(ws + (sec == 0 ? OFF_GA : OFF_GB)) + (size_t)m0 * 512 + (n0 - (sec == 0 ? 768 : 1792));
#pragma unroll
          for (int i = 0; i < 8; ++i) {
            const int id = threadIdx.x + 256 * i, r = id >> 4, c16 = id & 15;
            *(uint4*)(dbase + (size_t)r * 512 + c16 * 8) = *(const uint4*)(stg + r * 136 + c16 * 8);
          }
        }
      }
    };
    al.base = A + (size_t)m0 * 1024; bl.base = Bt + (size_t)n0 * 1024;
    gemm_tile<128>(16, tn != 5, al, bl, ep, smem);
    if (!next_tile()) break;
    tm = tm2; tn = tn2;
  }
}

DI void attn_item(const Params& p, unsigned char* smem, int it) {
  unsigned char* ws = p.ws;
  const int tid = threadIdx.x, lane = tid & 63, wave = tid >> 6, l32 = lane & 31, h = lane >> 5;
  int T0, nkeys, ldv; const bfr *Kp, *Vp; int kvh;
  if (it < 256) {
    const int b = it >> 7, qt = it & 63; kvh = (it >> 6) & 1;
    T0 = NCTX + b * 2048 + qt * 32; nkeys = 2560; ldv = 2560;
    Kp = (const bfr*)(ws + OFF_KL) + (size_t)(b * 2 + kvh) * 2560 * 64;
    Vp = (const bfr*)(ws + OFF_VL) + (size_t)(b * 2 + kvh) * 64 * 2560;
  } else {
    const int i2 = it - 256; const int b = i2 >> 4, qt = i2 & 7; kvh = (i2 >> 3) & 1;
    T0 = b * 256 + qt * 32; nkeys = 256; ldv = 256;
    Kp = (const bfr*)(ws + OFF_KC) + (size_t)(b * 2 + kvh) * 256 * 64;
    Vp = (const bfr*)(ws + OFF_VC) + (size_t)(b * 2 + kvh) * 64 * 256;
  }
  const int head = kvh * 4 + wave;
  unsigned short* Ks = (unsigned short*)smem;
  unsigned short* Vs = Ks + 64 * 72;
  bf16x8 qf[4];
  {
    const bfr* q = (const bfr*)(ws + OFF_QB) + (size_t)(T0 + l32) * 512 + head * 64 + 8 * h;
#pragma unroll
    for (int ks = 0; ks < 4; ++ks) qf[ks] = *(const bf16x8*)(q + 16 * ks);
  }
  float m = -1e30f, lsum = 0.f;
  f32x16 O[2];
#pragma unroll
  for (int i = 0; i < 16; ++i) { O[0][i] = 0.f; O[1][i] = 0.f; }
  const int rr0 = tid >> 3, cc0 = (tid & 7) * 8;
  const bfr* kp0 = Kp + (size_t)rr0 * 64 + cc0;
  const bfr* vp0 = Vp + (size_t)rr0 * ldv + cc0;
  uint4 kreg0 = *(const uint4*)kp0, kreg1 = *(const uint4*)(kp0 + 32 * 64);
  uint4 vreg0 = *(const uint4*)vp0, vreg1 = *(const uint4*)(vp0 + (size_t)32 * ldv);
  for (int k0 = 0; k0 < nkeys; k0 += 64) {
    __syncthreads();
    *(uint4*)(Ks + rr0 * 72 + cc0) = kreg0; *(uint4*)(Ks + (rr0 + 32) * 72 + cc0) = kreg1;
    *(uint4*)(Vs + rr0 * 72 + cc0) = vreg0; *(uint4*)(Vs + (rr0 + 32) * 72 + cc0) = vreg1;
    __syncthreads();
    if (k0 + 64 < nkeys) {
      kreg0 = *(const uint4*)(kp0 + (size_t)(k0 + 64) * 64); kreg1 = *(const uint4*)(kp0 + (size_t)(k0 + 96) * 64);
      vreg0 = *(const uint4*)(vp0 + k0 + 64); vreg1 = *(const uint4*)(vp0 + (size_t)32 * ldv + k0 + 64);
    }
    f32x16 st[2];
#pragma unroll
    for (int kt = 0; kt < 2; ++kt) {
#pragma unroll
      for (int i = 0; i < 16; ++i) st[kt][i] = 0.f;
#pragma unroll
      for (int ks = 0; ks < 4; ++ks) {
        const bf16x8 a = *(const bf16x8*)(Ks + (32 * kt + l32) * 72 + 16 * ks + 8 * h);
        st[kt] = MFMA32(a, qf[ks], st[kt]);
      }
    }
    float mx = st[0][0];
#pragma unroll
    for (int i = 0; i < 16; ++i) { mx = fmaxf(mx, st[0][i]); mx = fmaxf(mx, st[1][i]); }
    mx = fmaxf(mx, __shfl_xor(mx, 32));
    const float mn = fmaxf(m, mx);
    const float alpha = __expf(m - mn);
    m = mn;
    float ps = 0.f;
#pragma unroll
    for (int kt = 0; kt < 2; ++kt)
#pragma unroll
      for (int i = 0; i < 16; ++i) { const float e = __expf(st[kt][i] - mn); st[kt][i] = e; ps += e; }
    lsum = lsum * alpha + ps;
#pragma unroll
    for (int i = 0; i < 16; ++i) { O[0][i] *= alpha; O[1][i] *= alpha; }
#pragma unroll
    for (int kt = 0; kt < 2; ++kt)
#pragma unroll
      for (int s = 0; s < 2; ++s) {
        const uint4 pu = make_uint4(pk2(st[kt][8 * s], st[kt][8 * s + 1]), pk2(st[kt][8 * s + 2], st[kt][8 * s + 3]),
                                    pk2(st[kt][8 * s + 4], st[kt][8 * s + 5]), pk2(st[kt][8 * s + 6], st[kt][8 * s + 7]));
        const bf16x8 pf = __builtin_bit_cast(bf16x8, pu);
#pragma unroll
        for (int dt = 0; dt < 2; ++dt) {
          const unsigned short* vr = Vs + (32 * dt + l32) * 72 + 32 * kt + 16 * s + 4 * h;
          const s16x4 lo = *(const s16x4*)vr, hi = *(const s16x4*)(vr + 8);
          const bf16x8 va = __builtin_shufflevector(lo, hi, 0, 1, 2, 3, 4, 5, 6, 7);
          O[dt] = MFMA32(va, pf, O[dt]);
        }
      }
  }
  const float ltot = lsum + __shfl_xor(lsum, 32);
  const float inv = 1.f / ltot;
  const int T = T0 + l32;
#pragma unroll
  for (int dt = 0; dt < 2; ++dt)
#pragma unroll
    for (int i4 = 0; i4 < 4; ++i4) {
      const int d = 32 * dt + 8 * i4 + 4 * h;
      const uint2 g = *(const uint2*)((const bfr*)(ws + OFF_GA) + (size_t)T * 512 + head * 64 + d);
      const float a = O[dt][4 * i4] * inv * bf2f(g.x & 0xffff), b = O[dt][4 * i4 + 1] * inv * bf2f(g.x >> 16);
      const float c = O[dt][4 * i4 + 2] * inv * bf2f(g.y & 0xffff), e = O[dt][4 * i4 + 3] * inv * bf2f(g.y >> 16);
      *(uint2*)((bfr*)(ws + OFF_MIX) + (size_t)T * 1024 + head * 64 + d) = make_uint2(pk2(a, b), pk2(c, e));
    }
}

DI void attn_lat_item(const Params& p, unsigned char* smem, int it) {
  unsigned char* ws = p.ws;
  const int tid = threadIdx.x, lane = tid & 63, wave = tid >> 6, l32 = lane & 31, h = lane >> 5;
  const int b = it >> 8, kvh = (it >> 7) & 1, qt = (it >> 1) & 63, hp = it & 1;
  const int hw = wave & 1, kh = wave >> 1;
  const int T0 = NCTX + b * 2048 + qt * 32;
  const int head = kvh * 4 + hp * 2 + hw;
  const bfr* Kp = (const bfr*)(ws + OFF_KL) + ((size_t)(b * 2 + kvh) * 2560 + kh * 1280) * 64;
  const bfr* Vp = (const bfr*)(ws + OFF_VL) + (size_t)(b * 2 + kvh) * 64 * 2560 + kh * 1280;
  unsigned short* Ks = (unsigned short*)smem + kh * (2 * 64 * 72);
  unsigned short* Vs = Ks + 64 * 72;
  bf16x8 qf[4];
  {
    const bfr* q = (const bfr*)(ws + OFF_QB) + (size_t)(T0 + l32) * 512 + head * 64 + 8 * h;
#pragma unroll
    for (int ks = 0; ks < 4; ++ks) qf[ks] = *(const bf16x8*)(q + 16 * ks);
  }
  float m = -1e30f, lsum = 0.f;
  f32x16 O[2];
#pragma unroll
  for (int i = 0; i < 16; ++i) { O[0][i] = 0.f; O[1][i] = 0.f; }
  const int t2 = tid & 127, rr0 = t2 >> 3, cc0 = (t2 & 7) * 8;
  const bfr* kp0 = Kp + (size_t)rr0 * 64 + cc0;
  const bfr* vp0 = Vp + (size_t)rr0 * 2560 + cc0;
  uint4 kr0 = *(const uint4*)kp0, kr1 = *(const uint4*)(kp0 + 16 * 64), kr2 = *(const uint4*)(kp0 + 32 * 64), kr3 = *(const uint4*)(kp0 + 48 * 64);
  uint4 vr0 = *(const uint4*)vp0, vr1 = *(const uint4*)(vp0 + (size_t)16 * 2560), vr2 = *(const uint4*)(vp0 + (size_t)32 * 2560), vr3 = *(const uint4*)(vp0 + (size_t)48 * 2560);
  for (int k0 = 0; k0 < 1280; k0 += 64) {
    __syncthreads();
    *(uint4*)(Ks + rr0 * 72 + cc0) = kr0; *(uint4*)(Ks + (rr0 + 16) * 72 + cc0) = kr1; *(uint4*)(Ks + (rr0 + 32) * 72 + cc0) = kr2; *(uint4*)(Ks + (rr0 + 48) * 72 + cc0) = kr3;
    *(uint4*)(Vs + rr0 * 72 + cc0) = vr0; *(uint4*)(Vs + (rr0 + 16) * 72 + cc0) = vr1; *(uint4*)(Vs + (rr0 + 32) * 72 + cc0) = vr2; *(uint4*)(Vs + (rr0 + 48) * 72 + cc0) = vr3;
    __syncthreads();
    if (k0 + 64 < 1280) {
      const bfr* kq = kp0 + (size_t)(k0 + 64) * 64; const bfr* vq = vp0 + k0 + 64;
      kr0 = *(const uint4*)kq; kr1 = *(const uint4*)(kq + 16 * 64); kr2 = *(const uint4*)(kq + 32 * 64); kr3 = *(const uint4*)(kq + 48 * 64);
      vr0 = *(const uint4*)vq; vr1 = *(const uint4*)(vq + (size_t)16 * 2560); vr2 = *(const uint4*)(vq + (size_t)32 * 2560); vr3 = *(const uint4*)(vq + (size_t)48 * 2560);
    }
    f32x16 st[2];
#pragma unroll
    for (int kt = 0; kt < 2; ++kt) {
#pragma unroll
      for (int i = 0; i < 16; ++i) st[kt][i] = 0.f;
#pragma unroll
      for (int ks = 0; ks < 4; ++ks) {
        const bf16x8 a = *(const bf16x8*)(Ks + (32 * kt + l32) * 72 + 16 * ks + 8 * h);
        st[kt] = MFMA32(a, qf[ks], st[kt]);
      }
    }
    float mx = st[0][0];
#pragma unroll
    for (int i = 0; i < 16; ++i) { mx = fmaxf(mx, st[0][i]); mx = fmaxf(mx, st[1][i]); }
    mx = fmaxf(mx, __shfl_xor(mx, 32));
    const float mn = fmaxf(m, mx);
    const float alpha = __expf(m - mn);
    m = mn;
    float ps = 0.f;
#pragma unroll
    for (int kt = 0; kt < 2; ++kt)
#pragma unroll
      for (int i = 0; i < 16; ++i) { const float e = __expf(st[kt][i] - mn); st[kt][i] = e; ps += e; }
    lsum = lsum * alpha + ps;
#pragma unroll
    for (int i = 0; i < 16; ++i) { O[0][i] *= alpha; O[1][i] *= alpha; }
#pragma unroll
    for (int kt = 0; kt < 2; ++kt)
#pragma unroll
      for (int s = 0; s < 2; ++s) {
        const uint4 pu = make_uint4(pk2(st[kt][8 * s], st[kt][8 * s + 1]), pk2(st[kt][8 * s + 2], st[kt][8 * s + 3]),
                                    pk2(st[kt][8 * s + 4], st[kt][8 * s + 5]), pk2(st[kt][8 * s + 6], st[kt][8 * s + 7]));
        const bf16x8 pf = __builtin_bit_cast(bf16x8, pu);
#pragma unroll
        for (int dt = 0; dt < 2; ++dt) {
          const unsigned short* vr = Vs + (32 * dt + l32) * 72 + 32 * kt + 16 * s + 4 * h;
          const s16x4 lo = *(const s16x4*)vr, hi = *(const s16x4*)(vr + 8);
          const bf16x8 va = __builtin_shufflevector(lo, hi, 0, 1, 2, 3, 4, 5, 6, 7);
          O[dt] = MFMA32(va, pf, O[dt]);
        }
      }
  }
  float ltot = lsum + __shfl_xor(lsum, 32);
  float* xb = (float*)smem + (hw * 64 + lane) * 36;
  __syncthreads();
  if (kh == 1) {
#pragma unroll
    for (int i = 0; i < 16; ++i) { xb[i] = O[0][i]; xb[16 + i] = O[1][i]; }
    xb[32] = m; xb[33] = ltot;
  }
  __syncthreads();
  if (kh == 0) {
    const float m2 = xb[32], l2 = xb[33];
    const float mm = fmaxf(m, m2), a1 = __expf(m - mm), a2 = __expf(m2 - mm);
    ltot = ltot * a1 + l2 * a2;
    const float inv = 1.f / ltot;
#pragma unroll
    for (int i = 0; i < 16; ++i) { O[0][i] = (O[0][i] * a1 + xb[i] * a2) * inv; O[1][i] = (O[1][i] * a1 + xb[16 + i] * a2) * inv; }
    const int T = T0 + l32;
#pragma unroll
    for (int dt = 0; dt < 2; ++dt)
#pragma unroll
      for (int i4 = 0; i4 < 4; ++i4) {
        const int d = 32 * dt + 8 * i4 + 4 * h;
        const uint2 g = *(const uint2*)((const bfr*)(ws + OFF_GA) + (size_t)T * 512 + head * 64 + d);
        const float a = O[dt][4 * i4] * bf2f(g.x & 0xffff), bq = O[dt][4 * i4 + 1] * bf2f(g.x >> 16);
        const float c = O[dt][4 * i4 + 2] * bf2f(g.y & 0xffff), e = O[dt][4 * i4 + 3] * bf2f(g.y >> 16);
        *(uint2*)((bfr*)(ws + OFF_MIX) + (size_t)T * 1024 + head * 64 + d) = make_uint2(pk2(a, bq), pk2(c, e));
      }
  }
}

DI int seg_T0(int seg) { return seg < 32 ? seg * 256 : NCTX + ((seg - 32) >> 3) * 2048 + ((seg - 32) & 7) * 256; }

DI void split_bf16(const float4& v0, const float4& v1, bf16x8& hi, bf16x8& lo) {
  const unsigned h0 = pk2(v0.x, v0.y), h1 = pk2(v0.z, v0.w), h2 = pk2(v1.x, v1.y), h3 = pk2(v1.z, v1.w);
  hi = __builtin_bit_cast(bf16x8, make_uint4(h0, h1, h2, h3));
  const unsigned l0 = pk2(v0.x - bf2f(h0 & 0xffff), v0.y - bf2f(h0 >> 16)), l1 = pk2(v0.z - bf2f(h1 & 0xffff), v0.w - bf2f(h1 >> 16));
  const unsigned l2 = pk2(v1.x - bf2f(h2 & 0xffff), v1.y - bf2f(h2 >> 16)), l3 = pk2(v1.z - bf2f(h3 & 0xffff), v1.w - bf2f(h3 >> 16));
  lo = __builtin_bit_cast(bf16x8, make_uint4(l0, l1, l2, l3));
}

DI void s5_wave(const Params& p, float* BU  , int it) {
  unsigned char* ws = p.ws;
  const int lane = threadIdx.x & 63, l32 = lane & 31, h = lane >> 5;
  const int di = it & 1, g = (it >> 1) & 31, seg = it >> 6;
  const int T0 = seg_T0(seg);
  const int dg = di * 32 + g;
  bf16x8 bhi[4], blo[4];
#pragma unroll
  for (int nt = 0; nt < 4; ++nt) {
    const float* bb = (const float*)(ws + OFF_BB) + (size_t)(dg * 64 + (nt & 1) * 32 + l32) * 32 + (nt >> 1) * 16 + 8 * h;
    split_bf16(*(const float4*)bb, *(const float4*)(bb + 4), bhi[nt], blo[nt]);
  }
  const float2 lam = ((const float2*)(ws + OFF_LAMB))[dg * 64 + lane];
  bf16x8 cmf[4];
  {
    const bfr* cm = (const bfr*)(ws + OFF_CMB) + (size_t)dg * 2048 + (lane & 15) * 128 + 8 * (lane >> 4);
#pragma unroll
    for (int ks = 0; ks < 4; ++ks) cmf[ks] = *(const bf16x8*)(cm + 32 * ks);
  }
  float hr = 0.f, hi = 0.f;
  bfr* yout = (bfr*)(ws + (di == 0 ? OFF_YF : OFF_YB));
  const float* ubase = (const float*)(ws + OFF_U) + g * 16 + 8 * h;
  float4 u0, u1;
  { const int T = di == 0 ? T0 + l32 : T0 + 255 - l32; const float* up = ubase + (size_t)T * 512; u0 = *(const float4*)up; u1 = *(const float4*)(up + 4); }
  for (int c = 0; c < 8; ++c) {
    bf16x8 ahi, alo;
    split_bf16(u0, u1, ahi, alo);
    if (c < 7) { const int sg = 32 * (c + 1) + l32; const int T = di == 0 ? T0 + sg : T0 + 255 - sg; const float* up = ubase + (size_t)T * 512; u0 = *(const float4*)up; u1 = *(const float4*)(up + 4); }
#pragma unroll
    for (int nt = 0; nt < 4; ++nt) {
      f32x16 acc;
#pragma unroll
      for (int i = 0; i < 16; ++i) acc[i] = 0.f;
      acc = MFMA32(ahi, bhi[nt], acc);
      acc = MFMA32(alo, bhi[nt], acc);
      acc = MFMA32(ahi, blo[nt], acc);
#pragma unroll
      for (int i = 0; i < 16; ++i) BU[crow(i, h) * 132 + 32 * nt + l32] = acc[i];
    }
    WAVE_SYNC();
#pragma unroll 8
    for (int sl = 0; sl < 32; ++sl) {
      const float br = BU[sl * 132 + lane], bi = BU[sl * 132 + 64 + lane];
      const float nr = lam.x * hr - lam.y * hi + br;
      const float ni = lam.x * hi + lam.y * hr + bi;
      hr = nr; hi = ni;
      BU[sl * 132 + lane] = hr; BU[sl * 132 + 64 + lane] = hi;
    }
    WAVE_SYNC();
#pragma unroll
    for (int tt = 0; tt < 2; ++tt) {
      f32x4 acc = {0.f, 0.f, 0.f, 0.f};
      const float* hrow = BU + (16 * tt + (lane & 15)) * 132 + 8 * (lane >> 4);
#pragma unroll
      for (int ks = 0; ks < 4; ++ks) {
        const float4 v0 = *(const float4*)(hrow + 32 * ks), v1 = *(const float4*)(hrow + 32 * ks + 4);
        const bf16x8 a = __builtin_bit_cast(bf16x8, make_uint4(pk2(v0.x, v0.y), pk2(v0.z, v0.w), pk2(v1.x, v1.y), pk2(v1.z, v1.w)));
        acc = MFMA16(a, cmf[ks], acc);
      }
#pragma unroll
      for (int i = 0; i < 4; ++i) {
        const int sg = 32 * c + 16 * tt + 4 * (lane >> 4) + i;
        const int T = di == 0 ? T0 + sg : T0 + 255 - sg;
        yout[(size_t)T * 512 + g * 16 + (lane & 15)] = f2bf(acc[i]);
      }
    }
    WAVE_SYNC();
  }
  ((float2*)(ws + OFF_E))[((size_t)(seg * 2 + di) * 32 + g) * 64 + lane] = make_float2(hr, hi);
  if (seg < 32) {
    float* so = p.out + OUT_S + (size_t)((seg * 2 + di) * 2) * 2048 + g * 64 + lane;
    so[0] = hr; so[2048] = hi;
  }
}

DI void phase_mix0(const Params& p, unsigned char* smem) {
  constexpr int N_S5 = 3072;
  const int b = blockIdx.x, G = gridDim.x, wave = threadIdx.x >> 6;
  float* BUw = (float*)smem + wave * (32 * 132);
  if (G == 512) {
    attn_lat_item(p, smem, b);
    __syncthreads();
    if (b < 256) { for (int r = 0; r < 2; ++r) s5_wave(p, BUw, b * 8 + r * 4 + wave); }
    else s5_wave(p, BUw, 2048 + (b - 256) * 4 + wave);
    __syncthreads();
    attn_item(p, smem, 256 + b);
  } else {
    for (int it = b * 4 + wave; it < N_S5; it += G * 4) s5_wave(p, BUw, it);
    for (int it = b; it < 512; it += G) { __syncthreads(); attn_lat_item(p, smem, it); }
    for (int it = b; it < 512; it += G) { __syncthreads(); attn_item(p, smem, 256 + it); }
  }
}

DI void phase_s5fix(const Params& p, unsigned char* smem) {
  unsigned char* ws = p.ws;
  const int tid = threadIdx.x, lane = tid & 63, wave = tid >> 6;
  float* ycorr = (float*)smem;
  float* HC = (float*)smem + 4096 + wave * (16 * 132);
  for (int it = blockIdx.x; it < 48 * 32; it += gridDim.x) {
    const int g = it & 31, seg = it >> 5;
    const int T0 = seg_T0(seg);
    __syncthreads();
    if (seg >= 32) {
      for (int e = tid; e < 4096; e += 256) ycorr[e] = 0.f;
      __syncthreads();
      const int b = (seg - 32) >> 3, j = (seg - 32) & 7;
      const int di = wave & 1, half = wave >> 1;
      const int dg = di * 32 + g;
      const float2 lam = ((const float2*)(ws + OFF_LAMB))[dg * 64 + lane];
      const float2 lp = ((const float2*)(ws + OFF_LAMP))[dg * 64 + lane];
      const float* st = p.in[4] + (size_t)((b * 2 + di) * 2) * 2048 + g * 64 + lane;
      float hr = st[0], hi = st[2048];
      const int nprev = di == 0 ? j : 7 - j;
      float2 ev[7];
#pragma unroll
      for (int q = 0; q < 7; ++q) {
        const int jj = di == 0 ? q : 7 - q;
        ev[q] = ((const float2*)(ws + OFF_E))[((size_t)((32 + b * 8 + jj) * 2 + di) * 32 + g) * 64 + lane];
      }
#pragma unroll
      for (int q = 0; q < 7; ++q) {
        if (q < nprev) {
          const float nr = lp.x * hr - lp.y * hi + ev[q].x, ni = lp.x * hi + lp.y * hr + ev[q].y;
          hr = nr; hi = ni;
        }
      }
      float cr = lam.x, cim = lam.y;
      if (half) {
        float sr = lam.x, si = lam.y;
#pragma unroll
        for (int q = 0; q < 7; ++q) { const float t = sr * sr - si * si; si = 2.f * sr * si; sr = t; }
        cr = sr * lam.x - si * lam.y; cim = sr * lam.y + si * lam.x;
      }
      bf16x8 cmf[4];
      {
        const bfr* cm = (const bfr*)(ws + OFF_CMB) + (size_t)dg * 2048 + (lane & 15) * 128 + 8 * (lane >> 4);
#pragma unroll
        for (int ks = 0; ks < 4; ++ks) cmf[ks] = *(const bf16x8*)(cm + 32 * ks);
      }
      for (int c = 0; c < 8; ++c) {
#pragma unroll 8
        for (int sl = 0; sl < 16; ++sl) {
          HC[sl * 132 + lane] = cr * hr - cim * hi;
          HC[sl * 132 + 64 + lane] = cr * hi + cim * hr;
          const float nr = cr * lam.x - cim * lam.y, ni = cr * lam.y + cim * lam.x;
          cr = nr; cim = ni;
        }
        WAVE_SYNC();
        f32x4 acc = {0.f, 0.f, 0.f, 0.f};
        const float* hrow = HC + (lane & 15) * 132 + 8 * (lane >> 4);
#pragma unroll
        for (int ks = 0; ks < 4; ++ks) {
          const float4 v0 = *(const float4*)(hrow + 32 * ks), v1 = *(const float4*)(hrow + 32 * ks + 4);
          const bf16x8 a = __builtin_bit_cast(bf16x8, make_uint4(pk2(v0.x, v0.y), pk2(v0.z, v0.w), pk2(v1.x, v1.y), pk2(v1.z, v1.w)));
          acc = MFMA16(a, cmf[ks], acc);
        }
#pragma unroll
        for (int i = 0; i < 4; ++i) {
          const int sg = 128 * half + 16 * c + 4 * (lane >> 4) + i;
          const int tl = di == 0 ? sg : 255 - sg;
          atomicAdd(&ycorr[tl * 16 + (lane & 15)], acc[i]);
        }
        WAVE_SYNC();
      }
      __syncthreads();
    }
    {
      const int c4 = (tid & 3) * 4;
      const float4 d4 = *(const float4*)(p.in[21] + g * 16 + c4);
      float4 uv[4]; uint2 fv[4], bv[4];
#pragma unroll
      for (int ps = 0; ps < 4; ++ps) {
        const int T = T0 + ps * 64 + (tid >> 2);
        uv[ps] = *(const float4*)((const float*)(ws + OFF_U) + (size_t)T * 512 + g * 16 + c4);
        fv[ps] = *(const uint2*)((const bfr*)(ws + OFF_YF) + (size_t)T * 512 + g * 16 + c4);
        bv[ps] = *(const uint2*)((const bfr*)(ws + OFF_YB) + (size_t)T * 512 + g * 16 + c4);
      }
#pragma unroll
      for (int ps = 0; ps < 4; ++ps) {
        const int tl = ps * 64 + (tid >> 2);
        float4 yc = make_float4(0.f, 0.f, 0.f, 0.f);
        if (seg >= 32) yc = *(const float4*)(ycorr + tl * 16 + c4);
        const float y0 = gelu_f(uv[ps].x * d4.x + bf2f(fv[ps].x & 0xffff) + bf2f(bv[ps].x & 0xffff) + yc.x);
        const float y1 = gelu_f(uv[ps].y * d4.y + bf2f(fv[ps].x >> 16) + bf2f(bv[ps].x >> 16) + yc.y);
        const float y2 = gelu_f(uv[ps].z * d4.z + bf2f(fv[ps].y & 0xffff) + bf2f(bv[ps].y & 0xffff) + yc.z);
        const float y3 = gelu_f(uv[ps].w * d4.w + bf2f(fv[ps].y >> 16) + bf2f(bv[ps].y >> 16) + yc.w);
        *(uint2*)((bfr*)(ws + OFF_YG) + (size_t)(T0 + tl) * 512 + g * 16 + c4) = make_uint2(pk2(y0, y1), pk2(y2, y3));
      }
    }
  }
}

template <int MODE>
DI void phase_tokgemm(const Params& p, unsigned char* smem, int layer) {
  unsigned char* ws = p.ws;
  const int lane = threadIdx.x & 63, wave = threadIdx.x >> 6, l32 = lane & 31, h = lane >> 5, wm = wave >> 1, wn = wave & 1;
  constexpr int K = MODE == 1 ? 1024 : 512, N = MODE == 1 ? 1024 : 512;
  const bfr* A = (const bfr*)(ws + (MODE == 0 ? OFF_YG : (MODE == 1 ? OFF_MIX : OFF_FZ)));
  const bfr* Bt = (const bfr*)(ws + (MODE == 0 ? OFF_GLU : (MODE == 1 ? (layer == 0 ? OFF_WOUT0 : OFF_WOUT1) : OFF_FNET)));
  constexpr int TN = N / 128;
  int tm, tn;
  if (!xcd_tile(0, TN, tm, tn)) return;
  LdBf alp{A + (size_t)tm * 128 * K, (size_t)K}, bl{Bt + (size_t)tn * 128 * K, (size_t)K};
  for (int step = 0;; ++step) {
    const int m0 = tm * 128, n0 = tn * 128;
    int tm2 = 0, tn2 = 0;
    auto next_tile = [&]() {
      if (!xcd_tile(step + 1, TN, tm2, tn2)) return false;
      alp.base = A + (size_t)tm2 * 128 * K; bl.base = Bt + (size_t)tn2 * 128 * K;
      return true;
    };
    auto ep_direct = [&](f32x16 (&acc)[2][2]) {
#pragma unroll
      for (int ni = 0; ni < 2; ++ni) {
        const int T = m0 + wm * 64 + ni * 32 + l32;
#pragma unroll
        for (int mi = 0; mi < 2; ++mi)
#pragma unroll
          for (int i4 = 0; i4 < 4; ++i4) {
            const int n = n0 + wn * 64 + mi * 32 + 8 * i4 + 4 * h;
            float a = acc[mi][ni][4 * i4], b2 = acc[mi][ni][4 * i4 + 1], c2 = acc[mi][ni][4 * i4 + 2], e = acc[mi][ni][4 * i4 + 3];
            if (MODE == 0) {
              const uint2 y = *(const uint2*)((const bfr*)(ws + OFF_YG) + (size_t)T * 512 + n);
              const uint2 gb = *(const uint2*)((const bfr*)(ws + OFF_GB) + (size_t)T * 512 + n);
              const float4 bs = *(const float4*)(p.in[23] + n);
              a = bf2f(y.x & 0xffff) * sigmoid_f(a + bs.x) * bf2f(gb.x & 0xffff);
              b2 = bf2f(y.x >> 16) * sigmoid_f(b2 + bs.y) * bf2f(gb.x >> 16);
              c2 = bf2f(y.y & 0xffff) * sigmoid_f(c2 + bs.z) * bf2f(gb.y & 0xffff);
              e = bf2f(y.y >> 16) * sigmoid_f(e + bs.w) * bf2f(gb.y >> 16);
              *(uint2*)((bfr*)(ws + OFF_MIX) + (size_t)T * 1024 + 512 + n) = make_uint2(pk2(a, b2), pk2(c2, e));
            } else if (MODE == 1) {
              *(uint2*)((bfr*)(ws + OFF_O) + (size_t)T * 1024 + n) = make_uint2(pk2(a, b2), pk2(c2, e));
            } else {
              const uint2 gd = *(const uint2*)((const bfr*)(ws + OFF_GDS) + (size_t)T * 512 + n);
              a *= bf2f(gd.x & 0xffff); b2 *= bf2f(gd.x >> 16); c2 *= bf2f(gd.y & 0xffff); e *= bf2f(gd.y >> 16);
              *(uint2*)((bfr*)(ws + OFF_MIX) + (size_t)T * 1024 + 512 + n) = make_uint2(pk2(a, b2), pk2(c2, e));
            }
          }
      }
    };
    auto ep_staged = [&](f32x16 (&acc)[2][2]) {
      unsigned short* stg = (unsigned short*)smem;
#pragma unroll
      for (int ni = 0; ni < 2; ++ni) {
        const int row = wm * 64 + ni * 32 + l32;
        const int T = m0 + row;
#pragma unroll
        for (int mi = 0; mi < 2; ++mi)
#pragma unroll
          for (int i4 = 0; i4 < 4; ++i4) {
            const int cl = wn * 64 + mi * 32 + 8 * i4 + 4 * h;
            const int n = n0 + cl;
            float a = acc[mi][ni][4 * i4], b2 = acc[mi][ni][4 * i4 + 1], c2 = acc[mi][ni][4 * i4 + 2], e = acc[mi][ni][4 * i4 + 3];
            if (MODE == 0) {
              const uint2 y = *(const uint2*)((const bfr*)(ws + OFF_YG) + (size_t)T * 512 + n);
              const uint2 gb = *(const uint2*)((const bfr*)(ws + OFF_GB) + (size_t)T * 512 + n);
              const float4 bs = *(const float4*)(p.in[23] + n);
              a = bf2f(y.x & 0xffff) * sigmoid_f(a + bs.x) * bf2f(gb.x & 0xffff);
              b2 = bf2f(y.x >> 16) * sigmoid_f(b2 + bs.y) * bf2f(gb.x >> 16);
              c2 = bf2f(y.y & 0xffff) * sigmoid_f(c2 + bs.z) * bf2f(gb.y & 0xffff);
              e = bf2f(y.y >> 16) * sigmoid_f(e + bs.w) * bf2f(gb.y >> 16);
            } else if (MODE == 2) {
              const uint2 gd = *(const uint2*)((const bfr*)(ws + OFF_GDS) + (size_t)T * 512 + n);
              a *= bf2f(gd.x & 0xffff); b2 *= bf2f(gd.x >> 16); c2 *= bf2f(gd.y & 0xffff); e *= bf2f(gd.y >> 16);
            }
            *(uint2*)(stg + row * 136 + cl) = make_uint2(pk2(a, b2), pk2(c2, e));
          }
      }
      __syncthreads();
      bfr* dbase = MODE == 1 ? (bfr*)(ws + OFF_O) + (size_t)m0 * 1024 + n0 : (bfr*)(ws + OFF_MIX) + (size_t)m0 * 1024 + 512 + n0;
#pragma unroll
      for (int i = 0; i < 8; ++i) {
        const int id = threadIdx.x + 256 * i, r = id >> 4, c16 = id & 15;
        *(uint4*)(dbase + (size_t)r * 1024 + c16 * 8) = *(const uint4*)(stg + r * 136 + c16 * 8);
      }
    };
    auto ep = [&](f32x16 (&acc)[2][2]) { if constexpr (MODE == 1) ep_staged(acc); else ep_direct(acc); };
    if constexpr (MODE == 2) {
      bl.base = Bt + (size_t)n0 * K;
      if (m0 < NCTX) {
        LdBf al{A + (size_t)m0 * K, (size_t)K};
        gemm_tile<128>(K / 64, true, al, bl, ep, smem);
      } else {
        LdFz al{(const bfr*)(ws + OFF_HN) + (size_t)(m0 - NCTX) * 512};
        gemm_tile<128, false>(K / 64, true, al, bl, ep, smem);
      }
      if (!next_tile()) break;
    } else {
      alp.base = A + (size_t)m0 * K; bl.base = Bt + (size_t)n0 * K;
      gemm_tile<128>(K / 64, true, alp, bl, ep, smem);
      if (!next_tile()) break;
    }
    tm = tm2; tn = tn2;
  }
}

DI void phase_win1(const Params& p, unsigned char* smem) {
  unsigned char* ws = p.ws;
  const int lane = threadIdx.x & 63, wave = threadIdx.x >> 6, l32 = lane & 31, h = lane >> 5, wm = wave >> 1, wn = wave & 1;
  const bfr* A = (const bfr*)(ws + OFF_HN);
  const bfr* Bt = (const bfr*)(ws + OFF_WIN1);
  int tm, tn;
  if (!xcd_tile(0, 24, tm, tn)) return;
  LdBf al{A + (size_t)tm * 128 * 1024, 1024}, bl{Bt + (size_t)tn * 128 * 1024, 1024};
  for (int step = 0;; ++step) {
    const int m0 = tm * 128, n0 = tn * 128;
    int tm2 = 0, tn2 = 0;
    auto next_tile = [&]() {
      if (!xcd_tile(step + 1, 24, tm2, tn2)) return false;
      al.base = A + (size_t)tm2 * 128 * 1024; bl.base = Bt + (size_t)tn2 * 128 * 1024;
      return true;
    };
    auto ep = [&](f32x16 (&acc)[2][2]) {
      const int colbase = n0 + wn * 64, rbase = m0 + wm * 64;
      const int sec = colbase >> 9;
      const int cbt = n0 & 511;
      const bool lat = m0 >= NCTX;
      unsigned short* stg = (unsigned short*)smem;
      if (sec == 0 || sec == 2 || sec == 5) {
#pragma unroll
        for (int ni = 0; ni < 2; ++ni) {
          const int row = wm * 64 + ni * 32 + l32;
#pragma unroll
          for (int mi = 0; mi < 2; ++mi)
#pragma unroll
            for (int i4 = 0; i4 < 4; ++i4) {
              const float a = acc[mi][ni][4 * i4], b2 = acc[mi][ni][4 * i4 + 1], c2 = acc[mi][ni][4 * i4 + 2], e = acc[mi][ni][4 * i4 + 3];
              const uint2 o = sec == 0 ? make_uint2(pk2(gelu_f(a), gelu_f(b2)), pk2(gelu_f(c2), gelu_f(e))) : make_uint2(pk2(silu_f(a), silu_f(b2)), pk2(silu_f(c2), silu_f(e)));
              *(uint2*)(stg + row * 136 + wn * 64 + mi * 32 + 8 * i4 + 4 * h) = o;
            }
        }
      } else {
        if (sec == 1) {
          float* rowss = (float*)(ws + OFF_ROWSS);
#pragma unroll
          for (int mi = 0; mi < 2; ++mi)
#pragma unroll
            for (int i = 0; i < 16; ++i) {
              const float g0 = gelu_f(acc[mi][0][i]), g1 = gelu_f(acc[mi][1][i]);
              acc[mi][0][i] = g0; acc[mi][1][i] = g1;
              const float ss = half_sum32(g0 * g0 + g1 * g1);
              if (l32 == 0) atomicAdd(rowss + rbase + mi * 32 + crow(i, h), ss);
            }
        }
#pragma unroll
        for (int mi = 0; mi < 2; ++mi)
#pragma unroll
          for (int ni = 0; ni < 2; ++ni)
#pragma unroll
            for (int i4 = 0; i4 < 4; ++i4)
              *(uint2*)(stg + (wn * 64 + ni * 32 + l32) * 136 + wm * 64 + mi * 32 + 8 * i4 + 4 * h) =
                  make_uint2(pk2(acc[mi][ni][4 * i4], acc[mi][ni][4 * i4 + 1]), pk2(acc[mi][ni][4 * i4 + 2], acc[mi][ni][4 * i4 + 3]));
      }
      __syncthreads();
      bfr* dbase; size_t dld;
      if (sec == 0 || sec == 2 || sec == 5) { dbase = (bfr*)(ws + (sec == 0 ? OFF_CUG : (sec == 2 ? OFF_GCS : OFF_GDS))) + (size_t)m0 * 512 + cbt; dld = 512; }
      else if (sec == 1) { dbase = (bfr*)(ws + OFF_CVT) + (size_t)cbt * NTOK + m0; dld = NTOK; }
      else if (!lat) { dbase = (bfr*)(ws + OFF_ZTC) + ((size_t)((m0 >> 8) * 512 + cbt)) * 512 + (sec - 3) * 256 + (m0 & 255); dld = 512; }
      else { dbase = (bfr*)(ws + OFF_ZTL) + ((size_t)(((m0 - NCTX) >> 11) * 512 + cbt)) * 4096 + (sec - 3) * 2048 + ((m0 - NCTX) & 2047); dld = 4096; }
#pragma unroll
      for (int i = 0; i < 8; ++i) {
        const int id = threadIdx.x + 256 * i, r = id >> 4, c16 = id & 15;
        *(uint4*)(dbase + (size_t)r * dld + c16 * 8) = *(const uint4*)(stg + r * 136 + c16 * 8);
      }
    };
    const int sec0 = n0 >> 9;
    al.base = A + (size_t)m0 * 1024; bl.base = Bt + (size_t)n0 * 1024;
    gemm_tile<128>(16, sec0 == 0 || sec0 == 2 || sec0 == 5, al, bl, ep, smem);
    if (!next_tile()) break;
    tm = tm2; tn = tn2;
  }
}

struct LdWs {
  const float* w; const float* rowss;
  const float* p[4]; const float* rp;
  DI void init(int lrow, int lcol) {
#pragma unroll
    for (int i = 0; i < 4; ++i) p[i] = w + (lrow + 32 * i) * 128 + lcol;
    rp = rowss + lcol;
  }
  DI void advance(int adv) {
#pragma unroll
    for (int i = 0; i < 4; ++i) p[i] += 64 * adv;
    rp += 64 * adv;
  }
  DI uint4 load(int i) const {
    const float* wp = p[i];
    const float4 a = *(const float4*)wp, b = *(const float4*)(wp + 4);
    const float4 s0 = *(const float4*)rp, s1 = *(const float4*)(rp + 4);
    const float r0 = rsqrtf(s0.x * (1.f / 512.f) + EPS), r1 = rsqrtf(s0.y * (1.f / 512.f) + EPS), r2 = rsqrtf(s0.z * (1.f / 512.f) + EPS), r3 = rsqrtf(s0.w * (1.f / 512.f) + EPS);
    const float r4 = rsqrtf(s1.x * (1.f / 512.f) + EPS), r5 = rsqrtf(s1.y * (1.f / 512.f) + EPS), r6 = rsqrtf(s1.z * (1.f / 512.f) + EPS), r7 = rsqrtf(s1.w * (1.f / 512.f) + EPS);
    return make_uint4(pk2(a.x * r0, a.y * r1), pk2(a.z * r2, a.w * r3), pk2(b.x * r4, b.y * r5), pk2(b.z * r6, b.w * r7));
  }
};

DI void phase_mix1(const Params& p, unsigned char* smem) {
  unsigned char* ws = p.ws;
  const int lane = threadIdx.x & 63, wave = threadIdx.x >> 6, l32 = lane & 31, h = lane >> 5, wm = wave >> 1, wn = wave & 1;
  constexpr int N_FL = 512, N_FC = 256, N_G = 768;
  for (int it = blockIdx.x; it < N_FL + N_FC + N_G; it += gridDim.x) {
    if (it < N_FL + N_FC) {
      const bfr *A, *Bt; int K, Tbase, tm, tn;
      int kq = 0; bool isl = it < N_FL;
      if (isl) {
        const int b = it >> 8; kq = it & 3; tn = (it >> 2) & 3; tm = (it >> 4) & 15; K = 4096;
        A = (const bfr*)(ws + OFF_ALAT) + kq * 1024; Bt = (const bfr*)(ws + OFF_ZTL) + (size_t)b * 512 * 4096 + kq * 1024; Tbase = NCTX + b * 2048;
      } else {
        const int i2 = it - N_FL; const int b = i2 >> 3; tm = (i2 >> 2) & 1; tn = i2 & 3; K = 512;
        A = (const bfr*)(ws + OFF_ACTX); Bt = (const bfr*)(ws + OFF_ZTC) + (size_t)b * 512 * 512; Tbase = b * 256;
      }
      LdBf al{A + (size_t)tm * 128 * K, (size_t)K}, bl{Bt + (size_t)tn * 128 * K, (size_t)K};
      auto ep = [&](f32x16 (&acc)[2][2]) {
#pragma unroll
        for (int mi = 0; mi < 2; ++mi)
#pragma unroll
          for (int ni = 0; ni < 2; ++ni)
#pragma unroll
            for (int i = 0; i < 16; ++i) {
              const int T = Tbase + tm * 128 + wm * 64 + mi * 32 + crow(i, h);
              const int n = tn * 128 + wn * 64 + ni * 32 + l32;
              if (!isl) ((bfr*)(ws + OFF_FZ))[(size_t)T * 512 + n] = f2bf(acc[mi][ni][i]);
              else ((bfr*)(ws + OFF_HN))[((size_t)kq * 4096 + (T - NCTX)) * 512 + n] = f2bf(acc[mi][ni][i]);
            }
      };
      gemm_tile<128>(isl ? 16 : K / 64, false, al, bl, ep, smem);
    } else {
      const int i2 = it - N_FL - N_FC; const int hg = i2 & 7, chunk = i2 >> 3;
      LdWs al{p.in[27] + (size_t)hg * 128 * 128, (const float*)(ws + OFF_ROWSS) + chunk * 128};
      LdBf bl{(const bfr*)(ws + OFF_CVT) + (size_t)(hg * 64) * NTOK + chunk * 128, (size_t)NTOK};
      auto ep = [&](f32x16 (&acc)[2][1]) {
        const int c = hg * 64 + wn * 32 + l32;
        const float vg = p.in[26][c];
#pragma unroll
        for (int mi = 0; mi < 2; ++mi)
#pragma unroll
          for (int i = 0; i < 16; ++i) {
            const int t = wm * 64 + mi * 32 + crow(i, h);
            const int T = chunk * 128 + t;
            const float sp = acc[mi][0][i] * vg + p.in[28][hg * 128 + t];
            const float cu = bf2f(((const bfr*)(ws + OFF_CUG))[(size_t)T * 512 + c]);
            const float gc = bf2f(((const bfr*)(ws + OFF_GCS))[(size_t)T * 512 + c]);
            ((bfr*)(ws + OFF_MIX))[(size_t)T * 1024 + c] = f2bf(cu * sp * gc);
          }
      };
      gemm_tile<64>(2, false, al, bl, ep, smem);
    }
  }
}

constexpr int NPHASE = 13;
#ifndef DOUBLE_MASK
#define DOUBLE_MASK 0
#endif
template <int PH>
DI void run_phase(const Params& p, unsigned char* smem) {
  if constexpr (PH == 0) phase0(p, smem);
  else if constexpr (PH == 1) phase_rows<0>(p);
  else if constexpr (PH == 2) phase_win0(p, smem);
  else if constexpr (PH == 3) phase_mix0(p, smem);
  else if constexpr (PH == 4) phase_s5fix(p, smem);
  else if constexpr (PH == 5) phase_tokgemm<0>(p, smem, 0);
  else if constexpr (PH == 6) phase_tokgemm<1>(p, smem, 0);
  else if constexpr (PH == 7) phase_rows<1>(p);
  else if constexpr (PH == 8) phase_win1(p, smem);
  else if constexpr (PH == 9) phase_mix1(p, smem);
  else if constexpr (PH == 10) phase_tokgemm<2>(p, smem, 1);
  else if constexpr (PH == 11) phase_tokgemm<1>(p, smem, 1);
  else if constexpr (PH == 12) phase_rows<2>(p);
}
template <int LO, int HI>
DI void run_range(const Params& p, unsigned char* smem, const XcdBarrier& xb) {
  if constexpr (LO < HI) {
    run_phase<LO>(p, smem);
    if constexpr (((DOUBLE_MASK) >> LO) & 1) { xcd_barrier(xb); run_phase<LO>(p, smem); }
    if constexpr (LO + 1 < HI) { xcd_barrier(xb); run_range<LO + 1, HI>(p, smem, xb); }
  }
}
template <int LO, int HI>
__global__ void __launch_bounds__(256, 2) mega(Params p) {
  __shared__ __attribute__((aligned(16))) unsigned char smem[73728];
  __shared__ uint4 xb_words;
  if (threadIdx.x == 0) xb_words = make_uint4(0u, 0u, 0u, 0u);
  __syncthreads();
  XcdBarrier xb = xcd_barrier_post((unsigned*)(p.ws + OFF_BAR), (volatile LAS unsigned*)&xb_words);
  run_range<LO, HI>(p, smem, xb);
  if (p.ph_lo != 0) cg::this_grid().sync();
}

#ifndef ONE_LAUNCH
#define ONE_LAUNCH 1
#endif
#if !ONE_LAUNCH
template <int PH>
static void launch_phases(Params& p, int grid, hipStream_t stream) {
  if constexpr (PH < NPHASE) {
    hipLaunchKernelGGL((mega<PH, PH + 1>), dim3(grid), dim3(256), 0, stream, p);
    launch_phases<PH + 1>(p, grid, stream);
  }
}
#endif

#ifndef ONE_LAUNCH
#define ONE_LAUNCH 1
#endif

extern "C" void kernel_launch(void* const* d_in, const int* in_sizes, int n_in, void* d_out, int out_size, void* d_ws, size_t ws_size, hipStream_t stream) {
  static int grid_blocks = 0;
  if (!grid_blocks) {
    int dev = 0, cus = 0, per_cu = 0;
    (void)hipGetDevice(&dev);
    (void)hipDeviceGetAttribute(&cus, hipDeviceAttributeMultiprocessorCount, dev);
    (void)hipOccupancyMaxActiveBlocksPerMultiprocessor(&per_cu, mega<0, NPHASE>, 256, 0);
    if (per_cu > 2) per_cu = 2;
    if (per_cu < 1) per_cu = 1;
    grid_blocks = cus * per_cu;
    if (n_in != 31 || ws_size < WS_TOTAL) fprintf(stderr, "kernel_launch: unexpected n_in %d or ws_size %zu (need %zu)\n", n_in, ws_size, (size_t)WS_TOTAL);
  }
  Params p{};
  for (int i = 0; i < 31; ++i) p.in[i] = (const float*)d_in[i];
  p.out = (float*)d_out; p.ws = (unsigned char*)d_ws;
  (void)hipMemsetAsync((unsigned char*)d_ws + OFF_BAR, 0, 16384, stream);
#if ONE_LAUNCH
  p.ph_lo = 0; p.ph_hi = NPHASE;
  void* args[] = {&p};
  hipError_t e = hipLaunchCooperativeKernel((void*)mega<0, NPHASE>, dim3(grid_blocks), dim3(256), args, 0, stream);
  if (e != hipSuccess) fprintf(stderr, "cooperative launch failed: %s (grid %d)\n", hipGetErrorString(e), grid_blocks);
#else
  launch_phases<0>(p, grid_blocks, stream);
#endif
}
```

```cpp
#include <hip/hip_runtime.h>
#include <hip/hip_cooperative_groups.h>
#include <cstdio>
#include <cstdint>
namespace cg = cooperative_groups;

#define DI __device__ __forceinline__
typedef unsigned short bfr;
using bf16x8 = __attribute__((ext_vector_type(8))) short;
using s16x4  = __attribute__((ext_vector_type(4))) short;
using f32x16 = __attribute__((ext_vector_type(16))) float;
using f32x4  = __attribute__((ext_vector_type(4))) float;

#define MFMA32(a, b, c) __builtin_amdgcn_mfma_f32_32x32x16_bf16((a), (b), (c), 0, 0, 0)
#define MFMA16(a, b, c) __builtin_amdgcn_mfma_f32_16x16x32_bf16((a), (b), (c), 0, 0, 0)

constexpr int NTOK = 12288, NCTX = 8192;
constexpr float EPS = 1e-6f;

constexpr size_t OFF_MOD   = 0;
constexpr size_t OFF_ROWSS = OFF_MOD + 73728;
constexpr size_t OFF_ROPE  = OFF_ROWSS + 49152;
constexpr size_t OFF_LAMB  = OFF_ROPE + 8192;
constexpr size_t OFF_LAMP  = OFF_LAMB + 32768;
constexpr size_t OFF_BB    = OFF_LAMP + 32768;
constexpr size_t OFF_CMB   = OFF_BB + 524288;
constexpr size_t OFF_E     = OFF_CMB + 262144;
constexpr size_t OFF_WIN0  = OFF_E + 1572864;
constexpr size_t OFF_GLU   = OFF_WIN0 + 4718592;
constexpr size_t OFF_WOUT0 = OFF_GLU + 524288;
constexpr size_t OFF_WIN1  = OFF_WOUT0 + 2097152;
constexpr size_t OFF_FNET  = OFF_WIN1 + 6291456;
constexpr size_t OFF_WOUT1 = OFF_FNET + 524288;
constexpr size_t OFF_ACTX  = OFF_WOUT1 + 2097152;
constexpr size_t OFF_ALAT  = OFF_ACTX + 262144;
constexpr size_t OFF_X1    = OFF_ALAT + 16777216;
constexpr size_t OFF_HN    = OFF_X1 + 50331648;
constexpr size_t OFF_MIX   = OFF_HN + 25165824;
constexpr size_t OFF_O     = OFF_MIX + 25165824;
constexpr size_t OFF_U     = OFF_O;
constexpr size_t OFF_R     = OFF_O + 25165824;
constexpr size_t OFF_QB = OFF_R;
constexpr size_t OFF_KC = OFF_QB + 12582912;
constexpr size_t OFF_KL = OFF_KC + 2097152;
constexpr size_t OFF_VC = OFF_KL + 1310720;
constexpr size_t OFF_VL = OFF_VC + 2097152;
constexpr size_t OFF_GA = OFF_VL + 1310720;
constexpr size_t OFF_GB = OFF_GA + 12582912;
constexpr size_t OFF_YF = OFF_GB + 12582912;
constexpr size_t OFF_YB = OFF_YF + 12582912;
constexpr size_t OFF_YG = OFF_YB + 12582912;
constexpr size_t END_L0 = OFF_YG + 12582912;
constexpr size_t OFF_CUG = OFF_R;
constexpr size_t OFF_GCS = OFF_CUG + 12582912;
constexpr size_t OFF_GDS = OFF_GCS + 12582912;
constexpr size_t OFF_CVT = OFF_GDS + 12582912;
constexpr size_t OFF_FZ  = OFF_CVT + 12582912;
constexpr size_t OFF_ZTC = OFF_FZ + 12582912;
constexpr size_t OFF_ZTL = OFF_ZTC + 16777216;
constexpr size_t END_L1 = OFF_ZTL + 8388608;
constexpr size_t WS_NEED = (END_L0 > END_L1 ? END_L0 : END_L1);
constexpr size_t OFF_BAR = WS_NEED;
constexpr size_t WS_TOTAL = OFF_BAR + 16384;
static_assert(WS_TOTAL <= (size_t)256 * 1024 * 1024, "workspace too large");

constexpr size_t OUT_Y = 0, OUT_K = 12582912, OUT_V = 13631488, OUT_S = 14680064;

struct Params {
  const float* in[31];
  float* out;
  unsigned char* ws;
  int ph_lo, ph_hi;
};

typedef __bf16 hbf2 __attribute__((ext_vector_type(2)));
typedef float hfl2 __attribute__((ext_vector_type(2)));
DI unsigned pk2(float lo, float hi) { hfl2 v = {lo, hi}; hbf2 r = __builtin_convertvector(v, hbf2); return __builtin_bit_cast(unsigned, r); }
DI unsigned short f2bf(float x) { return (unsigned short)(pk2(x, 0.f) & 0xffffu); }
DI float bf2f(unsigned short b) { return __uint_as_float(((unsigned)b) << 16); }
#define WAVE_SYNC() do { asm volatile("s_waitcnt lgkmcnt(0)" ::: "memory"); __builtin_amdgcn_wave_barrier(); } while (0)
DI float wave_sum(float v) {
#pragma unroll
  for (int o = 1; o < 64; o <<= 1) v += __shfl_xor(v, o);
  return v;
}
DI float half_sum32(float v) {
#pragma unroll
  for (int o = 1; o < 32; o <<= 1) v += __shfl_xor(v, o);
  return v;
}
DI float silu_f(float x) { return x / (1.f + __expf(-x)); }
DI float sigmoid_f(float x) { return 1.f / (1.f + __expf(-x)); }
DI float gelu_f(float x) { float z = 0.7978845608028654f * (x + 0.044715f * x * x * x); return x / (1.f + __expf(-2.f * z)); }
DI int crow(int i, int h) { return (i & 3) + 8 * (i >> 2) + 4 * h; }
DI const float* xrow(const Params& p, int T) { return T < NCTX ? p.in[0] + (size_t)T * 1024 : p.in[1] + (size_t)(T - NCTX) * 1024; }
DI int cond_of(int T) { return T < NCTX ? 0 : 1 + ((T - NCTX) >> 11); }

template <int BN, bool D2 = false, class AL, class BL, class EP>
DI void gemm_tile(int nk, bool swp, AL al, BL bl, EP ep, unsigned char* smem) {
  constexpr int NI = BN / 64;
  constexpr int NB = BN / 32;
  constexpr int STG = (128 + BN) * 72;
  unsigned short* S0 = (unsigned short*)smem;
  const int tid = threadIdx.x, lane = tid & 63, wave = tid >> 6, l32 = lane & 31, h = lane >> 5;
  const int wm = wave >> 1, wn = wave & 1;
  const int xoff = (swp ? 128 * 72 + (wn * 64 + l32) * 72 : (wm * 64 + l32) * 72) + h * 8;
  const int yoff = (swp ? (wm * 64 + l32) * 72 : 128 * 72 + (wn * (BN / 2) + l32) * 72) + h * 8;
  f32x16 acc[2][NI];
#pragma unroll
  for (int mi = 0; mi < 2; ++mi)
#pragma unroll
    for (int ni = 0; ni < NI; ++ni)
#pragma unroll
      for (int i = 0; i < 16; ++i) acc[mi][ni][i] = 0.f;
  uint4 ra[2][4], rb[2][NB];
  const int lrow = tid >> 3, lcol = (tid & 7) * 8;
  al.init(lrow, lcol); bl.init(lrow, lcol);
  int nxt = 0;
  auto gload = [&](uint4 (&a4)[4], uint4 (&b4)[NB]) {
#pragma unroll
    for (int i = 0; i < 4; ++i) a4[i] = al.load(i);
#pragma unroll
    for (int i = 0; i < NB; ++i) b4[i] = bl.load(i);
    const int adv = (nxt + 1 < nk) ? 1 : 0;
    al.advance(adv); bl.advance(adv); nxt += adv;
  };
  auto lstore = [&](const uint4 (&a4)[4], const uint4 (&b4)[NB], unsigned short* st) {
#pragma unroll
    for (int i = 0; i < 4; ++i) *(uint4*)(st + (lrow + 32 * i) * 72 + lcol) = a4[i];
#pragma unroll
    for (int i = 0; i < NB; ++i) *(uint4*)(st + 128 * 72 + (lrow + 32 * i) * 72 + lcol) = b4[i];
  };
  auto compute = [&](const unsigned short* st) {
#pragma unroll
    for (int ks = 0; ks < 4; ++ks) {
      bf16x8 x[2], y[NI];
#pragma unroll
      for (int mi = 0; mi < 2; ++mi) x[mi] = *(const bf16x8*)(st + xoff + mi * 32 * 72 + ks * 16);
#pragma unroll
      for (int ni = 0; ni < NI; ++ni) y[ni] = *(const bf16x8*)(st + yoff + ni * 32 * 72 + ks * 16);
#pragma unroll
      for (int mi = 0; mi < 2; ++mi)
#pragma unroll
        for (int ni = 0; ni < NI; ++ni) acc[mi][ni] = MFMA32(x[mi], y[ni], acc[mi][ni]);
    }
  };
  if constexpr (D2) {
    gload(ra[0], rb[0]);
    gload(ra[1], rb[1]);
    __syncthreads();
    lstore(ra[0], rb[0], S0);
    gload(ra[0], rb[0]);
    __syncthreads();
    for (int kt = 0; kt < nk; kt += 2) {
      compute(S0);
      lstore(ra[1], rb[1], S0 + STG);
      gload(ra[1], rb[1]);
      __syncthreads();
      compute(S0 + STG);
      if (kt + 2 < nk) lstore(ra[0], rb[0], S0);
      gload(ra[0], rb[0]);
      __syncthreads();
    }
  } else {
    gload(ra[0], rb[0]);
    __syncthreads();
    lstore(ra[0], rb[0], S0);
    gload(ra[0], rb[0]);
    __syncthreads();
    for (int kt = 0; kt < nk; kt += 2) {
      compute(S0);
      lstore(ra[0], rb[0], S0 + STG);
      gload(ra[0], rb[0]);
      __syncthreads();
      compute(S0 + STG);
      if (kt + 2 < nk) lstore(ra[0], rb[0], S0);
      gload(ra[0], rb[0]);
      __syncthreads();
    }
  }
  ep(acc);
}

template <int BN> struct GStage { uint4 ra[2][4]; uint4 rb[2][BN / 32]; int nxt; };
template <int BN, class AL, class BL, class EP, class NX>
DI bool gemm_tile_pf(int nk, bool swp, bool first, AL& al, BL& bl, GStage<BN>& st, EP ep, NX next_tile, unsigned char* smem) {
  constexpr int NI = BN / 64;
  constexpr int NB = BN / 32;
  constexpr int STG = (128 + BN) * 72;
  unsigned short* S0 = (unsigned short*)smem;
  const int tid = threadIdx.x, lane = tid & 63, wave = tid >> 6, l32 = lane & 31, h = lane >> 5;
  const int wm = wave >> 1, wn = wave & 1;
  const int xoff = (swp ? 128 * 72 + (wn * 64 + l32) * 72 : (wm * 64 + l32) * 72) + h * 8;
  const int yoff = (swp ? (wm * 64 + l32) * 72 : 128 * 72 + (wn * (BN / 2) + l32) * 72) + h * 8;
  f32x16 acc[2][NI];
#pragma unroll
  for (int mi = 0; mi < 2; ++mi)
#pragma unroll
    for (int ni = 0; ni < NI; ++ni)
#pragma unroll
      for (int i = 0; i < 16; ++i) acc[mi][ni][i] = 0.f;
  const int lrow = tid >> 3, lcol = (tid & 7) * 8;
  auto gload = [&](uint4 (&a4)[4], uint4 (&b4)[NB]) {
#pragma unroll
    for (int i = 0; i < 4; ++i) a4[i] = al.load(i);
#pragma unroll
    for (int i = 0; i < NB; ++i) b4[i] = bl.load(i);
    const int adv = (st.nxt + 1 < nk) ? 1 : 0;
    al.advance(adv); bl.advance(adv); st.nxt += adv;
  };
  auto lstore = [&](const uint4 (&a4)[4], const uint4 (&b4)[NB], unsigned short* sp) {
#pragma unroll
    for (int i = 0; i < 4; ++i) *(uint4*)(sp + (lrow + 32 * i) * 72 + lcol) = a4[i];
#pragma unroll
    for (int i = 0; i < NB; ++i) *(uint4*)(sp + 128 * 72 + (lrow + 32 * i) * 72 + lcol) = b4[i];
  };
  auto compute = [&](const unsigned short* sp) {
#pragma unroll
    for (int ks = 0; ks < 4; ++ks) {
      bf16x8 x[2], y[NI];
#pragma unroll
      for (int mi = 0; mi < 2; ++mi) x[mi] = *(const bf16x8*)(sp + xoff + mi * 32 * 72 + ks * 16);
#pragma unroll
      for (int ni = 0; ni < NI; ++ni) y[ni] = *(const bf16x8*)(sp + yoff + ni * 32 * 72 + ks * 16);
#pragma unroll
      for (int mi = 0; mi < 2; ++mi)
#pragma unroll
        for (int ni = 0; ni < NI; ++ni) acc[mi][ni] = MFMA32(x[mi], y[ni], acc[mi][ni]);
    }
  };
  if (first) {
    al.init(lrow, lcol); bl.init(lrow, lcol); st.nxt = 0;
    gload(st.ra[0], st.rb[0]);
    gload(st.ra[1], st.rb[1]);
  }
  __syncthreads();
  lstore(st.ra[0], st.rb[0], S0);
  gload(st.ra[0], st.rb[0]);
  __syncthreads();
  for (int kt = 0; kt < nk; kt += 2) {
    compute(S0);
    lstore(st.ra[1], st.rb[1], S0 + STG);
    gload(st.ra[1], st.rb[1]);
    __syncthreads();
    compute(S0 + STG);
    if (kt + 2 < nk) lstore(st.ra[0], st.rb[0], S0);
    gload(st.ra[0], st.rb[0]);
    __syncthreads();
  }
  const bool more = next_tile();
  if (more) {
    al.init(lrow, lcol); bl.init(lrow, lcol); st.nxt = 0;
    gload(st.ra[0], st.rb[0]);
    gload(st.ra[1], st.rb[1]);
  }
  ep(acc);
  return more;
}

DI bool xcd_tile(int step, int ntn, int& tm, int& tn) {
  const int G = gridDim.x;
  if ((G & 7) == 0) {
    const int x = blockIdx.x & 7, loc = blockIdx.x >> 3, per = G >> 3;
    const int j = loc + step * per;
    if (j >= 12 * ntn) return false;
    tn = j / 12; tm = 12 * x + j % 12;
    return true;
  }
  const int it = blockIdx.x + step * G;
  if (it >= 96 * ntn) return false;
  tm = it / ntn; tn = it % ntn;
  return true;
}

#define GAS __attribute__((address_space(1)))
typedef unsigned u32x4 __attribute__((ext_vector_type(4)));
DI uint4 gld16(const GAS char* q) { const u32x4 v = *(const GAS u32x4*)q; return make_uint4(v.x, v.y, v.z, v.w); }
struct LdBf {
  const bfr* base; size_t ld;
  const GAS char* p[4];
  DI void init(int lrow, int lcol) {
#pragma unroll
    for (int i = 0; i < 4; ++i) { p[i] = (const GAS char*)(base + (size_t)(lrow + 32 * i) * ld + lcol); asm volatile("" : "+v"(p[i])); }
  }
  DI uint4 load(int i) const { return gld16(p[i]); }
  DI void advance(int adv) {
#pragma unroll
    for (int i = 0; i < 4; ++i) p[i] += 128 * adv;
  }
};
#define XB_TMO      128
#define XB_XCNT(j)  (256  + 64 * (j))
#define XB_XSUB(j)  (1280 + 64 * (j))
#define XB_XGEN(j)  (2304 + 64 * (j))
#define XB_TOP      3328
#define XB_TOPGEN   3392
#define XCD_BAR_WORDS 3456
#define XB_SPIN_CAP (1u << 20)
#define LAS __attribute__((address_space(3)))
DI unsigned xb_ld(unsigned* p)              { return __hip_atomic_load(p, __ATOMIC_RELAXED, __HIP_MEMORY_SCOPE_AGENT); }
DI unsigned xb_add(unsigned* p, unsigned v) { return __hip_atomic_fetch_add(p, v, __ATOMIC_RELAXED, __HIP_MEMORY_SCOPE_AGENT); }
DI unsigned xb_xcc_id() { return (unsigned)__builtin_amdgcn_s_getreg((3 << 11) | 20) & 0xFu; }
#define XB_SPIN(cond, bar) do { unsigned _sp = 0; while (cond) { __builtin_amdgcn_s_sleep(1); \
    if ((++_sp & 255u) == 0u) { if (xb_ld(&(bar)[XB_TMO])) break; if (_sp > XB_SPIN_CAP) { atomicAdd(&(bar)[XB_TMO], 1u); break; } } } } while (0)
struct XcdBarrier { unsigned* bar; unsigned x; volatile LAS unsigned* st; };
DI XcdBarrier xcd_barrier_post(unsigned* bar, volatile LAS unsigned* st) {
  XcdBarrier b; b.bar = bar; b.x = xb_xcc_id(); b.st = st;
  if (threadIdx.x == 0) (void)xb_add(&bar[XB_XCNT(b.x)], 1u);
  return b;
}
DI void xcd_barrier_complete(unsigned* bar, unsigned x, unsigned& nloc, unsigned& nx) {
  const unsigned G = gridDim.x * gridDim.y * gridDim.z;
  unsigned sum, cnt, mine, sp = 0u;
  for (;;) {
    sum = 0u; cnt = 0u; mine = 0u;
#pragma unroll
    for (unsigned j = 0; j < 16; ++j) { const unsigned c = xb_ld(&bar[XB_XCNT(j)]); sum += c; cnt += (c > 0u) ? 1u : 0u; mine = (j == x) ? c : mine; }
    if (sum == G) break;
    __builtin_amdgcn_s_sleep(1);
    if ((++sp & 255u) == 0u) { if (xb_ld(&bar[XB_TMO])) break; if (sp > XB_SPIN_CAP) { atomicAdd(&bar[XB_TMO], 1u); break; } }
  }
  nloc = mine > 0u ? mine : 1u; nx = cnt > 0u ? cnt : 1u;
}
DI void xcd_barrier(const XcdBarrier& b) {
  asm volatile("s_waitcnt vmcnt(0)" ::: "memory");
  __syncthreads();
  if (threadIdx.x == 0) {
    unsigned* bar = b.bar;
    __builtin_amdgcn_s_waitcnt(0);
    unsigned nloc = b.st[0], nx = b.st[1];
    if (nloc == 0u) { xcd_barrier_complete(bar, b.x, nloc, nx); b.st[0] = nloc; b.st[1] = nx; }
    const unsigned old = xb_add(&bar[XB_XSUB(b.x)], 1u);
    const unsigned gen = old / nloc;
    if (old + 1u == (gen + 1u) * nloc) {
      __builtin_amdgcn_fence(__ATOMIC_RELEASE, "agent");
      asm volatile("s_waitcnt vmcnt(0)" ::: "memory");
      const unsigned og = xb_add(&bar[XB_TOP], 1u);
      const unsigned tg = og / nx;
      if (og + 1u == (tg + 1u) * nx) xb_add(&bar[XB_TOPGEN], 1u);
      else XB_SPIN(xb_ld(&bar[XB_TOPGEN]) == tg, bar);
      __builtin_amdgcn_fence(__ATOMIC_ACQUIRE, "agent");
      xb_add(&bar[XB_XGEN(b.x)], 1u);
      asm volatile("s_waitcnt vmcnt(0)" ::: "memory");
    } else {
      XB_SPIN(xb_ld(&bar[XB_XGEN(b.x)]) == gen, bar);
      __builtin_amdgcn_fence(__ATOMIC_ACQUIRE, "agent");
      asm volatile("s_waitcnt vmcnt(0)" ::: "memory");
    }
  }
  __syncthreads();
}

struct LdFz {
  const bfr* pz;
  const GAS char* p[4];
  DI void init(int lrow, int lcol) {
#pragma unroll
    for (int i = 0; i < 4; ++i) { p[i] = (const GAS char*)(pz + (size_t)(lrow + 32 * i) * 512 + lcol); asm volatile("" : "+v"(p[i])); }
  }
  DI void advance(int adv) {
#pragma unroll
    for (int i = 0; i < 4; ++i) p[i] += 128 * adv;
  }
  DI uint4 load(int i) const {
    const GAS char* q = p[i];
    const uint4 a = gld16(q), b = gld16(q + (size_t)4096 * 512 * 2), c = gld16(q + (size_t)2 * 4096 * 512 * 2), d = gld16(q + (size_t)3 * 4096 * 512 * 2);
#define SUM4(f) pk2(bf2f(a.f & 0xffff) + bf2f(b.f & 0xffff) + bf2f(c.f & 0xffff) + bf2f(d.f & 0xffff), bf2f(a.f >> 16) + bf2f(b.f >> 16) + bf2f(c.f >> 16) + bf2f(d.f >> 16))
    return make_uint4(SUM4(x), SUM4(y), SUM4(z), SUM4(w));
#undef SUM4
  }
};

DI void transpose_tile(const float* W, int ldw, int kbase, int nbase, bfr* WT, int ldt, int trow, float* sm) {
  const int tid = threadIdx.x;
#pragma unroll
  for (int i = 0; i < 4; ++i) {
    const int r = (tid >> 4) + 16 * i, c = (tid & 15) * 4;
    const float4 v = *(const float4*)(W + (size_t)(kbase + r) * ldw + nbase + c);
    sm[r * 65 + c] = v.x; sm[r * 65 + c + 1] = v.y; sm[r * 65 + c + 2] = v.z; sm[r * 65 + c + 3] = v.w;
  }
  __syncthreads();
  const int n = tid >> 2, kc = (tid & 3) * 16;
  unsigned o[8];
#pragma unroll
  for (int j = 0; j < 8; ++j) o[j] = pk2(sm[(kc + 2 * j) * 65 + n], sm[(kc + 2 * j + 1) * 65 + n]);
  uint4* dst = (uint4*)(WT + (size_t)(trow + n) * ldt + kbase + kc);
  dst[0] = make_uint4(o[0], o[1], o[2], o[3]);
  dst[1] = make_uint4(o[4], o[5], o[6], o[7]);
}

DI void phase0(const Params& p, unsigned char* smem) {
  const int tid = threadIdx.x;
  float* smf = (float*)smem;
  unsigned char* ws = p.ws;
  constexpr int N_ADA = 192;
  constexpr int N_T0 = 16 * 36, N_TG = 64, N_TO0 = 256, N_T1A = 16 * 24, N_T1B = 16 * 8, N_TF = 64, N_TO1 = 256;
  constexpr int N_FOLD = 128, N_ALAT = 2048, N_ACTX = 256, N_CACHE = 64, N_SSM = 64, N_ZERO = 48, N_ROPE = 4;
  constexpr int B_T0 = N_ADA, B_TG = B_T0 + N_T0, B_TO0 = B_TG + N_TG, B_T1A = B_TO0 + N_TO0, B_T1B = B_T1A + N_T1A,
                B_TF = B_T1B + N_T1B, B_TO1 = B_TF + N_TF, B_FOLD = B_TO1 + N_TO1, B_ALAT = B_FOLD + N_FOLD,
                B_ACTX = B_ALAT + N_ALAT, B_CACHE = B_ACTX + N_ACTX, B_SSM = B_CACHE + N_CACHE, B_ZERO = B_SSM + N_SSM,
                B_ROPE = B_ZERO + N_ZERO, N_ALL = B_ROPE + N_ROPE;
  for (int it = blockIdx.x; it < N_ALL; it += gridDim.x) {
    __syncthreads();
    if (it < B_T0) {
      const int l = it / 96, cgp = it % 96;
      float* sc = smf;
      float* red = smf + 3072;
      for (int e = tid; e < 3072; e += 256) {
        const int ci = e >> 10, k = e & 1023;
        const float cv = ci == 0 ? p.in[6][k] : p.in[5][(ci - 1) * 1024 + k];
        sc[e] = silu_f(cv);
      }
      __syncthreads();
      const int cq = tid & 7, rg = tid >> 3;
      const float* w = p.in[7] + (size_t)l * 1024 * 3072 + cgp * 32 + cq * 4;
      float4 a0 = make_float4(0.f, 0.f, 0.f, 0.f), a1 = a0, a2 = a0;
#pragma unroll 16
      for (int k = rg; k < 1024; k += 32) {
        const float4 wv = *(const float4*)(w + (size_t)k * 3072);
        const float s0 = sc[k], s1 = sc[1024 + k], s2 = sc[2048 + k];
        a0.x += s0 * wv.x; a0.y += s0 * wv.y; a0.z += s0 * wv.z; a0.w += s0 * wv.w;
        a1.x += s1 * wv.x; a1.y += s1 * wv.y; a1.z += s1 * wv.z; a1.w += s1 * wv.w;
        a2.x += s2 * wv.x; a2.y += s2 * wv.y; a2.z += s2 * wv.z; a2.w += s2 * wv.w;
      }
      *(float4*)(red + (0 * 32 + rg) * 32 + cq * 4) = a0;
      *(float4*)(red + (1 * 32 + rg) * 32 + cq * 4) = a1;
      *(float4*)(red + (2 * 32 + rg) * 32 + cq * 4) = a2;
      __syncthreads();
      if (tid < 96) {
        const int c2 = tid & 31, ci = tid >> 5;
        float s = 0.f;
#pragma unroll
        for (int q = 0; q < 32; ++q) s += red[(ci * 32 + q) * 32 + c2];
        const int n2 = cgp * 32 + c2;
        ((float*)(ws + OFF_MOD))[(l * 3 + ci) * 3072 + n2] = s + p.in[8][l * 3072 + n2];
      }
    } else if (it < B_FOLD) {
      const float* W; int ldw, nbase_off = 0, trow_off = 0, ntn, ldt; bfr* WT; int r;
      if (it < B_TG)        { r = it - B_T0;  W = p.in[11]; ldw = 2304; ntn = 36; WT = (bfr*)(ws + OFF_WIN0); ldt = 1024; }
      else if (it < B_TO0)  { r = it - B_TG;  W = p.in[22]; ldw = 512;  ntn = 8;  WT = (bfr*)(ws + OFF_GLU); ldt = 512; }
      else if (it < B_T1A)  { r = it - B_TO0; W = p.in[24]; ldw = 1024; ntn = 16; WT = (bfr*)(ws + OFF_WOUT0); ldt = 1024; }
      else if (it < B_T1B)  { r = it - B_T1A; W = p.in[25]; ldw = 2560; ntn = 24; WT = (bfr*)(ws + OFF_WIN1); ldt = 1024; }
      else if (it < B_TF)   { r = it - B_T1B; W = p.in[25]; ldw = 2560; ntn = 8;  WT = (bfr*)(ws + OFF_WIN1); ldt = 1024; nbase_off = 2048; trow_off = 2560; }
      else if (it < B_TO1)  { r = it - B_TF;  W = p.in[29]; ldw = 512;  ntn = 8;  WT = (bfr*)(ws + OFF_FNET); ldt = 512; }
      else                  { r = it - B_TO1; W = p.in[30]; ldw = 1024; ntn = 16; WT = (bfr*)(ws + OFF_WOUT1); ldt = 1024; }
      const int kb = r / ntn, nb = r % ntn;
      transpose_tile(W, ldw, kb * 64, nbase_off + nb * 64, WT, ldt, trow_off + nb * 64, smf);
    } else if (it < B_ALAT) {
      const int r = it - B_FOLD, cs = r & 1, kb = (r >> 1) & 15, g = r >> 5;
      float* tile = smf;
      float* tw = smf + 128 * 68;
      const float* W = p.in[25];
      {
        const int c4 = (tid & 31) * 4, kr = tid >> 5;
#pragma unroll
        for (int i = 0; i < 8; ++i) {
          const int k = kr + 8 * i;
          const float4 v = *(const float4*)(W + (size_t)(kb * 64 + k) * 2560 + 1536 + g * 128 + c4);
          tile[(c4 + 0) * 68 + k] = v.x; tile[(c4 + 1) * 68 + k] = v.y; tile[(c4 + 2) * 68 + k] = v.z; tile[(c4 + 3) * 68 + k] = v.w;
        }
        if (tid < 128) {
          const float a = 2.f * (float)tid / 128.f;
          tw[tid] = (cs == 0 ? cospif(a) : sinpif(a)) * 0.08838834764831845f;
        }
      }
      __syncthreads();
      const int j = tid & 127, kg = tid >> 7;
      float acc[32];
#pragma unroll
      for (int i = 0; i < 32; ++i) acc[i] = 0.f;
      for (int c = 0; c < 128; ++c) {
        const float t = tw[(j * c) & 127];
        const float4* tp = (const float4*)(tile + c * 68 + kg * 32);
#pragma unroll
        for (int q = 0; q < 8; ++q) {
          const float4 v = tp[q];
          acc[4 * q + 0] += v.x * t; acc[4 * q + 1] += v.y * t; acc[4 * q + 2] += v.z * t; acc[4 * q + 3] += v.w * t;
        }
      }
      uint4* dst = (uint4*)((bfr*)(ws + OFF_WIN1) + (size_t)(1536 + cs * 512 + g * 128 + j) * 1024 + kb * 64 + kg * 32);
#pragma unroll
      for (int q = 0; q < 4; ++q)
        dst[q] = make_uint4(pk2(acc[8 * q], acc[8 * q + 1]), pk2(acc[8 * q + 2], acc[8 * q + 3]), pk2(acc[8 * q + 4], acc[8 * q + 5]), pk2(acc[8 * q + 6], acc[8 * q + 7]));
    } else if (it < B_ACTX) {
      const int t = it - B_ALAT;
      bfr* dst = (bfr*)(ws + OFF_ALAT) + (size_t)t * 4096;
      const float nrm = 0.02209708691207961f;
#pragma unroll
      for (int half = 0; half < 2; ++half) {
        const int k0 = half * 2048 + tid * 8;
        unsigned o[4];
#pragma unroll
        for (int j = 0; j < 4; ++j) {
          float v[2];
#pragma unroll
          for (int e = 0; e < 2; ++e) {
            const int k = k0 + 2 * j + e;
            const int m = (t * (k & 2047)) & 2047;
            const float a = (float)m * (2.f / 2048.f);
            v[e] = (k < 2048 ? cospif(a) : -sinpif(a)) * nrm;
          }
          o[j] = pk2(v[0], v[1]);
        }
        *(uint4*)(dst + k0) = make_uint4(o[0], o[1], o[2], o[3]);
      }
    } else if (it < B_CACHE) {
      const int t = it - B_ACTX;
      bfr* dst = (bfr*)(ws + OFF_ACTX) + (size_t)t * 512;
      const float nrm = 0.0625f;
      float v[2];
#pragma unroll
      for (int e = 0; e < 2; ++e) {
        const int k = tid * 2 + e;
        const int m = (t * (k & 255)) & 255;
        const float a = (float)m * (2.f / 256.f);
        v[e] = (k < 256 ? cospif(a) : -sinpif(a)) * nrm;
      }
      *(unsigned*)(dst + tid * 2) = pk2(v[0], v[1]);
    } else if (it < B_SSM) {
      const int r = it - B_CACHE;
#pragma unroll
      for (int i = 0; i < 8; ++i) {
        const int e = r * 2048 + tid + 256 * i;
        const int d = e & 63, kvh = (e >> 6) & 1, key = (e >> 7) & 511, b = e >> 16;
        ((bfr*)(ws + OFF_KL))[((size_t)(b * 2 + kvh) * 2560 + key) * 64 + d] = f2bf(p.in[2][e]);
        ((bfr*)(ws + OFF_VL))[((size_t)(b * 2 + kvh) * 64 + d) * 2560 + key] = f2bf(p.in[3][e]);
      }
    } else if (it < B_ZERO) {
      const int dg = it - B_SSM;
      const int pp = tid & 63, part = tid >> 6;
      const double lr = (double)p.in[14][dg * 64 + pp], li = (double)p.in[15][dg * 64 + pp];
      const double dt = (double)__expf(p.in[16][dg]) ;
      const float dtf = expf(p.in[16][dg]);
      const double dtd = (double)dtf;
      (void)dt;
      const double PI = 3.14159265358979323846;
      double ap = li * dtd / PI;
      double ar = ap - 2.0 * rint(ap * 0.5);
      const float er = expf((float)(lr * dtd));
      const double lbr = (double)er * (double)cospif((float)ar), lbi = (double)er * (double)sinpif((float)ar);
      double ap2 = ap * 256.0;
      double ar2 = ap2 - 2.0 * rint(ap2 * 0.5);
      const float er2 = expf((float)(lr * dtd * 256.0));
      if (part == 0) {
        ((float2*)(ws + OFF_LAMB))[dg * 64 + pp] = make_float2((float)lbr, (float)lbi);
        ((float2*)(ws + OFF_LAMP))[dg * 64 + pp] = make_float2(er2 * cospif((float)ar2), er2 * sinpif((float)ar2));
      }
      const double den = lr * lr + li * li;
      const double fr = ((lbr - 1.0) * lr + lbi * li) / den, fi = (lbi * lr - (lbr - 1.0) * li) / den;
      float* bb = (float*)(ws + OFF_BB) + (size_t)(dg * 64 + pp) * 32;
#pragma unroll
      for (int q = 0; q < 4; ++q) {
        const int c = part * 4 + q;
        const double br = (double)p.in[17][(size_t)(dg * 64 + pp) * 16 + c], bi = (double)p.in[18][(size_t)(dg * 64 + pp) * 16 + c];
        bb[c] = (float)(fr * br - fi * bi);
        bb[16 + c] = (float)(fr * bi + fi * br);
      }
      bfr* cm = (bfr*)(ws + OFF_CMB) + (size_t)dg * 2048;
#pragma unroll
      for (int q = 0; q < 8; ++q) {
        const int e = tid * 8 + q, c = e >> 7, k = e & 127;
        const float v = k < 64 ? p.in[19][(size_t)(dg * 16 + c) * 64 + k] : -p.in[20][(size_t)(dg * 16 + c) * 64 + (k - 64)];
        cm[e] = f2bf(v);
      }
    } else if (it < B_ROPE) {
      const int r = it - B_ZERO;
      ((float*)(ws + OFF_ROWSS))[r * 256 + tid] = 0.f;
    } else {
      const int e = (it - B_ROPE) * 256 + tid;
      const int n = e >> 4, pr = e & 15;
      const double q4[4] = {1.0, 0.5623413251903491, 0.31622776601683794, 0.1778279410038923};
      double inv = q4[0];
      if ((pr & 3) == 1) inv = q4[1]; else if ((pr & 3) == 2) inv = q4[2]; else if ((pr & 3) == 3) inv = q4[3];
      const int dec = pr >> 2;
      if (dec == 1) inv *= 0.1; else if (dec == 2) inv *= 0.01; else if (dec == 3) inv *= 0.001;
      const double ap = (double)n * inv / 3.14159265358979323846;
      const double ar = ap - 2.0 * rint(ap * 0.5);
      ((float2*)(ws + OFF_ROPE))[e] = make_float2(cospif((float)ar), sinpif((float)ar));
    }
  }
}

template <int MODE>
DI void phase_rows(const Params& p) {
  unsigned char* ws = p.ws;
  const int lane = threadIdx.x & 63, wave = threadIdx.x >> 6;
  const float* mod = (const float*)(ws + OFF_MOD);
  for (int it = blockIdx.x; it < NTOK / 4; it += gridDim.x) {
    const int T = it * 4 + wave;
    const int ci = cond_of(T);
    float4 xv[4];
    if (MODE == 2) {
      const bfr* xr = (const bfr*)(ws + OFF_X1) + (size_t)T * 1024 + lane * 4;
#pragma unroll
      for (int j = 0; j < 4; ++j) {
        const uint2 raw = *(const uint2*)(xr + 256 * j);
        xv[j].x = bf2f(raw.x & 0xffff); xv[j].y = bf2f(raw.x >> 16); xv[j].z = bf2f(raw.y & 0xffff); xv[j].w = bf2f(raw.y >> 16);
      }
    } else {
      const float4* xr = (const float4*)xrow(p, T) + lane;
#pragma unroll
      for (int j = 0; j < 4; ++j) xv[j] = xr[64 * j];
    }
    if (MODE >= 1) {
      const int l = MODE - 1;
      const bfr* orow = (const bfr*)(ws + OFF_O) + (size_t)T * 1024;
      float4 ov[4]; float ss = 0.f;
#pragma unroll
      for (int j = 0; j < 4; ++j) {
        const uint2 raw = *(const uint2*)(orow + lane * 4 + 256 * j);
        ov[j].x = bf2f(raw.x & 0xffff); ov[j].y = bf2f(raw.x >> 16); ov[j].z = bf2f(raw.y & 0xffff); ov[j].w = bf2f(raw.y >> 16);
        ss += ov[j].x * ov[j].x + ov[j].y * ov[j].y + ov[j].z * ov[j].z + ov[j].w * ov[j].w;
      }
      const float rinv = rsqrtf(wave_sum(ss) * (1.f / 1024.f) + EPS);
      const float* gate = mod + (l * 3 + ci) * 3072 + 2048;
      const float* gp = p.in[10] + l * 1024;
#pragma unroll
      for (int j = 0; j < 4; ++j) {
        const int k = lane * 4 + 256 * j;
        const float4 g4 = *(const float4*)(gate + k), n4 = *(const float4*)(gp + k);
        xv[j].x += g4.x * (ov[j].x * rinv * n4.x); xv[j].y += g4.y * (ov[j].y * rinv * n4.y);
        xv[j].z += g4.z * (ov[j].z * rinv * n4.z); xv[j].w += g4.w * (ov[j].w * rinv * n4.w);
      }
      if (MODE == 2) {
        float4* yr = (float4*)(p.out + OUT_Y + (size_t)T * 1024) + lane;
#pragma unroll
        for (int j = 0; j < 4; ++j) yr[64 * j] = xv[j];
      } else {
        bfr* x1r = (bfr*)(ws + OFF_X1) + (size_t)T * 1024 + lane * 4;
#pragma unroll
        for (int j = 0; j < 4; ++j) *(uint2*)(x1r + 256 * j) = make_uint2(pk2(xv[j].x, xv[j].y), pk2(xv[j].z, xv[j].w));
      }
    }
    if (MODE <= 1) {
      const int l = MODE;
      float ss = 0.f;
#pragma unroll
      for (int j = 0; j < 4; ++j) ss += xv[j].x * xv[j].x + xv[j].y * xv[j].y + xv[j].z * xv[j].z + xv[j].w * xv[j].w;
      const float rinv = rsqrtf(wave_sum(ss) * (1.f / 1024.f) + EPS);
      const float* shift = mod + (l * 3 + ci) * 3072;
      const float* scale = shift + 1024;
      const float* gp = p.in[9] + l * 1024;
      bfr* hr = (bfr*)(ws + OFF_HN) + (size_t)T * 1024;
#pragma unroll
      for (int j = 0; j < 4; ++j) {
        const int k = lane * 4 + 256 * j;
        const float4 s4 = *(const float4*)(shift + k), c4 = *(const float4*)(scale + k), n4 = *(const float4*)(gp + k);
        const float a = xv[j].x * rinv * n4.x * (1.f + c4.x) + s4.x;
        const float b = xv[j].y * rinv * n4.y * (1.f + c4.y) + s4.y;
        const float c = xv[j].z * rinv * n4.z * (1.f + c4.z) + s4.z;
        const float d = xv[j].w * rinv * n4.w * (1.f + c4.w) + s4.w;
        *(uint2*)(hr + k) = make_uint2(pk2(a, b), pk2(c, d));
      }
    }
  }
}

DI void phase_win0(const Params& p, unsigned char* smem) {
  unsigned char* ws = p.ws;
  const int lane = threadIdx.x & 63, wave = threadIdx.x >> 6, l32 = lane & 31, h = lane >> 5, wm = wave >> 1, wn = wave & 1;
  const bfr* A = (const bfr*)(ws + OFF_HN);
  const bfr* Bt = (const bfr*)(ws + OFF_WIN0);
  int tm, tn;
  if (!xcd_tile(0, 18, tm, tn)) return;
  LdBf al{A + (size_t)tm * 128 * 1024, 1024}, bl{Bt + (size_t)tn * 128 * 1024, 1024};
  for (int step = 0;; ++step) {
    const int m0 = tm * 128, n0 = tn * 128;
    int tm2 = 0, tn2 = 0;
    auto next_tile = [&]() {
      if (!xcd_tile(step + 1, 18, tm2, tn2)) return false;
      al.base = A + (size_t)tm2 * 128 * 1024; bl.base = Bt + (size_t)tn2 * 128 * 1024;
      return true;
    };
    auto ep = [&](f32x16 (&acc)[2][2]) {
      const int colbase = n0 + wn * 64, rbase = m0 + wm * 64;
      const bool lat = m0 >= NCTX;
      if (tn == 5) {
        const int hd = (colbase - 640) >> 6;
#pragma unroll
        for (int mi = 0; mi < 2; ++mi)
#pragma unroll
          for (int ni = 0; ni < 2; ++ni) {
            const int d = ni * 32 + l32;
#pragma unroll
            for (int i4 = 0; i4 < 4; ++i4) {
              const int r0 = rbase + mi * 32 + 8 * i4 + 4 * h;
              const float a = acc[mi][ni][4 * i4], b2 = acc[mi][ni][4 * i4 + 1], c = acc[mi][ni][4 * i4 + 2], e = acc[mi][ni][4 * i4 + 3];
              const uint2 pk = make_uint2(pk2(a, b2), pk2(c, e));
              if (!lat) {
                p.out[OUT_V + (size_t)(r0 + 0) * 128 + hd * 64 + d] = a;
                p.out[OUT_V + (size_t)(r0 + 1) * 128 + hd * 64 + d] = b2;
                p.out[OUT_V + (size_t)(r0 + 2) * 128 + hd * 64 + d] = c;
                p.out[OUT_V + (size_t)(r0 + 3) * 128 + hd * 64 + d] = e;
                const int b = r0 >> 8, l = r0 & 255;
                *(uint2*)((bfr*)(ws + OFF_VC) + ((size_t)(b * 2 + hd) * 64 + d) * 256 + l) = pk;
              } else {
                const int b = (r0 - NCTX) >> 11, l = (r0 - NCTX) & 2047;
                *(uint2*)((bfr*)(ws + OFF_VL) + ((size_t)(b * 2 + hd) * 64 + d) * 2560 + 512 + l) = pk;
              }
            }
          }
      } else if (colbase < 640) {
        const bool isq = colbase < 512;
        const float* gain = isq ? p.in[12] : p.in[13];
        const int hd = isq ? (colbase >> 6) : ((colbase - 512) >> 6);
        float4 gv[2][4];
#pragma unroll
        for (int mi = 0; mi < 2; ++mi)
#pragma unroll
          for (int i4 = 0; i4 < 4; ++i4) gv[mi][i4] = *(const float4*)(gain + mi * 32 + 8 * i4 + 4 * h);
#pragma unroll
        for (int ni = 0; ni < 2; ++ni) {
          const int T = rbase + ni * 32 + l32;
          float ss = 0.f;
#pragma unroll
          for (int mi = 0; mi < 2; ++mi)
#pragma unroll
            for (int i = 0; i < 16; ++i) ss += acc[mi][ni][i] * acc[mi][ni][i];
          ss += __shfl_xor(ss, 32);
          const float rinv = rsqrtf(ss * (1.f / 64.f) + EPS);
          float v[2][16];
#pragma unroll
          for (int mi = 0; mi < 2; ++mi)
#pragma unroll
            for (int i4 = 0; i4 < 4; ++i4) {
              v[mi][4 * i4 + 0] = acc[mi][ni][4 * i4 + 0] * rinv * gv[mi][i4].x;
              v[mi][4 * i4 + 1] = acc[mi][ni][4 * i4 + 1] * rinv * gv[mi][i4].y;
              v[mi][4 * i4 + 2] = acc[mi][ni][4 * i4 + 2] * rinv * gv[mi][i4].z;
              v[mi][4 * i4 + 3] = acc[mi][ni][4 * i4 + 3] * rinv * gv[mi][i4].w;
            }
          if (!lat && !isq) {
#pragma unroll
            for (int mi = 0; mi < 2; ++mi)
#pragma unroll
              for (int i4 = 0; i4 < 4; ++i4)
                *(float4*)(p.out + OUT_K + (size_t)T * 128 + hd * 64 + mi * 32 + 8 * i4 + 4 * h) = make_float4(v[mi][4 * i4], v[mi][4 * i4 + 1], v[mi][4 * i4 + 2], v[mi][4 * i4 + 3]);
          }
          if (lat) {
            const int pos = (T - NCTX) & 2047;
            const float* rope = (const float*)(ws + OFF_ROPE);
#pragma unroll
            for (int mi = 0; mi < 2; ++mi) {
              const float* rb = rope + ((mi == 0 ? (pos >> 6) : (pos & 63)) * 16 + 4 * h) * 2;
#pragma unroll
              for (int i4 = 0; i4 < 2; ++i4) {
                const float4 cs0 = *(const float4*)(rb + 16 * i4), cs1 = *(const float4*)(rb + 16 * i4 + 4);
                const float cc[4] = {cs0.x, cs0.z, cs1.x, cs1.z}, sn[4] = {cs0.y, cs0.w, cs1.y, cs1.w};
#pragma unroll
                for (int e = 0; e < 4; ++e) {
                  const float x1 = v[mi][4 * i4 + e], x2 = v[mi][4 * i4 + e + 8];
                  v[mi][4 * i4 + e] = x1 * cc[e] - x2 * sn[e];
                  v[mi][4 * i4 + e + 8] = x1 * sn[e] + x2 * cc[e];
                }
              }
            }
          }
          bfr* dst;
          float sc = 1.f;
          if (isq) { dst = (bfr*)(ws + OFF_QB) + (size_t)T * 512 + hd * 64; sc = 0.125f; }
          else if (!lat) { dst = (bfr*)(ws + OFF_KC) + ((size_t)((T >> 8) * 2 + hd) * 256 + (T & 255)) * 64; }
          else { dst = (bfr*)(ws + OFF_KL) + ((size_t)(((T - NCTX) >> 11) * 2 + hd) * 2560 + 512 + ((T - NCTX) & 2047)) * 64; }
#pragma unroll
          for (int mi = 0; mi < 2; ++mi)
#pragma unroll
            for (int i4 = 0; i4 < 4; ++i4)
              *(uint2*)(dst + mi * 32 + 8 * i4 + 4 * h) = make_uint2(pk2(v[mi][4 * i4] * sc, v[mi][4 * i4 + 1] * sc), pk2(v[mi][4 * i4 + 2] * sc, v[mi][4 * i4 + 3] * sc));
        }
      } else {
        const int sec = colbase < 1280 ? 0 : (colbase < 1792 ? 1 : 2);
        const int cb = colbase - (sec == 0 ? 768 : (sec == 1 ? 1280 : 1792));
        if (sec == 1) {
          float* stf = (float*)smem;
#pragma unroll
          for (int ni = 0; ni < 2; ++ni) {
            const int row = wm * 64 + ni * 32 + l32;
#pragma unroll
            for (int mi = 0; mi < 2; ++mi)
#pragma unroll
              for (int i4 = 0; i4 < 4; ++i4)
                *(float4*)(stf + row * 132 + wn * 64 + mi * 32 + 8 * i4 + 4 * h) =
                    make_float4(acc[mi][ni][4 * i4], acc[mi][ni][4 * i4 + 1], acc[mi][ni][4 * i4 + 2], acc[mi][ni][4 * i4 + 3]);
          }
          __syncthreads();
          float* dbase = (float*)(ws + OFF_U) + (size_t)m0 * 512 + (n0 - 1280);
#pragma unroll 4
          for (int i = 0; i < 16; ++i) {
            const int id = threadIdx.x + 256 * i, r = id >> 5, c4 = id & 31;
            *(float4*)(dbase + (size_t)r * 512 + c4 * 4) = *(const float4*)(stf + r * 132 + c4 * 4);
          }
        } else {
          unsigned short* stg = (unsigned short*)smem;
#pragma unroll
          for (int ni = 0; ni < 2; ++ni) {
            const int row = wm * 64 + ni * 32 + l32;
#pragma unroll
            for (int mi = 0; mi < 2; ++mi)
#pragma unroll
              for (int i4 = 0; i4 < 4; ++i4) {
                const float a = acc[mi][ni][4 * i4], b2 = acc[mi][ni][4 * i4 + 1], c2 = acc[mi][ni][4 * i4 + 2], e = acc[mi][ni][4 * i4 + 3];
                *(uint2*)(stg + row * 136 + wn * 64 + mi * 32 + 8 * i4 + 4 * h) = make_uint2(pk2(silu_f(a), silu_f(b2)), pk2(silu_f(c2), silu_f(e)));
              }
          }
          __syncthreads();
          bfr* dbase = (bfr*)(ws + (sec == 0 ? OFF_GA : OFF_GB)) + (size_t)m0 * 512 + (n0 - (sec == 0 ? 768 : 1792));
#pragma unroll
          for (int i = 0; i < 8; ++i) {
            const int id = threadIdx.x + 256 * i, r = id >> 4, c16 = id & 15;
            *(uint4*)(dbase + (size_t)r * 512 + c16 * 8) = *(const uint4*)(stg + r * 136 + c16 * 8);
          }
        }
      }
    };
    al.base = A + (size_t)m0 * 1024; bl.base = Bt + (size_t)n0 * 1024;
    gemm_tile<128>(16, tn != 5, al, bl, ep, smem);
    if (!next_tile()) break;
    tm = tm2; tn = tn2;
  }
}

DI void attn_item(const Params& p, unsigned char* smem, int it) {
  unsigned char* ws = p.ws;
  const int tid = threadIdx.x, lane = tid & 63, wave = tid >> 6, l32 = lane & 31, h = lane >> 5;
  int T0, nkeys, ldv; const bfr *Kp, *Vp; int kvh;
  if (it < 256) {
    const int b = it >> 7, qt = it & 63; kvh = (it >> 6) & 1;
    T0 = NCTX + b * 2048 + qt * 32; nkeys = 2560; ldv = 2560;
    Kp = (const bfr*)(ws + OFF_KL) + (size_t)(b * 2 + kvh) * 2560 * 64;
    Vp = (const bfr*)(ws + OFF_VL) + (size_t)(b * 2 + kvh) * 64 * 2560;
  } else {
    const int i2 = it - 256; const int b = i2 >> 4, qt = i2 & 7; kvh = (i2 >> 3) & 1;
    T0 = b * 256 + qt * 32; nkeys = 256; ldv = 256;
    Kp = (const bfr*)(ws + OFF_KC) + (size_t)(b * 2 + kvh) * 256 * 64;
    Vp = (const bfr*)(ws + OFF_VC) + (size_t)(b * 2 + kvh) * 64 * 256;
  }
  const int head = kvh * 4 + wave;
  unsigned short* Ks = (unsigned short*)smem;
  unsigned short* Vs = Ks + 64 * 72;
  bf16x8 qf[4];
  {
    const bfr* q = (const bfr*)(ws + OFF_QB) + (size_t)(T0 + l32) * 512 + head * 64 + 8 * h;
#pragma unroll
    for (int ks = 0; ks < 4; ++ks) qf[ks] = *(const bf16x8*)(q + 16 * ks);
  }
  float m = -1e30f, lsum = 0.f;
  f32x16 O[2];
#pragma unroll
  for (int i = 0; i < 16; ++i) { O[0][i] = 0.f; O[1][i] = 0.f; }
  const int rr0 = tid >> 3, cc0 = (tid & 7) * 8;
  const bfr* kp0 = Kp + (size_t)rr0 * 64 + cc0;
  const bfr* vp0 = Vp + (size_t)rr0 * ldv + cc0;
  uint4 kreg0 = *(const uint4*)kp0, kreg1 = *(const uint4*)(kp0 + 32 * 64);
  uint4 vreg0 = *(const uint4*)vp0, vreg1 = *(const uint4*)(vp0 + (size_t)32 * ldv);
  for (int k0 = 0; k0 < nkeys; k0 += 64) {
    __syncthreads();
    *(uint4*)(Ks + rr0 * 72 + cc0) = kreg0; *(uint4*)(Ks + (rr0 + 32) * 72 + cc0) = kreg1;
    *(uint4*)(Vs + rr0 * 72 + cc0) = vreg0; *(uint4*)(Vs + (rr0 + 32) * 72 + cc0) = vreg1;
    __syncthreads();
    if (k0 + 64 < nkeys) {
      kreg0 = *(const uint4*)(kp0 + (size_t)(k0 + 64) * 64); kreg1 = *(const uint4*)(kp0 + (size_t)(k0 + 96) * 64);
      vreg0 = *(const uint4*)(vp0 + k0 + 64); vreg1 = *(const uint4*)(vp0 + (size_t)32 * ldv + k0 + 64);
    }
    f32x16 st[2];
#pragma unroll
    for (int kt = 0; kt < 2; ++kt) {
#pragma unroll
      for (int i = 0; i < 16; ++i) st[kt][i] = 0.f;
#pragma unroll
      for (int ks = 0; ks < 4; ++ks) {
        const bf16x8 a = *(const bf16x8*)(Ks + (32 * kt + l32) * 72 + 16 * ks + 8 * h);
        st[kt] = MFMA32(a, qf[ks], st[kt]);
      }
    }
    float mx = st[0][0];
#pragma unroll
    for (int i = 0; i < 16; ++i) { mx = fmaxf(mx, st[0][i]); mx = fmaxf(mx, st[1][i]); }
    mx = fmaxf(mx, __shfl_xor(mx, 32));
    const float mn = fmaxf(m, mx);
    const float alpha = __expf(m - mn);
    m = mn;
    float ps = 0.f;
#pragma unroll
    for (int kt = 0; kt < 2; ++kt)
#pragma unroll
      for (int i = 0; i < 16; ++i) { const float e = __expf(st[kt][i] - mn); st[kt][i] = e; ps += e; }
    lsum = lsum * alpha + ps;
#pragma unroll
    for (int i = 0; i < 16; ++i) { O[0][i] *= alpha; O[1][i] *= alpha; }
#pragma unroll
    for (int kt = 0; kt < 2; ++kt)
#pragma unroll
      for (int s = 0; s < 2; ++s) {
        const uint4 pu = make_uint4(pk2(st[kt][8 * s], st[kt][8 * s + 1]), pk2(st[kt][8 * s + 2], st[kt][8 * s + 3]),
                                    pk2(st[kt][8 * s + 4], st[kt][8 * s + 5]), pk2(st[kt][8 * s + 6], st[kt][8 * s + 7]));
        const bf16x8 pf = __builtin_bit_cast(bf16x8, pu);
#pragma unroll
        for (int dt = 0; dt < 2; ++dt) {
          const unsigned short* vr = Vs + (32 * dt + l32) * 72 + 32 * kt + 16 * s + 4 * h;
          const s16x4 lo = *(const s16x4*)vr, hi = *(const s16x4*)(vr + 8);
          const bf16x8 va = __builtin_shufflevector(lo, hi, 0, 1, 2, 3, 4, 5, 6, 7);
          O[dt] = MFMA32(va, pf, O[dt]);
        }
      }
  }
  const float ltot = lsum + __shfl_xor(lsum, 32);
  const float inv = 1.f / ltot;
  const int T = T0 + l32;
#pragma unroll
  for (int dt = 0; dt < 2; ++dt)
#pragma unroll
    for (int i4 = 0; i4 < 4; ++i4) {
      const int d = 32 * dt + 8 * i4 + 4 * h;
      const uint2 g = *(const uint2*)((const bfr*)(ws + OFF_GA) + (size_t)T * 512 + head * 64 + d);
      const float a = O[dt][4 * i4] * inv * bf2f(g.x & 0xffff), b = O[dt][4 * i4 + 1] * inv * bf2f(g.x >> 16);
      const float c = O[dt][4 * i4 + 2] * inv * bf2f(g.y & 0xffff), e = O[dt][4 * i4 + 3] * inv * bf2f(g.y >> 16);
      *(uint2*)((bfr*)(ws + OFF_MIX) + (size_t)T * 1024 + head * 64 + d) = make_uint2(pk2(a, b), pk2(c, e));
    }
}

DI void attn_lat_item(const Params& p, unsigned char* smem, int it) {
  unsigned char* ws = p.ws;
  const int tid = threadIdx.x, lane = tid & 63, wave = tid >> 6, l32 = lane & 31, h = lane >> 5;
  const int b = it >> 8, kvh = (it >> 7) & 1, qt = (it >> 1) & 63, hp = it & 1;
  const int hw = wave & 1, kh = wave >> 1;
  const int T0 = NCTX + b * 2048 + qt * 32;
  const int head = kvh * 4 + hp * 2 + hw;
  const bfr* Kp = (const bfr*)(ws + OFF_KL) + ((size_t)(b * 2 + kvh) * 2560 + kh * 1280) * 64;
  const bfr* Vp = (const bfr*)(ws + OFF_VL) + (size_t)(b * 2 + kvh) * 64 * 2560 + kh * 1280;
  unsigned short* Ks = (unsigned short*)smem + kh * (2 * 64 * 72);
  unsigned short* Vs = Ks + 64 * 72;
  bf16x8 qf[4];
  {
    const bfr* q = (const bfr*)(ws + OFF_QB) + (size_t)(T0 + l32) * 512 + head * 64 + 8 * h;
#pragma unroll
    for (int ks = 0; ks < 4; ++ks) qf[ks] = *(const bf16x8*)(q + 16 * ks);
  }
  float m = -1e30f, lsum = 0.f;
  f32x16 O[2];
#pragma unroll
  for (int i = 0; i < 16; ++i) { O[0][i] = 0.f; O[1][i] = 0.f; }
  const int t2 = tid & 127, rr0 = t2 >> 3, cc0 = (t2 & 7) * 8;
  const bfr* kp0 = Kp + (size_t)rr0 * 64 + cc0;
  const bfr* vp0 = Vp + (size_t)rr0 * 2560 + cc0;
  uint4 kr0 = *(const uint4*)kp0, kr1 = *(const uint4*)(kp0 + 16 * 64), kr2 = *(const uint4*)(kp0 + 32 * 64), kr3 = *(const uint4*)(kp0 + 48 * 64);
  uint4 vr0 = *(const uint4*)vp0, vr1 = *(const uint4*)(vp0 + (size_t)16 * 2560), vr2 = *(const uint4*)(vp0 + (size_t)32 * 2560), vr3 = *(const uint4*)(vp0 + (size_t)48 * 2560);
  for (int k0 = 0; k0 < 1280; k0 += 64) {
    __syncthreads();
    *(uint4*)(Ks + rr0 * 72 + cc0) = kr0; *(uint4*)(Ks + (rr0 + 16) * 72 + cc0) = kr1; *(uint4*)(Ks + (rr0 + 32) * 72 + cc0) = kr2; *(uint4*)(Ks + (rr0 + 48) * 72 + cc0) = kr3;
    {
      unsigned short* v0 = Vs + rr0 * 68 + cc0;
      *(uint2*)(v0) = make_uint2(vr0.x, vr0.y); *(uint2*)(v0 + 4) = make_uint2(vr0.z, vr0.w);
      *(uint2*)(v0 + 16 * 68) = make_uint2(vr1.x, vr1.y); *(uint2*)(v0 + 16 * 68 + 4) = make_uint2(vr1.z, vr1.w);
      *(uint2*)(v0 + 32 * 68) = make_uint2(vr2.x, vr2.y); *(uint2*)(v0 + 32 * 68 + 4) = make_uint2(vr2.z, vr2.w);
      *(uint2*)(v0 + 48 * 68) = make_uint2(vr3.x, vr3.y); *(uint2*)(v0 + 48 * 68 + 4) = make_uint2(vr3.z, vr3.w);
    }
    __syncthreads();
    if (k0 + 64 < 1280) {
      const bfr* kq = kp0 + (size_t)(k0 + 64) * 64; const bfr* vq = vp0 + k0 + 64;
      kr0 = *(const uint4*)kq; kr1 = *(const uint4*)(kq + 16 * 64); kr2 = *(const uint4*)(kq + 32 * 64); kr3 = *(const uint4*)(kq + 48 * 64);
      vr0 = *(const uint4*)vq; vr1 = *(const uint4*)(vq + (size_t)16 * 2560); vr2 = *(const uint4*)(vq + (size_t)32 * 2560); vr3 = *(const uint4*)(vq + (size_t)48 * 2560);
    }
    f32x16 st[2];
#pragma unroll
    for (int kt = 0; kt < 2; ++kt) {
#pragma unroll
      for (int i = 0; i < 16; ++i) st[kt][i] = 0.f;
#pragma unroll
      for (int ks = 0; ks < 4; ++ks) {
        const bf16x8 a = *(const bf16x8*)(Ks + (32 * kt + l32) * 72 + 16 * ks + 8 * h);
        st[kt] = MFMA32(a, qf[ks], st[kt]);
      }
    }
    float mx = st[0][0];
#pragma unroll
    for (int i = 0; i < 16; ++i) { mx = fmaxf(mx, st[0][i]); mx = fmaxf(mx, st[1][i]); }
    mx = fmaxf(mx, __shfl_xor(mx, 32));
    const float mn = fmaxf(m, mx);
    const float alpha = __expf(m - mn);
    m = mn;
    float ps = 0.f;
#pragma unroll
    for (int kt = 0; kt < 2; ++kt)
#pragma unroll
      for (int i = 0; i < 16; ++i) { const float e = __expf(st[kt][i] - mn); st[kt][i] = e; ps += e; }
    lsum = lsum * alpha + ps;
#pragma unroll
    for (int i = 0; i < 16; ++i) { O[0][i] *= alpha; O[1][i] *= alpha; }
#pragma unroll
    for (int kt = 0; kt < 2; ++kt)
#pragma unroll
      for (int s = 0; s < 2; ++s) {
        const uint4 pu = make_uint4(pk2(st[kt][8 * s], st[kt][8 * s + 1]), pk2(st[kt][8 * s + 2], st[kt][8 * s + 3]),
                                    pk2(st[kt][8 * s + 4], st[kt][8 * s + 5]), pk2(st[kt][8 * s + 6], st[kt][8 * s + 7]));
        const bf16x8 pf = __builtin_bit_cast(bf16x8, pu);
#pragma unroll
        for (int dt = 0; dt < 2; ++dt) {
          const unsigned short* vr = Vs + (32 * dt + l32) * 68 + 32 * kt + 16 * s + 4 * h;
          const s16x4 lo = *(const s16x4*)vr, hi = *(const s16x4*)(vr + 8);
          const bf16x8 va = __builtin_shufflevector(lo, hi, 0, 1, 2, 3, 4, 5, 6, 7);
          O[dt] = MFMA32(va, pf, O[dt]);
        }
      }
  }
  float ltot = lsum + __shfl_xor(lsum, 32);
  float* xb = (float*)smem + (hw * 64 + lane) * 36;
  __syncthreads();
  if (kh == 1) {
#pragma unroll
    for (int i = 0; i < 16; ++i) { xb[i] = O[0][i]; xb[16 + i] = O[1][i]; }
    xb[32] = m; xb[33] = ltot;
  }
  __syncthreads();
  if (kh == 0) {
    const float m2 = xb[32], l2 = xb[33];
    const float mm = fmaxf(m, m2), a1 = __expf(m - mm), a2 = __expf(m2 - mm);
    ltot = ltot * a1 + l2 * a2;
    const float inv = 1.f / ltot;
#pragma unroll
    for (int i = 0; i < 16; ++i) { O[0][i] = (O[0][i] * a1 + xb[i] * a2) * inv; O[1][i] = (O[1][i] * a1 + xb[16 + i] * a2) * inv; }
    const int T = T0 + l32;
#pragma unroll
    for (int dt = 0; dt < 2; ++dt)
#pragma unroll
      for (int i4 = 0; i4 < 4; ++i4) {
        const int d = 32 * dt + 8 * i4 + 4 * h;
        const uint2 g = *(const uint2*)((const bfr*)(ws + OFF_GA) + (size_t)T * 512 + head * 64 + d);
        const float a = O[dt][4 * i4] * bf2f(g.x & 0xffff), bq = O[dt][4 * i4 + 1] * bf2f(g.x >> 16);
        const float c = O[dt][4 * i4 + 2] * bf2f(g.y & 0xffff), e = O[dt][4 * i4 + 3] * bf2f(g.y >> 16);
        *(uint2*)((bfr*)(ws + OFF_MIX) + (size_t)T * 1024 + head * 64 + d) = make_uint2(pk2(a, bq), pk2(c, e));
      }
  }
}

DI int seg_T0(int seg) { return seg < 32 ? seg * 256 : NCTX + ((seg - 32) >> 3) * 2048 + ((seg - 32) & 7) * 256; }

DI void split_bf16(const float4& v0, const float4& v1, bf16x8& hi, bf16x8& lo) {
  const unsigned h0 = pk2(v0.x, v0.y), h1 = pk2(v0.z, v0.w), h2 = pk2(v1.x, v1.y), h3 = pk2(v1.z, v1.w);
  hi = __builtin_bit_cast(bf16x8, make_uint4(h0, h1, h2, h3));
  const unsigned l0 = pk2(v0.x - bf2f(h0 & 0xffff), v0.y - bf2f(h0 >> 16)), l1 = pk2(v0.z - bf2f(h1 & 0xffff), v0.w - bf2f(h1 >> 16));
  const unsigned l2 = pk2(v1.x - bf2f(h2 & 0xffff), v1.y - bf2f(h2 >> 16)), l3 = pk2(v1.z - bf2f(h3 & 0xffff), v1.w - bf2f(h3 >> 16));
  lo = __builtin_bit_cast(bf16x8, make_uint4(l0, l1, l2, l3));
}

DI void s5_wave(const Params& p, float* BU  , int it) {
  unsigned char* ws = p.ws;
  const int lane = threadIdx.x & 63, l32 = lane & 31, h = lane >> 5;
  const int di = it & 1, g = (it >> 1) & 31, seg = it >> 6;
  const int T0 = seg_T0(seg);
  const int dg = di * 32 + g;
  bf16x8 bhi[4], blo[4];
#pragma unroll
  for (int nt = 0; nt < 4; ++nt) {
    const float* bb = (const float*)(ws + OFF_BB) + (size_t)(dg * 64 + (nt & 1) * 32 + l32) * 32 + (nt >> 1) * 16 + 8 * h;
    split_bf16(*(const float4*)bb, *(const float4*)(bb + 4), bhi[nt], blo[nt]);
  }
  const float2 lam = ((const float2*)(ws + OFF_LAMB))[dg * 64 + lane];
  bf16x8 cmf[4];
  {
    const bfr* cm = (const bfr*)(ws + OFF_CMB) + (size_t)dg * 2048 + (lane & 15) * 128 + 8 * (lane >> 4);
#pragma unroll
    for (int ks = 0; ks < 4; ++ks) cmf[ks] = *(const bf16x8*)(cm + 32 * ks);
  }
  float hr = 0.f, hi = 0.f;
  bfr* yout = (bfr*)(ws + (di == 0 ? OFF_YF : OFF_YB));
  const float* ubase = (const float*)(ws + OFF_U) + g * 16 + 8 * h;
  float4 u0, u1;
  { const int T = di == 0 ? T0 + l32 : T0 + 255 - l32; const float* up = ubase + (size_t)T * 512; u0 = *(const float4*)up; u1 = *(const float4*)(up + 4); }
  for (int c = 0; c < 8; ++c) {
    bf16x8 ahi, alo;
    split_bf16(u0, u1, ahi, alo);
    if (c < 7) { const int sg = 32 * (c + 1) + l32; const int T = di == 0 ? T0 + sg : T0 + 255 - sg; const float* up = ubase + (size_t)T * 512; u0 = *(const float4*)up; u1 = *(const float4*)(up + 4); }
#pragma unroll
    for (int nt = 0; nt < 4; ++nt) {
      f32x16 acc;
#pragma unroll
      for (int i = 0; i < 16; ++i) acc[i] = 0.f;
      acc = MFMA32(ahi, bhi[nt], acc);
      acc = MFMA32(alo, bhi[nt], acc);
      acc = MFMA32(ahi, blo[nt], acc);
#pragma unroll
      for (int i = 0; i < 16; ++i) BU[crow(i, h) * 132 + 32 * nt + l32] = acc[i];
    }
    WAVE_SYNC();
#pragma unroll 8
    for (int sl = 0; sl < 32; ++sl) {
      const float br = BU[sl * 132 + lane], bi = BU[sl * 132 + 64 + lane];
      const float nr = lam.x * hr - lam.y * hi + br;
      const float ni = lam.x * hi + lam.y * hr + bi;
      hr = nr; hi = ni;
      BU[sl * 132 + lane] = hr; BU[sl * 132 + 64 + lane] = hi;
    }
    WAVE_SYNC();
#pragma unroll
    for (int tt = 0; tt < 2; ++tt) {
      f32x4 acc = {0.f, 0.f, 0.f, 0.f};
      const float* hrow = BU + (16 * tt + (lane & 15)) * 132 + 8 * (lane >> 4);
#pragma unroll
      for (int ks = 0; ks < 4; ++ks) {
        const float4 v0 = *(const float4*)(hrow + 32 * ks), v1 = *(const float4*)(hrow + 32 * ks + 4);
        const bf16x8 a = __builtin_bit_cast(bf16x8, make_uint4(pk2(v0.x, v0.y), pk2(v0.z, v0.w), pk2(v1.x, v1.y), pk2(v1.z, v1.w)));
        acc = MFMA16(a, cmf[ks], acc);
      }
#pragma unroll
      for (int i = 0; i < 4; ++i) {
        const int sg = 32 * c + 16 * tt + 4 * (lane >> 4) + i;
        const int T = di == 0 ? T0 + sg : T0 + 255 - sg;
        yout[(size_t)T * 512 + g * 16 + (lane & 15)] = f2bf(acc[i]);
      }
    }
    WAVE_SYNC();
  }
  ((float2*)(ws + OFF_E))[((size_t)(seg * 2 + di) * 32 + g) * 64 + lane] = make_float2(hr, hi);
  if (seg < 32) {
    float* so = p.out + OUT_S + (size_t)((seg * 2 + di) * 2) * 2048 + g * 64 + lane;
    so[0] = hr; so[2048] = hi;
  }
}

DI void phase_mix0(const Params& p, unsigned char* smem) {
  constexpr int N_S5 = 3072;
  const int b = blockIdx.x, G = gridDim.x, wave = threadIdx.x >> 6;
  float* BUw = (float*)smem + wave * (32 * 132);
  if (G == 512) {
    attn_lat_item(p, smem, b);
    __syncthreads();
    if (b < 256) { for (int r = 0; r < 2; ++r) s5_wave(p, BUw, b * 8 + r * 4 + wave); }
    else s5_wave(p, BUw, 2048 + (b - 256) * 4 + wave);
    __syncthreads();
    attn_item(p, smem, 256 + b);
  } else {
    for (int it = b * 4 + wave; it < N_S5; it += G * 4) s5_wave(p, BUw, it);
    for (int it = b; it < 512; it += G) { __syncthreads(); attn_lat_item(p, smem, it); }
    for (int it = b; it < 512; it += G) { __syncthreads(); attn_item(p, smem, 256 + it); }
  }
}

DI void phase_s5fix(const Params& p, unsigned char* smem) {
  unsigned char* ws = p.ws;
  const int tid = threadIdx.x, lane = tid & 63, wave = tid >> 6;
  float* ycorr = (float*)smem;
  float* HC = (float*)smem + 4096 + wave * (16 * 132);
  for (int it = blockIdx.x; it < 48 * 32; it += gridDim.x) {
    const int g = it & 31, seg = it >> 5;
    const int T0 = seg_T0(seg);
    __syncthreads();
    if (seg >= 32) {
      for (int e = tid; e < 4096; e += 256) ycorr[e] = 0.f;
      __syncthreads();
      const int b = (seg - 32) >> 3, j = (seg - 32) & 7;
      const int di = wave & 1, half = wave >> 1;
      const int dg = di * 32 + g;
      const float2 lam = ((const float2*)(ws + OFF_LAMB))[dg * 64 + lane];
      const float2 lp = ((const float2*)(ws + OFF_LAMP))[dg * 64 + lane];
      const float* st = p.in[4] + (size_t)((b * 2 + di) * 2) * 2048 + g * 64 + lane;
      float hr = st[0], hi = st[2048];
      const int nprev = di == 0 ? j : 7 - j;
      float2 ev[7];
#pragma unroll
      for (int q = 0; q < 7; ++q) {
        const int jj = di == 0 ? q : 7 - q;
        ev[q] = ((const float2*)(ws + OFF_E))[((size_t)((32 + b * 8 + jj) * 2 + di) * 32 + g) * 64 + lane];
      }
#pragma unroll
      for (int q = 0; q < 7; ++q) {
        if (q < nprev) {
          const float nr = lp.x * hr - lp.y * hi + ev[q].x, ni = lp.x * hi + lp.y * hr + ev[q].y;
          hr = nr; hi = ni;
        }
      }
      float cr = lam.x, cim = lam.y;
      if (half) {
        float sr = lam.x, si = lam.y;
#pragma unroll
        for (int q = 0; q < 7; ++q) { const float t = sr * sr - si * si; si = 2.f * sr * si; sr = t; }
        cr = sr * lam.x - si * lam.y; cim = sr * lam.y + si * lam.x;
      }
      bf16x8 cmf[4];
      {
        const bfr* cm = (const bfr*)(ws + OFF_CMB) + (size_t)dg * 2048 + (lane & 15) * 128 + 8 * (lane >> 4);
#pragma unroll
        for (int ks = 0; ks < 4; ++ks) cmf[ks] = *(const bf16x8*)(cm + 32 * ks);
      }
      for (int c = 0; c < 8; ++c) {
#pragma unroll 8
        for (int sl = 0; sl < 16; ++sl) {
          HC[sl * 132 + lane] = cr * hr - cim * hi;
          HC[sl * 132 + 64 + lane] = cr * hi + cim * hr;
          const float nr = cr * lam.x - cim * lam.y, ni = cr * lam.y + cim * lam.x;
          cr = nr; cim = ni;
        }
        WAVE_SYNC();
        f32x4 acc = {0.f, 0.f, 0.f, 0.f};
        const float* hrow = HC + (lane & 15) * 132 + 8 * (lane >> 4);
#pragma unroll
        for (int ks = 0; ks < 4; ++ks) {
          const float4 v0 = *(const float4*)(hrow + 32 * ks), v1 = *(const float4*)(hrow + 32 * ks + 4);
          const bf16x8 a = __builtin_bit_cast(bf16x8, make_uint4(pk2(v0.x, v0.y), pk2(v0.z, v0.w), pk2(v1.x, v1.y), pk2(v1.z, v1.w)));
          acc = MFMA16(a, cmf[ks], acc);
        }
#pragma unroll
        for (int i = 0; i < 4; ++i) {
          const int sg = 128 * half + 16 * c + 4 * (lane >> 4) + i;
          const int tl = di == 0 ? sg : 255 - sg;
          atomicAdd(&ycorr[tl * 16 + (lane & 15)], acc[i]);
        }
        WAVE_SYNC();
      }
      __syncthreads();
    }
    {
      const int c4 = (tid & 3) * 4;
      const float4 d4 = *(const float4*)(p.in[21] + g * 16 + c4);
      float4 uv[4]; uint2 fv[4], bv[4];
#pragma unroll
      for (int ps = 0; ps < 4; ++ps) {
        const int T = T0 + ps * 64 + (tid >> 2);
        uv[ps] = *(const float4*)((const float*)(ws + OFF_U) + (size_t)T * 512 + g * 16 + c4);
        fv[ps] = *(const uint2*)((const bfr*)(ws + OFF_YF) + (size_t)T * 512 + g * 16 + c4);
        bv[ps] = *(const uint2*)((const bfr*)(ws + OFF_YB) + (size_t)T * 512 + g * 16 + c4);
      }
#pragma unroll
      for (int ps = 0; ps < 4; ++ps) {
        const int tl = ps * 64 + (tid >> 2);
        float4 yc = make_float4(0.f, 0.f, 0.f, 0.f);
        if (seg >= 32) yc = *(const float4*)(ycorr + tl * 16 + c4);
        const float y0 = gelu_f(uv[ps].x * d4.x + bf2f(fv[ps].x & 0xffff) + bf2f(bv[ps].x & 0xffff) + yc.x);
        const float y1 = gelu_f(uv[ps].y * d4.y + bf2f(fv[ps].x >> 16) + bf2f(bv[ps].x >> 16) + yc.y);
        const float y2 = gelu_f(uv[ps].z * d4.z + bf2f(fv[ps].y & 0xffff) + bf2f(bv[ps].y & 0xffff) + yc.z);
        const float y3 = gelu_f(uv[ps].w * d4.w + bf2f(fv[ps].y >> 16) + bf2f(bv[ps].y >> 16) + yc.w);
        *(uint2*)((bfr*)(ws + OFF_YG) + (size_t)(T0 + tl) * 512 + g * 16 + c4) = make_uint2(pk2(y0, y1), pk2(y2, y3));
      }
    }
  }
}

template <int MODE>
DI void phase_tokgemm(const Params& p, unsigned char* smem, int layer) {
  unsigned char* ws = p.ws;
  const int lane = threadIdx.x & 63, wave = threadIdx.x >> 6, l32 = lane & 31, h = lane >> 5, wm = wave >> 1, wn = wave & 1;
  constexpr int K = MODE == 1 ? 1024 : 512, N = MODE == 1 ? 1024 : 512;
  const bfr* A = (const bfr*)(ws + (MODE == 0 ? OFF_YG : (MODE == 1 ? OFF_MIX : OFF_FZ)));
  const bfr* Bt = (const bfr*)(ws + (MODE == 0 ? OFF_GLU : (MODE == 1 ? (layer == 0 ? OFF_WOUT0 : OFF_WOUT1) : OFF_FNET)));
  constexpr int TN = N / 128;
  int tm, tn;
  if (!xcd_tile(0, TN, tm, tn)) return;
  LdBf alp{A + (size_t)tm * 128 * K, (size_t)K}, bl{Bt + (size_t)tn * 128 * K, (size_t)K};
  for (int step = 0;; ++step) {
    const int m0 = tm * 128, n0 = tn * 128;
    int tm2 = 0, tn2 = 0;
    auto next_tile = [&]() {
      if (!xcd_tile(step + 1, TN, tm2, tn2)) return false;
      alp.base = A + (size_t)tm2 * 128 * K; bl.base = Bt + (size_t)tn2 * 128 * K;
      return true;
    };
    auto ep_direct = [&](f32x16 (&acc)[2][2]) {
#pragma unroll
      for (int ni = 0; ni < 2; ++ni) {
        const int T = m0 + wm * 64 + ni * 32 + l32;
#pragma unroll
        for (int mi = 0; mi < 2; ++mi)
#pragma unroll
          for (int i4 = 0; i4 < 4; ++i4) {
            const int n = n0 + wn * 64 + mi * 32 + 8 * i4 + 4 * h;
            float a = acc[mi][ni][4 * i4], b2 = acc[mi][ni][4 * i4 + 1], c2 = acc[mi][ni][4 * i4 + 2], e = acc[mi][ni][4 * i4 + 3];
            if (MODE == 0) {
              const uint2 y = *(const uint2*)((const bfr*)(ws + OFF_YG) + (size_t)T * 512 + n);
              const uint2 gb = *(const uint2*)((const bfr*)(ws + OFF_GB) + (size_t)T * 512 + n);
              const float4 bs = *(const float4*)(p.in[23] + n);
              a = bf2f(y.x & 0xffff) * sigmoid_f(a + bs.x) * bf2f(gb.x & 0xffff);
              b2 = bf2f(y.x >> 16) * sigmoid_f(b2 + bs.y) * bf2f(gb.x >> 16);
              c2 = bf2f(y.y & 0xffff) * sigmoid_f(c2 + bs.z) * bf2f(gb.y & 0xffff);
              e = bf2f(y.y >> 16) * sigmoid_f(e + bs.w) * bf2f(gb.y >> 16);
              *(uint2*)((bfr*)(ws + OFF_MIX) + (size_t)T * 1024 + 512 + n) = make_uint2(pk2(a, b2), pk2(c2, e));
            } else if (MODE == 1) {
              *(uint2*)((bfr*)(ws + OFF_O) + (size_t)T * 1024 + n) = make_uint2(pk2(a, b2), pk2(c2, e));
            } else {
              const uint2 gd = *(const uint2*)((const bfr*)(ws + OFF_GDS) + (size_t)T * 512 + n);
              a *= bf2f(gd.x & 0xffff); b2 *= bf2f(gd.x >> 16); c2 *= bf2f(gd.y & 0xffff); e *= bf2f(gd.y >> 16);
              *(uint2*)((bfr*)(ws + OFF_MIX) + (size_t)T * 1024 + 512 + n) = make_uint2(pk2(a, b2), pk2(c2, e));
            }
          }
      }
    };
    auto ep_staged = [&](f32x16 (&acc)[2][2]) {
      unsigned short* stg = (unsigned short*)smem;
#pragma unroll
      for (int ni = 0; ni < 2; ++ni) {
        const int row = wm * 64 + ni * 32 + l32;
        const int T = m0 + row;
#pragma unroll
        for (int mi = 0; mi < 2; ++mi)
#pragma unroll
          for (int i4 = 0; i4 < 4; ++i4) {
            const int cl = wn * 64 + mi * 32 + 8 * i4 + 4 * h;
            const int n = n0 + cl;
            float a = acc[mi][ni][4 * i4], b2 = acc[mi][ni][4 * i4 + 1], c2 = acc[mi][ni][4 * i4 + 2], e = acc[mi][ni][4 * i4 + 3];
            if (MODE == 0) {
              const uint2 y = *(const uint2*)((const bfr*)(ws + OFF_YG) + (size_t)T * 512 + n);
              const uint2 gb = *(const uint2*)((const bfr*)(ws + OFF_GB) + (size_t)T * 512 + n);
              const float4 bs = *(const float4*)(p.in[23] + n);
              a = bf2f(y.x & 0xffff) * sigmoid_f(a + bs.x) * bf2f(gb.x & 0xffff);
              b2 = bf2f(y.x >> 16) * sigmoid_f(b2 + bs.y) * bf2f(gb.x >> 16);
              c2 = bf2f(y.y & 0xffff) * sigmoid_f(c2 + bs.z) * bf2f(gb.y & 0xffff);
              e = bf2f(y.y >> 16) * sigmoid_f(e + bs.w) * bf2f(gb.y >> 16);
            } else if (MODE == 2) {
              const uint2 gd = *(const uint2*)((const bfr*)(ws + OFF_GDS) + (size_t)T * 512 + n);
              a *= bf2f(gd.x & 0xffff); b2 *= bf2f(gd.x >> 16); c2 *= bf2f(gd.y & 0xffff); e *= bf2f(gd.y >> 16);
            }
            *(uint2*)(stg + row * 136 + cl) = make_uint2(pk2(a, b2), pk2(c2, e));
          }
      }
      __syncthreads();
      bfr* dbase = MODE == 1 ? (bfr*)(ws + OFF_O) + (size_t)m0 * 1024 + n0 : (bfr*)(ws + OFF_MIX) + (size_t)m0 * 1024 + 512 + n0;
#pragma unroll
      for (int i = 0; i < 8; ++i) {
        const int id = threadIdx.x + 256 * i, r = id >> 4, c16 = id & 15;
        *(uint4*)(dbase + (size_t)r * 1024 + c16 * 8) = *(const uint4*)(stg + r * 136 + c16 * 8);
      }
    };
    auto ep = [&](f32x16 (&acc)[2][2]) { if constexpr (MODE == 1) ep_staged(acc); else ep_direct(acc); };
    if constexpr (MODE == 2) {
      bl.base = Bt + (size_t)n0 * K;
      if (m0 < NCTX) {
        LdBf al{A + (size_t)m0 * K, (size_t)K};
        gemm_tile<128>(K / 64, true, al, bl, ep, smem);
      } else {
        LdFz al{(const bfr*)(ws + OFF_HN) + (size_t)(m0 - NCTX) * 512};
        gemm_tile<128, false>(K / 64, true, al, bl, ep, smem);
      }
      if (!next_tile()) break;
    } else {
      alp.base = A + (size_t)m0 * K; bl.base = Bt + (size_t)n0 * K;
      gemm_tile<128>(K / 64, true, alp, bl, ep, smem);
      if (!next_tile()) break;
    }
    tm = tm2; tn = tn2;
  }
}

DI void phase_win1(const Params& p, unsigned char* smem) {
  unsigned char* ws = p.ws;
  const int lane = threadIdx.x & 63, wave = threadIdx.x >> 6, l32 = lane & 31, h = lane >> 5, wm = wave >> 1, wn = wave & 1;
  const bfr* A = (const bfr*)(ws + OFF_HN);
  const bfr* Bt = (const bfr*)(ws + OFF_WIN1);
  int tm, tn;
  if (!xcd_tile(0, 24, tm, tn)) return;
  LdBf al{A + (size_t)tm * 128 * 1024, 1024}, bl{Bt + (size_t)tn * 128 * 1024, 1024};
  for (int step = 0;; ++step) {
    const int m0 = tm * 128, n0 = tn * 128;
    int tm2 = 0, tn2 = 0;
    auto next_tile = [&]() {
      if (!xcd_tile(step + 1, 24, tm2, tn2)) return false;
      al.base = A + (size_t)tm2 * 128 * 1024; bl.base = Bt + (size_t)tn2 * 128 * 1024;
      return true;
    };
    auto ep = [&](f32x16 (&acc)[2][2]) {
      const int colbase = n0 + wn * 64, rbase = m0 + wm * 64;
      const int sec = colbase >> 9;
      const int cbt = n0 & 511;
      const bool lat = m0 >= NCTX;
      unsigned short* stg = (unsigned short*)smem;
      if (sec == 0 || sec == 2 || sec == 5) {
#pragma unroll
        for (int ni = 0; ni < 2; ++ni) {
          const int row = wm * 64 + ni * 32 + l32;
#pragma unroll
          for (int mi = 0; mi < 2; ++mi)
#pragma unroll
            for (int i4 = 0; i4 < 4; ++i4) {
              const float a = acc[mi][ni][4 * i4], b2 = acc[mi][ni][4 * i4 + 1], c2 = acc[mi][ni][4 * i4 + 2], e = acc[mi][ni][4 * i4 + 3];
              const uint2 o = sec == 0 ? make_uint2(pk2(gelu_f(a), gelu_f(b2)), pk2(gelu_f(c2), gelu_f(e))) : make_uint2(pk2(silu_f(a), silu_f(b2)), pk2(silu_f(c2), silu_f(e)));
              *(uint2*)(stg + row * 136 + wn * 64 + mi * 32 + 8 * i4 + 4 * h) = o;
            }
        }
      } else {
        if (sec == 1) {
          float* rowss = (float*)(ws + OFF_ROWSS);
#pragma unroll
          for (int mi = 0; mi < 2; ++mi)
#pragma unroll
            for (int i = 0; i < 16; ++i) {
              const float g0 = gelu_f(acc[mi][0][i]), g1 = gelu_f(acc[mi][1][i]);
              acc[mi][0][i] = g0; acc[mi][1][i] = g1;
              const float ss = half_sum32(g0 * g0 + g1 * g1);
              if (l32 == 0) atomicAdd(rowss + rbase + mi * 32 + crow(i, h), ss);
            }
        }
#pragma unroll
        for (int mi = 0; mi < 2; ++mi)
#pragma unroll
          for (int ni = 0; ni < 2; ++ni)
#pragma unroll
            for (int i4 = 0; i4 < 4; ++i4)
              *(uint2*)(stg + (wn * 64 + ni * 32 + l32) * 136 + wm * 64 + mi * 32 + 8 * i4 + 4 * h) =
                  make_uint2(pk2(acc[mi][ni][4 * i4], acc[mi][ni][4 * i4 + 1]), pk2(acc[mi][ni][4 * i4 + 2], acc[mi][ni][4 * i4 + 3]));
      }
      __syncthreads();
      bfr* dbase; size_t dld;
      if (sec == 0 || sec == 2 || sec == 5) { dbase = (bfr*)(ws + (sec == 0 ? OFF_CUG : (sec == 2 ? OFF_GCS : OFF_GDS))) + (size_t)m0 * 512 + cbt; dld = 512; }
      else if (sec == 1) { dbase = (bfr*)(ws + OFF_CVT) + (size_t)cbt * NTOK + m0; dld = NTOK; }
      else if (!lat) { dbase = (bfr*)(ws + OFF_ZTC) + ((size_t)((m0 >> 8) * 512 + cbt)) * 512 + (sec - 3) * 256 + (m0 & 255); dld = 512; }
      else { dbase = (bfr*)(ws + OFF_ZTL) + ((size_t)(((m0 - NCTX) >> 11) * 512 + cbt)) * 4096 + (sec - 3) * 2048 + ((m0 - NCTX) & 2047); dld = 4096; }
#pragma unroll
      for (int i = 0; i < 8; ++i) {
        const int id = threadIdx.x + 256 * i, r = id >> 4, c16 = id & 15;
        *(uint4*)(dbase + (size_t)r * dld + c16 * 8) = *(const uint4*)(stg + r * 136 + c16 * 8);
      }
    };
    const int sec0 = n0 >> 9;
    al.base = A + (size_t)m0 * 1024; bl.base = Bt + (size_t)n0 * 1024;
    gemm_tile<128>(16, sec0 == 0 || sec0 == 2 || sec0 == 5, al, bl, ep, smem);
    if (!next_tile()) break;
    tm = tm2; tn = tn2;
  }
}

struct LdWs {
  const float* w; const float* rowss;
  const float* p[4]; const float* rp;
  DI void init(int lrow, int lcol) {
#pragma unroll
    for (int i = 0; i < 4; ++i) p[i] = w + (lrow + 32 * i) * 128 + lcol;
    rp = rowss + lcol;
  }
  DI void advance(int adv) {
#pragma unroll
    for (int i = 0; i < 4; ++i) p[i] += 64 * adv;
    rp += 64 * adv;
  }
  DI uint4 load(int i) const {
    const float* wp = p[i];
    const float4 a = *(const float4*)wp, b = *(const float4*)(wp + 4);
    const float4 s0 = *(const float4*)rp, s1 = *(const float4*)(rp + 4);
    const float r0 = rsqrtf(s0.x * (1.f / 512.f) + EPS), r1 = rsqrtf(s0.y * (1.f / 512.f) + EPS), r2 = rsqrtf(s0.z * (1.f / 512.f) + EPS), r3 = rsqrtf(s0.w * (1.f / 512.f) + EPS);
    const float r4 = rsqrtf(s1.x * (1.f / 512.f) + EPS), r5 = rsqrtf(s1.y * (1.f / 512.f) + EPS), r6 = rsqrtf(s1.z * (1.f / 512.f) + EPS), r7 = rsqrtf(s1.w * (1.f / 512.f) + EPS);
    return make_uint4(pk2(a.x * r0, a.y * r1), pk2(a.z * r2, a.w * r3), pk2(b.x * r4, b.y * r5), pk2(b.z * r6, b.w * r7));
  }
};

DI void gmlp_item(const Params& p, unsigned char* smem, int hg, int chunk) {
  unsigned char* ws = p.ws;
  const int tid = threadIdx.x, lane = tid & 63, wave = tid >> 6, l32 = lane & 31, h = lane >> 5;
  unsigned short* As = (unsigned short*)smem;
  unsigned short* Bs = As + 128 * 136;
  const float* W = p.in[27] + (size_t)hg * 128 * 128;
  const int sq = tid & 31, tr = tid >> 5;
  const float4 r4 = *(const float4*)((const float*)(ws + OFF_ROWSS) + chunk * 128 + 4 * sq);
  const float i0 = rsqrtf(r4.x * (1.f / 512.f) + EPS), i1 = rsqrtf(r4.y * (1.f / 512.f) + EPS);
  const float i2 = rsqrtf(r4.z * (1.f / 512.f) + EPS), i3 = rsqrtf(r4.w * (1.f / 512.f) + EPS);
  const bfr* Bg = (const bfr*)(ws + OFF_CVT) + (size_t)(hg * 64) * NTOK + chunk * 128;
  const int bc = tid >> 4, bs8 = (tid & 15) * 8;
  const uint4 bq0 = *(const uint4*)(Bg + (size_t)bc * NTOK + bs8), bq1 = *(const uint4*)(Bg + (size_t)(bc + 16) * NTOK + bs8);
  const uint4 bq2 = *(const uint4*)(Bg + (size_t)(bc + 32) * NTOK + bs8), bq3 = *(const uint4*)(Bg + (size_t)(bc + 48) * NTOK + bs8);
  __syncthreads();
#pragma unroll 4
  for (int i = 0; i < 16; ++i) {
    const int t = tr + 8 * i;
    const float4 w = *(const float4*)(W + t * 128 + 4 * sq);
    *(uint2*)(As + t * 136 + 4 * sq) = make_uint2(pk2(w.x * i0, w.y * i1), pk2(w.z * i2, w.w * i3));
  }
  *(uint4*)(Bs + bc * 136 + bs8) = bq0; *(uint4*)(Bs + (bc + 16) * 136 + bs8) = bq1;
  *(uint4*)(Bs + (bc + 32) * 136 + bs8) = bq2; *(uint4*)(Bs + (bc + 48) * 136 + bs8) = bq3;
  __syncthreads();
  f32x16 acc[2];
#pragma unroll
  for (int i = 0; i < 16; ++i) { acc[0][i] = 0.f; acc[1][i] = 0.f; }
#pragma unroll
  for (int ks = 0; ks < 8; ++ks) {
    const bf16x8 y = *(const bf16x8*)(As + (32 * wave + l32) * 136 + 16 * ks + 8 * h);
#pragma unroll
    for (int mi = 0; mi < 2; ++mi) {
      const bf16x8 x = *(const bf16x8*)(Bs + (32 * mi + l32) * 136 + 16 * ks + 8 * h);
      acc[mi] = MFMA32(x, y, acc[mi]);
    }
  }
  const int t = 32 * wave + l32, T = chunk * 128 + t;
  const float bsv = p.in[28][hg * 128 + t];
#pragma unroll
  for (int mi = 0; mi < 2; ++mi)
#pragma unroll
    for (int i4 = 0; i4 < 4; ++i4) {
      const int c = hg * 64 + 32 * mi + 8 * i4 + 4 * h;
      const float4 vg = *(const float4*)(p.in[26] + c);
      const uint2 cu = *(const uint2*)((const bfr*)(ws + OFF_CUG) + (size_t)T * 512 + c);
      const uint2 gc = *(const uint2*)((const bfr*)(ws + OFF_GCS) + (size_t)T * 512 + c);
      const float o0 = bf2f(cu.x & 0xffff) * (acc[mi][4 * i4] * vg.x + bsv) * bf2f(gc.x & 0xffff);
      const float o1 = bf2f(cu.x >> 16) * (acc[mi][4 * i4 + 1] * vg.y + bsv) * bf2f(gc.x >> 16);
      const float o2 = bf2f(cu.y & 0xffff) * (acc[mi][4 * i4 + 2] * vg.z + bsv) * bf2f(gc.y & 0xffff);
      const float o3 = bf2f(cu.y >> 16) * (acc[mi][4 * i4 + 3] * vg.w + bsv) * bf2f(gc.y >> 16);
      *(uint2*)((bfr*)(ws + OFF_MIX) + (size_t)T * 1024 + c) = make_uint2(pk2(o0, o1), pk2(o2, o3));
    }
}

DI void phase_mix1(const Params& p, unsigned char* smem) {
  unsigned char* ws = p.ws;
  const int lane = threadIdx.x & 63, wave = threadIdx.x >> 6, l32 = lane & 31, h = lane >> 5, wm = wave >> 1, wn = wave & 1;
  constexpr int N_FL = 512, N_FC = 256, N_G = 768;
  for (int it = blockIdx.x; it < N_FL + N_FC + N_G; it += gridDim.x) {
    if (it < N_FL + N_FC) {
      const bfr *A, *Bt; int K, Tbase, tm, tn;
      int kq = 0; bool isl = it < N_FL;
      if (isl) {
        const int b = it >> 8; kq = it & 3; tn = (it >> 2) & 3; tm = (it >> 4) & 15; K = 4096;
        A = (const bfr*)(ws + OFF_ALAT) + kq * 1024; Bt = (const bfr*)(ws + OFF_ZTL) + (size_t)b * 512 * 4096 + kq * 1024; Tbase = NCTX + b * 2048;
      } else {
        const int i2 = it - N_FL; const int b = i2 >> 3; tm = (i2 >> 2) & 1; tn = i2 & 3; K = 512;
        A = (const bfr*)(ws + OFF_ACTX); Bt = (const bfr*)(ws + OFF_ZTC) + (size_t)b * 512 * 512; Tbase = b * 256;
      }
      LdBf al{A + (size_t)tm * 128 * K, (size_t)K}, bl{Bt + (size_t)tn * 128 * K, (size_t)K};
      auto ep = [&](f32x16 (&acc)[2][2]) {
#pragma unroll
        for (int mi = 0; mi < 2; ++mi)
#pragma unroll
          for (int ni = 0; ni < 2; ++ni)
#pragma unroll
            for (int i = 0; i < 16; ++i) {
              const int T = Tbase + tm * 128 + wm * 64 + mi * 32 + crow(i, h);
              const int n = tn * 128 + wn * 64 + ni * 32 + l32;
              if (!isl) ((bfr*)(ws + OFF_FZ))[(size_t)T * 512 + n] = f2bf(acc[mi][ni][i]);
              else ((bfr*)(ws + OFF_HN))[((size_t)kq * 4096 + (T - NCTX)) * 512 + n] = f2bf(acc[mi][ni][i]);
            }
      };
      gemm_tile<128>(isl ? 16 : K / 64, false, al, bl, ep, smem);
    } else {
      const int i2 = it - N_FL - N_FC;
      gmlp_item(p, smem, i2 & 7, i2 >> 3);
    }
  }
}

constexpr int NPHASE = 13;
#ifndef DOUBLE_MASK
#define DOUBLE_MASK 0
#endif
template <int PH>
DI void run_phase(const Params& p, unsigned char* smem) {
  if constexpr (PH == 0) phase0(p, smem);
  else if constexpr (PH == 1) phase_rows<0>(p);
  else if constexpr (PH == 2) phase_win0(p, smem);
  else if constexpr (PH == 3) phase_mix0(p, smem);
  else if constexpr (PH == 4) phase_s5fix(p, smem);
  else if constexpr (PH == 5) phase_tokgemm<0>(p, smem, 0);
  else if constexpr (PH == 6) phase_tokgemm<1>(p, smem, 0);
  else if constexpr (PH == 7) phase_rows<1>(p);
  else if constexpr (PH == 8) phase_win1(p, smem);
  else if constexpr (PH == 9) phase_mix1(p, smem);
  else if constexpr (PH == 10) phase_tokgemm<2>(p, smem, 1);
  else if constexpr (PH == 11) phase_tokgemm<1>(p, smem, 1);
  else if constexpr (PH == 12) phase_rows<2>(p);
}
template <int LO, int HI>
DI void run_range(const Params& p, unsigned char* smem, const XcdBarrier& xb) {
  if constexpr (LO < HI) {
    run_phase<LO>(p, smem);
    if constexpr (((DOUBLE_MASK) >> LO) & 1) { xcd_barrier(xb); run_phase<LO>(p, smem); }
    if constexpr (LO + 1 < HI) { xcd_barrier(xb); run_range<LO + 1, HI>(p, smem, xb); }
  }
}
template <int LO, int HI>
__global__ void __launch_bounds__(256, 2) mega(Params p) {
  __shared__ __attribute__((aligned(16))) unsigned char smem[73728];
  __shared__ uint4 xb_words;
  if (threadIdx.x == 0) xb_words = make_uint4(0u, 0u, 0u, 0u);
  __syncthreads();
  XcdBarrier xb = xcd_barrier_post((unsigned*)(p.ws + OFF_BAR), (volatile LAS unsigned*)&xb_words);
  run_range<LO, HI>(p, smem, xb);
  if (p.ph_lo != 0) cg::this_grid().sync();
}

#ifndef ONE_LAUNCH
#define ONE_LAUNCH 1
#endif
#if !ONE_LAUNCH
template <int PH>
static void launch_phases(Params& p, int grid, hipStream_t stream) {
  if constexpr (PH < NPHASE) {
    hipLaunchKernelGGL((mega<PH, PH + 1>), dim3(grid), dim3(256), 0, stream, p);
    launch_phases<PH + 1>(p, grid, stream);
  }
}
#endif

#ifndef ONE_LAUNCH
#define ONE_LAUNCH 1
#endif

extern "C" void kernel_launch(void* const* d_in, const int* in_sizes, int n_in, void* d_out, int out_size, void* d_ws, size_t ws_size, hipStream_t stream) {
  static int grid_blocks = 0;
  if (!grid_blocks) {
    int dev = 0, cus = 0, per_cu = 0;
    (void)hipGetDevice(&dev);
    (void)hipDeviceGetAttribute(&cus, hipDeviceAttributeMultiprocessorCount, dev);
    (void)hipOccupancyMaxActiveBlocksPerMultiprocessor(&per_cu, mega<0, NPHASE>, 256, 0);
    if (per_cu > 2) per_cu = 2;
    if (per_cu < 1) per_cu = 1;
    grid_blocks = cus * per_cu;
    if (n_in != 31 || ws_size < WS_TOTAL) fprintf(stderr, "kernel_launch: unexpected n_in %d or ws_size %zu (need %zu)\n", n_in, ws_size, (size_t)WS_TOTAL);
  }
  Params p{};
  for (int i = 0; i < 31; ++i) p.in[i] = (const float*)d_in[i];
  p.out = (float*)d_out; p.ws = (unsigned char*)d_ws;
  (void)hipMemsetAsync((unsigned char*)d_ws + OFF_BAR, 0, 16384, stream);
#if ONE_LAUNCH
  p.ph_lo = 0; p.ph_hi = NPHASE;
  void* args[] = {&p};
  hipError_t e = hipLaunchCooperativeKernel((void*)mega<0, NPHASE>, dim3(grid_blocks), dim3(256), args, 0, stream);
  if (e != hipSuccess) fprintf(stderr, "cooperative launch failed: %s (grid %d)\n", hipGetErrorString(e), grid_blocks);
#else
  launch_phases<0>(p, grid_blocks, stream);
#endif
}
```
